# Optimizing an MI355X kernel written in HIP

```python
import math
import jax, jax.numpy as jnp
from jax import lax
import numpy as np

D_MODEL = 1024
BATCH = 8
SEQ = 4096
DEPTH = 1

CHUNK = 64
Q_BLOCK = 128
EPS = 1e-6
NEG_INF = -1e30

MLA_HEADS = 8
MLA_NOPE_DIM = 64
MLA_ROPE_DIM = 32
MLA_V_DIM = 64
MLA_Q_RANK = 256
MLA_KV_RANK = 128
ROPE_THETA = 10000.0

DIFF_HEADS = 4
DIFF_HEAD_DIM = 64
DIFF_V_DIM = 2 * DIFF_HEAD_DIM

REL_BUCKETS = 32
REL_MAX_DIST = 128

FFN_HIDDEN = -(-8 * D_MODEL // (3 * 256)) * 256

MIX_WIDTH = MLA_HEADS * MLA_V_DIM + DIFF_HEADS * DIFF_V_DIM
DIFF_QK_COLS = DIFF_HEADS * 2 * DIFF_HEAD_DIM
DIFF_V_COLS = DIFF_HEADS * DIFF_V_DIM
IN_SPLITS = [MLA_Q_RANK, MLA_KV_RANK, MLA_ROPE_DIM, DIFF_QK_COLS, DIFF_QK_COLS, DIFF_V_COLS]
IN_COLS = sum(IN_SPLITS)
IN_OFFSETS = [int(v) for v in np.cumsum(IN_SPLITS)[:-1]]

kernel_name = "hybrid_mla_diffattn_chunk_causal_layer"


def _rmsnorm(x, g):
    xf = x.astype(jnp.float32)
    y = xf * lax.rsqrt(jnp.mean(xf * xf, axis=-1, keepdims=True) + EPS)
    return (y * g.astype(jnp.float32)).astype(x.dtype)


def _rope(x, pos):
    half = x.shape[-1] // 2
    inv_freq = ROPE_THETA ** (-jnp.arange(half, dtype=jnp.float32) / half)
    ang = pos.astype(jnp.float32)[:, None] * inv_freq[None, :]
    cos = jnp.cos(ang)[None, :, None, :].astype(x.dtype)
    sin = jnp.sin(ang)[None, :, None, :].astype(x.dtype)
    x1, x2 = x[..., :half], x[..., half:]
    return jnp.concatenate([x1 * cos - x2 * sin, x2 * cos + x1 * sin], axis=-1)


def _to_blocks(t):
    b, s, h, d = t.shape
    return t.reshape(b, s // Q_BLOCK, Q_BLOCK, h, d).transpose(1, 0, 3, 2, 4)


def _from_blocks(t):
    nb, b, h, qb, d = t.shape
    return t.transpose(1, 0, 3, 2, 4).reshape(b, nb * qb, h, d)


def _block_positions(blk, seq):
    q_pos = blk * Q_BLOCK + jnp.arange(Q_BLOCK)
    k_pos = jnp.arange(seq)
    mask = (k_pos[None, :] // CHUNK) <= (q_pos[:, None] // CHUNK)
    return mask, q_pos, k_pos


def _t5_bucket(rel):
    nb = REL_BUCKETS // 2
    max_exact = nb // 2
    ret = (rel > 0).astype(jnp.int32) * nb
    n = jnp.abs(rel)
    nf = jnp.maximum(n, 1).astype(jnp.float32)
    large = max_exact + (jnp.log(nf / max_exact) / math.log(REL_MAX_DIST / max_exact)
                         * (nb - max_exact)).astype(jnp.int32)
    large = jnp.minimum(large, nb - 1)
    return ret + jnp.where(n < max_exact, n, large)


def _mla_attention(q_nope, q_rope, k_nope, k_rope, v):
    seq = q_nope.shape[1]
    scale = (MLA_NOPE_DIM + MLA_ROPE_DIM) ** -0.5
    kn = k_nope.transpose(0, 2, 1, 3)
    vv = v.transpose(0, 2, 1, 3)

    def one_block(args):
        qn, qr, blk = args
        s = (jnp.einsum('bhqd,bhkd->bhqk', qn, kn)
             + jnp.einsum('bhqd,bkd->bhqk', qr, k_rope)).astype(jnp.float32) * scale
        mask, _, _ = _block_positions(blk, seq)
        p = jax.nn.softmax(jnp.where(mask[None, None], s, NEG_INF), axis=-1)
        return jnp.einsum('bhqk,bhkd->bhqd', p.astype(vv.dtype), vv)

    out = lax.map(one_block, (_to_blocks(q_nope), _to_blocks(q_rope),
                              jnp.arange(seq // Q_BLOCK)))
    return _from_blocks(out)


def _diff_attention(q1, q2, k1, k2, v, lam, rel_bias):
    seq = q1.shape[1]
    scale = DIFF_HEAD_DIM ** -0.5
    k1t = k1.transpose(0, 2, 1, 3)
    k2t = k2.transpose(0, 2, 1, 3)
    vv = v.transpose(0, 2, 1, 3)

    def one_block(args):
        qa, qb, blk = args
        mask, q_pos, k_pos = _block_positions(blk, seq)
        bucket = _t5_bucket(k_pos[None, :] - q_pos[:, None])
        bias = rel_bias[bucket].astype(jnp.float32).transpose(2, 0, 1)[None]
        s1 = jnp.einsum('bhqd,bhkd->bhqk', qa, k1t).astype(jnp.float32) * scale + bias
        s2 = jnp.einsum('bhqd,bhkd->bhqk', qb, k2t).astype(jnp.float32) * scale + bias
        m = mask[None, None]
        p = (jax.nn.softmax(jnp.where(m, s1, NEG_INF), axis=-1)
             - lam * jax.nn.softmax(jnp.where(m, s2, NEG_INF), axis=-1))
        return jnp.einsum('bhqk,bhkd->bhqd', p.astype(vv.dtype), vv)

    out = lax.map(one_block, (_to_blocks(q1), _to_blocks(q2), jnp.arange(seq // Q_BLOCK)))
    return _from_blocks(out)


def setup_inputs(seed: int = 0) -> dict:
    key = jax.random.key(seed)
    ks = jax.random.split(key, 20)
    nrm = lambda k, shape, fan_in: jax.random.normal(k, shape, jnp.float32) * fan_in ** -0.5
    gain = lambda k, shape: 1.0 + 0.01 * jax.random.normal(k, shape, jnp.float32)
    L = DEPTH
    return {
        "x": jax.random.normal(ks[0], (BATCH, SEQ, D_MODEL), jnp.float32),
        "w_in": nrm(ks[1], (L, D_MODEL, IN_COLS), D_MODEL),
        "g_attn": gain(ks[2], (L, D_MODEL)),
        "g_q_a": gain(ks[3], (L, MLA_Q_RANK)),
        "w_q_b": nrm(ks[4], (L, MLA_Q_RANK, MLA_HEADS * (MLA_NOPE_DIM + MLA_ROPE_DIM)), MLA_Q_RANK),
        "g_kv_a": gain(ks[5], (L, MLA_KV_RANK)),
        "w_kv_b": nrm(ks[6], (L, MLA_KV_RANK, MLA_HEADS * (MLA_NOPE_DIM + MLA_V_DIM)), MLA_KV_RANK),
        "lam_q1": 0.1 * jax.random.normal(ks[7], (L, DIFF_HEAD_DIM), jnp.float32),
        "lam_k1": 0.1 * jax.random.normal(ks[8], (L, DIFF_HEAD_DIM), jnp.float32),
        "lam_q2": 0.1 * jax.random.normal(ks[9], (L, DIFF_HEAD_DIM), jnp.float32),
        "lam_k2": 0.1 * jax.random.normal(ks[10], (L, DIFF_HEAD_DIM), jnp.float32),
        "g_subln": gain(ks[11], (L, DIFF_V_DIM)),
        "rel_bias": 0.5 * jax.random.normal(ks[12], (REL_BUCKETS, DIFF_HEADS), jnp.float32),
        "w_o": nrm(ks[13], (L, MIX_WIDTH, D_MODEL), MIX_WIDTH),
        "g_ffn": gain(ks[14], (L, D_MODEL)),
        "w_ffn_gate": nrm(ks[15], (L, D_MODEL, FFN_HIDDEN), D_MODEL),
        "w_ffn_up": nrm(ks[16], (L, D_MODEL, FFN_HIDDEN), D_MODEL),
        "w_ffn_down": nrm(ks[17], (L, FFN_HIDDEN, D_MODEL), FFN_HIDDEN),
        "g_final": gain(ks[18], (D_MODEL,)),
    }


def reference(x, w_in, g_attn, g_q_a, w_q_b, g_kv_a, w_kv_b, lam_q1, lam_k1, lam_q2,
              lam_k2, g_subln, rel_bias, w_o, g_ffn, w_ffn_gate, w_ffn_up, w_ffn_down,
              g_final):
    b, s, _ = x.shape
    pos = jnp.arange(s)
    for l in range(DEPTH):
        h = _rmsnorm(x, g_attn[l])
        proj = h @ w_in[l]
        c_q, c_kv, k_r, d_q, d_k, d_v = jnp.split(proj, IN_OFFSETS, axis=-1)

        q = (_rmsnorm(c_q, g_q_a[l]) @ w_q_b[l]).reshape(b, s, MLA_HEADS, MLA_NOPE_DIM + MLA_ROPE_DIM)
        kv = (_rmsnorm(c_kv, g_kv_a[l]) @ w_kv_b[l]).reshape(b, s, MLA_HEADS, MLA_NOPE_DIM + MLA_V_DIM)
        q_nope, q_rope = q[..., :MLA_NOPE_DIM], _rope(q[..., MLA_NOPE_DIM:], pos)
        k_nope, v_mla = kv[..., :MLA_NOPE_DIM], kv[..., MLA_NOPE_DIM:]
        k_rope = _rope(k_r[:, :, None, :], pos)[:, :, 0, :]
        out_a = _mla_attention(q_nope, q_rope, k_nope, k_rope, v_mla)
        out_a = out_a.reshape(b, s, MLA_HEADS * MLA_V_DIM)

        dq = d_q.reshape(b, s, DIFF_HEADS, 2, DIFF_HEAD_DIM)
        dk = d_k.reshape(b, s, DIFF_HEADS, 2, DIFF_HEAD_DIM)
        dv = d_v.reshape(b, s, DIFF_HEADS, DIFF_V_DIM)
        lam_init = 0.8 - 0.6 * math.exp(-0.3 * l)
        lam = (jnp.exp(jnp.sum(lam_q1[l].astype(jnp.float32) * lam_k1[l].astype(jnp.float32)))
               - jnp.exp(jnp.sum(lam_q2[l].astype(jnp.float32) * lam_k2[l].astype(jnp.float32)))
               + lam_init)
        out_b = _diff_attention(dq[..., 0, :], dq[..., 1, :], dk[..., 0, :], dk[..., 1, :],
                                dv, lam, rel_bias)
        out_b = _rmsnorm(out_b, g_subln[l]) * (1.0 - lam_init)
        out_b = out_b.reshape(b, s, DIFF_HEADS * DIFF_V_DIM)

        mixed = jnp.concatenate([out_a, out_b], axis=-1)
        x = x + mixed @ w_o[l]

        h = _rmsnorm(x, g_ffn[l])
        x = x + (jax.nn.silu(h @ w_ffn_gate[l]) * (h @ w_ffn_up[l])) @ w_ffn_down[l]
    return _rmsnorm(x, g_final)
```

```cpp
#include <hip/hip_runtime.h>
#include <cstdio>
#include <cstdint>
namespace pg8 {
#define PG8_LAS __attribute__((address_space(3)))
typedef unsigned short bf16_t;
typedef short bf16x8 __attribute__((ext_vector_type(8)));
typedef float f32x4 __attribute__((ext_vector_type(4)));
typedef unsigned u32x4 __attribute__((ext_vector_type(4)));
constexpr int BM = 256, BK = 64, HALF = 128, HTB = HALF * BK * 2  , STAGE_BYTES = 8 * HTB, NXCD = 8, WGM = 8;

__host__ __device__ __forceinline__ int lds_byte(int r, int c) { const int st = (r >> 4) * 2 + (c >> 5), rr = r & 15, cc = c & 31, ob = rr * 64 + cc * 2; return st * 1024 + (ob ^ (((ob >> 9) & 1) << 5)); }
__host__ __device__ __forceinline__ void stage_rc(int b, int& R, int& C) { const int st = b / 1024, sb = b % 1024, swz = sb ^ (((sb >> 9) & 1) << 5); R = (st >> 1) * 16 + swz / 64; C = (st & 1) * 32 + (swz % 64) / 2; }
__host__ __device__ __forceinline__ int perm32(int rho) { const int n = rho >> 4, i = rho & 15; return 8 * (i >> 2) + 4 * n + (i & 3); }

struct Unit { int pm, pn; };
struct Gemm { const bf16_t* A; const bf16_t* Bt; int M, N, K; };

struct StaticOrder {
    int nM, nN, nwg, G, c;
    __host__ __device__ void init(int M, int N, int G_, int c_) { nM = M / BM; nN = N / BM; nwg = nM * nN; G = G_; c = c_; }
    __host__ __device__ bool next(int i, Unit& u) const {
        const long L = (long)i * G + c; if (L >= nwg) return false;
        int wgid = (int)L; { const int q = nwg / NXCD, r = nwg % NXCD, xcd = wgid % NXCD, off = wgid / NXCD; wgid = (xcd < r ? xcd * (q + 1) : r * (q + 1) + (xcd - r) * q) + off; }
        const int nig = WGM * nN, gid = wgid / nig, fm = gid * WGM, gsz = (nM - fm) < WGM ? (nM - fm) : WGM;
        u.pm = fm + ((wgid % nig) % gsz); u.pn = (wgid % nig) / gsz; return true;
    }
    __device__ __forceinline__ void a_ready(const Unit&) const {}
    __device__ __forceinline__ void done(const Unit&) const {}
};

__device__ __forceinline__ unsigned cvt_pk_bf16(float lo, float hi) { unsigned r; asm volatile("v_cvt_pk_bf16_f32 %0, %1, %2" : "=v"(r) : "v"(lo), "v"(hi)); return r; }
typedef float f32x2 __attribute__((ext_vector_type(2)));
__device__ __forceinline__ u32x4 pack8(const f32x4 a, const f32x4 b) { u32x4 w; w.x = cvt_pk_bf16(a[0], a[1]); w.y = cvt_pk_bf16(a[2], a[3]); w.z = cvt_pk_bf16(b[0], b[1]); w.w = cvt_pk_bf16(b[2], b[3]); return w; }
__device__ __forceinline__ float sq8(const f32x4 a, const f32x4 b) { return ((a[0] * a[0] + a[1] * a[1]) + (a[2] * a[2] + a[3] * a[3])) + ((b[0] * b[0] + b[1] * b[1]) + (b[2] * b[2] + b[3] * b[3])); }
__device__ __forceinline__ float fq_sum(float s) { s += __shfl_xor(s, 16); s += __shfl_xor(s, 32); return s; }
__device__ __forceinline__ void rope8(f32x4& v0, f32x4& v1, const f32x4 cs0, const f32x4 cs1) {
    const float a0 = v0[0] * cs0[0] - v0[1] * cs0[1], b0 = v0[1] * cs0[0] + v0[0] * cs0[1];
    const float a1 = v0[2] * cs0[2] - v0[3] * cs0[3], b1 = v0[3] * cs0[2] + v0[2] * cs0[3];
    const float a2 = v1[0] * cs1[0] - v1[1] * cs1[1], b2 = v1[1] * cs1[0] + v1[0] * cs1[1];
    const float a3 = v1[2] * cs1[2] - v1[3] * cs1[3], b3 = v1[3] * cs1[2] + v1[2] * cs1[3];
    v0 = (f32x4){a0, b0, a1, b1}; v1 = (f32x4){a2, b2, a3, b3};
}
constexpr int SEQ_LEN = 4096;
constexpr float RMS_EPS = 1e-6f;

struct EpiInProj {
    static constexpr bool PERM = true, AFTER_DRAIN = false;
    bf16_t *CQKV, *KR, *DQ, *DK, *DV; float *SSQ_Q, *SSQ_KV; const float* rope; float c2d;
    __device__ __forceinline__ void operator()(const f32x4 (&acc)[2][2][4][2], const Unit& u, int wr, int wc, int fr, int fq) const {
        { int t_ = threadIdx.x; asm volatile("" : "+v"(t_)); fr = t_ & 15; fq = (t_ >> 4) & 3; }
        const int row0 = u.pm * BM + wr * 64 + fr, cw = wc * 32 + 8 * fq;
        if (u.pn == 0) {
#pragma unroll
            for (int ai = 0; ai < 2; ++ai)
#pragma unroll
                for (int m = 0; m < 4; ++m) { const size_t row = (size_t)(row0 + ai * HALF + m * 16); float s = 0.f;
#pragma unroll
                    for (int bj = 0; bj < 2; ++bj) { const f32x4 v0 = acc[ai][bj][m][0], v1 = acc[ai][bj][m][1]; s += sq8(v0, v1); *(u32x4*)(CQKV + row * 384 + bj * HALF + cw) = pack8(v0, v1); }
                    s = fq_sum(s); if (fq == 0) SSQ_Q[row * 4 + wc] = s; }
        } else if (u.pn == 1) {
#pragma unroll
            for (int ai = 0; ai < 2; ++ai)
#pragma unroll
                for (int m = 0; m < 4; ++m) { const size_t row = (size_t)(row0 + ai * HALF + m * 16);
                    { const f32x4 v0 = acc[ai][0][m][0], v1 = acc[ai][0][m][1]; float s = sq8(v0, v1); *(u32x4*)(CQKV + row * 384 + 256 + cw) = pack8(v0, v1);
                      s = fq_sum(s); if (fq == 0) SSQ_KV[row * 4 + wc] = s; }
                    if (wc == 0) { f32x4 v0 = acc[ai][1][m][0], v1 = acc[ai][1][m][1]; const float* t = rope + (size_t)((int)row & (SEQ_LEN - 1)) * 32 + 8 * fq;
                        rope8(v0, v1, *(const f32x4*)t, *(const f32x4*)(t + 4)); *(u32x4*)(KR + row * 32 + 8 * fq) = pack8(v0, v1); } }
        } else {
            bf16_t* dst = DQ + (size_t)((u.pn - 2) >> 1) * ((size_t)32768 * 512); const int cb = ((u.pn - 2) & 1) * 256 + cw; const float sc = u.pn < 4 ? c2d : 1.f;
#pragma unroll
            for (int ai = 0; ai < 2; ++ai)
#pragma unroll
                for (int m = 0; m < 4; ++m) { const size_t row = (size_t)(row0 + ai * HALF + m * 16);
#pragma unroll
                    for (int bj = 0; bj < 2; ++bj) *(u32x4*)(dst + row * 512 + cb + bj * HALF) = pack8(acc[ai][bj][m][0] * sc, acc[ai][bj][m][1] * sc); }
        }
    }
};
struct EpiQKV {
    static constexpr bool PERM = true, AFTER_DRAIN = false;
    bf16_t *QA, *KN, *VA; const float *SSQ_Q, *SSQ_KV; const float* rope; float c2a;
    __device__ __forceinline__ float rstd_of(const float* ssq, size_t row, float inv) const { const f32x4 pp = *(const f32x4*)(ssq + row * 4); return __builtin_amdgcn_rsqf(((pp[0] + pp[1]) + (pp[2] + pp[3])) * inv + RMS_EPS); }
    __device__ __forceinline__ void operator()(const f32x4 (&acc)[2][2][4][2], const Unit& u, int wr, int wc, int fr, int fq) const {
        { int t_ = threadIdx.x; asm volatile("" : "+v"(t_)); fr = t_ & 15; fq = (t_ >> 4) & 3; }
        const int row0 = u.pm * BM + wr * 64 + fr, cw = wc * 32 + 8 * fq;
        if (u.pn < 2) {
#pragma unroll
            for (int ai = 0; ai < 2; ++ai)
#pragma unroll
                for (int m = 0; m < 4; ++m) { const size_t row = (size_t)(row0 + ai * HALF + m * 16); const float rs = rstd_of(SSQ_Q, row, 1.f / 256.f) * c2a;
#pragma unroll
                    for (int bj = 0; bj < 2; ++bj) { const int n = u.pn * 256 + bj * HALF + cw; *(u32x4*)(QA + row * 768 + (n >> 6) * 96 + (n & 63)) = pack8(acc[ai][bj][m][0] * rs, acc[ai][bj][m][1] * rs); }
                    asm volatile("" ::: "memory"); }
        } else if (u.pn == 2) {
#pragma unroll
            for (int ai = 0; ai < 2; ++ai)
#pragma unroll
                for (int m = 0; m < 4; ++m) { const size_t row = (size_t)(row0 + ai * HALF + m * 16); const float rs = rstd_of(SSQ_Q, row, 1.f / 256.f) * c2a;
                    const float* t = rope + (size_t)((int)row & (SEQ_LEN - 1)) * 32 + 8 * fq; const f32x4 cs0 = *(const f32x4*)t, cs1 = *(const f32x4*)(t + 4);
#pragma unroll
                    for (int bj = 0; bj < 2; ++bj) { f32x4 v0 = acc[ai][bj][m][0] * rs, v1 = acc[ai][bj][m][1] * rs; rope8(v0, v1, cs0, cs1); *(u32x4*)(QA + row * 768 + (4 * bj + wc) * 96 + 64 + 8 * fq) = pack8(v0, v1); }
                    asm volatile("" ::: "memory"); }
        } else {
            bf16_t* dst = KN + (size_t)((u.pn - 3) >> 1) * ((size_t)32768 * 512); const int cb = ((u.pn - 3) & 1) * 256 + cw;
#pragma unroll
            for (int ai = 0; ai < 2; ++ai)
#pragma unroll
                for (int m = 0; m < 4; ++m) { const size_t row = (size_t)(row0 + ai * HALF + m * 16); const float rs = rstd_of(SSQ_KV, row, 1.f / 128.f);
#pragma unroll
                    for (int bj = 0; bj < 2; ++bj) *(u32x4*)(dst + row * 512 + cb + bj * HALF) = pack8(acc[ai][bj][m][0] * rs, acc[ai][bj][m][1] * rs);
                    asm volatile("" ::: "memory"); }
        }
    }
};
struct EpiOutProj {
    static constexpr bool PERM = true, AFTER_DRAIN = false;
    const float* X; float* X1; bf16_t* X1B; float* SSQ;
    __device__ __forceinline__ void operator()(const f32x4 (&acc)[2][2][4][2], const Unit& u, int wr, int wc, int fr, int fq) const {
        { int t_ = threadIdx.x; asm volatile("" : "+v"(t_)); fr = t_ & 15; fq = (t_ >> 4) & 3; }
        const int row0 = u.pm * BM + wr * 64 + fr, cw = u.pn * BM + wc * 32 + 8 * fq;
#pragma unroll
        for (int ai = 0; ai < 2; ++ai)
#pragma unroll
            for (int m = 0; m < 4; ++m) { const size_t row = (size_t)(row0 + ai * HALF + m * 16); float s = 0.f;
#pragma unroll
                for (int bj = 0; bj < 2; ++bj) { const size_t off = row * 1024 + cw + bj * HALF;
                    const f32x4 v0 = acc[ai][bj][m][0] + *(const f32x4*)(X + off), v1 = acc[ai][bj][m][1] + *(const f32x4*)(X + off + 4);
                    s += sq8(v0, v1); *(f32x4*)(X1 + off) = v0; *(f32x4*)(X1 + off + 4) = v1; *(u32x4*)(X1B + off) = pack8(v0, v1); }
                s = fq_sum(s); if (fq == 0) SSQ[row * 16 + u.pn * 4 + wc] = s; }
    }
};
struct EpiGateUp {
    static constexpr bool PERM = true, AFTER_DRAIN = false;
    bf16_t* H; const float* SSQ;
    __device__ __forceinline__ void operator()(const f32x4 (&acc)[2][2][4][2], const Unit& u, int wr, int wc, int fr, int fq) const {
        { int t_ = threadIdx.x; asm volatile("" : "+v"(t_)); fr = t_ & 15; fq = (t_ >> 4) & 3; }
        const int row0 = u.pm * BM + wr * 64 + fr, cw = u.pn * HALF + wc * 32 + 8 * fq;
#pragma unroll
        for (int ai = 0; ai < 2; ++ai)
#pragma unroll
            for (int m = 0; m < 4; ++m) { const size_t row = (size_t)(row0 + ai * HALF + m * 16);
                const f32x4 pp = *(const f32x4*)(SSQ + row * 16 + 4 * fq); const float tot = fq_sum((pp[0] + pp[1]) + (pp[2] + pp[3]));
                const float rs = __builtin_amdgcn_rsqf(tot * (1.f / 1024.f) + RMS_EPS);
                f32x4 hv[2];
#pragma unroll
                for (int n = 0; n < 2; ++n) { const f32x4 g = acc[ai][0][m][n] * rs, up = acc[ai][1][m][n] * rs;
#pragma unroll
                    for (int j = 0; j < 4; ++j) { const float e = __builtin_amdgcn_exp2f(g[j] * -1.4426950408889634f); hv[n][j] = g[j] * __builtin_amdgcn_rcpf(1.0f + e) * up[j]; } }
                *(u32x4*)(H + row * 2816 + cw) = pack8(hv[0], hv[1]); }
    }
};
struct EpiDown {
    static constexpr bool PERM = true, AFTER_DRAIN = false;
    float* X1;
    __device__ __forceinline__ void operator()(const f32x4 (&acc)[2][2][4][2], const Unit& u, int wr, int wc, int fr, int fq) const {
        { int t_ = threadIdx.x; asm volatile("" : "+v"(t_)); fr = t_ & 15; fq = (t_ >> 4) & 3; }
        const int row0 = u.pm * BM + wr * 64 + fr, cw = u.pn * BM + wc * 32 + 8 * fq;
#pragma unroll
        for (int ai = 0; ai < 2; ++ai)
#pragma unroll
            for (int m = 0; m < 4; ++m) { const size_t row = (size_t)(row0 + ai * HALF + m * 16);
#pragma unroll
                for (int bj = 0; bj < 2; ++bj) { const size_t off = row * 1024 + cw + bj * HALF;
                    const f32x4 v0 = acc[ai][bj][m][0] + *(const f32x4*)(X1 + off), v1 = acc[ai][bj][m][1] + *(const f32x4*)(X1 + off + 4);
                    *(f32x4*)(X1 + off) = v0; *(f32x4*)(X1 + off + 4) = v1; } }
    }
};
template <class Epi, class Sched, bool ALIGN_EPI = false, bool SP2 = false>
__device__ __forceinline__ void gemm_phase(PG8_LAS unsigned char* lds, const Gemm g, const Sched& S, const Epi& E) {
    const int tid = threadIdx.x, wid = __builtin_amdgcn_readfirstlane(tid >> 6), lane = tid & 63, wr = wid >> 2, wc = wid & 3, fr = lane & 15, fq = lane >> 4;
    const int K = g.K, nt = K / BK;
    unsigned voffA[2], voffB[2];
#pragma unroll
    for (int i = 0; i < 2; ++i) { int R, C; stage_rc(tid * 16 + i * 8192, R, C); const int Rb = Epi::PERM ? ((R & ~31) + perm32(R & 31)) : R;
        voffA[i] = (unsigned)(R * K + C) * 2u; voffB[i] = (unsigned)(Rb * K + C) * 2u; }
    const size_t kstep = (size_t)(BK * 2);
    const size_t hstep = (size_t)HALF * K * 2;
    const size_t tstep = 2 * hstep;
    const unsigned ldsw = (unsigned)wid * 1024u;
    const int aoff = lds_byte(wr * 64 + fr, fq * 8), boff = lds_byte(wc * 32 + fr, fq * 8);
#define PG8_SA(b, h) (((b) * 2 + (h)) * HTB)
#define PG8_SB(b, h) ((4 + (b) * 2 + (h)) * HTB)
#define PG8_STAGE(bufoff, gbase, voff) do { _Pragma("unroll") for (int _i = 0; _i < 2; ++_i) \
        __builtin_amdgcn_global_load_lds((const unsigned*)((const char*)(gbase) + (voff)[_i]), (PG8_LAS unsigned*)(lds + (bufoff) + ldsw + _i * 8192), 16, 0, 0); } while (0)
#define PG8_LDA(dst, b, h) do { _Pragma("unroll") for (int m = 0; m < 4; ++m) _Pragma("unroll") for (int k = 0; k < 2; ++k) dst[m][k] = *(const PG8_LAS bf16x8*)(lds + PG8_SA(b, h) + aoff + m * 2048 + k * 1024); } while (0)
#define PG8_LDB(dst, b, h) do { _Pragma("unroll") for (int n = 0; n < 2; ++n) _Pragma("unroll") for (int k = 0; k < 2; ++k) dst[n][k] = *(const PG8_LAS bf16x8*)(lds + PG8_SB(b, h) + boff + n * 2048 + k * 1024); } while (0)
#define PG8_MMA(ai, bj, At, Bt) do { __builtin_amdgcn_s_setprio(1); _Pragma("unroll") for (int m = 0; m < 4; ++m) _Pragma("unroll") for (int n = 0; n < 2; ++n) _Pragma("unroll") for (int k = 0; k < 2; ++k) \
        acc[ai][bj][m][n] = __builtin_amdgcn_mfma_f32_16x16x32_bf16(Bt[n][k], At[m][k], acc[ai][bj][m][n], 0, 0, 0); __builtin_amdgcn_s_setprio(0); } while (0)
#define PG8_WAIT_V(n) asm volatile("s_waitcnt vmcnt(" #n ")" ::: "memory")
#define PG8_WAIT_L(n) asm volatile("s_waitcnt lgkmcnt(" #n ")" ::: "memory")
#define PG8_BAR __builtin_amdgcn_s_barrier()
#define PG8_SCHED __builtin_amdgcn_sched_barrier(0)
    Unit cur, nxt; int ui = 0;
    if (!S.next(0, cur)) return;
    f32x4 acc[2][2][4][2];
#pragma unroll
    for (int a = 0; a < 2; ++a)
#pragma unroll
        for (int b = 0; b < 2; ++b)
#pragma unroll
            for (int m = 0; m < 4; ++m)
#pragma unroll
                for (int n = 0; n < 2; ++n) acc[a][b][m][n] = (f32x4){0.f, 0.f, 0.f, 0.f};
    bf16x8 At[4][2], B0[2][2], B1[2][2];
    const char* cA = (const char*)g.A + (size_t)cur.pm * tstep; const char* cB = (const char*)g.Bt + (size_t)cur.pn * tstep;
    S.a_ready(cur);
    if constexpr (SP2) {
        PG8_STAGE(PG8_SB(0, 0), cB, voffB); PG8_STAGE(PG8_SB(0, 1), cB + hstep, voffB); PG8_STAGE(PG8_SA(0, 0), cA, voffA); PG8_STAGE(PG8_SA(0, 1), cA + hstep, voffA);
        if (wr == 1) PG8_BAR;
        PG8_WAIT_V(2); PG8_BAR;
        PG8_STAGE(PG8_SB(1, 0), cB + kstep, voffB); PG8_STAGE(PG8_SA(1, 0), cA + kstep, voffA); PG8_STAGE(PG8_SB(1, 1), cB + hstep + kstep, voffB);
        PG8_WAIT_V(6); PG8_BAR;
    } else {
        PG8_STAGE(PG8_SB(0, 0), cB, voffB); PG8_STAGE(PG8_SA(0, 0), cA, voffA); PG8_STAGE(PG8_SB(0, 1), cB + hstep, voffB); PG8_STAGE(PG8_SA(0, 1), cA + hstep, voffA);
        if (wr == 1) PG8_BAR;
        PG8_WAIT_V(4); PG8_BAR;
        PG8_STAGE(PG8_SB(1, 0), cB + kstep, voffB); PG8_STAGE(PG8_SA(1, 0), cA + kstep, voffA); PG8_STAGE(PG8_SB(1, 1), cB + hstep + kstep, voffB);
        PG8_WAIT_V(6); PG8_BAR;
    }
    for (;;) {
        const bool has_next = S.next(ui + 1, nxt);
        const char* nA = has_next ? (const char*)g.A + (size_t)nxt.pm * tstep : cA; const char* nB = has_next ? (const char*)g.Bt + (size_t)nxt.pn * tstep : cB;
        for (int t = 0; t < nt; t += 2) {
            const bool last = (t == nt - 2);
            const char* a1 = cA + (size_t)(t + 1) * kstep;
            const char* a2 = last ? nA : cA + (size_t)(t + 2) * kstep; const char* b2 = last ? nB : cB + (size_t)(t + 2) * kstep;
            const char* a3 = a2 + kstep; const char* b3 = b2 + kstep;
            if (last && has_next) S.a_ready(nxt);
            if constexpr (SP2) {
            PG8_LDB(B0, 0, 0); PG8_LDB(B1, 0, 1); PG8_SCHED; PG8_LDA(At, 0, 0); PG8_STAGE(PG8_SA(1, 1), a1 + hstep, voffA);
            PG8_WAIT_V(8); PG8_WAIT_L(0); PG8_BAR; PG8_MMA(0, 0, At, B0); PG8_MMA(0, 1, At, B1); PG8_BAR; PG8_SCHED;
            PG8_LDA(At, 0, 1); PG8_STAGE(PG8_SB(0, 0), b2, voffB); PG8_STAGE(PG8_SB(0, 1), b2 + hstep, voffB); PG8_STAGE(PG8_SA(0, 0), a2, voffA);
            PG8_WAIT_V(8); PG8_WAIT_L(0); PG8_BAR; PG8_MMA(1, 0, At, B0); PG8_MMA(1, 1, At, B1); PG8_BAR; PG8_SCHED;
            PG8_LDB(B0, 1, 0); PG8_LDB(B1, 1, 1); PG8_SCHED; PG8_LDA(At, 1, 0); PG8_STAGE(PG8_SA(0, 1), a2 + hstep, voffA);
            PG8_WAIT_V(8); PG8_WAIT_L(0); PG8_BAR; PG8_MMA(0, 0, At, B0); PG8_MMA(0, 1, At, B1); PG8_BAR; PG8_SCHED;
            PG8_LDA(At, 1, 1); PG8_STAGE(PG8_SB(1, 0), b3, voffB); PG8_STAGE(PG8_SB(1, 1), b3 + hstep, voffB); PG8_STAGE(PG8_SA(1, 0), a3, voffA);
            PG8_WAIT_V(8); PG8_WAIT_L(0); PG8_BAR; PG8_MMA(1, 0, At, B0); PG8_MMA(1, 1, At, B1); PG8_BAR; PG8_SCHED;
            } else {
            PG8_LDB(B0, 0, 0); PG8_SCHED; PG8_LDA(At, 0, 0); PG8_STAGE(PG8_SA(1, 1), a1 + hstep, voffA);
            PG8_WAIT_L(8); PG8_BAR; PG8_WAIT_L(0); PG8_MMA(0, 0, At, B0); PG8_BAR; PG8_SCHED;
            PG8_LDB(B1, 0, 1); PG8_STAGE(PG8_SB(0, 0), b2, voffB);
            PG8_BAR; PG8_WAIT_L(0); PG8_MMA(0, 1, At, B1); PG8_BAR;
            PG8_LDA(At, 0, 1); PG8_STAGE(PG8_SA(0, 0), a2, voffA);
            PG8_BAR; PG8_WAIT_L(0); PG8_MMA(1, 0, At, B0); PG8_BAR; PG8_SCHED;
            PG8_STAGE(PG8_SB(0, 1), b2 + hstep, voffB);
            PG8_WAIT_V(6); PG8_BAR; PG8_MMA(1, 1, At, B1); PG8_BAR;
            PG8_LDB(B0, 1, 0); PG8_SCHED; PG8_LDA(At, 1, 0); PG8_STAGE(PG8_SA(0, 1), a2 + hstep, voffA);
            PG8_WAIT_L(8); PG8_BAR; PG8_WAIT_L(0); PG8_MMA(0, 0, At, B0); PG8_BAR; PG8_SCHED;
            PG8_LDB(B1, 1, 1); PG8_STAGE(PG8_SB(1, 0), b3, voffB);
            PG8_BAR; PG8_WAIT_L(0); PG8_MMA(0, 1, At, B1); PG8_BAR;
            PG8_LDA(At, 1, 1); PG8_STAGE(PG8_SA(1, 0), a3, voffA);
            PG8_BAR; PG8_WAIT_L(0); PG8_MMA(1, 0, At, B0); PG8_BAR; PG8_SCHED;
            PG8_STAGE(PG8_SB(1, 1), b3 + hstep, voffB);
            PG8_WAIT_V(6); PG8_BAR; PG8_MMA(1, 1, At, B1); PG8_BAR;
            }
        }
        if constexpr (ALIGN_EPI) { if (wr == 0) PG8_BAR; }
        if constexpr (!Epi::AFTER_DRAIN) { E(acc, cur, wr, wc, fr, fq); S.done(cur); }
        if (!has_next) break;
#pragma unroll
        for (int a = 0; a < 2; ++a)
#pragma unroll
            for (int b = 0; b < 2; ++b)
#pragma unroll
                for (int m = 0; m < 4; ++m)
#pragma unroll
                    for (int n = 0; n < 2; ++n) acc[a][b][m][n] = (f32x4){0.f, 0.f, 0.f, 0.f};
        cur = nxt; cA = nA; cB = nB; ++ui;
        if constexpr (ALIGN_EPI) { if (wr == 1) PG8_BAR; }
    }
    PG8_WAIT_V(0);
    if constexpr (!ALIGN_EPI) { if (wr == 0) PG8_BAR; }
    PG8_BAR;
    if constexpr (Epi::AFTER_DRAIN) { E.fused(acc, cur, wr, wc, fr, fq, lds, wid, lane); S.done(cur); }
#undef PG8_SA
#undef PG8_SB
#undef PG8_STAGE
#undef PG8_LDA
#undef PG8_LDB
#undef PG8_MMA
#undef PG8_WAIT_V
#undef PG8_WAIT_L
#undef PG8_BAR
#undef PG8_SCHED
}
}
namespace att {
using bf16x8 = __attribute__((ext_vector_type(8))) short;
using s16x4 = __attribute__((ext_vector_type(4))) short;
using f32x16 = __attribute__((ext_vector_type(16))) float;
using u32x4 = __attribute__((ext_vector_type(4))) unsigned;
typedef unsigned short bf16;
constexpr int SEQ = 4096, NW = 8, QB = 256, KVBLK = 64, NSLOT = 3;
constexpr int THRL = 8;
__device__ __forceinline__ int otid() { int t = threadIdx.x; asm volatile("" : "+v"(t)); return t; }
template <int PAT> __device__ __forceinline__ float swz_xor(float v) { return __int_as_float(__builtin_amdgcn_ds_swizzle(__float_as_int(v), PAT)); }
__device__ __forceinline__ int crow(int r, int hi) { return (r & 3) + 8 * (r >> 2) + 4 * hi; }
#define SBAR() __builtin_amdgcn_sched_barrier(0)
#define WAIT_BAR(N) asm volatile("s_waitcnt vmcnt(" #N ") lgkmcnt(0)\n\ts_barrier" ::: "memory")
#define MFMA32(a, b, c) __builtin_amdgcn_mfma_f32_32x32x16_bf16(a, b, c, 0, 0, 0)
__device__ __forceinline__ void glds16(const void* gsrc, unsigned lds_dst) { unsigned keep;
    asm volatile("s_mov_b32 %0, m0\n\ts_mov_b32 m0, %2\n\ts_nop 0\n\tglobal_load_lds_dwordx4 %1, off\n\ts_mov_b32 m0, %0" : "=&s"(keep) : "v"(gsrc), "s"(lds_dst) : "memory"); }
typedef float f32x2_t __attribute__((ext_vector_type(2))); typedef __bf16 bf16x2_t __attribute__((ext_vector_type(2)));
__device__ __forceinline__ unsigned cvtpk_s(float lo, float hi) { f32x2_t v = {lo, hi}; bf16x2_t b = __builtin_convertvector(v, bf16x2_t); return __builtin_bit_cast(unsigned, b); }
typedef __attribute__((address_space(3))) const char* lds_cptr;
typedef short v4i16_t __attribute__((ext_vector_type(4)));
__device__ __forceinline__ s16x4 vtr(lds_cptr p) { return __builtin_bit_cast(s16x4, __builtin_amdgcn_ds_read_tr16_b64_v4i16((__attribute__((address_space(3))) v4i16_t*)p)); }
__device__ __forceinline__ float rowmax(const f32x16& p0, const f32x16& p1) {
    float a = fmaxf(fmaxf(p0[0], p0[1]), p1[0]), b = fmaxf(fmaxf(p0[2], p0[3]), p1[1]); a = fmaxf(fmaxf(a, p1[2]), p1[3]);
#pragma unroll
    for (int r = 4; r < 16; r += 4) { a = fmaxf(fmaxf(a, p0[r]), p0[r + 1]); b = fmaxf(fmaxf(b, p0[r + 2]), p0[r + 3]); a = fmaxf(fmaxf(a, p1[r]), p1[r + 1]); b = fmaxf(fmaxf(b, p1[r + 2]), p1[r + 3]); }
    const float m = fmaxf(a, b);
    auto rr = __builtin_amdgcn_permlane32_swap(__float_as_uint(m), __float_as_uint(m), false, false);
    return fmaxf(__uint_as_float(rr[0]), __uint_as_float(rr[1]));
}

template <int DQK, int DV> struct Lay {
    static constexpr int KB = 64 * DQK * 2, VB = 64 * DV * 2;
    static constexpr int LDS_K = 0, LDS_V = NSLOT * KB, LDS_WS = NSLOT * (KB + VB), LDS_OST = LDS_WS + NW * 256, LDS_BT = LDS_OST + NW * 4096, LDS_END = LDS_BT + 2048;
};

template <int DQK, int DV, bool BIAS>
__device__ __forceinline__ void attn_core(f32x16 (&o)[DV / 32], float& l_reg, const bf16* Qw, int qpitch, const bf16* K1, int k1pitch, const bf16* K2, const bf16* Vh, int vpitch,
                                          int NT, int my_last, int qpos0, char* shm, float cfar) {
    typedef Lay<DQK, DV> L;
    constexpr int ND = DQK / 16, NO = DV / 32;
    const int tid = otid(), lane = tid & 63, r32 = lane & 31, hi = lane >> 5; const int wid = __builtin_amdgcn_readfirstlane(tid >> 6);
    const unsigned lds0 = (unsigned)(uintptr_t)shm;
    float* wsf = (float*)(shm + L::LDS_WS) + wid * 64;
    const float* bt = (const float*)(shm + L::LDS_BT);
    const bf16* ksrc = K1 + (long)lane * k1pitch + wid * 8;
    const bf16* k2src = (DQK == 96) ? K2 + (long)lane * 32 + (wid & 3) * 8 : nullptr;
    const bf16* vsrc = Vh + (long)(16 * (wid & 3) + (lane >> 2)) * vpitch + (wid >> 2) * 32 + (lane & 3) * 8;
    const unsigned kdst = lds0 + L::LDS_K + wid * 1024, k2dst = lds0 + L::LDS_K + (8 + (wid & 3)) * 1024, vdst = lds0 + L::LDS_V + wid * 1024;
#define DMA_T(t, slot) do { glds16(ksrc + (long)(t) * KVBLK * k1pitch, (unsigned)__builtin_amdgcn_readfirstlane(kdst + (slot) * L::KB)); \
        if (DQK == 96) glds16(k2src + (long)(t) * KVBLK * 32, (unsigned)__builtin_amdgcn_readfirstlane(k2dst + (slot) * L::KB)); \
        glds16(vsrc + (long)(t) * KVBLK * vpitch, (unsigned)__builtin_amdgcn_readfirstlane(vdst + (slot) * L::VB)); \
        if (DV == 128) glds16(vsrc + (long)(t) * KVBLK * vpitch + 64, (unsigned)__builtin_amdgcn_readfirstlane(vdst + (slot) * L::VB + 8192)); } while (0)
    bf16x8 qr[ND];
#pragma unroll
    for (int d0 = 0; d0 < ND; ++d0) qr[d0] = *reinterpret_cast<const bf16x8*>(&Qw[(long)r32 * qpitch + d0 * 16 + hi * 8]);
    asm volatile("" ::: "memory");
    DMA_T(0, 0);
    if (NT > 1) DMA_T(1, 1);
    float mhat = 0.f; l_reg = 0.f;
#pragma unroll
    for (int d = 0; d < NO; ++d) o[d] = f32x16{};
    if (NT > 1) { WAIT_BAR(3); } else { WAIT_BAR(0); }
    const lds_cptr shm3 = (lds_cptr)shm;
    const lds_cptr vp0 = shm3 + L::LDS_V + ((lane >> 4) & 1) * 32 + (lane & 3) * 8 + (4 * hi + ((lane & 15) >> 2)) * 64;
    const lds_cptr kp0 = shm3 + L::LDS_K + hi * 1024 + r32 * 16;
    int slot = 0, slot2 = 2;
    bool first = true;
    for (int t = 0; t < NT; ++t) {
        if (t + 2 < NT) DMA_T(t + 2, slot2);
        if (t <= my_last) {
            const lds_cptr kp = kp0 + slot * L::KB;
            f32x16 c0, c1;
            const bool nearb = BIAS && (t >= my_last - 4);
            {
                f32x16 ini; { float iv = (BIAS && !nearb) ? (cfar - mhat) : -mhat; asm volatile("" : "+v"(iv));
#pragma unroll
                    for (int r = 0; r < 16; ++r) ini[r] = iv; }
#pragma unroll
                for (int d0 = 0; d0 < ND; ++d0) {
                    const bf16x8 b0 = *(const __attribute__((address_space(3))) bf16x8*)(kp + d0 * 2048);
                    const bf16x8 b1 = *(const __attribute__((address_space(3))) bf16x8*)(kp + d0 * 2048 + 512);
                    if (d0 == 0) { c0 = MFMA32(b0, qr[0], ini); c1 = MFMA32(b1, qr[0], ini); }
                    else { c0 = MFMA32(b0, qr[d0], c0); c1 = MFMA32(b1, qr[d0], c1); }
                }
            }
            if (BIAS && nearb) {
                const float* bp = bt + (64 * t - (qpos0 + r32) + 320 + 4 * hi);
#pragma unroll
                for (int r = 0; r < 16; ++r) { c0[r] += bp[(r & 3) + 8 * (r >> 2)]; c1[r] += bp[32 + (r & 3) + 8 * (r >> 2)]; }
            }
            const float rm = rowmax(c0, c1);
            bool resc = false;
            if (first || __any(rm > (float)THRL)) {
                const float dl = first ? rm : fmaxf(rm, 0.f); mhat += dl;
#pragma unroll
                for (int r = 0; r < 16; ++r) { c0[r] -= dl; c1[r] -= dl; }
                if (!first) { const float f = __builtin_amdgcn_exp2f(-dl); l_reg *= f; if (hi == 0) wsf[r32] = f; resc = true; }
                first = false;
            }
            float sacc = 0.f;
#pragma unroll
            for (int r = 0; r < 16; ++r) { c0[r] = __builtin_amdgcn_exp2f(c0[r]); c1[r] = __builtin_amdgcn_exp2f(c1[r]); sacc += c0[r] + c1[r]; }
            l_reg += sacc;
            if (resc) {
#pragma unroll
                for (int r = 0; r < 16; ++r) { const float f = wsf[crow(r, hi)];
#pragma unroll
                    for (int d = 0; d < NO; ++d) o[d][r] *= f; }
            }
            u32x4 pw[4];
#pragma unroll
            for (int k = 0; k < 2; ++k) {
                pw[k] = (u32x4){cvtpk_s(c0[8 * k], c0[8 * k + 1]), cvtpk_s(c0[8 * k + 2], c0[8 * k + 3]), cvtpk_s(c0[8 * k + 4], c0[8 * k + 5]), cvtpk_s(c0[8 * k + 6], c0[8 * k + 7])};
                pw[2 + k] = (u32x4){cvtpk_s(c1[8 * k], c1[8 * k + 1]), cvtpk_s(c1[8 * k + 2], c1[8 * k + 3]), cvtpk_s(c1[8 * k + 4], c1[8 * k + 5]), cvtpk_s(c1[8 * k + 6], c1[8 * k + 7])};
            }
            const lds_cptr vp = vp0 + slot * L::VB;
#pragma unroll
            for (int d = 0; d < NO; ++d) {
#pragma unroll
                for (int ks = 0; ks < 4; ++ks) {
                    const s16x4 lo = vtr(vp + d * 4096 + ks * 1024), hh = vtr(vp + d * 4096 + ks * 1024 + 512);
                    const bf16x8 vf = (bf16x8){lo[0], lo[1], lo[2], lo[3], hh[0], hh[1], hh[2], hh[3]};
                    o[d] = MFMA32(__builtin_bit_cast(bf16x8, pw[ks]), vf, o[d]);
                }
                SBAR();
            }
        }
        if (t + 2 < NT) { WAIT_BAR(3); } else { WAIT_BAR(0); }
        slot = (slot == NSLOT - 1) ? 0 : slot + 1; slot2 = (slot2 == NSLOT - 1) ? 0 : slot2 + 1;
    }
#undef DMA_T
}

template <int DQK, int DV>
__device__ __forceinline__ void store_rows(const f32x16 (&y)[DV / 32], bf16* dst, int pitch, char* shm) {
    typedef Lay<DQK, DV> L;
    const int tid_ = otid(), lane = tid_ & 63, r32 = lane & 31, hi = lane >> 5; const int wid = __builtin_amdgcn_readfirstlane(tid_ >> 6);
    bf16* stg = (bf16*)(shm + L::LDS_OST) + wid * 2048;
#pragma unroll
    for (int half = 0; half < DV / 64; ++half) {
#pragma unroll
        for (int r = 0; r < 16; ++r) { const int orow = crow(r, hi);
#pragma unroll
            for (int d0 = 0; d0 < 2; ++d0) { const unsigned pk = cvtpk_s(y[2 * half + d0][r], 0.f); stg[orow * 64 + d0 * 32 + r32] = (bf16)(pk & 0xffffu); } }
        asm volatile("s_waitcnt lgkmcnt(0)" ::: "memory");
#pragma unroll
        for (int i = 0; i < 4; ++i) { const int row = i * 8 + (lane >> 3), ch = lane & 7; const u32x4 v = *(const u32x4*)(stg + row * 64 + ch * 8); *(u32x4*)(dst + (long)row * pitch + half * 64 + ch * 8) = v; }
        asm volatile("s_waitcnt lgkmcnt(0)" ::: "memory");
    }
}
template <int DQK, int DV>
__device__ __forceinline__ void row_rcp(float (&rli)[16], float l_reg, char* shm) {
    typedef Lay<DQK, DV> L;
    const int tid_ = otid(), lane = tid_ & 63, r32 = lane & 31, hi = lane >> 5; const int wid = __builtin_amdgcn_readfirstlane(tid_ >> 6);
    float* wsf = (float*)(shm + L::LDS_WS) + wid * 64;
    { auto rr = __builtin_amdgcn_permlane32_swap(__float_as_uint(l_reg), __float_as_uint(l_reg), false, false); l_reg = __uint_as_float(rr[0]) + __uint_as_float(rr[1]); }
    if (hi == 0) wsf[32 + r32] = l_reg;
    asm volatile("s_waitcnt lgkmcnt(0)" ::: "memory");
#pragma unroll
    for (int r = 0; r < 16; ++r) rli[r] = __builtin_amdgcn_rcpf(wsf[32 + crow(r, hi)]);
}

struct MlaT { const bf16 *QA, *KN, *KR, *VA; bf16* MIX; };
__device__ __forceinline__ void mla_unit(int b, int h, int qb, const MlaT& T, char* shm) {
    typedef Lay<96, 64> L;
    const int wid = __builtin_amdgcn_readfirstlane(otid() >> 6);
    const long rowbase = (long)b * SEQ; const int q0 = qb * QB + wid * 32;
    f32x16 o[2]; float l_reg;
    attn_core<96, 64, false>(o, l_reg, T.QA + (rowbase + q0) * 768 + h * 96, 768, T.KN + rowbase * 512 + h * 64, 512, T.KR + rowbase * 32, T.VA + rowbase * 512 + h * 64, 512,
                             4 * qb + 4, 4 * qb + (wid >> 1), q0, shm, 0.f);
    float rli[16]; row_rcp<96, 64>(rli, l_reg, shm);
#pragma unroll
    for (int d = 0; d < 2; ++d)
#pragma unroll
        for (int r = 0; r < 16; ++r) o[d][r] *= rli[r];
    store_rows<96, 64>(o, T.MIX + (rowbase + q0) * 1024 + h * 64, 1024, shm);
    asm volatile("s_waitcnt vmcnt(0) lgkmcnt(0)\n\ts_barrier" ::: "memory");
}

struct DiffT { const bf16 *DQ, *DK, *DV; bf16* MIX; float* OB; const float *rel_bias, *g_subln; float lam; };
__device__ __forceinline__ int t5_bucket(int rel) {
    const int n = rel < 0 ? -rel : rel; int bk = n;
    if (n >= 8) { bk = 2 + (31 - __clz(n * n)); bk = bk > 15 ? 15 : bk; }
    return (rel > 0 ? 16 : 0) + bk;
}
__device__ __forceinline__ void diff_unit(int b, int h, int qb, const DiffT& T, char* shm) {
    typedef Lay<64, 128> L;
    const int tid = otid(); const int wid = __builtin_amdgcn_readfirstlane(tid >> 6);
    const long rowbase = (long)b * SEQ; const int q0 = qb * QB + wid * 32;
    constexpr float LOG2E = 1.4426950408889634f;
    { float* bt = (float*)(shm + L::LDS_BT); if (tid < 384) bt[tid] = T.rel_bias[t5_bucket(tid - 320) * 4 + h] * LOG2E; }
    const float cfar = T.rel_bias[15 * 4 + h] * LOG2E;
    asm volatile("s_waitcnt lgkmcnt(0)\n\ts_barrier" ::: "memory");
    float* obw = T.OB + ((((long)(b * 4 + h) * 16 + qb) * 8 + wid) * 4096);
    f32x16 o[4]; float l_reg; float rli[16];
    const float lam = T.lam;
#pragma nounroll
    for (int pass = 0; pass < 2; ++pass) {
        const int mo = (pass == 0) ? 64 : 0;
        attn_core<64, 128, true>(o, l_reg, T.DQ + (rowbase + q0) * 512 + h * 128 + mo, 512, T.DK + rowbase * 512 + h * 128 + mo, 512, nullptr, T.DV + rowbase * 512 + h * 128, 512,
                                 4 * qb + 4, 4 * qb + (wid >> 1), q0, shm, cfar);
        row_rcp<64, 128>(rli, l_reg, shm);
        if (pass == 0) { float* ob = obw + (otid() & 63);
#pragma unroll
            for (int d = 0; d < 4; ++d)
#pragma unroll
                for (int r = 0; r < 16; ++r) ob[(d * 16 + r) * 64] = o[d][r] * rli[r];
            asm volatile("s_waitcnt vmcnt(0)" ::: "memory");
        }
    }
    float ss[16]; const int lane2 = otid() & 63, r32 = lane2 & 31; const float* ob = obw + lane2;
#pragma unroll
    for (int r = 0; r < 16; ++r) { float s = 0.f;
#pragma unroll
        for (int d = 0; d < 4; ++d) { const float y = o[d][r] * rli[r] - lam * ob[(d * 16 + r) * 64]; o[d][r] = y; s += y * y; }
        ss[r] = s; if ((r & 3) == 3) asm volatile("" ::: "memory"); }
#define SWZ_STEP(K) _Pragma("unroll") for (int r = 0; r < 16; ++r) ss[r] += swz_xor<((K) << 10) | 0x1f>(ss[r]);
    SWZ_STEP(1) SWZ_STEP(2) SWZ_STEP(4) SWZ_STEP(8) SWZ_STEP(16)
#undef SWZ_STEP
#pragma unroll
    for (int d = 0; d < 4; ++d) { const float g = T.g_subln[d * 32 + r32] * 0.8f;
#pragma unroll
        for (int r = 0; r < 16; ++r) o[d][r] *= g * __builtin_amdgcn_rsqf(ss[r] * (1.f / 128.f) + 1e-6f); }
    store_rows<64, 128>(o, T.MIX + (rowbase + q0) * 1024 + 512 + h * 128, 1024, shm);
    asm volatile("s_waitcnt vmcnt(0) lgkmcnt(0)\n\ts_barrier" ::: "memory");
}
#undef SBAR
#undef WAIT_BAR
#undef MFMA32
}
#define GAS __attribute__((address_space(1)))
#define LAS __attribute__((address_space(3)))
typedef unsigned short bf16;
typedef unsigned v4u __attribute__((ext_vector_type(4)));
typedef float f32x4 __attribute__((ext_vector_type(4)));
typedef short bf16x8 __attribute__((ext_vector_type(8)));
typedef GAS unsigned gu32;
typedef GAS unsigned long long gu64;
#define RLX_AGENT __ATOMIC_RELAXED, __HIP_MEMORY_SCOPE_AGENT
#define LDS_WAIT() asm volatile("s_waitcnt lgkmcnt(0)" ::: "memory")
#define VM_WAIT() asm volatile("s_waitcnt vmcnt(0)" ::: "memory")
__device__ __forceinline__ unsigned long long rt() { return __builtin_amdgcn_s_memrealtime(); }
__device__ __forceinline__ unsigned f2bf(float f) { unsigned u = __builtin_bit_cast(unsigned, f); return (u + 0x7fffu + ((u >> 16) & 1u)) >> 16; }
__device__ __forceinline__ unsigned pk2(float lo, float hi) { return f2bf(lo) | (f2bf(hi) << 16); }

#define XB_TMO      128
#define XB_XCNT(j)  (256  + 64 * (j))
#define XB_XSUB(j)  (1280 + 64 * (j))
#define XB_XGEN(j)  (2304 + 64 * (j))
#define XB_TOP      3328
#define XB_TOPGEN   3392
#define XCD_BAR_WORDS 3456
#define XB_SPIN_CAP (1u << 18)

__device__ __forceinline__ unsigned xb_ld(unsigned* p)              { return __hip_atomic_load(p, __ATOMIC_RELAXED, __HIP_MEMORY_SCOPE_AGENT); }
__device__ __forceinline__ unsigned xb_add(unsigned* p, unsigned v) { return __hip_atomic_fetch_add(p, v, __ATOMIC_RELAXED, __HIP_MEMORY_SCOPE_AGENT); }
__device__ __forceinline__ unsigned xb_xcc_id() { return (unsigned)__builtin_amdgcn_s_getreg((3 << 11) | 20) & 0xFu; }
#define XB_SPIN(cond, bar) do { unsigned _sp = 0; while (cond) { __builtin_amdgcn_s_sleep(1); \
    if ((++_sp & 255u) == 0u) { if (xb_ld(&(bar)[XB_TMO])) break; if (_sp > XB_SPIN_CAP) { atomicAdd(&(bar)[XB_TMO], 1u); break; } } } } while (0)

struct XcdBarrier {
    unsigned* bar; unsigned x;
    volatile LAS unsigned* st;
};

__device__ __forceinline__ XcdBarrier xcd_barrier_post(unsigned* bar, volatile LAS unsigned* st) {
    XcdBarrier b; b.bar = bar; b.x = xb_xcc_id(); b.st = st;
    if (threadIdx.x == 0) (void)xb_add(&bar[XB_XCNT(b.x)], 1u);
    return b;
}
__device__ __forceinline__ void xcd_barrier_complete(unsigned* bar, unsigned x, unsigned& nloc, unsigned& nx) {
    const unsigned G = gridDim.x * gridDim.y * gridDim.z;
    unsigned sum, cnt, mine, sp = 0u;
    for (;;) {
        sum = 0u; cnt = 0u; mine = 0u;
#pragma unroll
        for (unsigned j = 0; j < 16; ++j) { const unsigned c = xb_ld(&bar[XB_XCNT(j)]); sum += c; cnt += (c > 0u) ? 1u : 0u; mine = (j == x) ? c : mine; }
        if (sum == G) break;
        __builtin_amdgcn_s_sleep(1);
        if ((++sp & 255u) == 0u) { if (xb_ld(&bar[XB_TMO])) break; if (sp > XB_SPIN_CAP) { atomicAdd(&bar[XB_TMO], 1u); break; } }
    }
    nloc = mine > 0u ? mine : 1u; nx = cnt > 0u ? cnt : 1u;
}

__device__ __forceinline__ void xcd_barrier(const XcdBarrier& b) {
    asm volatile("s_waitcnt vmcnt(0)" ::: "memory");
    __syncthreads();
    if (threadIdx.x == 0) {
        unsigned* bar = b.bar;
        __builtin_amdgcn_s_waitcnt(0);
        unsigned nloc = b.st[0], nx = b.st[1];
        if (nloc == 0u) { xcd_barrier_complete(bar, b.x, nloc, nx); b.st[0] = nloc; b.st[1] = nx; }
        const unsigned old = xb_add(&bar[XB_XSUB(b.x)], 1u);
        const unsigned gen = old / nloc;
        if (old + 1u == (gen + 1u) * nloc) {
            __builtin_amdgcn_fence(__ATOMIC_RELEASE, "agent");
            asm volatile("s_waitcnt vmcnt(0)" ::: "memory");
            const unsigned og = xb_add(&bar[XB_TOP], 1u);
            const unsigned tg = og / nx;
            if (og + 1u == (tg + 1u) * nx) xb_add(&bar[XB_TOPGEN], 1u);
            else XB_SPIN(xb_ld(&bar[XB_TOPGEN]) == tg, bar);
            __builtin_amdgcn_fence(__ATOMIC_ACQUIRE, "agent");
            xb_add(&bar[XB_XGEN(b.x)], 1u);
            asm volatile("s_waitcnt vmcnt(0)" ::: "memory");
        } else {
            XB_SPIN(xb_ld(&bar[XB_XGEN(b.x)]) == gen, bar);
            __builtin_amdgcn_fence(__ATOMIC_ACQUIRE, "agent");
            asm volatile("s_waitcnt vmcnt(0)" ::: "memory");
        }
    }
    __syncthreads();
}

constexpr int NWAVES = 8;
constexpr int M_TOK = 32768, D_MODEL = 1024, SEQ_L = 4096, FFN_H = 2816, IN_COLS = 1952;
constexpr size_t MiB = 1u << 20;
constexpr size_t WS_CTL = 0, CTL_ZERO_BYTES = 1 * MiB;
constexpr size_t WS_WIN = 2 * MiB;
constexpr size_t WS_WQKV = 6 * MiB;
constexpr size_t WS_WO = 8 * MiB;
constexpr size_t WS_WGU = 10 * MiB;
constexpr size_t WS_WD = 22 * MiB;
constexpr size_t WS_ROPE = 28 * MiB;
constexpr size_t WS_SSQQ = 29 * MiB;
constexpr size_t WS_SSQKV = 29 * MiB + 512 * 1024;
constexpr size_t WS_SSQX1 = 30 * MiB;
constexpr size_t WS_XN = 32 * MiB;
constexpr size_t WS_CQKV = 96 * MiB;
constexpr size_t WS_KR = 120 * MiB;
constexpr size_t WS_DQ = 128 * MiB, WS_DK = 160 * MiB, WS_DV = 192 * MiB;
constexpr size_t WS_QA = 224 * MiB;
constexpr size_t WS_KN = 272 * MiB, WS_VA = 304 * MiB;
constexpr size_t WS_MIX = 336 * MiB;
constexpr size_t WS_OB = 400 * MiB;
constexpr size_t WS_H = 96 * MiB;
constexpr size_t WS_END = 464 * MiB;
static_assert(WS_H + (size_t)M_TOK * FFN_H * 2 <= WS_MIX, "h overlay");
constexpr int CW_TMO = 0, CW_CODE = 1, CW_BAR = 4096;
constexpr int RING_OFF = 0, RING_BYTES = 131072;
constexpr int LDSCTL_OFF = RING_BYTES, MISC_OFF = LDSCTL_OFF + 320;
constexpr int LDS_BYTES = 147456;
static_assert(att::Lay<64, 128>::LDS_END <= RING_BYTES && att::Lay<96, 64>::LDS_END <= RING_BYTES, "attention scratch fits the ring region");

struct Args { const float* in[19]; float* out; unsigned char* ws; int ph_lo, ph_hi; };
static_assert(sizeof(Args) == 19 * 8 + 8 + 8 + 8, "no padding in Args");

__device__ __forceinline__ float wave_sum(float v) {
#pragma unroll
    for (int o = 1; o < 64; o <<= 1) v += __shfl_xor(v, o);
    return v;
}
__device__ __forceinline__ void transpose_item(const float* W, int ldw, const float* gain, bf16* WT, int ldt, LAS float* scr, int ks0, int kd0, int drow0, int srccol, int lane) {
#pragma unroll 8
    for (int i = 0; i < 32; ++i) { const int kk = 2 * i + (lane >> 5); float v = 0.f; if (srccol >= 0) { v = W[(size_t)(ks0 + kk) * ldw + srccol]; if (gain) v *= gain[ks0 + kk]; } scr[kk * 33 + (lane & 31)] = v; }
    LDS_WAIT(); asm volatile("" ::: "memory");
    const int c = lane & 7;
#pragma unroll
    for (int j = 0; j < 4; ++j) { const int n = (lane >> 3) + 8 * j; const LAS float* s = scr + (8 * c) * 33 + n;
        v4u o; o.x = pk2(s[0 * 33], s[1 * 33]); o.y = pk2(s[2 * 33], s[3 * 33]); o.z = pk2(s[4 * 33], s[5 * 33]); o.w = pk2(s[6 * 33], s[7 * 33]);
        *(GAS v4u*)(WT + (size_t)(drow0 + n) * ldt + kd0 + 8 * c) = o; }
    LDS_WAIT(); asm volatile("" ::: "memory");
}
__device__ __forceinline__ int map_win(int n) {
    if (n < 256) return n;
    if (n < 512) { const int j = n - 256; if (j < 128) return 256 + j; if (j < 160) { const int p = j - 128; return 384 + (p >> 1) + 16 * (p & 1); } return -1; }
    return 416 + (n - 512);
}
__device__ __forceinline__ int map_wq(int n) {
    if (n < 512) return (n >> 6) * 96 + (n & 63);
    const int j = n - 512, h = j >> 5, p = j & 31; return h * 96 + 64 + (p >> 1) + 16 * (p & 1);
}
__device__ __forceinline__ int map_wkv(int n) {
    if (n < 512) return (n >> 6) * 128 + (n & 63);
    const int j = n - 512; return (j >> 6) * 128 + 64 + (j & 63);
}

__constant__ float ROPE_INV_FREQ[16] = {1.0f, 0.5623413324356079f, 0.3162277638912201f, 0.17782793939113617f, 0.10000000149011612f, 0.05623413249850273f, 0.03162277489900589f, 0.017782794311642647f,
    0.009999999776482582f, 0.005623413249850273f, 0.003162277629598975f, 0.0017782794311642647f, 0.0010000000474974513f, 0.000562341301701963f, 0.0003162277571391314f, 0.00017782794020604342f};

struct Frame {
    LAS unsigned char* lds; volatile LAS unsigned* MISC; gu32* ctl;
    int tid, lane, wave, vcu, G;
};

__global__ void __launch_bounds__(NWAVES * 64, 2) hyb_fwd(Args args) {
    extern __shared__ __attribute__((aligned(16))) unsigned char lds[];
    Frame F;
    F.lds = (LAS unsigned char*)lds; F.MISC = (volatile LAS unsigned*)(F.lds + MISC_OFF);
    F.tid = threadIdx.x; F.lane = F.tid & 63; F.wave = __builtin_amdgcn_readfirstlane(F.tid >> 6);
    F.G = gridDim.x; { const int bx = blockIdx.x; F.vcu = (F.G % 8 == 0) ? (bx % 8) * (F.G / 8) + bx / 8 : bx; }
    unsigned char* ws = args.ws;
    F.ctl = (gu32*)(ws + WS_CTL);
    const float* x = args.in[0]; const float* w_in = args.in[1]; const float* g_attn = args.in[2]; const float* g_q_a = args.in[3]; const float* w_q_b = args.in[4];
    const float* g_kv_a = args.in[5]; const float* w_kv_b = args.in[6]; const float* lam_q1 = args.in[7]; const float* lam_k1 = args.in[8]; const float* lam_q2 = args.in[9];
    const float* lam_k2 = args.in[10]; const float* g_subln = args.in[11]; const float* rel_bias = args.in[12]; const float* w_o = args.in[13]; const float* g_ffn = args.in[14];
    const float* w_gate = args.in[15]; const float* w_up = args.in[16]; const float* w_down = args.in[17]; const float* g_final = args.in[18];
    float* out = args.out;
    bf16* Win_t = (bf16*)(ws + WS_WIN); bf16* Wqkv_t = (bf16*)(ws + WS_WQKV); bf16* Wo_t = (bf16*)(ws + WS_WO); bf16* Wgu_t = (bf16*)(ws + WS_WGU); bf16* Wd_t = (bf16*)(ws + WS_WD);
    float* ROPE = (float*)(ws + WS_ROPE); float* SSQ_Q = (float*)(ws + WS_SSQQ); float* SSQ_KV = (float*)(ws + WS_SSQKV); float* SSQ_X1 = (float*)(ws + WS_SSQX1);
    bf16* XN = (bf16*)(ws + WS_XN); bf16* CQKV = (bf16*)(ws + WS_CQKV); bf16* KR = (bf16*)(ws + WS_KR); bf16* DQ = (bf16*)(ws + WS_DQ); bf16* DK = (bf16*)(ws + WS_DK); bf16* DVb = (bf16*)(ws + WS_DV);
    bf16* QA = (bf16*)(ws + WS_QA); bf16* KN = (bf16*)(ws + WS_KN); bf16* VA = (bf16*)(ws + WS_VA); bf16* MIX = (bf16*)(ws + WS_MIX); float* OB = (float*)(ws + WS_OB); bf16* HB = (bf16*)(ws + WS_H);

    for (int u = F.tid; u < (LDS_BYTES - LDSCTL_OFF) / 4; u += NWAVES * 64) ((LAS unsigned*)(F.lds + LDSCTL_OFF))[u] = 0u;
    __syncthreads();
    XcdBarrier bar = xcd_barrier_post((unsigned*)(F.ctl + CW_BAR), F.MISC + 8);
    const int lo = args.ph_lo, hi = args.ph_hi;
#ifndef PHASES
#define PHASES 0xFF
#endif
#define IN(k) (((PHASES >> (k)) & 1) && lo <= (k) && (k) < hi)
#define BOTH(k) (IN(k) && IN((k) + 1))
#define GRID_BAR() xcd_barrier(bar)
    const int gw = F.vcu * NWAVES + F.wave, NGW = F.G * NWAVES;

    if (IN(0)) {
        LAS float* scr = (LAS float*)(F.lds + RING_OFF + F.wave * 16384);
        constexpr int I_IN = 16 * 64, I_Q = 4 * 24, I_KV = 2 * 32, I_O = 16 * 32, I_GU = 16 * 176, I_D = 44 * 32;
        constexpr int NITEMS = I_IN + I_Q + I_KV + I_O + I_GU + I_D;
        for (int it = gw; it < NITEMS; it += NGW) {
            int r = it; const int l31 = F.lane & 31;
            if (r < I_IN) { const int kb = r / 64, nb = r % 64; transpose_item(w_in, IN_COLS, nullptr, Win_t, 1024, scr, 64 * kb, 64 * kb, 32 * nb, map_win(32 * nb + l31), F.lane); continue; } r -= I_IN;
            if (r < I_Q) { const int kb = r / 24, nb = r % 24; transpose_item(w_q_b, 768, g_q_a, Wqkv_t, 384, scr, 64 * kb, 64 * kb, 32 * nb, map_wq(32 * nb + l31), F.lane); continue; } r -= I_Q;
            if (r < I_KV) { const int kb = r / 32, nb = r % 32; transpose_item(w_kv_b, 1024, g_kv_a, Wqkv_t, 384, scr, 64 * kb, 256 + 64 * kb, 768 + 32 * nb, map_wkv(32 * nb + l31), F.lane); continue; } r -= I_KV;
            if (r < I_O) { const int kb = r / 32, nb = r % 32; transpose_item(w_o, 1024, nullptr, Wo_t, 1024, scr, 64 * kb, 64 * kb, 32 * nb, 32 * nb + l31, F.lane); continue; } r -= I_O;
            if (r < I_GU) { const int kb = r / 176, nb = r % 176; const int n = 32 * nb + l31, pn = n >> 8, j = n & 255; const bool up = j >= 128;
                transpose_item(up ? w_up : w_gate, FFN_H, g_ffn, Wgu_t, 1024, scr, 64 * kb, 64 * kb, 32 * nb, 128 * pn + (j & 127), F.lane); continue; } r -= I_GU;
            { const int kb = r / 32, nb = r % 32; transpose_item(w_down, 1024, nullptr, Wd_t, FFN_H, scr, 64 * kb, 64 * kb, 32 * nb, 32 * nb + l31, F.lane); }
        }
        { const int gt = F.vcu * (NWAVES * 64) + F.tid, NGT = F.G * NWAVES * 64; const v4u z = (v4u){0u, 0u, 0u, 0u};
          for (int i = gt; i < 768 * 16; i += NGT) *(GAS v4u*)(Wqkv_t + (size_t)(i >> 4) * 384 + 256 + (i & 15) * 8) = z;
          for (int i = gt; i < 1024 * 32; i += NGT) *(GAS v4u*)(Wqkv_t + (size_t)(768 + (i >> 5)) * 384 + (i & 31) * 8) = z;
          for (int i = gt; i < SEQ_L * 16; i += NGT) { const int pos = i >> 4, k = i & 15; const float ang = (float)pos * ROPE_INV_FREQ[k];
              const double t = (double)ang * 0.15915494309189535; const float fr = (float)(t - __builtin_rint(t));
              ROPE[2 * i] = __builtin_amdgcn_cosf(fr); ROPE[2 * i + 1] = __builtin_amdgcn_sinf(fr); } }
        { f32x4 gv[4];
#pragma unroll
          for (int j = 0; j < 4; ++j) gv[j] = *((const GAS f32x4*)g_attn + F.lane + 64 * j);
          for (int m = gw; m < M_TOK; m += NGW) { const GAS f32x4* xr = (const GAS f32x4*)(x + (size_t)m * D_MODEL) + F.lane; f32x4 v[4]; float s = 0.f;
#pragma unroll
              for (int j = 0; j < 4; ++j) { v[j] = xr[64 * j]; s += (v[j].x * v[j].x + v[j].y * v[j].y) + (v[j].z * v[j].z + v[j].w * v[j].w); }
              const float rstd = 1.f / sqrtf(wave_sum(s) * (1.f / D_MODEL) + 1e-6f);
              GAS unsigned long long* o8 = (GAS unsigned long long*)(XN + (size_t)m * D_MODEL) + F.lane;
#pragma unroll
              for (int j = 0; j < 4; ++j) { const f32x4 y = v[j] * rstd * gv[j]; o8[64 * j] = (unsigned long long)pk2(y.x, y.y) | ((unsigned long long)pk2(y.z, y.w) << 32); } } }
        if (BOTH(0)) GRID_BAR();
    }
    if (IN(1)) {
        pg8::Gemm g{XN, Win_t, M_TOK, 2048, D_MODEL}; pg8::StaticOrder S; S.init(M_TOK, 2048, F.G, (int)blockIdx.x);
        pg8::EpiInProj E{CQKV, KR, DQ, DK, DVb, SSQ_Q, SSQ_KV, ROPE, 0.125f * 1.4426950408889634f};
        pg8::gemm_phase<pg8::EpiInProj, pg8::StaticOrder, true, true>(F.lds + RING_OFF, g, S, E);
        if (BOTH(1)) GRID_BAR();
    }
    if (IN(2)) {
        pg8::Gemm g{CQKV, Wqkv_t, M_TOK, 1792, 384}; pg8::StaticOrder S; S.init(M_TOK, 1792, F.G, (int)blockIdx.x);
        pg8::EpiQKV E{QA, KN, VA, SSQ_Q, SSQ_KV, ROPE, 0.10206207261596575f * 1.4426950408889634f};
        pg8::gemm_phase<pg8::EpiQKV, pg8::StaticOrder, true, true>(F.lds + RING_OFF, g, S, E);
        if (BOTH(2)) GRID_BAR();
    }
    if (IN(3)) {
        char* shm = (char*)lds + RING_OFF;
#ifndef ATT_ONLY
#define ATT_ONLY 3
#endif
        if (ATT_ONLY & 1) { const att::MlaT T{QA, KN, KR, VA, MIX}; const int bh = F.vcu >> 2, s = F.vcu & 3;
          for (int i = 0; i < 4; ++i) { const int qb = (i == 0) ? s : (i == 1) ? 7 - s : (i == 2) ? 8 + s : 15 - s; att::mla_unit(bh >> 3, bh & 7, qb, T, shm); } }
        if (ATT_ONLY & 2) { float lam;
          { const float a = wave_sum(lam_q1[F.lane] * lam_k1[F.lane]), b2 = wave_sum(lam_q2[F.lane] * lam_k2[F.lane]); lam = __expf(a) - __expf(b2) + 0.2f; }
          const att::DiffT T{DQ, DK, DVb, MIX, OB, rel_bias, g_subln, lam}; const int bh = F.vcu >> 3, s = F.vcu & 7;
          for (int i = 0; i < 2; ++i) { const int qb = (i == 0) ? s : 15 - s; att::diff_unit(bh >> 2, bh & 3, qb, T, shm); } }
        if (BOTH(3)) GRID_BAR();
    }
    if (IN(4)) {
        pg8::Gemm g{MIX, Wo_t, M_TOK, D_MODEL, D_MODEL}; pg8::StaticOrder S; S.init(M_TOK, D_MODEL, F.G, (int)blockIdx.x);
        pg8::EpiOutProj E{x, out, XN, SSQ_X1};
        pg8::gemm_phase<pg8::EpiOutProj, pg8::StaticOrder, true, true>(F.lds + RING_OFF, g, S, E);
        if (BOTH(4)) GRID_BAR();
    }
    if (IN(5)) {
        pg8::Gemm g{XN, Wgu_t, M_TOK, 2 * FFN_H, D_MODEL}; pg8::StaticOrder S; S.init(M_TOK, 2 * FFN_H, F.G, (int)blockIdx.x);
        pg8::EpiGateUp E{HB, SSQ_X1};
        pg8::gemm_phase<pg8::EpiGateUp, pg8::StaticOrder, true, true>(F.lds + RING_OFF, g, S, E);
        if (BOTH(5)) GRID_BAR();
    }
    if (IN(6)) {
        pg8::Gemm g{HB, Wd_t, M_TOK, D_MODEL, FFN_H}; pg8::StaticOrder S; S.init(M_TOK, D_MODEL, F.G, (int)blockIdx.x);
        pg8::EpiDown E{out};
        pg8::gemm_phase<pg8::EpiDown, pg8::StaticOrder, true, true>(F.lds + RING_OFF, g, S, E);
        if (BOTH(6)) GRID_BAR();
    }
    if (IN(7)) {
        f32x4 gv[4];
#pragma unroll
        for (int j = 0; j < 4; ++j) gv[j] = *((const GAS f32x4*)g_final + F.lane + 64 * j);
        for (int m = gw; m < M_TOK; m += NGW) { GAS f32x4* xr = (GAS f32x4*)(out + (size_t)m * D_MODEL) + F.lane; f32x4 v[4]; float s = 0.f;
#pragma unroll
            for (int j = 0; j < 4; ++j) { v[j] = xr[64 * j]; s += (v[j].x * v[j].x + v[j].y * v[j].y) + (v[j].z * v[j].z + v[j].w * v[j].w); }
            const float rstd = 1.f / sqrtf(wave_sum(s) * (1.f / D_MODEL) + 1e-6f);
#pragma unroll
            for (int j = 0; j < 4; ++j) xr[64 * j] = v[j] * rstd * gv[j]; }
    }
#undef IN
#undef BOTH
#undef GRID_BAR
}

#ifndef MK_N_LAUNCHES
#define MK_N_LAUNCHES 1
#endif
extern "C" void kernel_launch(void* const* d_in, const int* in_sizes, int n_in, void* d_out, int out_size, void* d_ws, size_t ws_size, hipStream_t stream) {
    static int grid = 0;
    if (grid == 0) {
        if (n_in != 19 || in_sizes[0] != M_TOK * D_MODEL || out_size != M_TOK * D_MODEL || ws_size < WS_END) { fprintf(stderr, "kernel_launch: unexpected shapes (n_in %d, in0 %d, out %d, ws %zu)\n", n_in, n_in > 0 ? in_sizes[0] : -1, out_size, ws_size); grid = -1; return; }
        int dev = 0, cus = 0, per_cu = 0;
        if (hipGetDevice(&dev) != hipSuccess || hipDeviceGetAttribute(&cus, hipDeviceAttributeMultiprocessorCount, dev) != hipSuccess) { grid = -1; return; }
        if (hipFuncSetAttribute((const void*)hyb_fwd, hipFuncAttributeMaxDynamicSharedMemorySize, LDS_BYTES) != hipSuccess) { fprintf(stderr, "kernel_launch: hipFuncSetAttribute failed\n"); grid = -1; return; }
        if (hipOccupancyMaxActiveBlocksPerMultiprocessor(&per_cu, (const void*)hyb_fwd, NWAVES * 64, LDS_BYTES) != hipSuccess || per_cu < 1) fprintf(stderr, "kernel_launch: occupancy query reports %d\n", per_cu);
        (void)hipGetLastError();
        grid = cus;
        if (grid != 256) fprintf(stderr, "kernel_launch: %d CUs (built for 256)\n", grid);
    }
    if (grid < 0) return;
    if (hipMemsetAsync((char*)d_ws + WS_CTL, 0, CTL_ZERO_BYTES, stream) != hipSuccess) return;
    Args a{};
    for (int i = 0; i < 19; ++i) a.in[i] = (const float*)d_in[i];
    a.out = (float*)d_out; a.ws = (unsigned char*)d_ws;
    if (MK_N_LAUNCHES == 1) { a.ph_lo = 0; a.ph_hi = 8; hipLaunchKernelGGL(hyb_fwd, dim3(grid), dim3(NWAVES * 64), LDS_BYTES, stream, a); }
    else { for (int p = 0; p < 8; ++p) { a.ph_lo = p; a.ph_hi = p + 1; hipLaunchKernelGGL(hyb_fwd, dim3(grid), dim3(NWAVES * 64), LDS_BYTES, stream, a); } }
}
```

```cpp
#include <hip/hip_runtime.h>
#include <cstdio>
#include <cstdint>
namespace pg8 {
#define PG8_LAS __attribute__((address_space(3)))
typedef unsigned short bf16_t;
typedef short bf16x8 __attribute__((ext_vector_type(8)));
typedef float f32x4 __attribute__((ext_vector_type(4)));
typedef unsigned u32x4 __attribute__((ext_vector_type(4)));
constexpr int BM = 256, BK = 64, HALF = 128, HTB = HALF * BK * 2  , STAGE_BYTES = 8 * HTB, NXCD = 8, WGM = 8;

__host__ __device__ __forceinline__ int lds_byte(int r, int c) { const int st = (r >> 4) * 2 + (c >> 5), rr = r & 15, cc = c & 31, ob = rr * 64 + cc * 2; return st * 1024 + (ob ^ (((ob >> 9) & 1) << 5)); }
__host__ __device__ __forceinline__ void stage_rc(int b, int& R, int& C) { const int st = b / 1024, sb = b % 1024, swz = sb ^ (((sb >> 9) & 1) << 5); R = (st >> 1) * 16 + swz / 64; C = (st & 1) * 32 + (swz % 64) / 2; }
__host__ __device__ __forceinline__ int perm32(int rho) { const int n = rho >> 4, i = rho & 15; return 8 * (i >> 2) + 4 * n + (i & 3); }

struct Unit { int pm, pn; int kofs, nt; };
struct Gemm { const bf16_t* A; const bf16_t* Bt; int M, N, K; };

struct StaticOrder {
    static constexpr bool KSPLIT = false, APANEL = false;
    int nM, nN, nwg, G, c;
    __host__ __device__ void init(int M, int N, int G_, int c_) { nM = M / BM; nN = N / BM; nwg = nM * nN; G = G_; c = c_; }
    __host__ __device__ bool next(int i, Unit& u) const {
        const long L = (long)i * G + c; if (L >= nwg) return false;
        int wgid = (int)L; { const int q = nwg / NXCD, r = nwg % NXCD, xcd = wgid % NXCD, off = wgid / NXCD; wgid = (xcd < r ? xcd * (q + 1) : r * (q + 1) + (xcd - r) * q) + off; }
        const int nig = WGM * nN, gid = wgid / nig, fm = gid * WGM, gsz = (nM - fm) < WGM ? (nM - fm) : WGM;
        u.pm = fm + ((wgid % nig) % gsz); u.pn = (wgid % nig) / gsz; return true;
    }
    __device__ __forceinline__ void a_ready(const Unit&) const {}
    __device__ __forceinline__ void done(const Unit&) const {}
};

typedef float f32x2p __attribute__((ext_vector_type(2))); typedef __bf16 bf16x2p __attribute__((ext_vector_type(2)));
__device__ __forceinline__ unsigned cvt_pk_bf16(float lo, float hi) { f32x2p v = {lo, hi}; bf16x2p b = __builtin_convertvector(v, bf16x2p); return __builtin_bit_cast(unsigned, b); }
typedef float f32x2 __attribute__((ext_vector_type(2)));
__device__ __forceinline__ u32x4 pack8(const f32x4 a, const f32x4 b) { u32x4 w; w.x = cvt_pk_bf16(a[0], a[1]); w.y = cvt_pk_bf16(a[2], a[3]); w.z = cvt_pk_bf16(b[0], b[1]); w.w = cvt_pk_bf16(b[2], b[3]); return w; }
__device__ __forceinline__ float sq8(const f32x4 a, const f32x4 b) { return ((a[0] * a[0] + a[1] * a[1]) + (a[2] * a[2] + a[3] * a[3])) + ((b[0] * b[0] + b[1] * b[1]) + (b[2] * b[2] + b[3] * b[3])); }
__device__ __forceinline__ float fq_sum(float s) {
    s += __int_as_float(__builtin_amdgcn_ds_swizzle(__float_as_int(s), (16 << 10) | 0x1f));
    auto rr = __builtin_amdgcn_permlane32_swap(__float_as_uint(s), __float_as_uint(s), false, false); return __uint_as_float(rr[0]) + __uint_as_float(rr[1]); }
__device__ __forceinline__ void rope8(f32x4& v0, f32x4& v1, const f32x4 cs0, const f32x4 cs1) {
    const float a0 = v0[0] * cs0[0] - v0[1] * cs0[1], b0 = v0[1] * cs0[0] + v0[0] * cs0[1];
    const float a1 = v0[2] * cs0[2] - v0[3] * cs0[3], b1 = v0[3] * cs0[2] + v0[2] * cs0[3];
    const float a2 = v1[0] * cs1[0] - v1[1] * cs1[1], b2 = v1[1] * cs1[0] + v1[0] * cs1[1];
    const float a3 = v1[2] * cs1[2] - v1[3] * cs1[3], b3 = v1[3] * cs1[2] + v1[2] * cs1[3];
    v0 = (f32x4){a0, b0, a1, b1}; v1 = (f32x4){a2, b2, a3, b3};
}
constexpr int SEQ_LEN = 4096;
constexpr float RMS_EPS = 1e-6f;

__device__ __forceinline__ u32x4 tr16x4(const u32x4 w, const int bidx) { u32x4 r; r.x = __builtin_amdgcn_ds_bpermute(bidx, w.x); r.y = __builtin_amdgcn_ds_bpermute(bidx, w.y); r.z = __builtin_amdgcn_ds_bpermute(bidx, w.z); r.w = __builtin_amdgcn_ds_bpermute(bidx, w.w); return r; }
#define EPI_LANE_T() const int bidx = (((t2_ & 3) * 16) + ((t2_ >> 2) & 15)) * 4, fr2 = (t2_ >> 2) & 15, fq2 = t2_ & 3
#define EPI_LANE() { int t_ = threadIdx.x; asm volatile("" : "+v"(t_)); fr = t_ & 15; fq = (t_ >> 4) & 3; }
struct EpiInProj {
    static constexpr bool PERM = true, AFTER_DRAIN = false;
    bf16_t *CQKV, *KR, *DQ, *DK, *DV; float *SSQ_Q, *SSQ_KV; const float* rope; const float* rstdx; float c2d;
    __device__ __forceinline__ void operator()(f32x4 (&acc)[2][2][4][2], const Unit& u, int wr, int wc, int fr, int fq) const {
        EPI_LANE(); int t2_ = threadIdx.x; asm volatile("" : "+v"(t2_)); EPI_LANE_T(); const int row2 = u.pm * BM + wr * 64 + fr2, cw2 = wc * 32 + 8 * fq2;
        const int row0 = u.pm * BM + wr * 64 + fr, cw = wc * 32 + 8 * fq;
        { float rx[2][4];
#pragma unroll
          for (int ai = 0; ai < 2; ++ai)
#pragma unroll
              for (int m = 0; m < 4; ++m) rx[ai][m] = rstdx[row0 + ai * HALF + m * 16];
#pragma unroll
          for (int ai = 0; ai < 2; ++ai)
#pragma unroll
              for (int m = 0; m < 4; ++m)
#pragma unroll
                  for (int bj = 0; bj < 2; ++bj) { acc[ai][bj][m][0] *= rx[ai][m]; acc[ai][bj][m][1] *= rx[ai][m]; } }
        if (u.pn == 0) {
#pragma unroll
            for (int ai = 0; ai < 2; ++ai)
#pragma unroll
                for (int m = 0; m < 4; ++m) { const size_t row = (size_t)(row0 + ai * HALF + m * 16); float s = 0.f;
#pragma unroll
                    for (int bj = 0; bj < 2; ++bj) { const f32x4 v0 = acc[ai][bj][m][0], v1 = acc[ai][bj][m][1]; s += sq8(v0, v1); *(u32x4*)(CQKV + (size_t)(row2 + ai * HALF + m * 16) * 384 + bj * HALF + cw2) = tr16x4(pack8(v0, v1), bidx); }
                    s = fq_sum(s); if (fq == 0) SSQ_Q[row * 4 + wc] = s; }
        } else if (u.pn == 1) {
            f32x4 cs[2][4][2];
            if (wc == 0) {
#pragma unroll
                for (int ai = 0; ai < 2; ++ai)
#pragma unroll
                    for (int m = 0; m < 4; ++m) { const float* t = rope + (size_t)((row0 + ai * HALF + m * 16) & (SEQ_LEN - 1)) * 32 + 8 * fq; cs[ai][m][0] = *(const f32x4*)t; cs[ai][m][1] = *(const f32x4*)(t + 4); }
            }
#pragma unroll
            for (int ai = 0; ai < 2; ++ai)
#pragma unroll
                for (int m = 0; m < 4; ++m) { const size_t row = (size_t)(row0 + ai * HALF + m * 16);
                    { const f32x4 v0 = acc[ai][0][m][0], v1 = acc[ai][0][m][1]; float s = sq8(v0, v1); *(u32x4*)(CQKV + (size_t)(row2 + ai * HALF + m * 16) * 384 + 256 + cw2) = tr16x4(pack8(v0, v1), bidx);
                      s = fq_sum(s); if (fq == 0) SSQ_KV[row * 4 + wc] = s; }
                    if (wc == 0) { f32x4 v0 = acc[ai][1][m][0], v1 = acc[ai][1][m][1]; rope8(v0, v1, cs[ai][m][0], cs[ai][m][1]); *(u32x4*)(KR + (size_t)(row2 + ai * HALF + m * 16) * 32 + 8 * fq2) = tr16x4(pack8(v0, v1), bidx); } }
        } else {
            bf16_t* dst = DQ + (size_t)((u.pn - 2) >> 1) * ((size_t)32768 * 512); const int cb2 = ((u.pn - 2) & 1) * 256 + cw2; const float sc = u.pn < 4 ? c2d : 1.f;
#pragma unroll
            for (int ai = 0; ai < 2; ++ai)
#pragma unroll
                for (int m = 0; m < 4; ++m) { const size_t row = (size_t)(row0 + ai * HALF + m * 16);
#pragma unroll
                    for (int bj = 0; bj < 2; ++bj) *(u32x4*)(dst + (size_t)(row2 + ai * HALF + m * 16) * 512 + cb2 + bj * HALF) = tr16x4(pack8(acc[ai][bj][m][0] * sc, acc[ai][bj][m][1] * sc), bidx); }
        }
    }
};
struct EpiQKV {
    static constexpr bool PERM = true, AFTER_DRAIN = false;
    bf16_t *QA, *KN, *VA; const float *SSQ_Q, *SSQ_KV; const float* rope; float c2a;
    __device__ __forceinline__ void rstd4(float (&rs)[4], const float* ssq, int rowb, float inv, float mul) const {
        f32x4 pp[4];
#pragma unroll
        for (int m = 0; m < 4; ++m) pp[m] = *(const f32x4*)(ssq + (size_t)(rowb + m * 16) * 4);
#pragma unroll
        for (int m = 0; m < 4; ++m) rs[m] = __builtin_amdgcn_rsqf(((pp[m][0] + pp[m][1]) + (pp[m][2] + pp[m][3])) * inv + RMS_EPS) * mul;
    }
    __device__ __forceinline__ void rstd8(float (&rs)[2][4], const float* ssq, int rowb, float inv, float mul) const {
        f32x4 pp[2][4];
#pragma unroll
        for (int ai = 0; ai < 2; ++ai)
#pragma unroll
            for (int m = 0; m < 4; ++m) pp[ai][m] = *(const f32x4*)(ssq + (size_t)(rowb + ai * HALF + m * 16) * 4);
#pragma unroll
        for (int ai = 0; ai < 2; ++ai)
#pragma unroll
            for (int m = 0; m < 4; ++m) rs[ai][m] = __builtin_amdgcn_rsqf(((pp[ai][m][0] + pp[ai][m][1]) + (pp[ai][m][2] + pp[ai][m][3])) * inv + RMS_EPS) * mul;
    }
    __device__ __forceinline__ void operator()(const f32x4 (&acc)[2][2][4][2], const Unit& u, int wr, int wc, int fr, int fq) const {
        EPI_LANE(); int t2_ = threadIdx.x; asm volatile("" : "+v"(t2_)); EPI_LANE_T(); const int row2 = u.pm * BM + wr * 64 + fr2, cw2 = wc * 32 + 8 * fq2;
        const int row0 = u.pm * BM + wr * 64 + fr, cw = wc * 32 + 8 * fq;
        if (u.pn < 2) {
            float rs2[2][4]; rstd8(rs2, SSQ_Q, row0, 1.f / 256.f, c2a);
#pragma unroll
            for (int ai = 0; ai < 2; ++ai) { const float (&rs)[4] = rs2[ai];
#pragma unroll
                for (int m = 0; m < 4; ++m) { const size_t row = (size_t)(row0 + ai * HALF + m * 16);
#pragma unroll
                    for (int bj = 0; bj < 2; ++bj) { const int n = u.pn * 256 + bj * HALF + cw2; *(u32x4*)(QA + (size_t)(row2 + ai * HALF + m * 16) * 768 + (n >> 6) * 96 + (n & 63)) = tr16x4(pack8(acc[ai][bj][m][0] * rs[m], acc[ai][bj][m][1] * rs[m]), bidx); } }
                asm volatile("" ::: "memory"); }
        } else if (u.pn == 2) {
            float rs2[2][4]; rstd8(rs2, SSQ_Q, row0, 1.f / 256.f, c2a);
            f32x4 cs[2][2][2];
#define QKV_CS_LOAD(B_, AI_, MP_) _Pragma("unroll") for (int mm = 0; mm < 2; ++mm) { const float* t = rope + (size_t)((row0 + (AI_) * HALF + (2 * (MP_) + mm) * 16) & (SEQ_LEN - 1)) * 32 + 8 * fq; cs[B_][mm][0] = *(const f32x4*)t; cs[B_][mm][1] = *(const f32x4*)(t + 4); }
            QKV_CS_LOAD(0, 0, 0);
#pragma unroll
            for (int ib = 0; ib < 4; ++ib) { const int ai = ib >> 1, mp = ib & 1, bb = ib & 1;
                if (ib + 1 < 4) { QKV_CS_LOAD((ib + 1) & 1, (ib + 1) >> 1, (ib + 1) & 1); }
#pragma unroll
                for (int mm = 0; mm < 2; ++mm) { const int m = 2 * mp + mm;
#pragma unroll
                    for (int bj = 0; bj < 2; ++bj) { f32x4 v0 = acc[ai][bj][m][0] * rs2[ai][m], v1 = acc[ai][bj][m][1] * rs2[ai][m]; rope8(v0, v1, cs[bb][mm][0], cs[bb][mm][1]); *(u32x4*)(QA + (size_t)(row2 + ai * HALF + m * 16) * 768 + (4 * bj + wc) * 96 + 64 + 8 * fq2) = tr16x4(pack8(v0, v1), bidx); } } }
#undef QKV_CS_LOAD
        } else {
            bf16_t* dst = KN + (size_t)((u.pn - 3) >> 1) * ((size_t)32768 * 512); const int cb2 = ((u.pn - 3) & 1) * 256 + cw2;
            float rs2[2][4]; rstd8(rs2, SSQ_KV, row0, 1.f / 128.f, 1.f);
#pragma unroll
            for (int ai = 0; ai < 2; ++ai) { const float (&rs)[4] = rs2[ai];
#pragma unroll
                for (int m = 0; m < 4; ++m) { const size_t row = (size_t)(row0 + ai * HALF + m * 16);
#pragma unroll
                    for (int bj = 0; bj < 2; ++bj) *(u32x4*)(dst + (size_t)(row2 + ai * HALF + m * 16) * 512 + cb2 + bj * HALF) = tr16x4(pack8(acc[ai][bj][m][0] * rs[m], acc[ai][bj][m][1] * rs[m]), bidx); }
                asm volatile("" ::: "memory"); }
        }
    }
};
struct EpiOutProj {
    static constexpr bool PERM = true, AFTER_DRAIN = false;
    const bf16_t* XB; bf16_t* X1B; float* SSQ;
    __device__ __forceinline__ void operator()(const f32x4 (&acc)[2][2][4][2], const Unit& u, int wr, int wc, int fr, int fq) const {
        EPI_LANE();
        int t2_ = threadIdx.x; asm volatile("" : "+v"(t2_)); EPI_LANE_T();
        const int row0 = u.pm * BM + wr * 64 + fr, cw = u.pn * BM + wc * 32 + 8 * fq;
        bf16_t* const st = X1B + (size_t)(u.pm * BM + wr * 64 + fr2) * 1024 + u.pn * BM + wc * 32 + 8 * fq2;
        u32x4 xb[2][4][2];
#pragma unroll
        for (int ai = 0; ai < 2; ++ai)
#pragma unroll
            for (int m = 0; m < 4; ++m)
#pragma unroll
                for (int bj = 0; bj < 2; ++bj) xb[ai][m][bj] = *(const u32x4*)(XB + (size_t)(row0 + ai * HALF + m * 16) * 1024 + cw + bj * HALF);
#pragma unroll
        for (int ai = 0; ai < 2; ++ai)
#pragma unroll
            for (int m = 0; m < 4; ++m) { const size_t row = (size_t)(row0 + ai * HALF + m * 16); float s = 0.f;
#pragma unroll
                for (int bj = 0; bj < 2; ++bj) { const u32x4 w = xb[ai][m][bj];
                    const f32x4 v0 = acc[ai][bj][m][0] + (f32x4){__uint_as_float(w.x << 16), __uint_as_float(w.x & 0xffff0000u), __uint_as_float(w.y << 16), __uint_as_float(w.y & 0xffff0000u)};
                    const f32x4 v1 = acc[ai][bj][m][1] + (f32x4){__uint_as_float(w.z << 16), __uint_as_float(w.z & 0xffff0000u), __uint_as_float(w.w << 16), __uint_as_float(w.w & 0xffff0000u)};
                    s += sq8(v0, v1); *(u32x4*)(st + (size_t)(ai * HALF + m * 16) * 1024 + bj * HALF) = tr16x4(pack8(v0, v1), bidx); }
                s = fq_sum(s); if (fq == 0) SSQ[row * 16 + u.pn * 4 + wc] = s; }
    }
};
struct HMap { unsigned char* ws; size_t xn, mix, dq, dk, dv;
    __host__ __device__ __forceinline__ bf16_t* panel(int pm) const { const int b = pm >> 4, p = pm & 15; constexpr size_t PB = (size_t)256 * 2816 * 2, MB = (size_t)1 << 20;
        size_t off;
        if (p < 5) off = xn + (size_t)b * 8 * MB + (size_t)p * PB;
        else if (p < 10) off = mix + (size_t)b * 8 * MB + (size_t)(p - 5) * PB;
        else if (p < 12) off = dq + (size_t)b * 4 * MB + (size_t)(p - 10) * PB;
        else if (p < 14) off = dk + (size_t)b * 4 * MB + (size_t)(p - 12) * PB;
        else off = dv + (size_t)b * 4 * MB + (size_t)(p - 14) * PB;
        return (bf16_t*)(ws + off); } };
struct PanelOrder {
    static constexpr bool KSPLIT = false, APANEL = true;
    StaticOrder so; HMap hm;
    __host__ __device__ void init(int M, int N, int G_, int c_) { so.init(M, N, G_, c_); }
    __host__ __device__ bool next(int i, Unit& u) const { return so.next(i, u); }
    __device__ __forceinline__ const char* a_panel(int pm) const { return (const char*)hm.panel(pm); }
    __device__ __forceinline__ void a_ready(const Unit&) const {}
    __device__ __forceinline__ void done(const Unit&) const {}
};
struct EpiGateUp {
    static constexpr bool PERM = true, AFTER_DRAIN = false;
    HMap hm; const float* SSQ;
    __device__ __forceinline__ void operator()(const f32x4 (&acc)[2][2][4][2], const Unit& u, int wr, int wc, int fr, int fq) const {
        EPI_LANE(); int t2_ = threadIdx.x; asm volatile("" : "+v"(t2_)); EPI_LANE_T(); const int row2 = u.pm * BM + wr * 64 + fr2, cw2 = wc * 32 + 8 * fq2;
        const int row0 = u.pm * BM + wr * 64 + fr, cw = u.pn * HALF + wc * 32 + 8 * fq;
        bf16_t* const Hp = hm.panel(u.pm) + (size_t)(wr * 64 + fr2) * 2816 + u.pn * HALF + cw2;
        float rs[2][4];
        { f32x4 pp[2][4];
#pragma unroll
          for (int ai = 0; ai < 2; ++ai)
#pragma unroll
              for (int m = 0; m < 4; ++m) pp[ai][m] = *(const f32x4*)(SSQ + (size_t)(row0 + ai * HALF + m * 16) * 16 + 4 * fq);
#pragma unroll
          for (int ai = 0; ai < 2; ++ai)
#pragma unroll
              for (int m = 0; m < 4; ++m) rs[ai][m] = __builtin_amdgcn_rsqf(fq_sum((pp[ai][m][0] + pp[ai][m][1]) + (pp[ai][m][2] + pp[ai][m][3])) * (1.f / 1024.f) + RMS_EPS); }
#pragma unroll
        for (int ai = 0; ai < 2; ++ai)
#pragma unroll
            for (int m = 0; m < 4; ++m) { const size_t row = (size_t)(row0 + ai * HALF + m * 16); const float r = rs[ai][m];
                f32x4 hv[2];
#pragma unroll
                for (int n = 0; n < 2; ++n) { const f32x4 g = acc[ai][0][m][n] * r, up = acc[ai][1][m][n] * r;
#pragma unroll
                    for (int j = 0; j < 4; ++j) { const float e = __builtin_amdgcn_exp2f(g[j] * -1.4426950408889634f); hv[n][j] = g[j] * __builtin_amdgcn_rcpf(1.0f + e) * up[j]; } }
                *(u32x4*)(Hp + (size_t)(ai * HALF + m * 16) * 2816) = tr16x4(pack8(hv[0], hv[1]), bidx); }
    }
};
struct EpiDownNorm {
    static constexpr bool PERM = true, AFTER_DRAIN = false;
    const bf16_t* X1B; float* OUT; const float* G; unsigned* xbuf; unsigned* cnt; PG8_LAS unsigned char* xl;
    __device__ __forceinline__ void operator()(f32x4 (&acc)[2][2][4][2], const Unit& u, int wr, int wc, int fr, int fq) const {
        int t_ = threadIdx.x; asm volatile("" : "+v"(t_)); fr = t_ & 15; fq = (t_ >> 4) & 3; const int lane = t_ & 63, wid = wr * 4 + wc; const int t2_ = t_; EPI_LANE_T();
        PG8_LAS float* P = (PG8_LAS float*)xl; PG8_LAS float* S = (PG8_LAS float*)(xl + 4096); PG8_LAS unsigned* flag = (PG8_LAS unsigned*)(xl + 5120);
        const int row0 = u.pm * BM + wr * 64 + fr, cw = u.pn * BM + wc * 32 + 8 * fq;
        f32x4 gv[2][2];
#pragma unroll
        for (int bj = 0; bj < 2; ++bj) { gv[bj][0] = *(const f32x4*)(G + cw + bj * HALF); gv[bj][1] = *(const f32x4*)(G + cw + bj * HALF + 4); }
        u32x4 xb[2][4][2];
#pragma unroll
        for (int ai = 0; ai < 2; ++ai)
#pragma unroll
            for (int m = 0; m < 4; ++m)
#pragma unroll
                for (int bj = 0; bj < 2; ++bj) xb[ai][m][bj] = *(const u32x4*)(X1B + (size_t)(row0 + ai * HALF + m * 16) * 1024 + cw + bj * HALF);
#pragma unroll
        for (int ai = 0; ai < 2; ++ai) {
#pragma unroll
            for (int m = 0; m < 4; ++m) { float s = 0.f;
#pragma unroll
                for (int bj = 0; bj < 2; ++bj) { const u32x4 w = xb[ai][m][bj];
                    const f32x4 a0 = (f32x4){__uint_as_float(w.x << 16), __uint_as_float(w.x & 0xffff0000u), __uint_as_float(w.y << 16), __uint_as_float(w.y & 0xffff0000u)};
                    const f32x4 a1 = (f32x4){__uint_as_float(w.z << 16), __uint_as_float(w.z & 0xffff0000u), __uint_as_float(w.w << 16), __uint_as_float(w.w & 0xffff0000u)};
                    acc[ai][bj][m][0] += a0; acc[ai][bj][m][1] += a1; s += sq8(acc[ai][bj][m][0], acc[ai][bj][m][1]); }
                s = fq_sum(s); if (fq == 0) P[(ai * HALF + wr * 64 + m * 16 + fr) * 4 + wc] = s; }
        }
        asm volatile("s_waitcnt lgkmcnt(0)" ::: "memory"); __builtin_amdgcn_s_barrier(); asm volatile("" ::: "memory");
        const int prow = wid * 32 + (lane & 31);
        if (lane < 32) { const float tot = (P[prow * 4 + 0] + P[prow * 4 + 1]) + (P[prow * 4 + 2] + P[prow * 4 + 3]);
            __hip_atomic_store(xbuf + ((size_t)(u.pm * BM + prow) * 4 + u.pn), __float_as_uint(tot), __ATOMIC_RELAXED, __HIP_MEMORY_SCOPE_AGENT); }
        asm volatile("s_waitcnt vmcnt(0)" ::: "memory");
        if (lane == 0) __hip_atomic_fetch_add(cnt + 64 * u.pm, 1u, __ATOMIC_RELAXED, __HIP_MEMORY_SCOPE_AGENT);
        if (wid == 0) { unsigned sp = 0;
            while ((unsigned)__builtin_amdgcn_readfirstlane(__hip_atomic_load(cnt + 64 * u.pm, __ATOMIC_RELAXED, __HIP_MEMORY_SCOPE_AGENT)) < 32u) { __builtin_amdgcn_s_sleep(2); if (++sp > (1u << 22)) break; }
            __builtin_amdgcn_fence(__ATOMIC_ACQUIRE, "agent");
            if (lane == 0) flag[0] = sp; }
        asm volatile("s_waitcnt vmcnt(0) lgkmcnt(0)" ::: "memory"); __builtin_amdgcn_s_barrier(); asm volatile("" ::: "memory");
        if (lane < 32) { const unsigned* slot = xbuf + (size_t)(u.pm * BM + prow) * 4; float q = 0.f;
#pragma unroll
            for (int t = 0; t < 4; ++t) q += __uint_as_float(__hip_atomic_load(slot + t, __ATOMIC_RELAXED, __HIP_MEMORY_SCOPE_AGENT));
            S[prow] = __builtin_amdgcn_rsqf(q * (1.f / 1024.f) + RMS_EPS); }
        asm volatile("s_waitcnt lgkmcnt(0)" ::: "memory"); __builtin_amdgcn_s_barrier(); asm volatile("" ::: "memory");
#pragma unroll
        for (int ai = 0; ai < 2; ++ai)
#pragma unroll
            for (int m = 0; m < 4; ++m) { const int r = ai * HALF + wr * 64 + m * 16 + fr; const float rs = S[r]; const size_t off = (size_t)(u.pm * BM + r) * 1024 + cw;
#pragma unroll
                for (int bj = 0; bj < 2; ++bj) { const f32x4 o0 = acc[ai][bj][m][0] * rs * gv[bj][0], o1 = acc[ai][bj][m][1] * rs * gv[bj][1]; float* const op = OUT + (size_t)(u.pm * BM + ai * HALF + wr * 64 + m * 16 + fr2) * 1024 + u.pn * BM + wc * 32 + 8 * fq2 + bj * HALF;
                    *(u32x4*)op = tr16x4(__builtin_bit_cast(u32x4, o0), bidx); *(u32x4*)(op + 4) = tr16x4(__builtin_bit_cast(u32x4, o1), bidx); } }
    }
};

struct SplitOrder {
    static constexpr bool KSPLIT = true, APANEL = false;
    StaticOrder so;
    __host__ __device__ void init(int M, int N, int G_, int c_) { so.init(M, N, G_, c_); }
    __host__ __device__ bool next(int i, Unit& u) const { if (!so.next(i, u)) return false; if (u.pn < 3) { u.kofs = 0; u.nt = 4; } else { u.kofs = 256 * 2; u.nt = 2; } return true; }
    __device__ __forceinline__ void a_ready(const Unit&) const {}
    __device__ __forceinline__ void done(const Unit&) const {}
};
template <class Epi, class Sched, bool ALIGN_EPI = false, bool SP2 = false>
__device__ __forceinline__ void gemm_phase(PG8_LAS unsigned char* lds, const Gemm g, const Sched& S, const Epi& E) {
    const int tid = threadIdx.x, wid = __builtin_amdgcn_readfirstlane(tid >> 6), lane = tid & 63, wr = wid >> 2, wc = wid & 3, fr = lane & 15, fq = lane >> 4;
    const int K = g.K; int nt = K / BK;
    unsigned voffA[2], voffB[2];
#pragma unroll
    for (int i = 0; i < 2; ++i) { int R, C; stage_rc(tid * 16 + i * 8192, R, C); const int Rb = Epi::PERM ? ((R & ~31) + perm32(R & 31)) : R;
        voffA[i] = (unsigned)(R * K + C) * 2u; voffB[i] = (unsigned)(Rb * K + C) * 2u; }
    const size_t kstep = (size_t)(BK * 2);
    const size_t hstep = (size_t)HALF * K * 2;
    const size_t tstep = 2 * hstep;
    const unsigned ldsw = (unsigned)wid * 1024u;
    const int aoff = lds_byte(wr * 64 + fr, fq * 8), boff = lds_byte(wc * 32 + fr, fq * 8);
#define PG8_SA(b, h) (((b) * 2 + (h)) * HTB)
#define PG8_SB(b, h) ((4 + (b) * 2 + (h)) * HTB)
#define PG8_STAGE(bufoff, gbase, voff) do { _Pragma("unroll") for (int _i = 0; _i < 2; ++_i) \
        __builtin_amdgcn_global_load_lds((const unsigned*)((const char*)(gbase) + (voff)[_i]), (PG8_LAS unsigned*)(lds + (bufoff) + ldsw + _i * 8192), 16, 0, 0); } while (0)
#define PG8_LDA(dst, b, h) do { _Pragma("unroll") for (int m = 0; m < 4; ++m) _Pragma("unroll") for (int k = 0; k < 2; ++k) dst[m][k] = *(const PG8_LAS bf16x8*)(lds + PG8_SA(b, h) + aoff + m * 2048 + k * 1024); } while (0)
#define PG8_LDB(dst, b, h) do { _Pragma("unroll") for (int n = 0; n < 2; ++n) _Pragma("unroll") for (int k = 0; k < 2; ++k) dst[n][k] = *(const PG8_LAS bf16x8*)(lds + PG8_SB(b, h) + boff + n * 2048 + k * 1024); } while (0)
#define PG8_MMA(ai, bj, At, Bt) do { __builtin_amdgcn_s_setprio(1); _Pragma("unroll") for (int m = 0; m < 4; ++m) _Pragma("unroll") for (int n = 0; n < 2; ++n) _Pragma("unroll") for (int k = 0; k < 2; ++k) \
        acc[ai][bj][m][n] = __builtin_amdgcn_mfma_f32_16x16x32_bf16(Bt[n][k], At[m][k], acc[ai][bj][m][n], 0, 0, 0); __builtin_amdgcn_s_setprio(0); } while (0)
#define PG8_WAIT_V(n) asm volatile("s_waitcnt vmcnt(" #n ")" ::: "memory")
#define PG8_WAIT_L(n) asm volatile("s_waitcnt lgkmcnt(" #n ")" ::: "memory")
#define PG8_BAR __builtin_amdgcn_s_barrier()
#define PG8_SCHED __builtin_amdgcn_sched_barrier(0)
    Unit cur, nxt; int ui = 0;
    if (!S.next(0, cur)) return;
    f32x4 acc[2][2][4][2];
#pragma unroll
    for (int a = 0; a < 2; ++a)
#pragma unroll
        for (int b = 0; b < 2; ++b)
#pragma unroll
            for (int m = 0; m < 4; ++m)
#pragma unroll
                for (int n = 0; n < 2; ++n) acc[a][b][m][n] = (f32x4){0.f, 0.f, 0.f, 0.f};
    bf16x8 At[4][2], B0[2][2], B1[2][2];
    const char* cA; if constexpr (Sched::APANEL) cA = S.a_panel(cur.pm); else cA = (const char*)g.A + (size_t)cur.pm * tstep + (Sched::KSPLIT ? cur.kofs : 0);
    const char* cB = (const char*)g.Bt + (size_t)cur.pn * tstep + (Sched::KSPLIT ? cur.kofs : 0);
    S.a_ready(cur);
    if constexpr (SP2) {
        PG8_STAGE(PG8_SB(0, 0), cB, voffB); PG8_STAGE(PG8_SB(0, 1), cB + hstep, voffB); PG8_STAGE(PG8_SA(0, 0), cA, voffA); PG8_STAGE(PG8_SA(0, 1), cA + hstep, voffA);
        if (wr == 1) PG8_BAR;
        PG8_WAIT_V(2); PG8_BAR;
        PG8_STAGE(PG8_SB(1, 0), cB + kstep, voffB); PG8_STAGE(PG8_SA(1, 0), cA + kstep, voffA); PG8_STAGE(PG8_SB(1, 1), cB + hstep + kstep, voffB);
        PG8_WAIT_V(6); PG8_BAR;
    } else {
        PG8_STAGE(PG8_SB(0, 0), cB, voffB); PG8_STAGE(PG8_SA(0, 0), cA, voffA); PG8_STAGE(PG8_SB(0, 1), cB + hstep, voffB); PG8_STAGE(PG8_SA(0, 1), cA + hstep, voffA);
        if (wr == 1) PG8_BAR;
        PG8_WAIT_V(4); PG8_BAR;
        PG8_STAGE(PG8_SB(1, 0), cB + kstep, voffB); PG8_STAGE(PG8_SA(1, 0), cA + kstep, voffA); PG8_STAGE(PG8_SB(1, 1), cB + hstep + kstep, voffB);
        PG8_WAIT_V(6); PG8_BAR;
    }
    for (;;) {
        const bool has_next = S.next(ui + 1, nxt);
        const char* nA; if constexpr (Sched::APANEL) nA = has_next ? S.a_panel(nxt.pm) : cA; else nA = has_next ? (const char*)g.A + (size_t)nxt.pm * tstep + (Sched::KSPLIT ? nxt.kofs : 0) : cA;
        const char* nB = has_next ? (const char*)g.Bt + (size_t)nxt.pn * tstep + (Sched::KSPLIT ? nxt.kofs : 0) : cB;
        if constexpr (Sched::KSPLIT) nt = cur.nt;
        for (int t = 0; t < nt; t += 2) {
            const bool last = (t == nt - 2);
            const char* a1 = cA + (size_t)(t + 1) * kstep;
            const char* a2 = last ? nA : cA + (size_t)(t + 2) * kstep; const char* b2 = last ? nB : cB + (size_t)(t + 2) * kstep;
            const char* a3 = a2 + kstep; const char* b3 = b2 + kstep;
            if (last && has_next) S.a_ready(nxt);
            if constexpr (SP2) {
            PG8_LDB(B0, 0, 0); PG8_LDB(B1, 0, 1); PG8_SCHED; PG8_LDA(At, 0, 0); PG8_STAGE(PG8_SA(1, 1), a1 + hstep, voffA);
            PG8_WAIT_V(8); PG8_WAIT_L(0); PG8_BAR; PG8_MMA(0, 0, At, B0); PG8_MMA(0, 1, At, B1); PG8_BAR; PG8_SCHED;
            PG8_LDA(At, 0, 1); PG8_STAGE(PG8_SB(0, 0), b2, voffB); PG8_STAGE(PG8_SB(0, 1), b2 + hstep, voffB); PG8_STAGE(PG8_SA(0, 0), a2, voffA);
            PG8_WAIT_V(8); PG8_WAIT_L(0); PG8_BAR; PG8_MMA(1, 0, At, B0); PG8_MMA(1, 1, At, B1); PG8_BAR; PG8_SCHED;
            PG8_LDB(B0, 1, 0); PG8_LDB(B1, 1, 1); PG8_SCHED; PG8_LDA(At, 1, 0); PG8_STAGE(PG8_SA(0, 1), a2 + hstep, voffA);
            PG8_WAIT_V(8); PG8_WAIT_L(0); PG8_BAR; PG8_MMA(0, 0, At, B0); PG8_MMA(0, 1, At, B1); PG8_BAR; PG8_SCHED;
            PG8_LDA(At, 1, 1); PG8_STAGE(PG8_SB(1, 0), b3, voffB); PG8_STAGE(PG8_SB(1, 1), b3 + hstep, voffB); PG8_STAGE(PG8_SA(1, 0), a3, voffA);
            PG8_WAIT_V(8); PG8_WAIT_L(0); PG8_BAR; PG8_MMA(1, 0, At, B0); PG8_MMA(1, 1, At, B1); PG8_BAR; PG8_SCHED;
            } else {
            PG8_LDB(B0, 0, 0); PG8_SCHED; PG8_LDA(At, 0, 0); PG8_STAGE(PG8_SA(1, 1), a1 + hstep, voffA);
            PG8_WAIT_L(8); PG8_BAR; PG8_WAIT_L(0); PG8_MMA(0, 0, At, B0); PG8_BAR; PG8_SCHED;
            PG8_LDB(B1, 0, 1); PG8_STAGE(PG8_SB(0, 0), b2, voffB);
            PG8_BAR; PG8_WAIT_L(0); PG8_MMA(0, 1, At, B1); PG8_BAR;
            PG8_LDA(At, 0, 1); PG8_STAGE(PG8_SA(0, 0), a2, voffA);
            PG8_BAR; PG8_WAIT_L(0); PG8_MMA(1, 0, At, B0); PG8_BAR; PG8_SCHED;
            PG8_STAGE(PG8_SB(0, 1), b2 + hstep, voffB);
            PG8_WAIT_V(6); PG8_BAR; PG8_MMA(1, 1, At, B1); PG8_BAR;
            PG8_LDB(B0, 1, 0); PG8_SCHED; PG8_LDA(At, 1, 0); PG8_STAGE(PG8_SA(0, 1), a2 + hstep, voffA);
            PG8_WAIT_L(8); PG8_BAR; PG8_WAIT_L(0); PG8_MMA(0, 0, At, B0); PG8_BAR; PG8_SCHED;
            PG8_LDB(B1, 1, 1); PG8_STAGE(PG8_SB(1, 0), b3, voffB);
            PG8_BAR; PG8_WAIT_L(0); PG8_MMA(0, 1, At, B1); PG8_BAR;
            PG8_LDA(At, 1, 1); PG8_STAGE(PG8_SA(1, 0), a3, voffA);
            PG8_BAR; PG8_WAIT_L(0); PG8_MMA(1, 0, At, B0); PG8_BAR; PG8_SCHED;
            PG8_STAGE(PG8_SB(1, 1), b3 + hstep, voffB);
            PG8_WAIT_V(6); PG8_BAR; PG8_MMA(1, 1, At, B1); PG8_BAR;
            }
        }
        if constexpr (ALIGN_EPI) { if (wr == 0) PG8_BAR; }
        if constexpr (!Epi::AFTER_DRAIN) { E(acc, cur, wr, wc, fr, fq); S.done(cur); }
        if (!has_next) break;
#pragma unroll
        for (int a = 0; a < 2; ++a)
#pragma unroll
            for (int b = 0; b < 2; ++b)
#pragma unroll
                for (int m = 0; m < 4; ++m)
#pragma unroll
                    for (int n = 0; n < 2; ++n) acc[a][b][m][n] = (f32x4){0.f, 0.f, 0.f, 0.f};
        cur = nxt; cA = nA; cB = nB; ++ui;
        if constexpr (ALIGN_EPI) { if (wr == 1) PG8_BAR; }
    }
    PG8_WAIT_V(0);
    if constexpr (!ALIGN_EPI) { if (wr == 0) PG8_BAR; }
    PG8_BAR;
    if constexpr (Epi::AFTER_DRAIN) { E.fused(acc, cur, wr, wc, fr, fq, lds, wid, lane); S.done(cur); }
#undef PG8_SA
#undef PG8_SB
#undef PG8_STAGE
#undef PG8_LDA
#undef PG8_LDB
#undef PG8_MMA
#undef PG8_WAIT_V
#undef PG8_WAIT_L
#undef PG8_BAR
#undef PG8_SCHED
}
}
namespace att {
using bf16x8 = __attribute__((ext_vector_type(8))) short;
using s16x4 = __attribute__((ext_vector_type(4))) short;
using f32x16 = __attribute__((ext_vector_type(16))) float;
using u32x4 = __attribute__((ext_vector_type(4))) unsigned;
typedef unsigned short bf16;
constexpr int SEQ = 4096, NW = 8, QB = 256, KVBLK = 64, NSLOT = 3;
#ifndef ATT_THRL
#define ATT_THRL 8
#endif
constexpr int THRL = ATT_THRL;
__device__ __forceinline__ int otid() { int t = threadIdx.x; asm volatile("" : "+v"(t)); return t; }
template <int PAT> __device__ __forceinline__ float swz_xor(float v) { return __int_as_float(__builtin_amdgcn_ds_swizzle(__float_as_int(v), PAT)); }
__device__ __forceinline__ int crow(int r, int hi) { return (r & 3) + 8 * (r >> 2) + 4 * hi; }
#define SBAR() __builtin_amdgcn_sched_barrier(0)
#define PIN(x) asm volatile("" : "+v"(x))
#define WAIT_BAR(N) asm volatile("s_waitcnt vmcnt(" #N ") lgkmcnt(0)\n\ts_barrier" ::: "memory")
#define MFMA32(a, b, c) __builtin_amdgcn_mfma_f32_32x32x16_bf16(a, b, c, 0, 0, 0)
#define EX(v) __builtin_amdgcn_exp2f(v)
#define MX3(a, b, c) __builtin_fmaxf(__builtin_fmaxf((a), (b)), (c))
__device__ __forceinline__ void glds16(const void* gsrc, unsigned lds_dst) { unsigned keep;
    asm volatile("s_mov_b32 %0, m0\n\ts_mov_b32 m0, %2\n\ts_nop 0\n\tglobal_load_lds_dwordx4 %1, off\n\ts_mov_b32 m0, %0" : "=&s"(keep) : "v"(gsrc), "s"(lds_dst) : "memory"); }
typedef float f32x2_t __attribute__((ext_vector_type(2))); typedef __bf16 bf16x2_t __attribute__((ext_vector_type(2)));
__device__ __forceinline__ unsigned cvtpk_s(float lo, float hi) { f32x2_t v = {lo, hi}; bf16x2_t b = __builtin_convertvector(v, bf16x2_t); return __builtin_bit_cast(unsigned, b); }
typedef __attribute__((address_space(3))) const char* lds_cptr;
typedef short v4i16_t __attribute__((ext_vector_type(4)));
__device__ __forceinline__ s16x4 vtr(lds_cptr p) { return __builtin_bit_cast(s16x4, __builtin_amdgcn_ds_read_tr16_b64_v4i16((__attribute__((address_space(3))) v4i16_t*)p)); }
__device__ __forceinline__ bf16x8 kld(lds_cptr p) { return *(const __attribute__((address_space(3))) bf16x8*)p; }
__device__ __forceinline__ float rowmax(const f32x16& p0, const f32x16& p1) {
    float a = MX3(p0[0], p0[1], p1[0]), b = MX3(p0[2], p0[3], p1[1]); a = MX3(a, p1[2], p1[3]);
#pragma unroll
    for (int r = 4; r < 16; r += 4) { a = MX3(a, p0[r], p0[r + 1]); b = MX3(b, p0[r + 2], p0[r + 3]); a = MX3(a, p1[r], p1[r + 1]); b = MX3(b, p1[r + 2], p1[r + 3]); }
    const float m = __builtin_fmaxf(a, b);
    auto rr = __builtin_amdgcn_permlane32_swap(__float_as_uint(m), __float_as_uint(m), false, false);
    return __builtin_fmaxf(__uint_as_float(rr[0]), __uint_as_float(rr[1]));
}
template <int DQK, int DV> struct Lay {
    static constexpr int KB = 64 * DQK * 2, VB = 64 * DV * 2;
    static constexpr int LDS_K = 0, LDS_V = NSLOT * KB, LDS_WS = NSLOT * (KB + VB), OSTW = (DV == 128) ? 8192 : 4096, LDS_OST = LDS_WS + NW * 256, LDS_BT = LDS_OST + NW * OSTW, LDS_END = LDS_BT + 2048;
};
#define STEP_MLA(C0, C1, P0, P1, t, BAND, GK, GV, GL) do { SBAR(); \
    const lds_cptr vp_ = vp0 + sl_prev * L::VB; \
      \
    float sacc = P0[0] + P0[1]; \
    VRD(0, 0); SBAR(); C0 = MFMA32(kf[0], qr[0], negm); sacc += P0[2]; sacc += P0[3]; sacc += P0[4]; PIN(sacc); pw0[0] = PKW(P0, 0); pw0[1] = PKW(P0, 2); PIN(pw0); SBAR(); \
    VRD(4, 4); SBAR(); C1 = MFMA32(kf[1], qr[0], negm); sacc += P0[5]; sacc += P0[6]; sacc += P0[7]; PIN(sacc); pw0[2] = PKW(P0, 4); pw0[3] = PKW(P0, 6); PIN(pw0); SBAR(); \
    VRD(1, 1); SBAR(); C0 = MFMA32(kf[2], qr[1], C0); sacc += P0[8]; sacc += P0[9]; sacc += P0[10]; PIN(sacc); pw1[0] = PKW(P0, 8); pw1[1] = PKW(P0, 10); PIN(pw1); SBAR(); \
    VRD(5, 5); SBAR(); C1 = MFMA32(kf[3], qr[1], C1); sacc += P0[11]; sacc += P0[12]; sacc += P0[13]; PIN(sacc); pw1[2] = PKW(P0, 12); pw1[3] = PKW(P0, 14); PIN(pw1); SBAR(); \
    VRD(2, 2); SBAR(); C0 = MFMA32(kf[4], qr[2], C0); sacc += P0[14]; sacc += P0[15]; sacc += P1[0]; PIN(sacc); pw2[0] = PKW(P1, 0); PIN(pw2); SBAR(); \
    VRD(6, 6); SBAR(); C1 = MFMA32(kf[5], qr[2], C1); sacc += P1[1]; sacc += P1[2]; sacc += P1[3]; PIN(sacc); pw2[1] = PKW(P1, 2); PIN(pw2); SBAR(); \
    VRD(3, 3); SBAR(); C0 = MFMA32(kf[6], qr[3], C0); sacc += P1[4]; sacc += P1[5]; PIN(sacc); pw2[2] = PKW(P1, 4); PIN(pw2); SBAR(); \
    VRD(7, 7); SBAR(); C1 = MFMA32(kf[7], qr[3], C1); sacc += P1[6]; sacc += P1[7]; PIN(sacc); pw2[3] = PKW(P1, 6); PIN(pw2); SBAR(); \
    C0 = MFMA32(kf[8], qr[4], C0); sacc += P1[8]; sacc += P1[9]; PIN(sacc); pw3[0] = PKW(P1, 8); PIN(pw3); SBAR(); \
    C1 = MFMA32(kf[9], qr[4], C1); sacc += P1[10]; sacc += P1[11]; PIN(sacc); pw3[1] = PKW(P1, 10); PIN(pw3); SBAR(); \
    C0 = MFMA32(kf[10], qr[5], C0); sacc += P1[12]; sacc += P1[13]; PIN(sacc); pw3[2] = PKW(P1, 12); PIN(pw3); SBAR(); \
    C1 = MFMA32(kf[11], qr[5], C1); sacc += P1[14]; sacc += P1[15]; PIN(sacc); pw3[3] = PKW(P1, 14); PIN(pw3); SBAR(); \
    l_reg += sacc; \
    MIDDLE(C0, C1, t, BAND); \
    SBAR(); \
    o[0] = MFMA32(PAF(0), VFR(0), o[0]); if (GK) DMA_K((t) + 3, sl_cur); if (GV) DMA_V((t) + 1, sl_next); C0[0] = EX(C0[0]); C0[1] = EX(C0[1]); C0[2] = EX(C0[2]); C0[3] = EX(C0[3]); PIN(C0); SBAR(); \
    KRD(GL, 0); o[1] = MFMA32(PAF(0), VFR(4), o[1]); C0[4] = EX(C0[4]); C0[5] = EX(C0[5]); C0[6] = EX(C0[6]); C0[7] = EX(C0[7]); PIN(C0); SBAR(); \
    KRD(GL, 1); o[0] = MFMA32(PAF(1), VFR(1), o[0]); C0[8] = EX(C0[8]); C0[9] = EX(C0[9]); C0[10] = EX(C0[10]); C0[11] = EX(C0[11]); PIN(C0); SBAR(); \
    KRD(GL, 2); o[1] = MFMA32(PAF(1), VFR(5), o[1]); C0[12] = EX(C0[12]); C0[13] = EX(C0[13]); C0[14] = EX(C0[14]); C0[15] = EX(C0[15]); PIN(C0); SBAR(); \
    KRD(GL, 3); o[0] = MFMA32(PAF(2), VFR(2), o[0]); C1[0] = EX(C1[0]); C1[1] = EX(C1[1]); C1[2] = EX(C1[2]); C1[3] = EX(C1[3]); PIN(C1); SBAR(); \
    KRD(GL, 4); o[1] = MFMA32(PAF(2), VFR(6), o[1]); C1[4] = EX(C1[4]); C1[5] = EX(C1[5]); C1[6] = EX(C1[6]); C1[7] = EX(C1[7]); PIN(C1); SBAR(); \
    KRD(GL, 5); o[0] = MFMA32(PAF(3), VFR(3), o[0]); C1[8] = EX(C1[8]); C1[9] = EX(C1[9]); C1[10] = EX(C1[10]); C1[11] = EX(C1[11]); PIN(C1); SBAR(); \
    o[1] = MFMA32(PAF(3), VFR(7), o[1]); C1[12] = EX(C1[12]); C1[13] = EX(C1[13]); C1[14] = EX(C1[14]); C1[15] = EX(C1[15]); PIN(C1); SBAR(); \
    } while (0)
#define STEP_DIF(C0, C1, P0, P1, t, BAND, GK, GV, GL) do { SBAR(); \
    const lds_cptr vp_ = vp0 + sl_prev * L::VB; \
      \
    float sacc = P0[0] + P0[1]; \
    C0 = MFMA32(kf[0], qr[0], inin); sacc += P0[2]; sacc += P0[3]; sacc += P0[4]; sacc += P0[5]; PIN(sacc); pw0[0] = PKW(P0, 0); pw0[1] = PKW(P0, 2); PIN(pw0); SBAR(); \
    C1 = MFMA32(kf[1], qr[0], inin); sacc += P0[6]; sacc += P0[7]; sacc += P0[8]; sacc += P0[9]; PIN(sacc); pw0[2] = PKW(P0, 4); pw0[3] = PKW(P0, 6); PIN(pw0); SBAR(); \
    C0 = MFMA32(kf[2], qr[1], C0); sacc += P0[10]; sacc += P0[11]; sacc += P0[12]; sacc += P0[13]; PIN(sacc); pw1[0] = PKW(P0, 8); pw1[1] = PKW(P0, 10); PIN(pw1); SBAR(); \
    C1 = MFMA32(kf[3], qr[1], C1); sacc += P0[14]; sacc += P0[15]; sacc += P1[0]; sacc += P1[1]; PIN(sacc); pw1[2] = PKW(P0, 12); pw1[3] = PKW(P0, 14); PIN(pw1); SBAR(); \
    VRD(0, 0); SBAR(); C0 = MFMA32(kf[4], qr[2], C0); sacc += P1[2]; sacc += P1[3]; sacc += P1[4]; sacc += P1[5]; PIN(sacc); pw2[0] = PKW(P1, 0); pw2[1] = PKW(P1, 2); PIN(pw2); SBAR(); \
    VRD(1, 4); SBAR(); C1 = MFMA32(kf[5], qr[2], C1); sacc += P1[6]; sacc += P1[7]; sacc += P1[8]; sacc += P1[9]; PIN(sacc); pw2[2] = PKW(P1, 4); pw2[3] = PKW(P1, 6); PIN(pw2); SBAR(); \
    VRD(2, 8); SBAR(); C0 = MFMA32(kf[6], qr[3], C0); sacc += P1[10]; sacc += P1[11]; sacc += P1[12]; sacc += P1[13]; PIN(sacc); pw3[0] = PKW(P1, 8); pw3[1] = PKW(P1, 10); PIN(pw3); SBAR(); \
    VRD(3, 12); SBAR(); C1 = MFMA32(kf[7], qr[3], C1); sacc += P1[14]; sacc += P1[15]; PIN(sacc); pw3[2] = PKW(P1, 12); pw3[3] = PKW(P1, 14); PIN(pw3); SBAR(); \
    l_reg += sacc; \
    MIDDLE(C0, C1, t, BAND); \
    SBAR(); \
    o[0] = MFMA32(PAF(0), VFR(0), o[0]); if (GK) DMA_K((t) + 3, sl_cur); if (GV) DMA_V((t) + 1, sl_next); VRD(0, 1); C0[0] = EX(C0[0]); C0[1] = EX(C0[1]); PIN(C0); SBAR(); \
    o[1] = MFMA32(PAF(0), VFR(1), o[1]); VRD(1, 5); C0[2] = EX(C0[2]); C0[3] = EX(C0[3]); PIN(C0); SBAR(); \
    o[2] = MFMA32(PAF(0), VFR(2), o[2]); VRD(2, 9); C0[4] = EX(C0[4]); C0[5] = EX(C0[5]); PIN(C0); SBAR(); \
    o[3] = MFMA32(PAF(0), VFR(3), o[3]); VRD(3, 13); C0[6] = EX(C0[6]); C0[7] = EX(C0[7]); PIN(C0); SBAR(); \
    o[0] = MFMA32(PAF(1), VFR(0), o[0]); VRD(0, 2); C0[8] = EX(C0[8]); C0[9] = EX(C0[9]); PIN(C0); SBAR(); \
    o[1] = MFMA32(PAF(1), VFR(1), o[1]); VRD(1, 6); C0[10] = EX(C0[10]); C0[11] = EX(C0[11]); PIN(C0); SBAR(); \
    o[2] = MFMA32(PAF(1), VFR(2), o[2]); VRD(2, 10); C0[12] = EX(C0[12]); C0[13] = EX(C0[13]); PIN(C0); SBAR(); \
    o[3] = MFMA32(PAF(1), VFR(3), o[3]); VRD(3, 14); C0[14] = EX(C0[14]); C0[15] = EX(C0[15]); PIN(C0); SBAR(); \
    o[0] = MFMA32(PAF(2), VFR(0), o[0]); VRD(0, 3); C1[0] = EX(C1[0]); C1[1] = EX(C1[1]); PIN(C1); SBAR(); \
    KRD(GL, 0); o[1] = MFMA32(PAF(2), VFR(1), o[1]); VRD(1, 7); C1[2] = EX(C1[2]); C1[3] = EX(C1[3]); PIN(C1); SBAR(); \
    KRD(GL, 1); o[2] = MFMA32(PAF(2), VFR(2), o[2]); VRD(2, 11); C1[4] = EX(C1[4]); C1[5] = EX(C1[5]); PIN(C1); SBAR(); \
    KRD(GL, 2); o[3] = MFMA32(PAF(2), VFR(3), o[3]); VRD(3, 15); C1[6] = EX(C1[6]); C1[7] = EX(C1[7]); PIN(C1); SBAR(); \
    KRD(GL, 3); o[0] = MFMA32(PAF(3), VFR(0), o[0]); C1[8] = EX(C1[8]); C1[9] = EX(C1[9]); PIN(C1); SBAR(); \
    o[1] = MFMA32(PAF(3), VFR(1), o[1]); C1[10] = EX(C1[10]); C1[11] = EX(C1[11]); PIN(C1); SBAR(); \
    o[2] = MFMA32(PAF(3), VFR(2), o[2]); C1[12] = EX(C1[12]); C1[13] = EX(C1[13]); PIN(C1); SBAR(); \
    o[3] = MFMA32(PAF(3), VFR(3), o[3]); C1[14] = EX(C1[14]); C1[15] = EX(C1[15]); PIN(C1); { float iv_ = INI_ADD((t) + 1) - mhat; _Pragma("unroll") for (int r_ = 0; r_ < 16; ++r_) inin[r_] = iv_; } PIN(inin); SBAR(); \
    } while (0)
#define PKW(P, i) cvtpk_s(P[i], P[i + 1])
#define PAF(k) __builtin_bit_cast(bf16x8, pw##k)
#define VFR(i) (bf16x8){vlo[i][0], vlo[i][1], vlo[i][2], vlo[i][3], vhi[i][0], vhi[i][1], vhi[i][2], vhi[i][3]}
#define VRD(s, f) do { vlo[s] = vtr(vp_ + (((f) >> 2) * 4096 + ((f) & 3) * 1024)); vhi[s] = vtr(vp_ + (((f) >> 2) * 4096 + ((f) & 3) * 1024 + 512)); } while (0)
#define KRD(G, j) do { if (G) { const lds_cptr kq_ = kp0 + sl_next * L::KB + (j) * 2048; kf[2 * (j)] = kld(kq_); kf[2 * (j) + 1] = kld(kq_ + 512); SBAR(); } } while (0)
#define ROT() do { sl_prev = sl_cur; sl_cur = sl_next; sl_next = (sl_next == NSLOT - 1) ? 0 : sl_next + 1; } while (0)
#define CMASK(C0, C1, t) do { } while (0)
#define DECIDE(C0, C1) do { float a_ = MX3(C0[0], C0[1], C1[0]), b_ = MX3(C0[2], C0[3], C1[1]); a_ = MX3(a_, C1[2], C1[3]); \
      _Pragma("unroll") for (int r_ = 4; r_ < 16; r_ += 4) { a_ = MX3(a_, C0[r_], C0[r_ + 1]); b_ = MX3(b_, C0[r_ + 2], C0[r_ + 3]); a_ = MX3(a_, C1[r_], C1[r_ + 1]); b_ = MX3(b_, C1[r_ + 2], C1[r_ + 3]); } \
      float rm_ = __builtin_fmaxf(a_, b_); { auto rr_ = __builtin_amdgcn_permlane32_swap(__float_as_uint(rm_), __float_as_uint(rm_), false, false); rm_ = __builtin_fmaxf(__uint_as_float(rr_[0]), __uint_as_float(rr_[1])); } \
      resc = false; \
      if (__builtin_expect(__any(rm_ > (float)THRL), 0)) { const float dl_ = __builtin_fmaxf(rm_, 0.f); mhat += dl_; NEGM_UPDATE(); \
        _Pragma("unroll") for (int r_ = 0; r_ < 16; ++r_) { C0[r_] -= dl_; C1[r_] -= dl_; } \
        const float f_ = __builtin_amdgcn_exp2f(-dl_); l_reg *= f_; if (hi == 0) wsf[r32] = f_; resc = true; } } while (0)
#define RESC(NO_) do { if (resc) { asm volatile("s_waitcnt lgkmcnt(0)" ::: "memory"); \
      _Pragma("unroll") for (int r_ = 0; r_ < 16; ++r_) { const float f_ = wsf[crow(r_, hi)]; _Pragma("unroll") for (int d_ = 0; d_ < NO_; ++d_) o[d_][r_] *= f_; } } } while (0)
#define ENDW(tt, W2, W1) do { if ((tt) + 3 < NT) { WAIT_BAR(W2); } else if ((tt) + 2 < NT) { WAIT_BAR(W1); } else { WAIT_BAR(0); } } while (0)
#define DRAIN_PV(P0, P1, slot_, NO_) do { float sacc_ = P0[0] + P0[1]; \
      _Pragma("unroll") for (int r_ = 2; r_ < 16; ++r_) sacc_ += P0[r_]; \
      _Pragma("unroll") for (int r_ = 0; r_ < 16; ++r_) sacc_ += P1[r_]; \
      l_reg += sacc_; \
      pw0 = (u32x4){PKW(P0, 0), PKW(P0, 2), PKW(P0, 4), PKW(P0, 6)}; pw1 = (u32x4){PKW(P0, 8), PKW(P0, 10), PKW(P0, 12), PKW(P0, 14)}; \
      pw2 = (u32x4){PKW(P1, 0), PKW(P1, 2), PKW(P1, 4), PKW(P1, 6)}; pw3 = (u32x4){PKW(P1, 8), PKW(P1, 10), PKW(P1, 12), PKW(P1, 14)}; \
      const lds_cptr vp_ = vp0 + (slot_) * L::VB; \
      _Pragma("unroll") for (int d_ = 0; d_ < NO_; ++d_) { \
          VRD(0, d_ * 4 + 0); VRD(1, d_ * 4 + 1); VRD(2, d_ * 4 + 2); VRD(3, d_ * 4 + 3); \
          o[d_] = MFMA32(PAF(0), VFR(0), o[d_]); o[d_] = MFMA32(PAF(1), VFR(1), o[d_]); o[d_] = MFMA32(PAF(2), VFR(2), o[d_]); o[d_] = MFMA32(PAF(3), VFR(3), o[d_]); SBAR(); } } while (0)
#define BSTEP(STEPX, NO_, C0, C1, P0, P1, t, GK, GV, GL) do { \
      if ((t) <= Lw) { STEPX(C0, C1, P0, P1, t, false, GK, GV, ((GL) && ((t) + 1 <= Lw))); } \
      else { resc = false; if (GK) DMA_K((t) + 3, sl_cur); if (GV) DMA_V((t) + 1, sl_next); \
             if ((t) == Lw + 1) DRAIN_PV(P0, P1, sl_prev, NO_); } } while (0)

template <int DQK, int DV>
__device__ __forceinline__ void store_rows(const f32x16 (&y)[DV / 32], bf16* dst, int pitch, char* shm) {
    typedef Lay<DQK, DV> L;
    const int tid_ = otid(), lane = tid_ & 63, r32 = lane & 31, hi = lane >> 5; const int wid = __builtin_amdgcn_readfirstlane(tid_ >> 6);
    bf16* stg = (bf16*)(shm + L::LDS_OST + wid * L::OSTW);
#pragma unroll
    for (int half = 0; half < DV / 64; ++half) {
#pragma unroll
        for (int r = 0; r < 16; ++r) { const int orow = crow(r, hi);
#pragma unroll
            for (int d0 = 0; d0 < 2; ++d0) { const unsigned pk = cvtpk_s(y[2 * half + d0][r], 0.f); stg[orow * 64 + d0 * 32 + r32] = (bf16)(pk & 0xffffu); } }
        asm volatile("s_waitcnt lgkmcnt(0)" ::: "memory");
#pragma unroll
        for (int i = 0; i < 4; ++i) { const int row = i * 8 + (lane >> 3), ch = lane & 7; const u32x4 v = *(const u32x4*)(stg + row * 64 + ch * 8);
            *(u32x4*)(dst + (long)(32 * wid + i * 8 + (lane >> 3)) * pitch + half * 64 + ch * 8) = v; }
        asm volatile("s_waitcnt lgkmcnt(0)" ::: "memory");
    }
}
template <int DQK, int DV>
__device__ __forceinline__ void row_rcp(float (&rli)[16], float l_reg, char* shm) {
    typedef Lay<DQK, DV> L;
    const int tid_ = otid(), lane = tid_ & 63, r32 = lane & 31, hi = lane >> 5; const int wid = __builtin_amdgcn_readfirstlane(tid_ >> 6);
    float* wsf = (float*)(shm + L::LDS_WS) + wid * 64;
    { auto rr = __builtin_amdgcn_permlane32_swap(__float_as_uint(l_reg), __float_as_uint(l_reg), false, false); l_reg = __uint_as_float(rr[0]) + __uint_as_float(rr[1]); }
    if (hi == 0) wsf[32 + r32] = l_reg;
    asm volatile("s_waitcnt lgkmcnt(0)" ::: "memory");
#pragma unroll
    for (int r = 0; r < 16; ++r) rli[r] = __builtin_amdgcn_rcpf(wsf[32 + crow(r, hi)]);
}

struct MlaT { const bf16 *QA, *KN, *KR, *VA; bf16* MIX; };
__device__ __forceinline__ void mla_unit(int b, int h, int qb, const MlaT& T, char* shm) {
    typedef Lay<96, 64> L;
    const int tid = otid(), lane = tid & 63, r32 = lane & 31, hi = lane >> 5; const int wid = __builtin_amdgcn_readfirstlane(tid >> 6);
    const long rowbase = (long)b * SEQ; const int q0 = qb * QB, NT = 4 * qb + 4; const int Lw = NT - 4 + (wid >> 1);
    const bf16* Qrow = T.QA + (rowbase + q0 + 32 * wid + r32) * 768 + h * 96;
    const unsigned lds0 = (unsigned)(uintptr_t)shm; float* wsf = (float*)(shm + L::LDS_WS) + wid * 64;
    const bf16* ksrc = T.KN + rowbase * 512 + h * 64 + (long)lane * 512 + wid * 8;
    const bf16* k2src = T.KR + rowbase * 32 + (long)lane * 32 + (wid & 3) * 8;
    const bf16* vsrc = T.VA + rowbase * 512 + h * 64 + (long)(16 * (wid & 3) + (lane >> 2)) * 512 + (wid >> 2) * 32 + (lane & 3) * 8;
    const unsigned kdst = lds0 + L::LDS_K + wid * 1024, k2dst = lds0 + L::LDS_K + (8 + (wid & 3)) * 1024, vdst = lds0 + L::LDS_V + wid * 1024;
#define DMA_K(t, slot) do { glds16(ksrc + (long)(t) * KVBLK * 512, (unsigned)__builtin_amdgcn_readfirstlane(kdst + (slot) * L::KB)); glds16(k2src + (long)(t) * KVBLK * 32, (unsigned)__builtin_amdgcn_readfirstlane(k2dst + (slot) * L::KB)); } while (0)
#define DMA_V(t, slot) glds16(vsrc + (long)(t) * KVBLK * 512, (unsigned)__builtin_amdgcn_readfirstlane(vdst + (slot) * L::VB))
#define INI_ADD(t) 0.f
#define NEGM_UPDATE() do { _Pragma("unroll") for (int r_ = 0; r_ < 16; ++r_) negm[r_] = -mhat; } while (0)
#define MIDDLE(C0, C1, t, BAND) do { if (BAND) CMASK(C0, C1, t); DECIDE(C0, C1); } while (0)
    const lds_cptr shm3 = (lds_cptr)shm;
    const lds_cptr vp0 = shm3 + L::LDS_V + ((lane >> 4) & 1) * 32 + (lane & 3) * 8 + (4 * hi + ((lane & 15) >> 2)) * 64;
    const lds_cptr kp0 = shm3 + L::LDS_K + hi * 1024 + r32 * 16;
    DMA_K(0, 0); DMA_V(0, 0); DMA_K(1, 1);
    bf16x8 qr[6];
#pragma unroll
    for (int d0 = 0; d0 < 6; ++d0) qr[d0] = *reinterpret_cast<const bf16x8*>(&Qrow[d0 * 16 + hi * 8]);
    float mhat = 0.f, l_reg = 0.f; f32x16 o[2]; o[0] = f32x16{}; o[1] = f32x16{};
    bool resc = false;
    f32x16 pA0, pA1, pB0, pB1; bf16x8 kf[12]; s16x4 vlo[8], vhi[8]; u32x4 pw0, pw1, pw2, pw3;
    int sl_prev = 0, sl_cur = 0, sl_next = 1;
    DMA_K(2, 2);
    WAIT_BAR(5);
    { f32x16 z = f32x16{};
#pragma unroll
      for (int d0 = 0; d0 < 6; ++d0) { const bf16x8 b0 = kld(kp0 + d0 * 2048), b1 = kld(kp0 + d0 * 2048 + 512);
          if (d0 == 0) { pA0 = MFMA32(b0, qr[0], z); pA1 = MFMA32(b1, qr[0], z); } else { pA0 = MFMA32(b0, qr[d0], pA0); pA1 = MFMA32(b1, qr[d0], pA1); } }
      const float rm = rowmax(pA0, pA1); mhat = rm;
#pragma unroll
      for (int r = 0; r < 16; ++r) { pA0[r] = EX(pA0[r] - rm); pA1[r] = EX(pA1[r] - rm); } }
    f32x16 negm; NEGM_UPDATE(); asm volatile("" : "+v"(negm));
    WAIT_BAR(0);
    DMA_K(3, 0); DMA_V(1, 1); ROT();
#pragma unroll
    for (int j = 0; j < 6; ++j) { const lds_cptr kq = kp0 + sl_cur * L::KB + j * 2048; kf[2 * j] = kld(kq); kf[2 * j + 1] = kld(kq + 512); }
    WAIT_BAR(3);
    int t = 1;
    for (; t + 5 < NT; t += 2) {
        STEP_MLA(pB0, pB1, pA0, pA1, t, false, true, true, true);     WAIT_BAR(3); RESC(2); ROT();
        STEP_MLA(pA0, pA1, pB0, pB1, t + 1, false, true, true, true); WAIT_BAR(3); RESC(2); ROT();
    }
#pragma nounroll
    for (; t <= Lw; ++t) {
        STEP_MLA(pB0, pB1, pA0, pA1, t, false, (t + 3 < NT), (t + 1 < NT), (t + 1 <= Lw));
        if (t + 1 < NT) { ENDW(t, 3, 1); }
        RESC(2);
        if (t + 1 < NT) ROT();
        pA0 = pB0; pA1 = pB1;
    }
    if (t < NT) {
        if (t + 3 < NT) DMA_K(t + 3, sl_cur); if (t + 1 < NT) DMA_V(t + 1, sl_next);
        DRAIN_PV(pA0, pA1, sl_prev, 2);
        if (t + 1 < NT) { ENDW(t, 3, 1); ROT(); }
        ++t;
#pragma nounroll
        for (; t < NT; ++t) {
            if (t + 3 < NT) DMA_K(t + 3, sl_cur); if (t + 1 < NT) DMA_V(t + 1, sl_next);
            if (t + 1 < NT) { ENDW(t, 3, 1); ROT(); }
        }
    } else { DRAIN_PV(pA0, pA1, sl_cur, 2); }
    float rli[16]; row_rcp<96, 64>(rli, l_reg, shm);
#pragma unroll
    for (int d = 0; d < 2; ++d)
#pragma unroll
        for (int r = 0; r < 16; ++r) o[d][r] *= rli[r];
    store_rows<96, 64>(o, T.MIX + (rowbase + q0) * 1024 + h * 64, 1024, shm);
    asm volatile("s_waitcnt vmcnt(0) lgkmcnt(0)\n\ts_barrier" ::: "memory");
#undef DMA_K
#undef DMA_V
#undef INI_ADD
#undef NEGM_UPDATE
#undef MIDDLE
}

struct DiffT { const bf16 *DQ, *DK, *DV; bf16* MIX; float* OB; const float *rel_bias, *g_subln; float lam; };
__device__ __forceinline__ int t5_bucket(int rel) {
    const int n = rel < 0 ? -rel : rel; int bk = n;
    if (n >= 8) { bk = 2 + (31 - __clz(n * n)); bk = bk > 15 ? 15 : bk; }
    return (rel > 0 ? 16 : 0) + bk;
}
__device__ __forceinline__ void diff_pass(f32x16 (&o)[4], float& l_out, int b, int h, int qb, int mo, const DiffT& T, char* shm, float cfar) {
    typedef Lay<64, 128> L;
    const int tid = otid(), lane = tid & 63, r32 = lane & 31, hi = lane >> 5; const int wid = __builtin_amdgcn_readfirstlane(tid >> 6);
    const long rowbase = (long)b * SEQ; const int q0 = qb * QB, NT = 4 * qb + 4; const int Lw = NT - 4 + (wid >> 1);
    const int urow = 32 * wid + r32;
    const bf16* Qrow = T.DQ + (rowbase + q0 + urow) * 512 + h * 128 + mo;
    const unsigned lds0 = (unsigned)(uintptr_t)shm; float* wsf = (float*)(shm + L::LDS_WS) + wid * 64;
    const float* bt = (const float*)(shm + L::LDS_BT);
    const bf16* ksrc = T.DK + rowbase * 512 + h * 128 + mo + (long)lane * 512 + wid * 8;
    const bf16* vsrc = T.DV + rowbase * 512 + h * 128 + (long)(16 * (wid & 3) + (lane >> 2)) * 512 + (wid >> 2) * 32 + (lane & 3) * 8;
    const unsigned kdst = lds0 + L::LDS_K + wid * 1024, vdst = lds0 + L::LDS_V + wid * 1024;
#define DMA_K(t, slot) glds16(ksrc + (long)(t) * KVBLK * 512, (unsigned)__builtin_amdgcn_readfirstlane(kdst + (slot) * L::KB))
#define DMA_V(t, slot) do { glds16(vsrc + (long)(t) * KVBLK * 512, (unsigned)__builtin_amdgcn_readfirstlane(vdst + (slot) * L::VB)); glds16(vsrc + (long)(t) * KVBLK * 512 + 64, (unsigned)__builtin_amdgcn_readfirstlane(vdst + (slot) * L::VB + 8192)); } while (0)
#define INI_ADD(t) (((t) < NT - 6) ? cfar : 0.f)
#define NEGM_UPDATE() do { } while (0)
#define BIAS_ADD(C0, C1, t) do { if ((t) >= NT - 6) { const float* bp_ = bt + (64 * (t) - (q0 + urow) + 384 + 4 * hi); \
      _Pragma("unroll") for (int r_ = 0; r_ < 16; ++r_) { C0[r_] += bp_[(r_ & 3) + 8 * (r_ >> 2)]; C1[r_] += bp_[32 + (r_ & 3) + 8 * (r_ >> 2)]; } } } while (0)
#define MIDDLE(C0, C1, t, BAND) do { BIAS_ADD(C0, C1, t); if (BAND) CMASK(C0, C1, t); DECIDE(C0, C1); } while (0)
    const lds_cptr shm3 = (lds_cptr)shm;
    const lds_cptr vp0 = shm3 + L::LDS_V + ((lane >> 4) & 1) * 32 + (lane & 3) * 8 + (4 * hi + ((lane & 15) >> 2)) * 64;
    const lds_cptr kp0 = shm3 + L::LDS_K + hi * 1024 + r32 * 16;
    DMA_K(0, 0); DMA_V(0, 0); DMA_K(1, 1);
    bf16x8 qr[4];
#pragma unroll
    for (int d0 = 0; d0 < 4; ++d0) qr[d0] = *reinterpret_cast<const bf16x8*>(&Qrow[d0 * 16 + hi * 8]);
    float mhat = 0.f, l_reg = 0.f;
#pragma unroll
    for (int d = 0; d < 4; ++d) o[d] = f32x16{};
    bool resc = false;
    f32x16 pA0, pA1, pB0, pB1; bf16x8 kf[8]; s16x4 vlo[8], vhi[8]; u32x4 pw0, pw1, pw2, pw3;
    int sl_prev = 0, sl_cur = 0, sl_next = 1;
    DMA_K(2, 2);
    WAIT_BAR(4);
    { f32x16 z; { const float iv = INI_ADD(0);
#pragma unroll
        for (int r = 0; r < 16; ++r) z[r] = iv; }
#pragma unroll
      for (int d0 = 0; d0 < 4; ++d0) { const bf16x8 b0 = kld(kp0 + d0 * 2048), b1 = kld(kp0 + d0 * 2048 + 512);
          if (d0 == 0) { pA0 = MFMA32(b0, qr[0], z); pA1 = MFMA32(b1, qr[0], z); } else { pA0 = MFMA32(b0, qr[d0], pA0); pA1 = MFMA32(b1, qr[d0], pA1); } }
      BIAS_ADD(pA0, pA1, 0);
      const float rm = rowmax(pA0, pA1); mhat = rm;
#pragma unroll
      for (int r = 0; r < 16; ++r) { pA0[r] = EX(pA0[r] - rm); pA1[r] = EX(pA1[r] - rm); } }
    f32x16 inin; { const float iv = INI_ADD(1) - mhat;
#pragma unroll
        for (int r = 0; r < 16; ++r) inin[r] = iv; }
    asm volatile("" : "+v"(inin));
    WAIT_BAR(0);
    DMA_K(3, 0); DMA_V(1, 1); ROT();
#pragma unroll
    for (int j = 0; j < 4; ++j) { const lds_cptr kq = kp0 + sl_cur * L::KB + j * 2048; kf[2 * j] = kld(kq); kf[2 * j + 1] = kld(kq + 512); }
    WAIT_BAR(3);
    int t = 1;
    for (; t + 5 < NT; t += 2) {
        STEP_DIF(pB0, pB1, pA0, pA1, t, false, true, true, true);     WAIT_BAR(3); RESC(4); ROT();
        STEP_DIF(pA0, pA1, pB0, pB1, t + 1, false, true, true, true); WAIT_BAR(3); RESC(4); ROT();
    }
#pragma nounroll
    for (; t <= Lw; ++t) {
        STEP_DIF(pB0, pB1, pA0, pA1, t, false, (t + 3 < NT), (t + 1 < NT), (t + 1 <= Lw));
        if (t + 1 < NT) { ENDW(t, 3, 2); }
        RESC(4);
        if (t + 1 < NT) ROT();
        pA0 = pB0; pA1 = pB1;
    }
    if (t < NT) {
        if (t + 3 < NT) DMA_K(t + 3, sl_cur); if (t + 1 < NT) DMA_V(t + 1, sl_next);
        DRAIN_PV(pA0, pA1, sl_prev, 4);
        if (t + 1 < NT) { ENDW(t, 3, 2); ROT(); }
        ++t;
#pragma nounroll
        for (; t < NT; ++t) {
            if (t + 3 < NT) DMA_K(t + 3, sl_cur); if (t + 1 < NT) DMA_V(t + 1, sl_next);
            if (t + 1 < NT) { ENDW(t, 3, 2); ROT(); }
        }
    } else { DRAIN_PV(pA0, pA1, sl_cur, 4); }
    l_out = l_reg;
    asm volatile("s_waitcnt lgkmcnt(0)\n\ts_barrier" ::: "memory");
#undef DMA_K
#undef DMA_V
#undef INI_ADD
#undef NEGM_UPDATE
#undef BIAS_ADD
#undef MIDDLE
}
__device__ __forceinline__ void diff_unit(int b, int h, int qb, const DiffT& T, char* shm) {
    typedef Lay<64, 128> L;
    const int tid = otid(); const int wid = __builtin_amdgcn_readfirstlane(tid >> 6);
    const long rowbase = (long)b * SEQ; const int q0 = qb * QB;
    constexpr float LOG2E = 1.4426950408889634f;
    { float* bt = (float*)(shm + L::LDS_BT); if (tid < 448) bt[tid] = T.rel_bias[t5_bucket(tid - 384) * 4 + h] * LOG2E; }
    const float cfar = T.rel_bias[15 * 4 + h] * LOG2E;
    asm volatile("s_waitcnt lgkmcnt(0)\n\ts_barrier" ::: "memory");
    unsigned* const obw = (unsigned*)(shm + L::LDS_OST + wid * L::OSTW);
    f32x16 o[4]; float l_reg; float rli[16];
    const float lam = T.lam;
#pragma nounroll
    for (int pass = 0; pass < 2; ++pass) {
        diff_pass(o, l_reg, b, h, qb, (pass == 0) ? 64 : 0, T, shm, cfar);
        row_rcp<64, 128>(rli, l_reg, shm);
        if (pass == 0) { unsigned* ob = obw + (otid() & 63);
#pragma unroll
            for (int d = 0; d < 4; ++d)
#pragma unroll
                for (int r = 0; r < 16; r += 2) ob[(d * 8 + (r >> 1)) * 64] = cvtpk_s(o[d][r] * rli[r], o[d][r + 1] * rli[r + 1]);
        }
    }
    float ss[16]; const int lane2 = otid() & 63, r32 = lane2 & 31; const unsigned* ob = obw + lane2;
    unsigned pk2_[4][8];
#pragma unroll
    for (int d = 0; d < 4; ++d)
#pragma unroll
        for (int j = 0; j < 8; ++j) pk2_[d][j] = ob[(d * 8 + j) * 64];
    asm volatile("s_waitcnt lgkmcnt(0)" ::: "memory");
#pragma unroll
    for (int r = 0; r < 16; ++r) { float s = 0.f;
#pragma unroll
        for (int d = 0; d < 4; ++d) { const unsigned w = pk2_[d][r >> 1]; const float o2 = __uint_as_float((r & 1) ? (w & 0xffff0000u) : (w << 16));
            const float y = o[d][r] * rli[r] - lam * o2; o[d][r] = y; s += y * y; }
        ss[r] = s; }
#define SWZ_STEP(K) _Pragma("unroll") for (int r = 0; r < 16; ++r) ss[r] += swz_xor<((K) << 10) | 0x1f>(ss[r]);
    SWZ_STEP(1) SWZ_STEP(2) SWZ_STEP(4) SWZ_STEP(8) SWZ_STEP(16)
#undef SWZ_STEP
#pragma unroll
    for (int d = 0; d < 4; ++d) { const float g = T.g_subln[d * 32 + r32] * 0.8f;
#pragma unroll
        for (int r = 0; r < 16; ++r) o[d][r] *= g * __builtin_amdgcn_rsqf(ss[r] * (1.f / 128.f) + 1e-6f); }
    store_rows<64, 128>(o, T.MIX + (rowbase + q0) * 1024 + 512 + h * 128, 1024, shm);
    asm volatile("s_waitcnt vmcnt(0) lgkmcnt(0)\n\ts_barrier" ::: "memory");
}
#undef SBAR
#undef PIN
#undef WAIT_BAR
#undef MFMA32
#undef EX
#undef MX3
}
#define GAS __attribute__((address_space(1)))
#define LAS __attribute__((address_space(3)))
typedef unsigned short bf16;
typedef unsigned v4u __attribute__((ext_vector_type(4)));
typedef float f32x4 __attribute__((ext_vector_type(4)));
typedef short bf16x8 __attribute__((ext_vector_type(8)));
typedef GAS unsigned gu32;
typedef GAS unsigned long long gu64;
#define RLX_AGENT __ATOMIC_RELAXED, __HIP_MEMORY_SCOPE_AGENT
#define LDS_WAIT() asm volatile("s_waitcnt lgkmcnt(0)" ::: "memory")
#define VM_WAIT() asm volatile("s_waitcnt vmcnt(0)" ::: "memory")
__device__ __forceinline__ unsigned long long rt() { return __builtin_amdgcn_s_memrealtime(); }
__device__ __forceinline__ unsigned f2bf(float f) { unsigned u = __builtin_bit_cast(unsigned, f); return (u + 0x7fffu + ((u >> 16) & 1u)) >> 16; }
__device__ __forceinline__ unsigned pk2(float lo, float hi) { return f2bf(lo) | (f2bf(hi) << 16); }

#define XB_TMO      128
#define XB_XCNT(j)  (256  + 64 * (j))
#define XB_XSUB(j)  (1280 + 64 * (j))
#define XB_XGEN(j)  (2304 + 64 * (j))
#define XB_TOP      3328
#define XB_TOPGEN   3392
#define XCD_BAR_WORDS 3456
#define XB_SPIN_CAP (1u << 18)

__device__ __forceinline__ unsigned xb_ld(unsigned* p)              { return __hip_atomic_load(p, __ATOMIC_RELAXED, __HIP_MEMORY_SCOPE_AGENT); }
__device__ __forceinline__ unsigned xb_add(unsigned* p, unsigned v) { return __hip_atomic_fetch_add(p, v, __ATOMIC_RELAXED, __HIP_MEMORY_SCOPE_AGENT); }
__device__ __forceinline__ unsigned xb_xcc_id() { return (unsigned)__builtin_amdgcn_s_getreg((3 << 11) | 20) & 0xFu; }
#define XB_SPIN(cond, bar) do { unsigned _sp = 0; while (cond) { __builtin_amdgcn_s_sleep(1); \
    if ((++_sp & 255u) == 0u) { if (xb_ld(&(bar)[XB_TMO])) break; if (_sp > XB_SPIN_CAP) { atomicAdd(&(bar)[XB_TMO], 1u); break; } } } } while (0)

struct XcdBarrier {
    unsigned* bar; unsigned x;
    volatile LAS unsigned* st;
};

__device__ __forceinline__ XcdBarrier xcd_barrier_post(unsigned* bar, volatile LAS unsigned* st) {
    XcdBarrier b; b.bar = bar; b.x = xb_xcc_id(); b.st = st;
    if (threadIdx.x == 0) st[2] = xb_add(&bar[XB_XCNT(b.x)], 1u);
    return b;
}
__device__ __forceinline__ void xcd_barrier_complete(unsigned* bar, unsigned x, unsigned& nloc, unsigned& nx) {
    const unsigned G = gridDim.x * gridDim.y * gridDim.z;
    unsigned sum, cnt, mine, sp = 0u;
    for (;;) {
        sum = 0u; cnt = 0u; mine = 0u;
#pragma unroll
        for (unsigned j = 0; j < 16; ++j) { const unsigned c = xb_ld(&bar[XB_XCNT(j)]); sum += c; cnt += (c > 0u) ? 1u : 0u; mine = (j == x) ? c : mine; }
        if (sum == G) break;
        __builtin_amdgcn_s_sleep(1);
        if ((++sp & 255u) == 0u) { if (xb_ld(&bar[XB_TMO])) break; if (sp > XB_SPIN_CAP) { atomicAdd(&bar[XB_TMO], 1u); break; } }
    }
    nloc = mine > 0u ? mine : 1u; nx = cnt > 0u ? cnt : 1u;
}

__device__ __forceinline__ void xcd_barrier(const XcdBarrier& b) {
    asm volatile("s_waitcnt vmcnt(0)" ::: "memory");
    __syncthreads();
    if (threadIdx.x == 0) {
        unsigned* bar = b.bar;
        __builtin_amdgcn_s_waitcnt(0);
        unsigned nloc = b.st[0], nx = b.st[1];
        if (nloc == 0u) { xcd_barrier_complete(bar, b.x, nloc, nx); b.st[0] = nloc; b.st[1] = nx; }
        const unsigned old = xb_add(&bar[XB_XSUB(b.x)], 1u);
        const unsigned gen = old / nloc;
        if (old + 1u == (gen + 1u) * nloc) {
            __builtin_amdgcn_fence(__ATOMIC_RELEASE, "agent");
            asm volatile("s_waitcnt vmcnt(0)" ::: "memory");
            const unsigned og = xb_add(&bar[XB_TOP], 1u);
            const unsigned tg = og / nx;
            if (og + 1u == (tg + 1u) * nx) xb_add(&bar[XB_TOPGEN], 1u);
            else XB_SPIN(xb_ld(&bar[XB_TOPGEN]) == tg, bar);
            __builtin_amdgcn_fence(__ATOMIC_ACQUIRE, "agent");
            xb_add(&bar[XB_XGEN(b.x)], 1u);
            asm volatile("s_waitcnt vmcnt(0)" ::: "memory");
        } else {
            XB_SPIN(xb_ld(&bar[XB_XGEN(b.x)]) == gen, bar);
            __builtin_amdgcn_fence(__ATOMIC_ACQUIRE, "agent");
            asm volatile("s_waitcnt vmcnt(0)" ::: "memory");
        }
    }
    __syncthreads();
}

__device__ __forceinline__ void xcc_barrier(const XcdBarrier& b) {
    asm volatile("s_waitcnt vmcnt(0)" ::: "memory");
    __syncthreads();
    if (threadIdx.x == 0) {
        unsigned* bar = b.bar;
        __builtin_amdgcn_s_waitcnt(0);
        const unsigned nloc = b.st[0];
        const unsigned old = xb_add(&bar[XB_XSUB(b.x)], 1u);
        const unsigned gen = old / nloc;
        if (old + 1u == (gen + 1u) * nloc) xb_add(&bar[XB_XGEN(b.x)], 1u);
        else XB_SPIN(xb_ld(&bar[XB_XGEN(b.x)]) == gen, bar);
        __builtin_amdgcn_fence(__ATOMIC_ACQUIRE, "agent");
        asm volatile("s_waitcnt vmcnt(0)" ::: "memory");
    }
    __syncthreads();
}
__device__ __forceinline__ bool xcc_team_setup(const XcdBarrier& b) {
    if (threadIdx.x < 64) { const unsigned G = gridDim.x, j = threadIdx.x & 15u;
        const unsigned c = xb_ld(&b.bar[XB_XCNT(j)]);
        const bool okl = (j < 8u) ? (c == G / 8u) : (c == 0u);
        const bool ok = ((G % 8u) == 0u) && (__all(okl ? 1 : 0) != 0);
        if (threadIdx.x == 0) b.st[3] = ok ? 1u : 0u; }
    __syncthreads();
    return b.st[3] != 0u;
}

constexpr int NWAVES = 8;
constexpr int M_TOK = 32768, D_MODEL = 1024, SEQ_L = 4096, FFN_H = 2816, IN_COLS = 1952;
constexpr size_t MiB = 1u << 20;
constexpr size_t WS_CTL = 0, CTL_ZERO_BYTES = 128 * 1024;
constexpr size_t WS_WIN = 2 * MiB;
constexpr size_t WS_WQKV = 6 * MiB;
constexpr size_t WS_WO = 8 * MiB;
constexpr size_t WS_WGU = 10 * MiB;
constexpr size_t WS_WD = 22 * MiB;
constexpr size_t WS_XCH = 27 * MiB + 512 * 1024;
constexpr size_t WS_ROPE = 28 * MiB;
constexpr size_t WS_RSTDX = 28 * MiB + 512 * 1024;
constexpr size_t WS_SSQQ = 29 * MiB;
constexpr size_t WS_SSQKV = 29 * MiB + 512 * 1024;
constexpr size_t WS_SSQX1 = 30 * MiB;
constexpr size_t WS_XN = 32 * MiB;
constexpr size_t WS_CQKV = 96 * MiB;
constexpr size_t WS_KR = 120 * MiB;
constexpr size_t WS_DQ = 128 * MiB, WS_DK = 160 * MiB, WS_DV = 192 * MiB;
constexpr size_t WS_QA = 224 * MiB;
constexpr size_t WS_KN = 272 * MiB, WS_VA = 304 * MiB;
constexpr size_t WS_MIX = 336 * MiB;
constexpr size_t WS_OB = 400 * MiB;
constexpr size_t WS_H = 96 * MiB;
constexpr size_t WS_END = 464 * MiB;
static_assert(WS_H + (size_t)M_TOK * FFN_H * 2 <= WS_MIX, "h overlay");
constexpr int CW_TMO = 0, CW_CODE = 1, CW_BAR = 4096, CW_SEAM = 16384;
constexpr int RING_OFF = 0, RING_BYTES = 131072;
constexpr int LDS_BYTES = 147456;
constexpr int XL_OFF = RING_BYTES;
constexpr int LDSCTL_OFF = LDS_BYTES - 1024, MISC_OFF = LDSCTL_OFF + 320;
static_assert(att::Lay<64, 128>::LDS_END <= LDSCTL_OFF && att::Lay<96, 64>::LDS_END <= LDSCTL_OFF, "attention scratch stays below the control words");

struct Args { const float* in[19]; float* out; unsigned char* ws; int ph_lo, ph_hi; };
static_assert(sizeof(Args) == 19 * 8 + 8 + 8 + 8, "no padding in Args");

__device__ __forceinline__ float wave_sum(float v) {
#pragma unroll
    for (int o = 1; o < 64; o <<= 1) v += __shfl_xor(v, o);
    return v;
}
__device__ __forceinline__ void transpose_item(const float* W, int ldw, const float* gain, bf16* WT, int ldt, LAS float* scr, int ks0, int kd0, int drow0, int srccol, int lane) {
    float v[32]; const int sc = srccol < 0 ? 0 : srccol;
#pragma unroll
    for (int i = 0; i < 32; ++i) { const int kk = 2 * i + (lane >> 5); v[i] = __builtin_nontemporal_load(&W[(size_t)(ks0 + kk) * ldw + sc]); }
    if (gain) {
        float gg[32];
#pragma unroll
        for (int i = 0; i < 32; ++i) { const int kk = 2 * i + (lane >> 5); gg[i] = gain[ks0 + kk]; }
#pragma unroll
        for (int i = 0; i < 32; ++i) v[i] *= gg[i];
    }
#pragma unroll
    for (int i = 0; i < 32; ++i) { const int kk = 2 * i + (lane >> 5); scr[kk * 33 + (lane & 31)] = srccol < 0 ? 0.f : v[i]; }
    LDS_WAIT(); asm volatile("" ::: "memory");
    const int c = lane & 7;
#pragma unroll
    for (int j = 0; j < 4; ++j) { const int n = (lane >> 3) + 8 * j; const LAS float* s = scr + (8 * c) * 33 + n;
        v4u o; o.x = pk2(s[0 * 33], s[1 * 33]); o.y = pk2(s[2 * 33], s[3 * 33]); o.z = pk2(s[4 * 33], s[5 * 33]); o.w = pk2(s[6 * 33], s[7 * 33]);
        *(GAS v4u*)(WT + (size_t)(drow0 + n) * ldt + kd0 + 8 * c) = o; }
    LDS_WAIT(); asm volatile("" ::: "memory");
}
__device__ __forceinline__ int map_win(int n) {
    if (n < 256) return n;
    if (n < 512) { const int j = n - 256; if (j < 128) return 256 + j; if (j < 160) { const int p = j - 128; return 384 + (p >> 1) + 16 * (p & 1); } return -1; }
    return 416 + (n - 512);
}
__device__ __forceinline__ int map_wq(int n) {
    if (n < 512) return (n >> 6) * 96 + (n & 63);
    const int j = n - 512, h = j >> 5, p = j & 31; return h * 96 + 64 + (p >> 1) + 16 * (p & 1);
}
__device__ __forceinline__ int map_wkv(int n) {
    if (n < 512) return (n >> 6) * 128 + (n & 63);
    const int j = n - 512; return (j >> 6) * 128 + 64 + (j & 63);
}

__constant__ float ROPE_INV_FREQ[16] = {1.0f, 0.5623413324356079f, 0.3162277638912201f, 0.17782793939113617f, 0.10000000149011612f, 0.05623413249850273f, 0.03162277489900589f, 0.017782794311642647f,
    0.009999999776482582f, 0.005623413249850273f, 0.003162277629598975f, 0.0017782794311642647f, 0.0010000000474974513f, 0.000562341301701963f, 0.0003162277571391314f, 0.00017782794020604342f};

struct Frame {
    LAS unsigned char* lds; volatile LAS unsigned* MISC; gu32* ctl;
    int wave, vcu, G;
};

__global__ void __launch_bounds__(NWAVES * 64, 2) hyb_fwd(Args args) {
    extern __shared__ __attribute__((aligned(16))) unsigned char lds[];
    Frame F;
    F.lds = (LAS unsigned char*)lds; F.MISC = (volatile LAS unsigned*)(F.lds + MISC_OFF);
    F.wave = __builtin_amdgcn_readfirstlane((int)threadIdx.x >> 6);
    F.G = gridDim.x; { const int bx = blockIdx.x; F.vcu = (F.G % 8 == 0) ? (bx % 8) * (F.G / 8) + bx / 8 : bx; }
    F.ctl = (gu32*)(args.ws + WS_CTL);
#define CAS __attribute__((address_space(4)))
#define PH_BEGIN() const CAS char* kap_ = (const CAS char*)__builtin_amdgcn_kernarg_segment_ptr(); asm volatile("" : "+s"(kap_)); unsigned char* const ws = *(unsigned char* const CAS*)(kap_ + 160)
#define INP(k) (*(const float* const CAS*)(kap_ + 8 * (k)))
#define OUTP() (*(float* const CAS*)(kap_ + 152))
#define Win_t ((bf16*)(ws + WS_WIN))
#define Wqkv_t ((bf16*)(ws + WS_WQKV))
#define Wo_t ((bf16*)(ws + WS_WO))
#define Wgu_t ((bf16*)(ws + WS_WGU))
#define Wd_t ((bf16*)(ws + WS_WD))
#define ROPE ((float*)(ws + WS_ROPE))
#define RSTDX ((float*)(ws + WS_RSTDX))
#define SSQ_Q ((float*)(ws + WS_SSQQ))
#define SSQ_KV ((float*)(ws + WS_SSQKV))
#define SSQ_X1 ((float*)(ws + WS_SSQX1))
#define XN ((bf16*)(ws + WS_XN))
#define CQKV ((bf16*)(ws + WS_CQKV))
#define KR ((bf16*)(ws + WS_KR))
#define DQ ((bf16*)(ws + WS_DQ))
#define DK ((bf16*)(ws + WS_DK))
#define DVb ((bf16*)(ws + WS_DV))
#define QA ((bf16*)(ws + WS_QA))
#define KN ((bf16*)(ws + WS_KN))
#define VA ((bf16*)(ws + WS_VA))
#define MIX ((bf16*)(ws + WS_MIX))
#define OB ((float*)(ws + WS_OB))
#define X1B ((bf16*)(ws + WS_OB))
#define HB ((bf16*)(ws + WS_H))
    for (int u = threadIdx.x; u < (LDS_BYTES - LDSCTL_OFF) / 4; u += NWAVES * 64) ((LAS unsigned*)(F.lds + LDSCTL_OFF))[u] = 0u;
    __syncthreads();
    XcdBarrier bar = xcd_barrier_post((unsigned*)(F.ctl + CW_BAR), F.MISC + 8);
    const int lo = args.ph_lo, hi = args.ph_hi;
#ifndef PHASES
#define PHASES 0xFF
#endif
#define IN(k) (((PHASES >> (k)) & 1) && lo <= (k) && (k) < hi)
#define BOTH(k) (IN(k) && IN((k) + 1))
#define GRID_BAR() do { if (team) xcc_barrier(bar); else xcd_barrier(bar); } while (0)
    bool team = false; int bxv = (int)blockIdx.x;
#ifndef PROBE_REPEAT
#define PROBE_REPEAT -1
#endif
#define REPS(k) ((PROBE_REPEAT == (k)) ? reps2 : 1)
    int reps2 = 2; asm volatile("" : "+s"(reps2));
    const int gw = F.vcu * NWAVES + F.wave, NGW = F.G * NWAVES;

    if (IN(0)) _Pragma("nounroll") for (int rep_ = 0; rep_ < REPS(0); ++rep_) {
        PH_BEGIN(); const int tid_ = att::otid(), lane_ = tid_ & 63;
        const float* x = INP(0); const float* w_in = INP(1); const float* g_attn = INP(2); const float* g_q_a = INP(3); const float* w_q_b = INP(4); const float* g_kv_a = INP(5); const float* w_kv_b = INP(6);
        const float* w_o = INP(13); const float* g_ffn = INP(14); const float* w_gate = INP(15); const float* w_up = INP(16); const float* w_down = INP(17);
        LAS float* scr = (LAS float*)(F.lds + RING_OFF + F.wave * 16384);
        constexpr int I_IN = 16 * 64, I_Q = 4 * 24, I_KV = 2 * 32, I_O = 16 * 32, I_GU = 16 * 176, I_D = 44 * 32;
        constexpr int NITEMS = I_IN + I_Q + I_KV + I_O + I_GU + I_D;
        for (int it = gw; it < NITEMS; it += NGW) {
            int r = it; const int l31 = lane_ & 31;
            if (r < I_IN) { const int kb = r / 64, nb = r % 64; transpose_item(w_in, IN_COLS, g_attn, Win_t, 1024, scr, 64 * kb, 64 * kb, 32 * nb, map_win(32 * nb + l31), lane_); continue; } r -= I_IN;
            if (r < I_Q) { const int kb = r / 24, nb = r % 24; transpose_item(w_q_b, 768, g_q_a, Wqkv_t, 384, scr, 64 * kb, 64 * kb, 32 * nb, map_wq(32 * nb + l31), lane_); continue; } r -= I_Q;
            if (r < I_KV) { const int kb = r / 32, nb = r % 32; transpose_item(w_kv_b, 1024, g_kv_a, Wqkv_t, 384, scr, 64 * kb, 256 + 64 * kb, 768 + 32 * nb, map_wkv(32 * nb + l31), lane_); continue; } r -= I_KV;
            if (r < I_O) { const int kb = r / 32, nb = r % 32; transpose_item(w_o, 1024, nullptr, Wo_t, 1024, scr, 64 * kb, 64 * kb, 32 * nb, 32 * nb + l31, lane_); continue; } r -= I_O;
            if (r < I_GU) { const int kb = r / 176, nb = r % 176; const int n = 32 * nb + l31, pn = n >> 8, j = n & 255; const bool up = j >= 128;
                transpose_item(up ? w_up : w_gate, FFN_H, g_ffn, Wgu_t, 1024, scr, 64 * kb, 64 * kb, 32 * nb, 128 * pn + (j & 127), lane_); continue; } r -= I_GU;
            { const int kb = r / 32, nb = r % 32; transpose_item(w_down, 1024, nullptr, Wd_t, FFN_H, scr, 64 * kb, 64 * kb, 32 * nb, 32 * nb + l31, lane_); }
        }
        { const int gt = F.vcu * (NWAVES * 64) + tid_, NGT = F.G * NWAVES * 64; const v4u z = (v4u){0u, 0u, 0u, 0u};
          for (int i = gt; i < 768 * 16; i += NGT) *(GAS v4u*)(Wqkv_t + (size_t)(i >> 4) * 384 + 256 + (i & 15) * 8) = z;
          for (int i = gt; i < 1024 * 32; i += NGT) *(GAS v4u*)(Wqkv_t + (size_t)(768 + (i >> 5)) * 384 + (i & 31) * 8) = z;
          for (int i = gt; i < SEQ_L * 16; i += NGT) { const int pos = i >> 4, k = i & 15; const float ang = (float)pos * ROPE_INV_FREQ[k];
              const double t = (double)ang * 0.15915494309189535; const float fr = (float)(t - __builtin_rint(t));
              ROPE[2 * i] = __builtin_amdgcn_cosf(fr); ROPE[2 * i + 1] = __builtin_amdgcn_sinf(fr); } }
        { for (int m = gw; m < M_TOK; m += 4 * NGW) { f32x4 v[4][4]; float s[4];
#pragma unroll
              for (int q = 0; q < 4; ++q) { const GAS f32x4* xr = (const GAS f32x4*)(x + (size_t)(m + q * NGW) * D_MODEL) + lane_;
#pragma unroll
                  for (int j = 0; j < 4; ++j) v[q][j] = __builtin_nontemporal_load(&xr[64 * j]); }
#pragma unroll
              for (int q = 0; q < 4; ++q) { float t = 0.f;
#pragma unroll
                  for (int j = 0; j < 4; ++j) t += (v[q][j].x * v[q][j].x + v[q][j].y * v[q][j].y) + (v[q][j].z * v[q][j].z + v[q][j].w * v[q][j].w);
                  s[q] = t; }
#pragma unroll
              for (int o = 1; o < 64; o <<= 1)
#pragma unroll
                  for (int q = 0; q < 4; ++q) s[q] += __shfl_xor(s[q], o);
#pragma unroll
              for (int q = 0; q < 4; ++q) { const float rstd = __builtin_amdgcn_rsqf(s[q] * (1.f / D_MODEL) + 1e-6f);
                  GAS unsigned long long* o8 = (GAS unsigned long long*)(XN + (size_t)(m + q * NGW) * D_MODEL) + lane_;
#pragma unroll
                  for (int j = 0; j < 4; ++j) { const f32x4 y = v[q][j]; o8[64 * j] = (unsigned long long)pk2(y.x, y.y) | ((unsigned long long)pk2(y.z, y.w) << 32); }
                  if (lane_ == 0) RSTDX[m + q * NGW] = rstd; } } }
        if (BOTH(0) && rep_ == REPS(0) - 1) { xcd_barrier(bar);
#ifndef NO_TEAM
            team = xcc_team_setup(bar);
            if (team) { const int rank = (int)bar.st[2]; bxv = rank * 8 + (int)bar.x; F.vcu = (int)bar.x * (F.G / 8) + rank;
#if defined(STAGGER_TICKS) && STAGGER_TICKS > 0
                { const unsigned long long t0 = __builtin_amdgcn_s_memrealtime(), dt = (unsigned long long)bar.x * STAGGER_TICKS; while (__builtin_amdgcn_s_memrealtime() - t0 < dt) __builtin_amdgcn_s_sleep(8); }
#endif
            }
#endif
        }
        if (PROBE_REPEAT == 9 && rep_ == 0) { _Pragma("nounroll") for (int q_ = 0; q_ < 4 * reps2; ++q_) GRID_BAR(); }
    }
    if (IN(1)) _Pragma("nounroll") for (int rep_ = 0; rep_ < REPS(1); ++rep_) {
        PH_BEGIN();
        pg8::Gemm g{XN, Win_t, M_TOK, 2048, D_MODEL}; pg8::StaticOrder S; S.init(M_TOK, 2048, F.G, bxv);
        pg8::EpiInProj E{CQKV, KR, DQ, DK, DVb, SSQ_Q, SSQ_KV, ROPE, RSTDX, 0.125f * 1.4426950408889634f};
        pg8::gemm_phase<pg8::EpiInProj, pg8::StaticOrder, true, true>(F.lds + RING_OFF, g, S, E);
        if (BOTH(1) && rep_ == REPS(1) - 1) GRID_BAR();
    }
    if (IN(2)) _Pragma("nounroll") for (int rep_ = 0; rep_ < REPS(2); ++rep_) {
        PH_BEGIN();
        int kq_ = 384; asm volatile("" : "+s"(kq_));
        pg8::Gemm g{CQKV, Wqkv_t, M_TOK, 1792, kq_}; pg8::SplitOrder S; S.init(M_TOK, 1792, F.G, bxv);
        pg8::EpiQKV E{QA, KN, VA, SSQ_Q, SSQ_KV, ROPE, 0.10206207261596575f * 1.4426950408889634f};
        pg8::gemm_phase<pg8::EpiQKV, pg8::SplitOrder, true, true>(F.lds + RING_OFF, g, S, E);
        if (BOTH(2) && rep_ == REPS(2) - 1) GRID_BAR();
    }
    if (IN(3)) _Pragma("nounroll") for (int rep_ = 0; rep_ < REPS(3); ++rep_) {
        PH_BEGIN();
        const float* lam_q1 = INP(7); const float* lam_k1 = INP(8); const float* lam_q2 = INP(9); const float* lam_k2 = INP(10); const float* g_subln = INP(11); const float* rel_bias = INP(12);
        char* shm = (char*)lds + RING_OFF;
#ifndef ATT_ONLY
#define ATT_ONLY 3
#endif
        if (ATT_ONLY & 1) { const att::MlaT T{QA, KN, KR, VA, MIX}; const int bb = F.vcu >> 5, v = F.vcu & 31;
          for (int i = 0; i < 4; ++i) { const int qb = (i & 1) ? 15 - (v & 15) : (v & 15); att::mla_unit(bb, 2 * i + (v >> 4), qb, T, shm); } }
        if (ATT_ONLY & 2) { float lam;
          { const float a = wave_sum(lam_q1[att::otid() & 63] * lam_k1[att::otid() & 63]), b2 = wave_sum(lam_q2[att::otid() & 63] * lam_k2[att::otid() & 63]); lam = __expf(a) - __expf(b2) + 0.2f; }
          const att::DiffT T{DQ, DK, DVb, MIX, OB, rel_bias, g_subln, lam}; const int bb = F.vcu >> 5, v = F.vcu & 31;
          for (int i = 0; i < 2; ++i) { const int qb = (i & 1) ? 15 - (v & 15) : (v & 15); att::diff_unit(bb, 2 * i + (v >> 4), qb, T, shm); } }
        if (BOTH(3) && rep_ == REPS(3) - 1) GRID_BAR();
    }
    if (IN(4)) _Pragma("nounroll") for (int rep_ = 0; rep_ < REPS(4); ++rep_) {
        PH_BEGIN();
        pg8::Gemm g{MIX, Wo_t, M_TOK, D_MODEL, D_MODEL}; pg8::StaticOrder S; S.init(M_TOK, D_MODEL, F.G, bxv);
        pg8::EpiOutProj E{XN, X1B, SSQ_X1};
        pg8::gemm_phase<pg8::EpiOutProj, pg8::StaticOrder, true, true>(F.lds + RING_OFF, g, S, E);
        if (BOTH(4) && rep_ == REPS(4) - 1) GRID_BAR();
    }
    if (IN(5)) _Pragma("nounroll") for (int rep_ = 0; rep_ < REPS(5); ++rep_) {
        PH_BEGIN();
        pg8::Gemm g{X1B, Wgu_t, M_TOK, 2 * FFN_H, D_MODEL}; pg8::StaticOrder S; S.init(M_TOK, 2 * FFN_H, F.G, bxv);
        const pg8::HMap hm{ws, WS_XN, WS_MIX, WS_DQ, WS_DK, WS_DV}; pg8::EpiGateUp E{hm, SSQ_X1};
        pg8::gemm_phase<pg8::EpiGateUp, pg8::StaticOrder, true, true>(F.lds + RING_OFF, g, S, E);
        if (BOTH(5) && rep_ == REPS(5) - 1) GRID_BAR();
    }
    if (IN(6)) _Pragma("nounroll") for (int rep_ = 0; rep_ < REPS(6); ++rep_) {
        PH_BEGIN(); float* out = OUTP(); const float* g_final = INP(18);
        pg8::Gemm g{HB, Wd_t, M_TOK, D_MODEL, FFN_H}; pg8::PanelOrder S; S.init(M_TOK, D_MODEL, F.G, bxv); S.hm = pg8::HMap{ws, WS_XN, WS_MIX, WS_DQ, WS_DK, WS_DV};
        pg8::EpiDownNorm E{X1B, out, g_final, (unsigned*)(ws + WS_XCH), (unsigned*)(F.ctl + CW_SEAM), F.lds + XL_OFF};
        pg8::gemm_phase<pg8::EpiDownNorm, pg8::PanelOrder, true, true>(F.lds + RING_OFF, g, S, E);
    }
#undef IN
#undef BOTH
#undef GRID_BAR
}

#ifndef MK_N_LAUNCHES
#define MK_N_LAUNCHES 1
#endif
extern "C" void kernel_launch(void* const* d_in, const int* in_sizes, int n_in, void* d_out, int out_size, void* d_ws, size_t ws_size, hipStream_t stream) {
    static int grid = 0;
    if (grid == 0) {
        if (n_in != 19 || in_sizes[0] != M_TOK * D_MODEL || out_size != M_TOK * D_MODEL || ws_size < WS_END) { fprintf(stderr, "kernel_launch: unexpected shapes (n_in %d, in0 %d, out %d, ws %zu)\n", n_in, n_in > 0 ? in_sizes[0] : -1, out_size, ws_size); grid = -1; return; }
        int dev = 0, cus = 0, per_cu = 0;
        if (hipGetDevice(&dev) != hipSuccess || hipDeviceGetAttribute(&cus, hipDeviceAttributeMultiprocessorCount, dev) != hipSuccess) { grid = -1; return; }
        if (hipFuncSetAttribute((const void*)hyb_fwd, hipFuncAttributeMaxDynamicSharedMemorySize, LDS_BYTES) != hipSuccess) { fprintf(stderr, "kernel_launch: hipFuncSetAttribute failed\n"); grid = -1; return; }
        if (hipOccupancyMaxActiveBlocksPerMultiprocessor(&per_cu, (const void*)hyb_fwd, NWAVES * 64, LDS_BYTES) != hipSuccess || per_cu < 1) fprintf(stderr, "kernel_launch: occupancy query reports %d\n", per_cu);
        (void)hipGetLastError();
        grid = cus;
        if (grid != 256) fprintf(stderr, "kernel_launch: %d CUs (built for 256)\n", grid);
    }
    if (grid < 0) return;
    if (hipMemsetAsync((char*)d_ws + WS_CTL, 0, CTL_ZERO_BYTES, stream) != hipSuccess) return;
    Args a{};
    for (int i = 0; i < 19; ++i) a.in[i] = (const float*)d_in[i];
    a.out = (float*)d_out; a.ws = (unsigned char*)d_ws;
    if (MK_N_LAUNCHES == 1) { a.ph_lo = 0; a.ph_hi = 7; hipLaunchKernelGGL(hyb_fwd, dim3(grid), dim3(NWAVES * 64), LDS_BYTES, stream, a); }
    else { for (int p = 0; p < 7; ++p) { a.ph_lo = p; a.ph_hi = p + 1; hipLaunchKernelGGL(hyb_fwd, dim3(grid), dim3(NWAVES * 64), LDS_BYTES, stream, a); } }
}
```

```cpp
#include <hip/hip_runtime.h>
#include <cstdio>
#include <cstdint>
namespace pg8 {
#define PG8_LAS __attribute__((address_space(3)))
typedef unsigned short bf16_t;
typedef short bf16x8 __attribute__((ext_vector_type(8)));
typedef float f32x4 __attribute__((ext_vector_type(4)));
typedef unsigned u32x4 __attribute__((ext_vector_type(4)));
constexpr int BM = 256, BK = 64, HALF = 128, HTB = HALF * BK * 2  , STAGE_BYTES = 8 * HTB, NXCD = 8, WGM = 8;

__host__ __device__ __forceinline__ int lds_byte(int r, int c) { const int st = (r >> 4) * 2 + (c >> 5), rr = r & 15, cc = c & 31, ob = rr * 64 + cc * 2; return st * 1024 + (ob ^ (((ob >> 9) & 1) << 5)); }
__host__ __device__ __forceinline__ void stage_rc(int b, int& R, int& C) { const int st = b / 1024, sb = b % 1024, swz = sb ^ (((sb >> 9) & 1) << 5); R = (st >> 1) * 16 + swz / 64; C = (st & 1) * 32 + (swz % 64) / 2; }
__host__ __device__ __forceinline__ int perm32(int rho) { const int n = rho >> 4, i = rho & 15; return 8 * (i >> 2) + 4 * n + (i & 3); }

struct Unit { int pm, pn; int kofs, nt; };
struct Gemm { const bf16_t* A; const bf16_t* Bt; int M, N, K; };

struct StaticOrder {
    static constexpr bool KSPLIT = false, APANEL = false;
    int nM, nN, nwg, G, c;
    __host__ __device__ void init(int M, int N, int G_, int c_) { nM = M / BM; nN = N / BM; nwg = nM * nN; G = G_; c = c_; }
    __host__ __device__ bool next(int i, Unit& u) const {
        const long L = (long)i * G + c; if (L >= nwg) return false;
        int wgid = (int)L; { const int q = nwg / NXCD, r = nwg % NXCD, xcd = wgid % NXCD, off = wgid / NXCD; wgid = (xcd < r ? xcd * (q + 1) : r * (q + 1) + (xcd - r) * q) + off; }
        const int nig = WGM * nN, gid = wgid / nig, fm = gid * WGM, gsz = (nM - fm) < WGM ? (nM - fm) : WGM;
        u.pm = fm + ((wgid % nig) % gsz); u.pn = (wgid % nig) / gsz; return true;
    }
    __device__ __forceinline__ void a_ready(const Unit&) const {}
    __device__ __forceinline__ void done(const Unit&) const {}
};

typedef float f32x2p __attribute__((ext_vector_type(2))); typedef __bf16 bf16x2p __attribute__((ext_vector_type(2)));
__device__ __forceinline__ unsigned cvt_pk_bf16(float lo, float hi) { f32x2p v = {lo, hi}; bf16x2p b = __builtin_convertvector(v, bf16x2p); return __builtin_bit_cast(unsigned, b); }
typedef float f32x2 __attribute__((ext_vector_type(2)));
__device__ __forceinline__ u32x4 pack8(const f32x4 a, const f32x4 b) { u32x4 w; w.x = cvt_pk_bf16(a[0], a[1]); w.y = cvt_pk_bf16(a[2], a[3]); w.z = cvt_pk_bf16(b[0], b[1]); w.w = cvt_pk_bf16(b[2], b[3]); return w; }
__device__ __forceinline__ float sq8(const f32x4 a, const f32x4 b) { return ((a[0] * a[0] + a[1] * a[1]) + (a[2] * a[2] + a[3] * a[3])) + ((b[0] * b[0] + b[1] * b[1]) + (b[2] * b[2] + b[3] * b[3])); }
__device__ __forceinline__ float fq_sum(float s) {
    s += __int_as_float(__builtin_amdgcn_ds_swizzle(__float_as_int(s), (16 << 10) | 0x1f));
    auto rr = __builtin_amdgcn_permlane32_swap(__float_as_uint(s), __float_as_uint(s), false, false); return __uint_as_float(rr[0]) + __uint_as_float(rr[1]); }
__device__ __forceinline__ void rope8(f32x4& v0, f32x4& v1, const f32x4 cs0, const f32x4 cs1) {
    const float a0 = v0[0] * cs0[0] - v0[1] * cs0[1], b0 = v0[1] * cs0[0] + v0[0] * cs0[1];
    const float a1 = v0[2] * cs0[2] - v0[3] * cs0[3], b1 = v0[3] * cs0[2] + v0[2] * cs0[3];
    const float a2 = v1[0] * cs1[0] - v1[1] * cs1[1], b2 = v1[1] * cs1[0] + v1[0] * cs1[1];
    const float a3 = v1[2] * cs1[2] - v1[3] * cs1[3], b3 = v1[3] * cs1[2] + v1[2] * cs1[3];
    v0 = (f32x4){a0, b0, a1, b1}; v1 = (f32x4){a2, b2, a3, b3};
}
constexpr int SEQ_LEN = 4096;
constexpr float RMS_EPS = 1e-6f;

__device__ __forceinline__ u32x4 tr16x4(const u32x4 w, const int bidx) { u32x4 r; r.x = __builtin_amdgcn_ds_bpermute(bidx, w.x); r.y = __builtin_amdgcn_ds_bpermute(bidx, w.y); r.z = __builtin_amdgcn_ds_bpermute(bidx, w.z); r.w = __builtin_amdgcn_ds_bpermute(bidx, w.w); return r; }
#define EPI_LANE_T() const int bidx = (((t2_ & 3) * 16) + ((t2_ >> 2) & 15)) * 4, fr2 = (t2_ >> 2) & 15, fq2 = t2_ & 3
#define EPI_LANE() { int t_ = threadIdx.x; asm volatile("" : "+v"(t_)); fr = t_ & 15; fq = (t_ >> 4) & 3; }
struct EpiInProj {
    static constexpr bool PERM = true, AFTER_DRAIN = false;
    bf16_t *CQKV, *KR, *DQ, *DK, *DV; float *SSQ_Q, *SSQ_KV; const float* rope; const float* rstdx; float c2d;
    __device__ __forceinline__ void operator()(f32x4 (&acc)[2][2][4][2], const Unit& u, int wr, int wc, int fr, int fq) const {
        EPI_LANE(); int t2_ = threadIdx.x; asm volatile("" : "+v"(t2_)); EPI_LANE_T(); const int row2 = u.pm * BM + wr * 64 + fr2, cw2 = wc * 32 + 8 * fq2;
        const int row0 = u.pm * BM + wr * 64 + fr, cw = wc * 32 + 8 * fq;
        { float rx[2][4];
#pragma unroll
          for (int ai = 0; ai < 2; ++ai)
#pragma unroll
              for (int m = 0; m < 4; ++m) rx[ai][m] = rstdx[row0 + ai * HALF + m * 16];
#pragma unroll
          for (int ai = 0; ai < 2; ++ai)
#pragma unroll
              for (int m = 0; m < 4; ++m)
#pragma unroll
                  for (int bj = 0; bj < 2; ++bj) { acc[ai][bj][m][0] *= rx[ai][m]; acc[ai][bj][m][1] *= rx[ai][m]; } }
        if (u.pn == 0) {
#pragma unroll
            for (int ai = 0; ai < 2; ++ai)
#pragma unroll
                for (int m = 0; m < 4; ++m) { const size_t row = (size_t)(row0 + ai * HALF + m * 16); float s = 0.f;
#pragma unroll
                    for (int bj = 0; bj < 2; ++bj) { const f32x4 v0 = acc[ai][bj][m][0], v1 = acc[ai][bj][m][1]; s += sq8(v0, v1); *(u32x4*)(CQKV + (size_t)(row2 + ai * HALF + m * 16) * 384 + bj * HALF + cw2) = tr16x4(pack8(v0, v1), bidx); }
                    s = fq_sum(s); if (fq == 0) SSQ_Q[row * 4 + wc] = s; }
        } else if (u.pn == 1) {
            f32x4 cs[2][4][2];
            if (wc == 0) {
#pragma unroll
                for (int ai = 0; ai < 2; ++ai)
#pragma unroll
                    for (int m = 0; m < 4; ++m) { const float* t = rope + (size_t)((row0 + ai * HALF + m * 16) & (SEQ_LEN - 1)) * 32 + 8 * fq; cs[ai][m][0] = *(const f32x4*)t; cs[ai][m][1] = *(const f32x4*)(t + 4); }
            }
#pragma unroll
            for (int ai = 0; ai < 2; ++ai)
#pragma unroll
                for (int m = 0; m < 4; ++m) { const size_t row = (size_t)(row0 + ai * HALF + m * 16);
                    { const f32x4 v0 = acc[ai][0][m][0], v1 = acc[ai][0][m][1]; float s = sq8(v0, v1); *(u32x4*)(CQKV + (size_t)(row2 + ai * HALF + m * 16) * 384 + 256 + cw2) = tr16x4(pack8(v0, v1), bidx);
                      s = fq_sum(s); if (fq == 0) SSQ_KV[row * 4 + wc] = s; }
                    if (wc == 0) { f32x4 v0 = acc[ai][1][m][0], v1 = acc[ai][1][m][1]; rope8(v0, v1, cs[ai][m][0], cs[ai][m][1]); *(u32x4*)(KR + (size_t)(row2 + ai * HALF + m * 16) * 32 + 8 * fq2) = tr16x4(pack8(v0, v1), bidx); } }
        } else {
            bf16_t* dst = DQ + (size_t)((u.pn - 2) >> 1) * ((size_t)32768 * 512); const int cb2 = ((u.pn - 2) & 1) * 256 + cw2; const float sc = u.pn < 4 ? c2d : 1.f;
#pragma unroll
            for (int ai = 0; ai < 2; ++ai)
#pragma unroll
                for (int m = 0; m < 4; ++m) { const size_t row = (size_t)(row0 + ai * HALF + m * 16);
#pragma unroll
                    for (int bj = 0; bj < 2; ++bj) *(u32x4*)(dst + (size_t)(row2 + ai * HALF + m * 16) * 512 + cb2 + bj * HALF) = tr16x4(pack8(acc[ai][bj][m][0] * sc, acc[ai][bj][m][1] * sc), bidx); }
        }
    }
};
struct EpiQKV {
    static constexpr bool PERM = true, AFTER_DRAIN = false;
    bf16_t *QA, *KN, *VA; const float *SSQ_Q, *SSQ_KV; const float* rope; float c2a;
    __device__ __forceinline__ void rstd4(float (&rs)[4], const float* ssq, int rowb, float inv, float mul) const {
        f32x4 pp[4];
#pragma unroll
        for (int m = 0; m < 4; ++m) pp[m] = *(const f32x4*)(ssq + (size_t)(rowb + m * 16) * 4);
#pragma unroll
        for (int m = 0; m < 4; ++m) rs[m] = __builtin_amdgcn_rsqf(((pp[m][0] + pp[m][1]) + (pp[m][2] + pp[m][3])) * inv + RMS_EPS) * mul;
    }
    __device__ __forceinline__ void rstd8(float (&rs)[2][4], const float* ssq, int rowb, float inv, float mul) const {
        f32x4 pp[2][4];
#pragma unroll
        for (int ai = 0; ai < 2; ++ai)
#pragma unroll
            for (int m = 0; m < 4; ++m) pp[ai][m] = *(const f32x4*)(ssq + (size_t)(rowb + ai * HALF + m * 16) * 4);
#pragma unroll
        for (int ai = 0; ai < 2; ++ai)
#pragma unroll
            for (int m = 0; m < 4; ++m) rs[ai][m] = __builtin_amdgcn_rsqf(((pp[ai][m][0] + pp[ai][m][1]) + (pp[ai][m][2] + pp[ai][m][3])) * inv + RMS_EPS) * mul;
    }
    __device__ __forceinline__ void operator()(const f32x4 (&acc)[2][2][4][2], const Unit& u, int wr, int wc, int fr, int fq) const {
        EPI_LANE(); int t2_ = threadIdx.x; asm volatile("" : "+v"(t2_)); EPI_LANE_T(); const int row2 = u.pm * BM + wr * 64 + fr2, cw2 = wc * 32 + 8 * fq2;
        const int row0 = u.pm * BM + wr * 64 + fr, cw = wc * 32 + 8 * fq;
        if (u.pn < 2) {
            float rs2[2][4]; rstd8(rs2, SSQ_Q, row0, 1.f / 256.f, c2a);
#pragma unroll
            for (int ai = 0; ai < 2; ++ai) { const float (&rs)[4] = rs2[ai];
#pragma unroll
                for (int m = 0; m < 4; ++m) { const size_t row = (size_t)(row0 + ai * HALF + m * 16);
#pragma unroll
                    for (int bj = 0; bj < 2; ++bj) { const int n = u.pn * 256 + bj * HALF + cw2; *(u32x4*)(QA + (size_t)(row2 + ai * HALF + m * 16) * 768 + (n >> 6) * 96 + (n & 63)) = tr16x4(pack8(acc[ai][bj][m][0] * rs[m], acc[ai][bj][m][1] * rs[m]), bidx); } }
                asm volatile("" ::: "memory"); }
        } else if (u.pn == 2) {
            float rs2[2][4]; rstd8(rs2, SSQ_Q, row0, 1.f / 256.f, c2a);
            f32x4 cs[2][2][2];
#define QKV_CS_LOAD(B_, AI_, MP_) _Pragma("unroll") for (int mm = 0; mm < 2; ++mm) { const float* t = rope + (size_t)((row0 + (AI_) * HALF + (2 * (MP_) + mm) * 16) & (SEQ_LEN - 1)) * 32 + 8 * fq; cs[B_][mm][0] = *(const f32x4*)t; cs[B_][mm][1] = *(const f32x4*)(t + 4); }
            QKV_CS_LOAD(0, 0, 0);
#pragma unroll
            for (int ib = 0; ib < 4; ++ib) { const int ai = ib >> 1, mp = ib & 1, bb = ib & 1;
                if (ib + 1 < 4) { QKV_CS_LOAD((ib + 1) & 1, (ib + 1) >> 1, (ib + 1) & 1); }
#pragma unroll
                for (int mm = 0; mm < 2; ++mm) { const int m = 2 * mp + mm;
#pragma unroll
                    for (int bj = 0; bj < 2; ++bj) { f32x4 v0 = acc[ai][bj][m][0] * rs2[ai][m], v1 = acc[ai][bj][m][1] * rs2[ai][m]; rope8(v0, v1, cs[bb][mm][0], cs[bb][mm][1]); *(u32x4*)(QA + (size_t)(row2 + ai * HALF + m * 16) * 768 + (4 * bj + wc) * 96 + 64 + 8 * fq2) = tr16x4(pack8(v0, v1), bidx); } } }
#undef QKV_CS_LOAD
        } else {
            bf16_t* dst = KN + (size_t)((u.pn - 3) >> 1) * ((size_t)32768 * 512); const int cb2 = ((u.pn - 3) & 1) * 256 + cw2;
            float rs2[2][4]; rstd8(rs2, SSQ_KV, row0, 1.f / 128.f, 1.f);
#pragma unroll
            for (int ai = 0; ai < 2; ++ai) { const float (&rs)[4] = rs2[ai];
#pragma unroll
                for (int m = 0; m < 4; ++m) { const size_t row = (size_t)(row0 + ai * HALF + m * 16);
#pragma unroll
                    for (int bj = 0; bj < 2; ++bj) *(u32x4*)(dst + (size_t)(row2 + ai * HALF + m * 16) * 512 + cb2 + bj * HALF) = tr16x4(pack8(acc[ai][bj][m][0] * rs[m], acc[ai][bj][m][1] * rs[m]), bidx); }
                asm volatile("" ::: "memory"); }
        }
    }
};
struct EpiOutProj {
    static constexpr bool PERM = true, AFTER_DRAIN = false;
    const bf16_t* XB; bf16_t* X1B; float* SSQ;
    __device__ __forceinline__ void operator()(const f32x4 (&acc)[2][2][4][2], const Unit& u, int wr, int wc, int fr, int fq) const {
        EPI_LANE();
        int t2_ = threadIdx.x; asm volatile("" : "+v"(t2_)); EPI_LANE_T();
        const int row0 = u.pm * BM + wr * 64 + fr, cw = u.pn * BM + wc * 32 + 8 * fq;
        bf16_t* const st = X1B + (size_t)(u.pm * BM + wr * 64 + fr2) * 1024 + u.pn * BM + wc * 32 + 8 * fq2;
        u32x4 xb[2][4][2];
#pragma unroll
        for (int ai = 0; ai < 2; ++ai)
#pragma unroll
            for (int m = 0; m < 4; ++m)
#pragma unroll
                for (int bj = 0; bj < 2; ++bj) xb[ai][m][bj] = __builtin_nontemporal_load((const u32x4*)(XB + (size_t)(row0 + ai * HALF + m * 16) * 1024 + cw + bj * HALF));
#pragma unroll
        for (int ai = 0; ai < 2; ++ai)
#pragma unroll
            for (int m = 0; m < 4; ++m) { const size_t row = (size_t)(row0 + ai * HALF + m * 16); float s = 0.f;
#pragma unroll
                for (int bj = 0; bj < 2; ++bj) { const u32x4 w = xb[ai][m][bj];
                    const f32x4 v0 = acc[ai][bj][m][0] + (f32x4){__uint_as_float(w.x << 16), __uint_as_float(w.x & 0xffff0000u), __uint_as_float(w.y << 16), __uint_as_float(w.y & 0xffff0000u)};
                    const f32x4 v1 = acc[ai][bj][m][1] + (f32x4){__uint_as_float(w.z << 16), __uint_as_float(w.z & 0xffff0000u), __uint_as_float(w.w << 16), __uint_as_float(w.w & 0xffff0000u)};
                    s += sq8(v0, v1); *(u32x4*)(st + (size_t)(ai * HALF + m * 16) * 1024 + bj * HALF) = tr16x4(pack8(v0, v1), bidx); }
                s = fq_sum(s); if (fq == 0) SSQ[row * 16 + u.pn * 4 + wc] = s; }
    }
};
struct HMap { unsigned char* ws; size_t xn, mix, dq, dk, dv;
    __host__ __device__ __forceinline__ bf16_t* panel(int pm) const { const int b = pm >> 4, p = pm & 15; constexpr size_t PB = (size_t)256 * 2816 * 2, MB = (size_t)1 << 20;
        size_t off;
        if (p < 5) off = xn + (size_t)b * 8 * MB + (size_t)p * PB;
        else if (p < 10) off = mix + (size_t)b * 8 * MB + (size_t)(p - 5) * PB;
        else if (p < 12) off = dq + (size_t)b * 4 * MB + (size_t)(p - 10) * PB;
        else if (p < 14) off = dk + (size_t)b * 4 * MB + (size_t)(p - 12) * PB;
        else off = dv + (size_t)b * 4 * MB + (size_t)(p - 14) * PB;
        return (bf16_t*)(ws + off); } };
struct PanelOrder {
    static constexpr bool KSPLIT = false, APANEL = true;
    StaticOrder so; HMap hm;
    __host__ __device__ void init(int M, int N, int G_, int c_) { so.init(M, N, G_, c_); }
    __host__ __device__ bool next(int i, Unit& u) const { return so.next(i, u); }
    __device__ __forceinline__ const char* a_panel(int pm) const { return (const char*)hm.panel(pm); }
    __device__ __forceinline__ void a_ready(const Unit&) const {}
    __device__ __forceinline__ void done(const Unit&) const {}
};
struct EpiGateUp {
    static constexpr bool PERM = true, AFTER_DRAIN = false;
    HMap hm; const float* SSQ;
    __device__ __forceinline__ void operator()(const f32x4 (&acc)[2][2][4][2], const Unit& u, int wr, int wc, int fr, int fq) const {
        EPI_LANE(); int t2_ = threadIdx.x; asm volatile("" : "+v"(t2_)); EPI_LANE_T(); const int row2 = u.pm * BM + wr * 64 + fr2, cw2 = wc * 32 + 8 * fq2;
        const int row0 = u.pm * BM + wr * 64 + fr, cw = u.pn * HALF + wc * 32 + 8 * fq;
        bf16_t* const Hp = hm.panel(u.pm) + (size_t)(wr * 64 + fr2) * 2816 + u.pn * HALF + cw2;
        float rs[2][4];
        { f32x4 pp[2][4];
#pragma unroll
          for (int ai = 0; ai < 2; ++ai)
#pragma unroll
              for (int m = 0; m < 4; ++m) pp[ai][m] = *(const f32x4*)(SSQ + (size_t)(row0 + ai * HALF + m * 16) * 16 + 4 * fq);
#pragma unroll
          for (int ai = 0; ai < 2; ++ai)
#pragma unroll
              for (int m = 0; m < 4; ++m) rs[ai][m] = __builtin_amdgcn_rsqf(fq_sum((pp[ai][m][0] + pp[ai][m][1]) + (pp[ai][m][2] + pp[ai][m][3])) * (1.f / 1024.f) + RMS_EPS); }
#pragma unroll
        for (int ai = 0; ai < 2; ++ai)
#pragma unroll
            for (int m = 0; m < 4; ++m) { const size_t row = (size_t)(row0 + ai * HALF + m * 16); const float r = rs[ai][m];
                f32x4 hv[2];
#pragma unroll
                for (int n = 0; n < 2; ++n) { const f32x4 g = acc[ai][0][m][n] * r, up = acc[ai][1][m][n] * r;
#pragma unroll
                    for (int j = 0; j < 4; ++j) { const float e = __builtin_amdgcn_exp2f(g[j] * -1.4426950408889634f); hv[n][j] = g[j] * __builtin_amdgcn_rcpf(1.0f + e) * up[j]; } }
                *(u32x4*)(Hp + (size_t)(ai * HALF + m * 16) * 2816) = tr16x4(pack8(hv[0], hv[1]), bidx); }
    }
};
struct EpiDownNorm {
    static constexpr bool PERM = true, AFTER_DRAIN = false;
    const bf16_t* X1B; float* OUT; const float* G; unsigned* xbuf; unsigned* cnt; PG8_LAS unsigned char* xl;
    __device__ __forceinline__ void operator()(f32x4 (&acc)[2][2][4][2], const Unit& u, int wr, int wc, int fr, int fq) const {
        int t_ = threadIdx.x; asm volatile("" : "+v"(t_)); fr = t_ & 15; fq = (t_ >> 4) & 3; const int lane = t_ & 63, wid = wr * 4 + wc; const int t2_ = t_; EPI_LANE_T();
        PG8_LAS float* P = (PG8_LAS float*)xl; PG8_LAS float* S = (PG8_LAS float*)(xl + 4096); PG8_LAS unsigned* flag = (PG8_LAS unsigned*)(xl + 5120);
        const int row0 = u.pm * BM + wr * 64 + fr, cw = u.pn * BM + wc * 32 + 8 * fq;
        f32x4 gv[2][2];
#pragma unroll
        for (int bj = 0; bj < 2; ++bj) { gv[bj][0] = *(const f32x4*)(G + cw + bj * HALF); gv[bj][1] = *(const f32x4*)(G + cw + bj * HALF + 4); }
        u32x4 xb[2][4][2];
#pragma unroll
        for (int ai = 0; ai < 2; ++ai)
#pragma unroll
            for (int m = 0; m < 4; ++m)
#pragma unroll
                for (int bj = 0; bj < 2; ++bj) xb[ai][m][bj] = __builtin_nontemporal_load((const u32x4*)(X1B + (size_t)(row0 + ai * HALF + m * 16) * 1024 + cw + bj * HALF));
#pragma unroll
        for (int ai = 0; ai < 2; ++ai) {
#pragma unroll
            for (int m = 0; m < 4; ++m) { float s = 0.f;
#pragma unroll
                for (int bj = 0; bj < 2; ++bj) { const u32x4 w = xb[ai][m][bj];
                    const f32x4 a0 = (f32x4){__uint_as_float(w.x << 16), __uint_as_float(w.x & 0xffff0000u), __uint_as_float(w.y << 16), __uint_as_float(w.y & 0xffff0000u)};
                    const f32x4 a1 = (f32x4){__uint_as_float(w.z << 16), __uint_as_float(w.z & 0xffff0000u), __uint_as_float(w.w << 16), __uint_as_float(w.w & 0xffff0000u)};
                    acc[ai][bj][m][0] += a0; acc[ai][bj][m][1] += a1; s += sq8(acc[ai][bj][m][0], acc[ai][bj][m][1]); }
                s = fq_sum(s); if (fq == 0) P[(ai * HALF + wr * 64 + m * 16 + fr) * 4 + wc] = s; }
        }
        asm volatile("s_waitcnt lgkmcnt(0)" ::: "memory"); __builtin_amdgcn_s_barrier(); asm volatile("" ::: "memory");
        const int prow = wid * 32 + (lane & 31);
        if (lane < 32) { const float tot = (P[prow * 4 + 0] + P[prow * 4 + 1]) + (P[prow * 4 + 2] + P[prow * 4 + 3]);
            __hip_atomic_store(xbuf + ((size_t)(u.pm * BM + prow) * 4 + u.pn), __float_as_uint(tot), __ATOMIC_RELAXED, __HIP_MEMORY_SCOPE_AGENT); }
        asm volatile("s_waitcnt vmcnt(0)" ::: "memory");
        if (lane == 0) __hip_atomic_fetch_add(cnt + 64 * u.pm, 1u, __ATOMIC_RELAXED, __HIP_MEMORY_SCOPE_AGENT);
        if (wid == 0) { unsigned sp = 0;
            while ((unsigned)__builtin_amdgcn_readfirstlane(__hip_atomic_load(cnt + 64 * u.pm, __ATOMIC_RELAXED, __HIP_MEMORY_SCOPE_AGENT)) < 32u) { __builtin_amdgcn_s_sleep(2); if (++sp > (1u << 22)) break; }
            __builtin_amdgcn_fence(__ATOMIC_ACQUIRE, "agent");
            if (lane == 0) flag[0] = sp; }
        asm volatile("s_waitcnt vmcnt(0) lgkmcnt(0)" ::: "memory"); __builtin_amdgcn_s_barrier(); asm volatile("" ::: "memory");
        if (lane < 32) { const unsigned* slot = xbuf + (size_t)(u.pm * BM + prow) * 4; float q = 0.f;
#pragma unroll
            for (int t = 0; t < 4; ++t) q += __uint_as_float(__hip_atomic_load(slot + t, __ATOMIC_RELAXED, __HIP_MEMORY_SCOPE_AGENT));
            S[prow] = __builtin_amdgcn_rsqf(q * (1.f / 1024.f) + RMS_EPS); }
        asm volatile("s_waitcnt lgkmcnt(0)" ::: "memory"); __builtin_amdgcn_s_barrier(); asm volatile("" ::: "memory");
#pragma unroll
        for (int ai = 0; ai < 2; ++ai)
#pragma unroll
            for (int m = 0; m < 4; ++m) { const int r = ai * HALF + wr * 64 + m * 16 + fr; const float rs = S[r]; const size_t off = (size_t)(u.pm * BM + r) * 1024 + cw;
#pragma unroll
                for (int bj = 0; bj < 2; ++bj) { const f32x4 o0 = acc[ai][bj][m][0] * rs * gv[bj][0], o1 = acc[ai][bj][m][1] * rs * gv[bj][1]; float* const op = OUT + (size_t)(u.pm * BM + ai * HALF + wr * 64 + m * 16 + fr2) * 1024 + u.pn * BM + wc * 32 + 8 * fq2 + bj * HALF;
                    *(u32x4*)op = tr16x4(__builtin_bit_cast(u32x4, o0), bidx); *(u32x4*)(op + 4) = tr16x4(__builtin_bit_cast(u32x4, o1), bidx); } }
    }
};

struct SplitOrder {
    static constexpr bool KSPLIT = true, APANEL = false;
    StaticOrder so;
    __host__ __device__ void init(int M, int N, int G_, int c_) { so.init(M, N, G_, c_); }
    __host__ __device__ bool next(int i, Unit& u) const { if (!so.next(i, u)) return false; if (u.pn < 3) { u.kofs = 0; u.nt = 4; } else { u.kofs = 256 * 2; u.nt = 2; } return true; }
    __device__ __forceinline__ void a_ready(const Unit&) const {}
    __device__ __forceinline__ void done(const Unit&) const {}
};
template <class Epi, class Sched, bool ALIGN_EPI = false, bool SP2 = false>
__device__ __forceinline__ void gemm_phase(PG8_LAS unsigned char* lds, const Gemm g, const Sched& S, const Epi& E) {
    const int tid = threadIdx.x, wid = __builtin_amdgcn_readfirstlane(tid >> 6), lane = tid & 63, wr = wid >> 2, wc = wid & 3, fr = lane & 15, fq = lane >> 4;
    const int K = g.K; int nt = K / BK;
    unsigned voffA[2], voffB[2];
#pragma unroll
    for (int i = 0; i < 2; ++i) { int R, C; stage_rc(tid * 16 + i * 8192, R, C); const int Rb = Epi::PERM ? ((R & ~31) + perm32(R & 31)) : R;
        voffA[i] = (unsigned)(R * K + C) * 2u; voffB[i] = (unsigned)(Rb * K + C) * 2u; }
    const size_t kstep = (size_t)(BK * 2);
    const size_t hstep = (size_t)HALF * K * 2;
    const size_t tstep = 2 * hstep;
    const unsigned ldsw = (unsigned)wid * 1024u;
    const int aoff = lds_byte(wr * 64 + fr, fq * 8), boff = lds_byte(wc * 32 + fr, fq * 8);
#define PG8_SA(b, h) (((b) * 2 + (h)) * HTB)
#define PG8_SB(b, h) ((4 + (b) * 2 + (h)) * HTB)
#define PG8_STAGE(bufoff, gbase, voff) do { _Pragma("unroll") for (int _i = 0; _i < 2; ++_i) \
        __builtin_amdgcn_global_load_lds((const unsigned*)((const char*)(gbase) + (voff)[_i]), (PG8_LAS unsigned*)(lds + (bufoff) + ldsw + _i * 8192), 16, 0, 0); } while (0)
#define PG8_LDA(dst, b, h) do { _Pragma("unroll") for (int m = 0; m < 4; ++m) _Pragma("unroll") for (int k = 0; k < 2; ++k) dst[m][k] = *(const PG8_LAS bf16x8*)(lds + PG8_SA(b, h) + aoff + m * 2048 + k * 1024); } while (0)
#define PG8_LDB(dst, b, h) do { _Pragma("unroll") for (int n = 0; n < 2; ++n) _Pragma("unroll") for (int k = 0; k < 2; ++k) dst[n][k] = *(const PG8_LAS bf16x8*)(lds + PG8_SB(b, h) + boff + n * 2048 + k * 1024); } while (0)
#define PG8_MMA(ai, bj, At, Bt) do { __builtin_amdgcn_s_setprio(1); _Pragma("unroll") for (int m = 0; m < 4; ++m) _Pragma("unroll") for (int n = 0; n < 2; ++n) _Pragma("unroll") for (int k = 0; k < 2; ++k) \
        acc[ai][bj][m][n] = __builtin_amdgcn_mfma_f32_16x16x32_bf16(Bt[n][k], At[m][k], acc[ai][bj][m][n], 0, 0, 0); __builtin_amdgcn_s_setprio(0); } while (0)
#define PG8_WAIT_V(n) asm volatile("s_waitcnt vmcnt(" #n ")" ::: "memory")
#define PG8_WAIT_L(n) asm volatile("s_waitcnt lgkmcnt(" #n ")" ::: "memory")
#define PG8_BAR __builtin_amdgcn_s_barrier()
#define PG8_SCHED __builtin_amdgcn_sched_barrier(0)
    Unit cur, nxt; int ui = 0;
    if (!S.next(0, cur)) return;
    f32x4 acc[2][2][4][2];
#pragma unroll
    for (int a = 0; a < 2; ++a)
#pragma unroll
        for (int b = 0; b < 2; ++b)
#pragma unroll
            for (int m = 0; m < 4; ++m)
#pragma unroll
                for (int n = 0; n < 2; ++n) acc[a][b][m][n] = (f32x4){0.f, 0.f, 0.f, 0.f};
    bf16x8 At[4][2], B0[2][2], B1[2][2];
    const char* cA; if constexpr (Sched::APANEL) cA = S.a_panel(cur.pm); else cA = (const char*)g.A + (size_t)cur.pm * tstep + (Sched::KSPLIT ? cur.kofs : 0);
    const char* cB = (const char*)g.Bt + (size_t)cur.pn * tstep + (Sched::KSPLIT ? cur.kofs : 0);
    S.a_ready(cur);
    if constexpr (SP2) {
        PG8_STAGE(PG8_SB(0, 0), cB, voffB); PG8_STAGE(PG8_SB(0, 1), cB + hstep, voffB); PG8_STAGE(PG8_SA(0, 0), cA, voffA); PG8_STAGE(PG8_SA(0, 1), cA + hstep, voffA);
        if (wr == 1) PG8_BAR;
        PG8_WAIT_V(2); PG8_BAR;
        PG8_STAGE(PG8_SB(1, 0), cB + kstep, voffB); PG8_STAGE(PG8_SA(1, 0), cA + kstep, voffA); PG8_STAGE(PG8_SB(1, 1), cB + hstep + kstep, voffB);
        PG8_WAIT_V(6); PG8_BAR;
    } else {
        PG8_STAGE(PG8_SB(0, 0), cB, voffB); PG8_STAGE(PG8_SA(0, 0), cA, voffA); PG8_STAGE(PG8_SB(0, 1), cB + hstep, voffB); PG8_STAGE(PG8_SA(0, 1), cA + hstep, voffA);
        if (wr == 1) PG8_BAR;
        PG8_WAIT_V(4); PG8_BAR;
        PG8_STAGE(PG8_SB(1, 0), cB + kstep, voffB); PG8_STAGE(PG8_SA(1, 0), cA + kstep, voffA); PG8_STAGE(PG8_SB(1, 1), cB + hstep + kstep, voffB);
        PG8_WAIT_V(6); PG8_BAR;
    }
    for (;;) {
        const bool has_next = S.next(ui + 1, nxt);
        const char* nA; if constexpr (Sched::APANEL) nA = has_next ? S.a_panel(nxt.pm) : cA; else nA = has_next ? (const char*)g.A + (size_t)nxt.pm * tstep + (Sched::KSPLIT ? nxt.kofs : 0) : cA;
        const char* nB = has_next ? (const char*)g.Bt + (size_t)nxt.pn * tstep + (Sched::KSPLIT ? nxt.kofs : 0) : cB;
        if constexpr (Sched::KSPLIT) nt = cur.nt;
        for (int t = 0; t < nt; t += 2) {
            const bool last = (t == nt - 2);
            const char* a1 = cA + (size_t)(t + 1) * kstep;
            const char* a2 = last ? nA : cA + (size_t)(t + 2) * kstep; const char* b2 = last ? nB : cB + (size_t)(t + 2) * kstep;
            const char* a3 = a2 + kstep; const char* b3 = b2 + kstep;
            if (last && has_next) S.a_ready(nxt);
            if constexpr (SP2) {
            PG8_LDB(B0, 0, 0); PG8_LDB(B1, 0, 1); PG8_SCHED; PG8_LDA(At, 0, 0); PG8_STAGE(PG8_SA(1, 1), a1 + hstep, voffA);
            PG8_WAIT_V(8); PG8_WAIT_L(0); PG8_BAR; PG8_MMA(0, 0, At, B0); PG8_MMA(0, 1, At, B1); PG8_BAR; PG8_SCHED;
            PG8_LDA(At, 0, 1); PG8_STAGE(PG8_SB(0, 0), b2, voffB); PG8_STAGE(PG8_SB(0, 1), b2 + hstep, voffB); PG8_STAGE(PG8_SA(0, 0), a2, voffA);
            PG8_WAIT_V(8); PG8_WAIT_L(0); PG8_BAR; PG8_MMA(1, 0, At, B0); PG8_MMA(1, 1, At, B1); PG8_BAR; PG8_SCHED;
            PG8_LDB(B0, 1, 0); PG8_LDB(B1, 1, 1); PG8_SCHED; PG8_LDA(At, 1, 0); PG8_STAGE(PG8_SA(0, 1), a2 + hstep, voffA);
            PG8_WAIT_V(8); PG8_WAIT_L(0); PG8_BAR; PG8_MMA(0, 0, At, B0); PG8_MMA(0, 1, At, B1); PG8_BAR; PG8_SCHED;
            PG8_LDA(At, 1, 1); PG8_STAGE(PG8_SB(1, 0), b3, voffB); PG8_STAGE(PG8_SB(1, 1), b3 + hstep, voffB); PG8_STAGE(PG8_SA(1, 0), a3, voffA);
            PG8_WAIT_V(8); PG8_WAIT_L(0); PG8_BAR; PG8_MMA(1, 0, At, B0); PG8_MMA(1, 1, At, B1); PG8_BAR; PG8_SCHED;
            } else {
            PG8_LDB(B0, 0, 0); PG8_SCHED; PG8_LDA(At, 0, 0); PG8_STAGE(PG8_SA(1, 1), a1 + hstep, voffA);
            PG8_WAIT_L(8); PG8_BAR; PG8_WAIT_L(0); PG8_MMA(0, 0, At, B0); PG8_BAR; PG8_SCHED;
            PG8_LDB(B1, 0, 1); PG8_STAGE(PG8_SB(0, 0), b2, voffB);
            PG8_BAR; PG8_WAIT_L(0); PG8_MMA(0, 1, At, B1); PG8_BAR;
            PG8_LDA(At, 0, 1); PG8_STAGE(PG8_SA(0, 0), a2, voffA);
            PG8_BAR; PG8_WAIT_L(0); PG8_MMA(1, 0, At, B0); PG8_BAR; PG8_SCHED;
            PG8_STAGE(PG8_SB(0, 1), b2 + hstep, voffB);
            PG8_WAIT_V(6); PG8_BAR; PG8_MMA(1, 1, At, B1); PG8_BAR;
            PG8_LDB(B0, 1, 0); PG8_SCHED; PG8_LDA(At, 1, 0); PG8_STAGE(PG8_SA(0, 1), a2 + hstep, voffA);
            PG8_WAIT_L(8); PG8_BAR; PG8_WAIT_L(0); PG8_MMA(0, 0, At, B0); PG8_BAR; PG8_SCHED;
            PG8_LDB(B1, 1, 1); PG8_STAGE(PG8_SB(1, 0), b3, voffB);
            PG8_BAR; PG8_WAIT_L(0); PG8_MMA(0, 1, At, B1); PG8_BAR;
            PG8_LDA(At, 1, 1); PG8_STAGE(PG8_SA(1, 0), a3, voffA);
            PG8_BAR; PG8_WAIT_L(0); PG8_MMA(1, 0, At, B0); PG8_BAR; PG8_SCHED;
            PG8_STAGE(PG8_SB(1, 1), b3 + hstep, voffB);
            PG8_WAIT_V(6); PG8_BAR; PG8_MMA(1, 1, At, B1); PG8_BAR;
            }
        }
        if constexpr (ALIGN_EPI) { if (wr == 0) PG8_BAR; }
        if constexpr (!Epi::AFTER_DRAIN) { E(acc, cur, wr, wc, fr, fq); S.done(cur); }
        if (!has_next) break;
#pragma unroll
        for (int a = 0; a < 2; ++a)
#pragma unroll
            for (int b = 0; b < 2; ++b)
#pragma unroll
                for (int m = 0; m < 4; ++m)
#pragma unroll
                    for (int n = 0; n < 2; ++n) acc[a][b][m][n] = (f32x4){0.f, 0.f, 0.f, 0.f};
        cur = nxt; cA = nA; cB = nB; ++ui;
        if constexpr (ALIGN_EPI) { if (wr == 1) PG8_BAR; }
    }
    PG8_WAIT_V(0);
    if constexpr (!ALIGN_EPI) { if (wr == 0) PG8_BAR; }
    PG8_BAR;
    if constexpr (Epi::AFTER_DRAIN) { E.fused(acc, cur, wr, wc, fr, fq, lds, wid, lane); S.done(cur); }
#undef PG8_SA
#undef PG8_SB
#undef PG8_STAGE
#undef PG8_LDA
#undef PG8_LDB
#undef PG8_MMA
#undef PG8_WAIT_V
#undef PG8_WAIT_L
#undef PG8_BAR
#undef PG8_SCHED
}
}
namespace att {
using bf16x8 = __attribute__((ext_vector_type(8))) short;
using s16x4 = __attribute__((ext_vector_type(4))) short;
using f32x16 = __attribute__((ext_vector_type(16))) float;
using u32x4 = __attribute__((ext_vector_type(4))) unsigned;
typedef unsigned short bf16;
constexpr int SEQ = 4096, NW = 8, QB = 256, KVBLK = 64, NSLOT = 3;
#ifndef ATT_THRL
#define ATT_THRL 8
#endif
constexpr int THRL = ATT_THRL;
__device__ __forceinline__ int otid() { int t = threadIdx.x; asm volatile("" : "+v"(t)); return t; }
template <int PAT> __device__ __forceinline__ float swz_xor(float v) { return __int_as_float(__builtin_amdgcn_ds_swizzle(__float_as_int(v), PAT)); }
__device__ __forceinline__ int crow(int r, int hi) { return (r & 3) + 8 * (r >> 2) + 4 * hi; }
#define SBAR() __builtin_amdgcn_sched_barrier(0)
#define PIN(x) asm volatile("" : "+v"(x))
#define WAIT_BAR(N) asm volatile("s_waitcnt vmcnt(" #N ") lgkmcnt(0)\n\ts_barrier" ::: "memory")
#define MFMA32(a, b, c) __builtin_amdgcn_mfma_f32_32x32x16_bf16(a, b, c, 0, 0, 0)
#define EX(v) __builtin_amdgcn_exp2f(v)
#define MX3(a, b, c) __builtin_fmaxf(__builtin_fmaxf((a), (b)), (c))
__device__ __forceinline__ void glds16(const void* gsrc, unsigned lds_dst) { unsigned keep;
    asm volatile("s_mov_b32 %0, m0\n\ts_mov_b32 m0, %2\n\ts_nop 0\n\tglobal_load_lds_dwordx4 %1, off\n\ts_mov_b32 m0, %0" : "=&s"(keep) : "v"(gsrc), "s"(lds_dst) : "memory"); }
typedef float f32x2_t __attribute__((ext_vector_type(2))); typedef __bf16 bf16x2_t __attribute__((ext_vector_type(2)));
__device__ __forceinline__ unsigned cvtpk_s(float lo, float hi) { f32x2_t v = {lo, hi}; bf16x2_t b = __builtin_convertvector(v, bf16x2_t); return __builtin_bit_cast(unsigned, b); }
typedef __attribute__((address_space(3))) const char* lds_cptr;
typedef short v4i16_t __attribute__((ext_vector_type(4)));
__device__ __forceinline__ s16x4 vtr(lds_cptr p) { return __builtin_bit_cast(s16x4, __builtin_amdgcn_ds_read_tr16_b64_v4i16((__attribute__((address_space(3))) v4i16_t*)p)); }
__device__ __forceinline__ bf16x8 kld(lds_cptr p) { return *(const __attribute__((address_space(3))) bf16x8*)p; }
__device__ __forceinline__ float rowmax(const f32x16& p0, const f32x16& p1) {
    float a = MX3(p0[0], p0[1], p1[0]), b = MX3(p0[2], p0[3], p1[1]); a = MX3(a, p1[2], p1[3]);
#pragma unroll
    for (int r = 4; r < 16; r += 4) { a = MX3(a, p0[r], p0[r + 1]); b = MX3(b, p0[r + 2], p0[r + 3]); a = MX3(a, p1[r], p1[r + 1]); b = MX3(b, p1[r + 2], p1[r + 3]); }
    const float m = __builtin_fmaxf(a, b);
    auto rr = __builtin_amdgcn_permlane32_swap(__float_as_uint(m), __float_as_uint(m), false, false);
    return __builtin_fmaxf(__uint_as_float(rr[0]), __uint_as_float(rr[1]));
}
template <int DQK, int DV> struct Lay {
    static constexpr int KB = 64 * DQK * 2, VB = 64 * DV * 2;
    static constexpr int LDS_K = 0, LDS_V = NSLOT * KB, LDS_WS = NSLOT * (KB + VB), OSTW = (DV == 128) ? 8192 : 4096, LDS_OST = LDS_WS + NW * 256, LDS_BT = LDS_OST + NW * OSTW, LDS_END = LDS_BT + 2048;
};
#define STEP_MLA(C0, C1, P0, P1, t, BAND, GK, GV, GL) do { SBAR(); \
    const lds_cptr vp_ = vp0 + sl_prev * L::VB; \
      \
    float sacc = P0[0] + P0[1]; \
    VRD(0, 0); SBAR(); C0 = MFMA32(kf[0], qr[0], negm); sacc += P0[2]; sacc += P0[3]; sacc += P0[4]; PIN(sacc); pw0[0] = PKW(P0, 0); pw0[1] = PKW(P0, 2); PIN(pw0); SBAR(); \
    VRD(4, 4); SBAR(); C1 = MFMA32(kf[1], qr[0], negm); sacc += P0[5]; sacc += P0[6]; sacc += P0[7]; PIN(sacc); pw0[2] = PKW(P0, 4); pw0[3] = PKW(P0, 6); PIN(pw0); SBAR(); \
    VRD(1, 1); SBAR(); C0 = MFMA32(kf[2], qr[1], C0); sacc += P0[8]; sacc += P0[9]; sacc += P0[10]; PIN(sacc); pw1[0] = PKW(P0, 8); pw1[1] = PKW(P0, 10); PIN(pw1); SBAR(); \
    VRD(5, 5); SBAR(); C1 = MFMA32(kf[3], qr[1], C1); sacc += P0[11]; sacc += P0[12]; sacc += P0[13]; PIN(sacc); pw1[2] = PKW(P0, 12); pw1[3] = PKW(P0, 14); PIN(pw1); SBAR(); \
    VRD(2, 2); SBAR(); C0 = MFMA32(kf[4], qr[2], C0); sacc += P0[14]; sacc += P0[15]; sacc += P1[0]; PIN(sacc); pw2[0] = PKW(P1, 0); PIN(pw2); SBAR(); \
    VRD(6, 6); SBAR(); C1 = MFMA32(kf[5], qr[2], C1); sacc += P1[1]; sacc += P1[2]; sacc += P1[3]; PIN(sacc); pw2[1] = PKW(P1, 2); PIN(pw2); SBAR(); \
    VRD(3, 3); SBAR(); C0 = MFMA32(kf[6], qr[3], C0); sacc += P1[4]; sacc += P1[5]; PIN(sacc); pw2[2] = PKW(P1, 4); PIN(pw2); SBAR(); \
    VRD(7, 7); SBAR(); C1 = MFMA32(kf[7], qr[3], C1); sacc += P1[6]; sacc += P1[7]; PIN(sacc); pw2[3] = PKW(P1, 6); PIN(pw2); SBAR(); \
    C0 = MFMA32(kf[8], qr[4], C0); sacc += P1[8]; sacc += P1[9]; PIN(sacc); pw3[0] = PKW(P1, 8); PIN(pw3); SBAR(); \
    C1 = MFMA32(kf[9], qr[4], C1); sacc += P1[10]; sacc += P1[11]; PIN(sacc); pw3[1] = PKW(P1, 10); PIN(pw3); SBAR(); \
    C0 = MFMA32(kf[10], qr[5], C0); sacc += P1[12]; sacc += P1[13]; PIN(sacc); pw3[2] = PKW(P1, 12); PIN(pw3); SBAR(); \
    C1 = MFMA32(kf[11], qr[5], C1); sacc += P1[14]; sacc += P1[15]; PIN(sacc); pw3[3] = PKW(P1, 14); PIN(pw3); SBAR(); \
    l_reg += sacc; \
    MIDDLE(C0, C1, t, BAND); \
    SBAR(); \
    o[0] = MFMA32(PAF(0), VFR(0), o[0]); if (GK) DMA_K((t) + 3, sl_cur); if (GV) DMA_V((t) + 1, sl_next); C0[0] = EX(C0[0]); C0[1] = EX(C0[1]); C0[2] = EX(C0[2]); C0[3] = EX(C0[3]); PIN(C0); SBAR(); \
    KRD(GL, 0); o[1] = MFMA32(PAF(0), VFR(4), o[1]); C0[4] = EX(C0[4]); C0[5] = EX(C0[5]); C0[6] = EX(C0[6]); C0[7] = EX(C0[7]); PIN(C0); SBAR(); \
    KRD(GL, 1); o[0] = MFMA32(PAF(1), VFR(1), o[0]); C0[8] = EX(C0[8]); C0[9] = EX(C0[9]); C0[10] = EX(C0[10]); C0[11] = EX(C0[11]); PIN(C0); SBAR(); \
    KRD(GL, 2); o[1] = MFMA32(PAF(1), VFR(5), o[1]); C0[12] = EX(C0[12]); C0[13] = EX(C0[13]); C0[14] = EX(C0[14]); C0[15] = EX(C0[15]); PIN(C0); SBAR(); \
    KRD(GL, 3); o[0] = MFMA32(PAF(2), VFR(2), o[0]); C1[0] = EX(C1[0]); C1[1] = EX(C1[1]); C1[2] = EX(C1[2]); C1[3] = EX(C1[3]); PIN(C1); SBAR(); \
    KRD(GL, 4); o[1] = MFMA32(PAF(2), VFR(6), o[1]); C1[4] = EX(C1[4]); C1[5] = EX(C1[5]); C1[6] = EX(C1[6]); C1[7] = EX(C1[7]); PIN(C1); SBAR(); \
    KRD(GL, 5); o[0] = MFMA32(PAF(3), VFR(3), o[0]); C1[8] = EX(C1[8]); C1[9] = EX(C1[9]); C1[10] = EX(C1[10]); C1[11] = EX(C1[11]); PIN(C1); SBAR(); \
    o[1] = MFMA32(PAF(3), VFR(7), o[1]); C1[12] = EX(C1[12]); C1[13] = EX(C1[13]); C1[14] = EX(C1[14]); C1[15] = EX(C1[15]); PIN(C1); SBAR(); \
    } while (0)
#define STEP_DIF(C0, C1, P0, P1, t, BAND, GK, GV, GL) do { SBAR(); \
    const lds_cptr vp_ = vp0 + sl_prev * L::VB; \
      \
    float sacc = P0[0] + P0[1]; \
    C0 = MFMA32(kf[0], qr[0], inin); sacc += P0[2]; sacc += P0[3]; sacc += P0[4]; sacc += P0[5]; PIN(sacc); pw0[0] = PKW(P0, 0); pw0[1] = PKW(P0, 2); PIN(pw0); SBAR(); \
    C1 = MFMA32(kf[1], qr[0], inin); sacc += P0[6]; sacc += P0[7]; sacc += P0[8]; sacc += P0[9]; PIN(sacc); pw0[2] = PKW(P0, 4); pw0[3] = PKW(P0, 6); PIN(pw0); SBAR(); \
    C0 = MFMA32(kf[2], qr[1], C0); sacc += P0[10]; sacc += P0[11]; sacc += P0[12]; sacc += P0[13]; PIN(sacc); pw1[0] = PKW(P0, 8); pw1[1] = PKW(P0, 10); PIN(pw1); SBAR(); \
    C1 = MFMA32(kf[3], qr[1], C1); sacc += P0[14]; sacc += P0[15]; sacc += P1[0]; sacc += P1[1]; PIN(sacc); pw1[2] = PKW(P0, 12); pw1[3] = PKW(P0, 14); PIN(pw1); SBAR(); \
    VRD(0, 0); SBAR(); C0 = MFMA32(kf[4], qr[2], C0); sacc += P1[2]; sacc += P1[3]; sacc += P1[4]; sacc += P1[5]; PIN(sacc); pw2[0] = PKW(P1, 0); pw2[1] = PKW(P1, 2); PIN(pw2); SBAR(); \
    VRD(1, 4); SBAR(); C1 = MFMA32(kf[5], qr[2], C1); sacc += P1[6]; sacc += P1[7]; sacc += P1[8]; sacc += P1[9]; PIN(sacc); pw2[2] = PKW(P1, 4); pw2[3] = PKW(P1, 6); PIN(pw2); SBAR(); \
    VRD(2, 8); SBAR(); C0 = MFMA32(kf[6], qr[3], C0); sacc += P1[10]; sacc += P1[11]; sacc += P1[12]; sacc += P1[13]; PIN(sacc); pw3[0] = PKW(P1, 8); pw3[1] = PKW(P1, 10); PIN(pw3); SBAR(); \
    VRD(3, 12); SBAR(); C1 = MFMA32(kf[7], qr[3], C1); sacc += P1[14]; sacc += P1[15]; PIN(sacc); pw3[2] = PKW(P1, 12); pw3[3] = PKW(P1, 14); PIN(pw3); SBAR(); \
    l_reg += sacc; \
    MIDDLE(C0, C1, t, BAND); \
    SBAR(); \
    o[0] = MFMA32(PAF(0), VFR(0), o[0]); if (GK) DMA_K((t) + 3, sl_cur); if (GV) DMA_V((t) + 1, sl_next); VRD(0, 1); C0[0] = EX(C0[0]); C0[1] = EX(C0[1]); PIN(C0); SBAR(); \
    o[1] = MFMA32(PAF(0), VFR(1), o[1]); VRD(1, 5); C0[2] = EX(C0[2]); C0[3] = EX(C0[3]); PIN(C0); SBAR(); \
    o[2] = MFMA32(PAF(0), VFR(2), o[2]); VRD(2, 9); C0[4] = EX(C0[4]); C0[5] = EX(C0[5]); PIN(C0); SBAR(); \
    o[3] = MFMA32(PAF(0), VFR(3), o[3]); VRD(3, 13); C0[6] = EX(C0[6]); C0[7] = EX(C0[7]); PIN(C0); SBAR(); \
    o[0] = MFMA32(PAF(1), VFR(0), o[0]); VRD(0, 2); C0[8] = EX(C0[8]); C0[9] = EX(C0[9]); PIN(C0); SBAR(); \
    o[1] = MFMA32(PAF(1), VFR(1), o[1]); VRD(1, 6); C0[10] = EX(C0[10]); C0[11] = EX(C0[11]); PIN(C0); SBAR(); \
    o[2] = MFMA32(PAF(1), VFR(2), o[2]); VRD(2, 10); C0[12] = EX(C0[12]); C0[13] = EX(C0[13]); PIN(C0); SBAR(); \
    o[3] = MFMA32(PAF(1), VFR(3), o[3]); VRD(3, 14); C0[14] = EX(C0[14]); C0[15] = EX(C0[15]); PIN(C0); SBAR(); \
    o[0] = MFMA32(PAF(2), VFR(0), o[0]); VRD(0, 3); C1[0] = EX(C1[0]); C1[1] = EX(C1[1]); PIN(C1); SBAR(); \
    KRD(GL, 0); o[1] = MFMA32(PAF(2), VFR(1), o[1]); VRD(1, 7); C1[2] = EX(C1[2]); C1[3] = EX(C1[3]); PIN(C1); SBAR(); \
    KRD(GL, 1); o[2] = MFMA32(PAF(2), VFR(2), o[2]); VRD(2, 11); C1[4] = EX(C1[4]); C1[5] = EX(C1[5]); PIN(C1); SBAR(); \
    KRD(GL, 2); o[3] = MFMA32(PAF(2), VFR(3), o[3]); VRD(3, 15); C1[6] = EX(C1[6]); C1[7] = EX(C1[7]); PIN(C1); SBAR(); \
    KRD(GL, 3); o[0] = MFMA32(PAF(3), VFR(0), o[0]); C1[8] = EX(C1[8]); C1[9] = EX(C1[9]); PIN(C1); SBAR(); \
    o[1] = MFMA32(PAF(3), VFR(1), o[1]); C1[10] = EX(C1[10]); C1[11] = EX(C1[11]); PIN(C1); SBAR(); \
    o[2] = MFMA32(PAF(3), VFR(2), o[2]); C1[12] = EX(C1[12]); C1[13] = EX(C1[13]); PIN(C1); SBAR(); \
    o[3] = MFMA32(PAF(3), VFR(3), o[3]); C1[14] = EX(C1[14]); C1[15] = EX(C1[15]); PIN(C1); { float iv_ = INI_ADD((t) + 1) - mhat; _Pragma("unroll") for (int r_ = 0; r_ < 16; ++r_) inin[r_] = iv_; } PIN(inin); SBAR(); \
    } while (0)
#define PKW(P, i) cvtpk_s(P[i], P[i + 1])
#define PAF(k) __builtin_bit_cast(bf16x8, pw##k)
#define VFR(i) (bf16x8){vlo[i][0], vlo[i][1], vlo[i][2], vlo[i][3], vhi[i][0], vhi[i][1], vhi[i][2], vhi[i][3]}
#define VRD(s, f) do { vlo[s] = vtr(vp_ + (((f) >> 2) * 4096 + ((f) & 3) * 1024)); vhi[s] = vtr(vp_ + (((f) >> 2) * 4096 + ((f) & 3) * 1024 + 512)); } while (0)
#define KRD(G, j) do { if (G) { const lds_cptr kq_ = kp0 + sl_next * L::KB + (j) * 2048; kf[2 * (j)] = kld(kq_); kf[2 * (j) + 1] = kld(kq_ + 512); SBAR(); } } while (0)
#define ROT() do { sl_prev = sl_cur; sl_cur = sl_next; sl_next = (sl_next == NSLOT - 1) ? 0 : sl_next + 1; } while (0)
#define CMASK(C0, C1, t) do { } while (0)
#define DECIDE(C0, C1) do { float a_ = MX3(C0[0], C0[1], C1[0]), b_ = MX3(C0[2], C0[3], C1[1]); a_ = MX3(a_, C1[2], C1[3]); \
      _Pragma("unroll") for (int r_ = 4; r_ < 16; r_ += 4) { a_ = MX3(a_, C0[r_], C0[r_ + 1]); b_ = MX3(b_, C0[r_ + 2], C0[r_ + 3]); a_ = MX3(a_, C1[r_], C1[r_ + 1]); b_ = MX3(b_, C1[r_ + 2], C1[r_ + 3]); } \
      float rm_ = __builtin_fmaxf(a_, b_); { auto rr_ = __builtin_amdgcn_permlane32_swap(__float_as_uint(rm_), __float_as_uint(rm_), false, false); rm_ = __builtin_fmaxf(__uint_as_float(rr_[0]), __uint_as_float(rr_[1])); } \
      resc = false; \
      if (__builtin_expect(__any(rm_ > (float)THRL), 0)) { const float dl_ = __builtin_fmaxf(rm_, 0.f); mhat += dl_; NEGM_UPDATE(); \
        _Pragma("unroll") for (int r_ = 0; r_ < 16; ++r_) { C0[r_] -= dl_; C1[r_] -= dl_; } \
        const float f_ = __builtin_amdgcn_exp2f(-dl_); l_reg *= f_; if (hi == 0) wsf[r32] = f_; resc = true; } } while (0)
#define RESC(NO_) do { if (resc) { asm volatile("s_waitcnt lgkmcnt(0)" ::: "memory"); \
      _Pragma("unroll") for (int r_ = 0; r_ < 16; ++r_) { const float f_ = wsf[crow(r_, hi)]; _Pragma("unroll") for (int d_ = 0; d_ < NO_; ++d_) o[d_][r_] *= f_; } } } while (0)
#define ENDW(tt, W2, W1) do { if ((tt) + 3 < NT) { WAIT_BAR(W2); } else if ((tt) + 2 < NT) { WAIT_BAR(W1); } else { WAIT_BAR(0); } } while (0)
#define DRAIN_PV(P0, P1, slot_, NO_) do { float sacc_ = P0[0] + P0[1]; \
      _Pragma("unroll") for (int r_ = 2; r_ < 16; ++r_) sacc_ += P0[r_]; \
      _Pragma("unroll") for (int r_ = 0; r_ < 16; ++r_) sacc_ += P1[r_]; \
      l_reg += sacc_; \
      pw0 = (u32x4){PKW(P0, 0), PKW(P0, 2), PKW(P0, 4), PKW(P0, 6)}; pw1 = (u32x4){PKW(P0, 8), PKW(P0, 10), PKW(P0, 12), PKW(P0, 14)}; \
      pw2 = (u32x4){PKW(P1, 0), PKW(P1, 2), PKW(P1, 4), PKW(P1, 6)}; pw3 = (u32x4){PKW(P1, 8), PKW(P1, 10), PKW(P1, 12), PKW(P1, 14)}; \
      const lds_cptr vp_ = vp0 + (slot_) * L::VB; \
      _Pragma("unroll") for (int d_ = 0; d_ < NO_; ++d_) { \
          VRD(0, d_ * 4 + 0); VRD(1, d_ * 4 + 1); VRD(2, d_ * 4 + 2); VRD(3, d_ * 4 + 3); \
          o[d_] = MFMA32(PAF(0), VFR(0), o[d_]); o[d_] = MFMA32(PAF(1), VFR(1), o[d_]); o[d_] = MFMA32(PAF(2), VFR(2), o[d_]); o[d_] = MFMA32(PAF(3), VFR(3), o[d_]); SBAR(); } } while (0)
#define BSTEP(STEPX, NO_, C0, C1, P0, P1, t, GK, GV, GL) do { \
      if ((t) <= Lw) { STEPX(C0, C1, P0, P1, t, false, GK, GV, ((GL) && ((t) + 1 <= Lw))); } \
      else { resc = false; if (GK) DMA_K((t) + 3, sl_cur); if (GV) DMA_V((t) + 1, sl_next); \
             if ((t) == Lw + 1) DRAIN_PV(P0, P1, sl_prev, NO_); } } while (0)

template <int DQK, int DV>
__device__ __forceinline__ void store_rows(const f32x16 (&y)[DV / 32], bf16* dst, int pitch, char* shm) {
    typedef Lay<DQK, DV> L;
    const int tid_ = otid(), lane = tid_ & 63, r32 = lane & 31, hi = lane >> 5; const int wid = __builtin_amdgcn_readfirstlane(tid_ >> 6);
    bf16* stg = (bf16*)(shm + L::LDS_OST + wid * L::OSTW);
#pragma unroll
    for (int half = 0; half < DV / 64; ++half) {
#pragma unroll
        for (int r = 0; r < 16; ++r) { const int orow = crow(r, hi);
#pragma unroll
            for (int d0 = 0; d0 < 2; ++d0) { const unsigned pk = cvtpk_s(y[2 * half + d0][r], 0.f); stg[orow * 64 + d0 * 32 + r32] = (bf16)(pk & 0xffffu); } }
        asm volatile("s_waitcnt lgkmcnt(0)" ::: "memory");
#pragma unroll
        for (int i = 0; i < 4; ++i) { const int row = i * 8 + (lane >> 3), ch = lane & 7; const u32x4 v = *(const u32x4*)(stg + row * 64 + ch * 8);
            *(u32x4*)(dst + (long)(32 * wid + i * 8 + (lane >> 3)) * pitch + half * 64 + ch * 8) = v; }
        asm volatile("s_waitcnt lgkmcnt(0)" ::: "memory");
    }
}
template <int DQK, int DV>
__device__ __forceinline__ void row_rcp(float (&rli)[16], float l_reg, char* shm) {
    typedef Lay<DQK, DV> L;
    const int tid_ = otid(), lane = tid_ & 63, r32 = lane & 31, hi = lane >> 5; const int wid = __builtin_amdgcn_readfirstlane(tid_ >> 6);
    float* wsf = (float*)(shm + L::LDS_WS) + wid * 64;
    { auto rr = __builtin_amdgcn_permlane32_swap(__float_as_uint(l_reg), __float_as_uint(l_reg), false, false); l_reg = __uint_as_float(rr[0]) + __uint_as_float(rr[1]); }
    if (hi == 0) wsf[32 + r32] = l_reg;
    asm volatile("s_waitcnt lgkmcnt(0)" ::: "memory");
#pragma unroll
    for (int r = 0; r < 16; ++r) rli[r] = __builtin_amdgcn_rcpf(wsf[32 + crow(r, hi)]);
}

struct MlaT { const bf16 *QA, *KN, *KR, *VA; bf16* MIX; };
__device__ __forceinline__ void mla_unit(int b, int h, int qb, const MlaT& T, char* shm) {
    typedef Lay<96, 64> L;
    const int tid = otid(), lane = tid & 63, r32 = lane & 31, hi = lane >> 5; const int wid = __builtin_amdgcn_readfirstlane(tid >> 6);
    const long rowbase = (long)b * SEQ; const int q0 = qb * QB, NT = 4 * qb + 4; const int Lw = NT - 4 + (wid >> 1);
    const bf16* Qrow = T.QA + (rowbase + q0 + 32 * wid + r32) * 768 + h * 96;
    const unsigned lds0 = (unsigned)(uintptr_t)shm; float* wsf = (float*)(shm + L::LDS_WS) + wid * 64;
    const bf16* ksrc = T.KN + rowbase * 512 + h * 64 + (long)lane * 512 + wid * 8;
    const bf16* k2src = T.KR + rowbase * 32 + (long)lane * 32 + (wid & 3) * 8;
    const bf16* vsrc = T.VA + rowbase * 512 + h * 64 + (long)(16 * (wid & 3) + (lane >> 2)) * 512 + (wid >> 2) * 32 + (lane & 3) * 8;
    const unsigned kdst = lds0 + L::LDS_K + wid * 1024, k2dst = lds0 + L::LDS_K + (8 + (wid & 3)) * 1024, vdst = lds0 + L::LDS_V + wid * 1024;
#define DMA_K(t, slot) do { glds16(ksrc + (long)(t) * KVBLK * 512, (unsigned)__builtin_amdgcn_readfirstlane(kdst + (slot) * L::KB)); glds16(k2src + (long)(t) * KVBLK * 32, (unsigned)__builtin_amdgcn_readfirstlane(k2dst + (slot) * L::KB)); } while (0)
#define DMA_V(t, slot) glds16(vsrc + (long)(t) * KVBLK * 512, (unsigned)__builtin_amdgcn_readfirstlane(vdst + (slot) * L::VB))
#define INI_ADD(t) 0.f
#define NEGM_UPDATE() do { _Pragma("unroll") for (int r_ = 0; r_ < 16; ++r_) negm[r_] = -mhat; } while (0)
#define MIDDLE(C0, C1, t, BAND) do { if (BAND) CMASK(C0, C1, t); DECIDE(C0, C1); } while (0)
    const lds_cptr shm3 = (lds_cptr)shm;
    const lds_cptr vp0 = shm3 + L::LDS_V + ((lane >> 4) & 1) * 32 + (lane & 3) * 8 + (4 * hi + ((lane & 15) >> 2)) * 64;
    const lds_cptr kp0 = shm3 + L::LDS_K + hi * 1024 + r32 * 16;
    DMA_K(0, 0); DMA_V(0, 0); DMA_K(1, 1);
    bf16x8 qr[6];
#pragma unroll
    for (int d0 = 0; d0 < 6; ++d0) qr[d0] = *reinterpret_cast<const bf16x8*>(&Qrow[d0 * 16 + hi * 8]);
    float mhat = 0.f, l_reg = 0.f; f32x16 o[2]; o[0] = f32x16{}; o[1] = f32x16{};
    bool resc = false;
    f32x16 pA0, pA1, pB0, pB1; bf16x8 kf[12]; s16x4 vlo[8], vhi[8]; u32x4 pw0, pw1, pw2, pw3;
    int sl_prev = 0, sl_cur = 0, sl_next = 1;
    DMA_K(2, 2);
    WAIT_BAR(5);
    { f32x16 z = f32x16{};
#pragma unroll
      for (int d0 = 0; d0 < 6; ++d0) { const bf16x8 b0 = kld(kp0 + d0 * 2048), b1 = kld(kp0 + d0 * 2048 + 512);
          if (d0 == 0) { pA0 = MFMA32(b0, qr[0], z); pA1 = MFMA32(b1, qr[0], z); } else { pA0 = MFMA32(b0, qr[d0], pA0); pA1 = MFMA32(b1, qr[d0], pA1); } }
      const float rm = rowmax(pA0, pA1); mhat = rm;
#pragma unroll
      for (int r = 0; r < 16; ++r) { pA0[r] = EX(pA0[r] - rm); pA1[r] = EX(pA1[r] - rm); } }
    f32x16 negm; NEGM_UPDATE(); asm volatile("" : "+v"(negm));
    WAIT_BAR(0);
    DMA_K(3, 0); DMA_V(1, 1); ROT();
#pragma unroll
    for (int j = 0; j < 6; ++j) { const lds_cptr kq = kp0 + sl_cur * L::KB + j * 2048; kf[2 * j] = kld(kq); kf[2 * j + 1] = kld(kq + 512); }
    WAIT_BAR(3);
    int t = 1;
    for (; t + 5 < NT; t += 2) {
        STEP_MLA(pB0, pB1, pA0, pA1, t, false, true, true, true);     WAIT_BAR(3); RESC(2); ROT();
        STEP_MLA(pA0, pA1, pB0, pB1, t + 1, false, true, true, true); WAIT_BAR(3); RESC(2); ROT();
    }
#pragma nounroll
    for (; t <= Lw; ++t) {
        STEP_MLA(pB0, pB1, pA0, pA1, t, false, (t + 3 < NT), (t + 1 < NT), (t + 1 <= Lw));
        if (t + 1 < NT) { ENDW(t, 3, 1); }
        RESC(2);
        if (t + 1 < NT) ROT();
        pA0 = pB0; pA1 = pB1;
    }
    if (t < NT) {
        if (t + 3 < NT) DMA_K(t + 3, sl_cur); if (t + 1 < NT) DMA_V(t + 1, sl_next);
        DRAIN_PV(pA0, pA1, sl_prev, 2);
        if (t + 1 < NT) { ENDW(t, 3, 1); ROT(); }
        ++t;
#pragma nounroll
        for (; t < NT; ++t) {
            if (t + 3 < NT) DMA_K(t + 3, sl_cur); if (t + 1 < NT) DMA_V(t + 1, sl_next);
            if (t + 1 < NT) { ENDW(t, 3, 1); ROT(); }
        }
    } else { DRAIN_PV(pA0, pA1, sl_cur, 2); }
    float rli[16]; row_rcp<96, 64>(rli, l_reg, shm);
#pragma unroll
    for (int d = 0; d < 2; ++d)
#pragma unroll
        for (int r = 0; r < 16; ++r) o[d][r] *= rli[r];
    store_rows<96, 64>(o, T.MIX + (rowbase + q0) * 1024 + h * 64, 1024, shm);
    asm volatile("s_waitcnt vmcnt(0) lgkmcnt(0)\n\ts_barrier" ::: "memory");
#undef DMA_K
#undef DMA_V
#undef INI_ADD
#undef NEGM_UPDATE
#undef MIDDLE
}

struct DiffT { const bf16 *DQ, *DK, *DV; bf16* MIX; float* OB; const float *rel_bias, *g_subln; float lam; };
__device__ __forceinline__ int t5_bucket(int rel) {
    const int n = rel < 0 ? -rel : rel; int bk = n;
    if (n >= 8) { bk = 2 + (31 - __clz(n * n)); bk = bk > 15 ? 15 : bk; }
    return (rel > 0 ? 16 : 0) + bk;
}
__device__ __forceinline__ void diff_pass(f32x16 (&o)[4], float& l_out, int b, int h, int qb, int mo, const DiffT& T, char* shm, float cfar) {
    typedef Lay<64, 128> L;
    const int tid = otid(), lane = tid & 63, r32 = lane & 31, hi = lane >> 5; const int wid = __builtin_amdgcn_readfirstlane(tid >> 6);
    const long rowbase = (long)b * SEQ; const int q0 = qb * QB, NT = 4 * qb + 4; const int Lw = NT - 4 + (wid >> 1);
    const int urow = 32 * wid + r32;
    const bf16* Qrow = T.DQ + (rowbase + q0 + urow) * 512 + h * 128 + mo;
    const unsigned lds0 = (unsigned)(uintptr_t)shm; float* wsf = (float*)(shm + L::LDS_WS) + wid * 64;
    const float* bt = (const float*)(shm + L::LDS_BT);
    const bf16* ksrc = T.DK + rowbase * 512 + h * 128 + mo + (long)lane * 512 + wid * 8;
    const bf16* vsrc = T.DV + rowbase * 512 + h * 128 + (long)(16 * (wid & 3) + (lane >> 2)) * 512 + (wid >> 2) * 32 + (lane & 3) * 8;
    const unsigned kdst = lds0 + L::LDS_K + wid * 1024, vdst = lds0 + L::LDS_V + wid * 1024;
#define DMA_K(t, slot) glds16(ksrc + (long)(t) * KVBLK * 512, (unsigned)__builtin_amdgcn_readfirstlane(kdst + (slot) * L::KB))
#define DMA_V(t, slot) do { glds16(vsrc + (long)(t) * KVBLK * 512, (unsigned)__builtin_amdgcn_readfirstlane(vdst + (slot) * L::VB)); glds16(vsrc + (long)(t) * KVBLK * 512 + 64, (unsigned)__builtin_amdgcn_readfirstlane(vdst + (slot) * L::VB + 8192)); } while (0)
#define INI_ADD(t) (((t) < NT - 6) ? cfar : 0.f)
#define NEGM_UPDATE() do { } while (0)
#define BIAS_ADD(C0, C1, t) do { if ((t) >= NT - 6) { const float* bp_ = bt + (64 * (t) - (q0 + urow) + 384 + 4 * hi); \
      _Pragma("unroll") for (int r_ = 0; r_ < 16; ++r_) { C0[r_] += bp_[(r_ & 3) + 8 * (r_ >> 2)]; C1[r_] += bp_[32 + (r_ & 3) + 8 * (r_ >> 2)]; } } } while (0)
#define MIDDLE(C0, C1, t, BAND) do { BIAS_ADD(C0, C1, t); if (BAND) CMASK(C0, C1, t); DECIDE(C0, C1); } while (0)
    const lds_cptr shm3 = (lds_cptr)shm;
    const lds_cptr vp0 = shm3 + L::LDS_V + ((lane >> 4) & 1) * 32 + (lane & 3) * 8 + (4 * hi + ((lane & 15) >> 2)) * 64;
    const lds_cptr kp0 = shm3 + L::LDS_K + hi * 1024 + r32 * 16;
    DMA_K(0, 0); DMA_V(0, 0); DMA_K(1, 1);
    bf16x8 qr[4];
#pragma unroll
    for (int d0 = 0; d0 < 4; ++d0) qr[d0] = *reinterpret_cast<const bf16x8*>(&Qrow[d0 * 16 + hi * 8]);
    float mhat = 0.f, l_reg = 0.f;
#pragma unroll
    for (int d = 0; d < 4; ++d) o[d] = f32x16{};
    bool resc = false;
    f32x16 pA0, pA1, pB0, pB1; bf16x8 kf[8]; s16x4 vlo[8], vhi[8]; u32x4 pw0, pw1, pw2, pw3;
    int sl_prev = 0, sl_cur = 0, sl_next = 1;
    DMA_K(2, 2);
    WAIT_BAR(4);
    { f32x16 z; { const float iv = INI_ADD(0);
#pragma unroll
        for (int r = 0; r < 16; ++r) z[r] = iv; }
#pragma unroll
      for (int d0 = 0; d0 < 4; ++d0) { const bf16x8 b0 = kld(kp0 + d0 * 2048), b1 = kld(kp0 + d0 * 2048 + 512);
          if (d0 == 0) { pA0 = MFMA32(b0, qr[0], z); pA1 = MFMA32(b1, qr[0], z); } else { pA0 = MFMA32(b0, qr[d0], pA0); pA1 = MFMA32(b1, qr[d0], pA1); } }
      BIAS_ADD(pA0, pA1, 0);
      const float rm = rowmax(pA0, pA1); mhat = rm;
#pragma unroll
      for (int r = 0; r < 16; ++r) { pA0[r] = EX(pA0[r] - rm); pA1[r] = EX(pA1[r] - rm); } }
    f32x16 inin; { const float iv = INI_ADD(1) - mhat;
#pragma unroll
        for (int r = 0; r < 16; ++r) inin[r] = iv; }
    asm volatile("" : "+v"(inin));
    WAIT_BAR(0);
    DMA_K(3, 0); DMA_V(1, 1); ROT();
#pragma unroll
    for (int j = 0; j < 4; ++j) { const lds_cptr kq = kp0 + sl_cur * L::KB + j * 2048; kf[2 * j] = kld(kq); kf[2 * j + 1] = kld(kq + 512); }
    WAIT_BAR(3);
    int t = 1;
    for (; t + 5 < NT; t += 2) {
        STEP_DIF(pB0, pB1, pA0, pA1, t, false, true, true, true);     WAIT_BAR(3); RESC(4); ROT();
        STEP_DIF(pA0, pA1, pB0, pB1, t + 1, false, true, true, true); WAIT_BAR(3); RESC(4); ROT();
    }
#pragma nounroll
    for (; t <= Lw; ++t) {
        STEP_DIF(pB0, pB1, pA0, pA1, t, false, (t + 3 < NT), (t + 1 < NT), (t + 1 <= Lw));
        if (t + 1 < NT) { ENDW(t, 3, 2); }
        RESC(4);
        if (t + 1 < NT) ROT();
        pA0 = pB0; pA1 = pB1;
    }
    if (t < NT) {
        if (t + 3 < NT) DMA_K(t + 3, sl_cur); if (t + 1 < NT) DMA_V(t + 1, sl_next);
        DRAIN_PV(pA0, pA1, sl_prev, 4);
        if (t + 1 < NT) { ENDW(t, 3, 2); ROT(); }
        ++t;
#pragma nounroll
        for (; t < NT; ++t) {
            if (t + 3 < NT) DMA_K(t + 3, sl_cur); if (t + 1 < NT) DMA_V(t + 1, sl_next);
            if (t + 1 < NT) { ENDW(t, 3, 2); ROT(); }
        }
    } else { DRAIN_PV(pA0, pA1, sl_cur, 4); }
    l_out = l_reg;
    asm volatile("s_waitcnt lgkmcnt(0)\n\ts_barrier" ::: "memory");
#undef DMA_K
#undef DMA_V
#undef INI_ADD
#undef NEGM_UPDATE
#undef BIAS_ADD
#undef MIDDLE
}
__device__ __forceinline__ void diff_unit(int b, int h, int qb, const DiffT& T, char* shm) {
    typedef Lay<64, 128> L;
    const int tid = otid(); const int wid = __builtin_amdgcn_readfirstlane(tid >> 6);
    const long rowbase = (long)b * SEQ; const int q0 = qb * QB;
    constexpr float LOG2E = 1.4426950408889634f;
    { float* bt = (float*)(shm + L::LDS_BT); if (tid < 448) bt[tid] = T.rel_bias[t5_bucket(tid - 384) * 4 + h] * LOG2E; }
    const float cfar = T.rel_bias[15 * 4 + h] * LOG2E;
    asm volatile("s_waitcnt lgkmcnt(0)\n\ts_barrier" ::: "memory");
    unsigned* const obw = (unsigned*)(shm + L::LDS_OST + wid * L::OSTW);
    f32x16 o[4]; float l_reg; float rli[16];
    const float lam = T.lam;
#pragma nounroll
    for (int pass = 0; pass < 2; ++pass) {
        diff_pass(o, l_reg, b, h, qb, (pass == 0) ? 64 : 0, T, shm, cfar);
        row_rcp<64, 128>(rli, l_reg, shm);
        if (pass == 0) { unsigned* ob = obw + (otid() & 63);
#pragma unroll
            for (int d = 0; d < 4; ++d)
#pragma unroll
                for (int r = 0; r < 16; r += 2) ob[(d * 8 + (r >> 1)) * 64] = cvtpk_s(o[d][r] * rli[r], o[d][r + 1] * rli[r + 1]);
        }
    }
    float ss[16]; const int lane2 = otid() & 63, r32 = lane2 & 31; const unsigned* ob = obw + lane2;
    unsigned pk2_[4][8];
#pragma unroll
    for (int d = 0; d < 4; ++d)
#pragma unroll
        for (int j = 0; j < 8; ++j) pk2_[d][j] = ob[(d * 8 + j) * 64];
    asm volatile("s_waitcnt lgkmcnt(0)" ::: "memory");
#pragma unroll
    for (int r = 0; r < 16; ++r) { float s = 0.f;
#pragma unroll
        for (int d = 0; d < 4; ++d) { const unsigned w = pk2_[d][r >> 1]; const float o2 = __uint_as_float((r & 1) ? (w & 0xffff0000u) : (w << 16));
            const float y = o[d][r] * rli[r] - lam * o2; o[d][r] = y; s += y * y; }
        ss[r] = s; }
#define SWZ_STEP(K) _Pragma("unroll") for (int r = 0; r < 16; ++r) ss[r] += swz_xor<((K) << 10) | 0x1f>(ss[r]);
    SWZ_STEP(1) SWZ_STEP(2) SWZ_STEP(4) SWZ_STEP(8) SWZ_STEP(16)
#undef SWZ_STEP
#pragma unroll
    for (int d = 0; d < 4; ++d) { const float g = T.g_subln[d * 32 + r32] * 0.8f;
#pragma unroll
        for (int r = 0; r < 16; ++r) o[d][r] *= g * __builtin_amdgcn_rsqf(ss[r] * (1.f / 128.f) + 1e-6f); }
    store_rows<64, 128>(o, T.MIX + (rowbase + q0) * 1024 + 512 + h * 128, 1024, shm);
    asm volatile("s_waitcnt vmcnt(0) lgkmcnt(0)\n\ts_barrier" ::: "memory");
}
#undef SBAR
#undef PIN
#undef WAIT_BAR
#undef MFMA32
#undef EX
#undef MX3
}
#define GAS __attribute__((address_space(1)))
#define LAS __attribute__((address_space(3)))
typedef unsigned short bf16;
typedef unsigned v4u __attribute__((ext_vector_type(4)));
typedef float f32x4 __attribute__((ext_vector_type(4)));
typedef short bf16x8 __attribute__((ext_vector_type(8)));
typedef GAS unsigned gu32;
typedef GAS unsigned long long gu64;
#define RLX_AGENT __ATOMIC_RELAXED, __HIP_MEMORY_SCOPE_AGENT
#define LDS_WAIT() asm volatile("s_waitcnt lgkmcnt(0)" ::: "memory")
#define VM_WAIT() asm volatile("s_waitcnt vmcnt(0)" ::: "memory")
__device__ __forceinline__ unsigned long long rt() { return __builtin_amdgcn_s_memrealtime(); }
__device__ __forceinline__ unsigned f2bf(float f) { unsigned u = __builtin_bit_cast(unsigned, f); return (u + 0x7fffu + ((u >> 16) & 1u)) >> 16; }
__device__ __forceinline__ unsigned pk2(float lo, float hi) { return f2bf(lo) | (f2bf(hi) << 16); }

#define XB_TMO      128
#define XB_XCNT(j)  (256  + 64 * (j))
#define XB_XSUB(j)  (1280 + 64 * (j))
#define XB_XGEN(j)  (2304 + 64 * (j))
#define XB_TOP      3328
#define XB_TOPGEN   3392
#define XCD_BAR_WORDS 3456
#define XB_SPIN_CAP (1u << 18)

__device__ __forceinline__ unsigned xb_ld(unsigned* p)              { return __hip_atomic_load(p, __ATOMIC_RELAXED, __HIP_MEMORY_SCOPE_AGENT); }
__device__ __forceinline__ unsigned xb_add(unsigned* p, unsigned v) { return __hip_atomic_fetch_add(p, v, __ATOMIC_RELAXED, __HIP_MEMORY_SCOPE_AGENT); }
__device__ __forceinline__ unsigned xb_xcc_id() { return (unsigned)__builtin_amdgcn_s_getreg((3 << 11) | 20) & 0xFu; }
#define XB_SPIN(cond, bar) do { unsigned _sp = 0; while (cond) { __builtin_amdgcn_s_sleep(1); \
    if ((++_sp & 255u) == 0u) { if (xb_ld(&(bar)[XB_TMO])) break; if (_sp > XB_SPIN_CAP) { atomicAdd(&(bar)[XB_TMO], 1u); break; } } } } while (0)

struct XcdBarrier {
    unsigned* bar; unsigned x;
    volatile LAS unsigned* st;
};

__device__ __forceinline__ XcdBarrier xcd_barrier_post(unsigned* bar, volatile LAS unsigned* st) {
    XcdBarrier b; b.bar = bar; b.x = xb_xcc_id(); b.st = st;
    if (threadIdx.x == 0) st[2] = xb_add(&bar[XB_XCNT(b.x)], 1u);
    return b;
}
__device__ __forceinline__ void xcd_barrier_complete(unsigned* bar, unsigned x, unsigned& nloc, unsigned& nx) {
    const unsigned G = gridDim.x * gridDim.y * gridDim.z;
    unsigned sum, cnt, mine, sp = 0u;
    for (;;) {
        sum = 0u; cnt = 0u; mine = 0u;
#pragma unroll
        for (unsigned j = 0; j < 16; ++j) { const unsigned c = xb_ld(&bar[XB_XCNT(j)]); sum += c; cnt += (c > 0u) ? 1u : 0u; mine = (j == x) ? c : mine; }
        if (sum == G) break;
        __builtin_amdgcn_s_sleep(1);
        if ((++sp & 255u) == 0u) { if (xb_ld(&bar[XB_TMO])) break; if (sp > XB_SPIN_CAP) { atomicAdd(&bar[XB_TMO], 1u); break; } }
    }
    nloc = mine > 0u ? mine : 1u; nx = cnt > 0u ? cnt : 1u;
}

__device__ __forceinline__ void xcd_barrier(const XcdBarrier& b) {
    asm volatile("s_waitcnt vmcnt(0)" ::: "memory");
    __syncthreads();
    if (threadIdx.x == 0) {
        unsigned* bar = b.bar;
        __builtin_amdgcn_s_waitcnt(0);
        unsigned nloc = b.st[0], nx = b.st[1];
        if (nloc == 0u) { xcd_barrier_complete(bar, b.x, nloc, nx); b.st[0] = nloc; b.st[1] = nx; }
        const unsigned old = xb_add(&bar[XB_XSUB(b.x)], 1u);
        const unsigned gen = old / nloc;
        if (old + 1u == (gen + 1u) * nloc) {
            __builtin_amdgcn_fence(__ATOMIC_RELEASE, "agent");
            asm volatile("s_waitcnt vmcnt(0)" ::: "memory");
            const unsigned og = xb_add(&bar[XB_TOP], 1u);
            const unsigned tg = og / nx;
            if (og + 1u == (tg + 1u) * nx) xb_add(&bar[XB_TOPGEN], 1u);
            else XB_SPIN(xb_ld(&bar[XB_TOPGEN]) == tg, bar);
            __builtin_amdgcn_fence(__ATOMIC_ACQUIRE, "agent");
            xb_add(&bar[XB_XGEN(b.x)], 1u);
            asm volatile("s_waitcnt vmcnt(0)" ::: "memory");
        } else {
            XB_SPIN(xb_ld(&bar[XB_XGEN(b.x)]) == gen, bar);
            __builtin_amdgcn_fence(__ATOMIC_ACQUIRE, "agent");
            asm volatile("s_waitcnt vmcnt(0)" ::: "memory");
        }
    }
    __syncthreads();
}

__device__ __forceinline__ void xcc_barrier(const XcdBarrier& b) {
    asm volatile("s_waitcnt vmcnt(0)" ::: "memory");
    __syncthreads();
    if (threadIdx.x == 0) {
        unsigned* bar = b.bar;
        __builtin_amdgcn_s_waitcnt(0);
        const unsigned nloc = b.st[0];
        const unsigned old = xb_add(&bar[XB_XSUB(b.x)], 1u);
        const unsigned gen = old / nloc;
        if (old + 1u == (gen + 1u) * nloc) xb_add(&bar[XB_XGEN(b.x)], 1u);
        else XB_SPIN(xb_ld(&bar[XB_XGEN(b.x)]) == gen, bar);
        __builtin_amdgcn_fence(__ATOMIC_ACQUIRE, "agent");
        asm volatile("s_waitcnt vmcnt(0)" ::: "memory");
    }
    __syncthreads();
}
__device__ __forceinline__ bool xcc_team_setup(const XcdBarrier& b) {
    if (threadIdx.x < 64) { const unsigned G = gridDim.x, j = threadIdx.x & 15u;
        const unsigned c = xb_ld(&b.bar[XB_XCNT(j)]);
        const bool okl = (j < 8u) ? (c == G / 8u) : (c == 0u);
        const bool ok = ((G % 8u) == 0u) && (__all(okl ? 1 : 0) != 0);
        if (threadIdx.x == 0) b.st[3] = ok ? 1u : 0u; }
    __syncthreads();
    return b.st[3] != 0u;
}

constexpr int NWAVES = 8;
constexpr int M_TOK = 32768, D_MODEL = 1024, SEQ_L = 4096, FFN_H = 2816, IN_COLS = 1952;
constexpr size_t MiB = 1u << 20;
constexpr size_t WS_CTL = 0, CTL_ZERO_BYTES = 128 * 1024;
constexpr size_t WS_WIN = 2 * MiB;
constexpr size_t WS_WQKV = 6 * MiB;
constexpr size_t WS_WO = 8 * MiB;
constexpr size_t WS_WGU = 10 * MiB;
constexpr size_t WS_WD = 22 * MiB;
constexpr size_t WS_XCH = 27 * MiB + 512 * 1024;
constexpr size_t WS_ROPE = 28 * MiB;
constexpr size_t WS_RSTDX = 28 * MiB + 512 * 1024;
constexpr size_t WS_SSQQ = 29 * MiB;
constexpr size_t WS_SSQKV = 29 * MiB + 512 * 1024;
constexpr size_t WS_SSQX1 = 30 * MiB;
constexpr size_t WS_XN = 32 * MiB;
constexpr size_t WS_CQKV = 96 * MiB;
constexpr size_t WS_KR = 120 * MiB;
constexpr size_t WS_DQ = 128 * MiB, WS_DK = 160 * MiB, WS_DV = 192 * MiB;
constexpr size_t WS_QA = 224 * MiB;
constexpr size_t WS_KN = 272 * MiB, WS_VA = 304 * MiB;
constexpr size_t WS_MIX = 336 * MiB;
constexpr size_t WS_OB = 400 * MiB;
constexpr size_t WS_H = 96 * MiB;
constexpr size_t WS_END = 464 * MiB;
static_assert(WS_H + (size_t)M_TOK * FFN_H * 2 <= WS_MIX, "h overlay");
constexpr int CW_TMO = 0, CW_CODE = 1, CW_BAR = 4096, CW_SEAM = 16384;
constexpr int RING_OFF = 0, RING_BYTES = 131072;
constexpr int LDS_BYTES = 147456;
constexpr int XL_OFF = RING_BYTES;
constexpr int LDSCTL_OFF = LDS_BYTES - 1024, MISC_OFF = LDSCTL_OFF + 320;
static_assert(att::Lay<64, 128>::LDS_END <= LDSCTL_OFF && att::Lay<96, 64>::LDS_END <= LDSCTL_OFF, "attention scratch stays below the control words");

struct Args { const float* in[19]; float* out; unsigned char* ws; int ph_lo, ph_hi; };
static_assert(sizeof(Args) == 19 * 8 + 8 + 8 + 8, "no padding in Args");

__device__ __forceinline__ float wave_sum(float v) {
#pragma unroll
    for (int o = 1; o < 64; o <<= 1) v += __shfl_xor(v, o);
    return v;
}
__device__ __forceinline__ void transpose_item(const float* W, int ldw, const float* gain, bf16* WT, int ldt, LAS float* scr, int ks0, int kd0, int drow0, int srccol, int lane) {
    float v[32]; const int sc = srccol < 0 ? 0 : srccol;
#pragma unroll
    for (int i = 0; i < 32; ++i) { const int kk = 2 * i + (lane >> 5); v[i] = __builtin_nontemporal_load(&W[(size_t)(ks0 + kk) * ldw + sc]); }
    if (gain) {
        float gg[32];
#pragma unroll
        for (int i = 0; i < 32; ++i) { const int kk = 2 * i + (lane >> 5); gg[i] = gain[ks0 + kk]; }
#pragma unroll
        for (int i = 0; i < 32; ++i) v[i] *= gg[i];
    }
#pragma unroll
    for (int i = 0; i < 32; ++i) { const int kk = 2 * i + (lane >> 5); scr[kk * 33 + (lane & 31)] = srccol < 0 ? 0.f : v[i]; }
    LDS_WAIT(); asm volatile("" ::: "memory");
    const int c = lane & 7;
#pragma unroll
    for (int j = 0; j < 4; ++j) { const int n = (lane >> 3) + 8 * j; const LAS float* s = scr + (8 * c) * 33 + n;
        v4u o; o.x = pk2(s[0 * 33], s[1 * 33]); o.y = pk2(s[2 * 33], s[3 * 33]); o.z = pk2(s[4 * 33], s[5 * 33]); o.w = pk2(s[6 * 33], s[7 * 33]);
        *(GAS v4u*)(WT + (size_t)(drow0 + n) * ldt + kd0 + 8 * c) = o; }
    LDS_WAIT(); asm volatile("" ::: "memory");
}
__device__ __forceinline__ int map_win(int n) {
    if (n < 256) return n;
    if (n < 512) { const int j = n - 256; if (j < 128) return 256 + j; if (j < 160) { const int p = j - 128; return 384 + (p >> 1) + 16 * (p & 1); } return -1; }
    return 416 + (n - 512);
}
__device__ __forceinline__ int map_wq(int n) {
    if (n < 512) return (n >> 6) * 96 + (n & 63);
    const int j = n - 512, h = j >> 5, p = j & 31; return h * 96 + 64 + (p >> 1) + 16 * (p & 1);
}
__device__ __forceinline__ int map_wkv(int n) {
    if (n < 512) return (n >> 6) * 128 + (n & 63);
    const int j = n - 512; return (j >> 6) * 128 + 64 + (j & 63);
}

__constant__ float ROPE_INV_FREQ[16] = {1.0f, 0.5623413324356079f, 0.3162277638912201f, 0.17782793939113617f, 0.10000000149011612f, 0.05623413249850273f, 0.03162277489900589f, 0.017782794311642647f,
    0.009999999776482582f, 0.005623413249850273f, 0.003162277629598975f, 0.0017782794311642647f, 0.0010000000474974513f, 0.000562341301701963f, 0.0003162277571391314f, 0.00017782794020604342f};

struct Frame {
    LAS unsigned char* lds; volatile LAS unsigned* MISC; gu32* ctl;
    int wave, vcu, G;
};

__global__ void __launch_bounds__(NWAVES * 64, 2) hyb_fwd(Args args) {
    extern __shared__ __attribute__((aligned(16))) unsigned char lds[];
    Frame F;
    F.lds = (LAS unsigned char*)lds; F.MISC = (volatile LAS unsigned*)(F.lds + MISC_OFF);
    F.wave = __builtin_amdgcn_readfirstlane((int)threadIdx.x >> 6);
    F.G = gridDim.x; { const int bx = blockIdx.x; F.vcu = (F.G % 8 == 0) ? (bx % 8) * (F.G / 8) + bx / 8 : bx; }
    F.ctl = (gu32*)(args.ws + WS_CTL);
#define CAS __attribute__((address_space(4)))
#define PH_BEGIN() const CAS char* kap_ = (const CAS char*)__builtin_amdgcn_kernarg_segment_ptr(); asm volatile("" : "+s"(kap_)); unsigned char* const ws = *(unsigned char* const CAS*)(kap_ + 160)
#define INP(k) (*(const float* const CAS*)(kap_ + 8 * (k)))
#define OUTP() (*(float* const CAS*)(kap_ + 152))
#define Win_t ((bf16*)(ws + WS_WIN))
#define Wqkv_t ((bf16*)(ws + WS_WQKV))
#define Wo_t ((bf16*)(ws + WS_WO))
#define Wgu_t ((bf16*)(ws + WS_WGU))
#define Wd_t ((bf16*)(ws + WS_WD))
#define ROPE ((float*)(ws + WS_ROPE))
#define RSTDX ((float*)(ws + WS_RSTDX))
#define SSQ_Q ((float*)(ws + WS_SSQQ))
#define SSQ_KV ((float*)(ws + WS_SSQKV))
#define SSQ_X1 ((float*)(ws + WS_SSQX1))
#define XN ((bf16*)(ws + WS_XN))
#define CQKV ((bf16*)(ws + WS_CQKV))
#define KR ((bf16*)(ws + WS_KR))
#define DQ ((bf16*)(ws + WS_DQ))
#define DK ((bf16*)(ws + WS_DK))
#define DVb ((bf16*)(ws + WS_DV))
#define QA ((bf16*)(ws + WS_QA))
#define KN ((bf16*)(ws + WS_KN))
#define VA ((bf16*)(ws + WS_VA))
#define MIX ((bf16*)(ws + WS_MIX))
#define OB ((float*)(ws + WS_OB))
#define X1B ((bf16*)(ws + WS_OB))
#define HB ((bf16*)(ws + WS_H))
    for (int u = threadIdx.x; u < (LDS_BYTES - LDSCTL_OFF) / 4; u += NWAVES * 64) ((LAS unsigned*)(F.lds + LDSCTL_OFF))[u] = 0u;
    __syncthreads();
    XcdBarrier bar = xcd_barrier_post((unsigned*)(F.ctl + CW_BAR), F.MISC + 8);
    const int lo = args.ph_lo, hi = args.ph_hi;
#ifndef PHASES
#define PHASES 0xFF
#endif
#define IN(k) (((PHASES >> (k)) & 1) && lo <= (k) && (k) < hi)
#define BOTH(k) (IN(k) && IN((k) + 1))
#define GRID_BAR() do { if (team) xcc_barrier(bar); else xcd_barrier(bar); } while (0)
    bool team = false; int bxv = (int)blockIdx.x;
#ifndef PROBE_REPEAT
#define PROBE_REPEAT -1
#endif
#define REPS(k) ((PROBE_REPEAT == (k)) ? reps2 : 1)
    int reps2 = 2; asm volatile("" : "+s"(reps2));
    const int gw = F.vcu * NWAVES + F.wave, NGW = F.G * NWAVES;

    if (IN(0)) _Pragma("nounroll") for (int rep_ = 0; rep_ < REPS(0); ++rep_) {
        PH_BEGIN(); const int tid_ = att::otid(), lane_ = tid_ & 63;
        const float* x = INP(0); const float* w_in = INP(1); const float* g_attn = INP(2); const float* g_q_a = INP(3); const float* w_q_b = INP(4); const float* g_kv_a = INP(5); const float* w_kv_b = INP(6);
        const float* w_o = INP(13); const float* g_ffn = INP(14); const float* w_gate = INP(15); const float* w_up = INP(16); const float* w_down = INP(17);
        LAS float* scr = (LAS float*)(F.lds + RING_OFF + F.wave * 16384);
        constexpr int I_IN = 16 * 64, I_Q = 4 * 24, I_KV = 2 * 32, I_O = 16 * 32, I_GU = 16 * 176, I_D = 44 * 32;
        constexpr int NITEMS = I_IN + I_Q + I_KV + I_O + I_GU + I_D;
        for (int it = gw; it < NITEMS; it += NGW) {
            int r = it; const int l31 = lane_ & 31;
            if (r < I_IN) { const int kb = r / 64, nb = r % 64; transpose_item(w_in, IN_COLS, g_attn, Win_t, 1024, scr, 64 * kb, 64 * kb, 32 * nb, map_win(32 * nb + l31), lane_); continue; } r -= I_IN;
            if (r < I_Q) { const int kb = r / 24, nb = r % 24; transpose_item(w_q_b, 768, g_q_a, Wqkv_t, 384, scr, 64 * kb, 64 * kb, 32 * nb, map_wq(32 * nb + l31), lane_); continue; } r -= I_Q;
            if (r < I_KV) { const int kb = r / 32, nb = r % 32; transpose_item(w_kv_b, 1024, g_kv_a, Wqkv_t, 384, scr, 64 * kb, 256 + 64 * kb, 768 + 32 * nb, map_wkv(32 * nb + l31), lane_); continue; } r -= I_KV;
            if (r < I_O) { const int kb = r / 32, nb = r % 32; transpose_item(w_o, 1024, nullptr, Wo_t, 1024, scr, 64 * kb, 64 * kb, 32 * nb, 32 * nb + l31, lane_); continue; } r -= I_O;
            if (r < I_GU) { const int kb = r / 176, nb = r % 176; const int n = 32 * nb + l31, pn = n >> 8, j = n & 255; const bool up = j >= 128;
                transpose_item(up ? w_up : w_gate, FFN_H, g_ffn, Wgu_t, 1024, scr, 64 * kb, 64 * kb, 32 * nb, 128 * pn + (j & 127), lane_); continue; } r -= I_GU;
            { const int kb = r / 32, nb = r % 32; transpose_item(w_down, 1024, nullptr, Wd_t, FFN_H, scr, 64 * kb, 64 * kb, 32 * nb, 32 * nb + l31, lane_); }
        }
        { const int gt = F.vcu * (NWAVES * 64) + tid_, NGT = F.G * NWAVES * 64; const v4u z = (v4u){0u, 0u, 0u, 0u};
          for (int i = gt; i < 768 * 16; i += NGT) *(GAS v4u*)(Wqkv_t + (size_t)(i >> 4) * 384 + 256 + (i & 15) * 8) = z;
          for (int i = gt; i < 1024 * 32; i += NGT) *(GAS v4u*)(Wqkv_t + (size_t)(768 + (i >> 5)) * 384 + (i & 31) * 8) = z;
          for (int i = gt; i < SEQ_L * 16; i += NGT) { const int pos = i >> 4, k = i & 15; const float ang = (float)pos * ROPE_INV_FREQ[k];
              const double t = (double)ang * 0.15915494309189535; const float fr = (float)(t - __builtin_rint(t));
              ROPE[2 * i] = __builtin_amdgcn_cosf(fr); ROPE[2 * i + 1] = __builtin_amdgcn_sinf(fr); } }
        { for (int m = gw; m < M_TOK; m += 4 * NGW) { f32x4 v[4][4]; float s[4];
#pragma unroll
              for (int q = 0; q < 4; ++q) { const GAS f32x4* xr = (const GAS f32x4*)(x + (size_t)(m + q * NGW) * D_MODEL) + lane_;
#pragma unroll
                  for (int j = 0; j < 4; ++j) v[q][j] = __builtin_nontemporal_load(&xr[64 * j]); }
#pragma unroll
              for (int q = 0; q < 4; ++q) { float t = 0.f;
#pragma unroll
                  for (int j = 0; j < 4; ++j) t += (v[q][j].x * v[q][j].x + v[q][j].y * v[q][j].y) + (v[q][j].z * v[q][j].z + v[q][j].w * v[q][j].w);
                  s[q] = t; }
#pragma unroll
              for (int o = 1; o < 64; o <<= 1)
#pragma unroll
                  for (int q = 0; q < 4; ++q) s[q] += __shfl_xor(s[q], o);
#pragma unroll
              for (int q = 0; q < 4; ++q) { const float rstd = __builtin_amdgcn_rsqf(s[q] * (1.f / D_MODEL) + 1e-6f);
                  GAS unsigned long long* o8 = (GAS unsigned long long*)(XN + (size_t)(m + q * NGW) * D_MODEL) + lane_;
#pragma unroll
                  for (int j = 0; j < 4; ++j) { const f32x4 y = v[q][j]; o8[64 * j] = (unsigned long long)pk2(y.x, y.y) | ((unsigned long long)pk2(y.z, y.w) << 32); }
                  if (lane_ == 0) RSTDX[m + q * NGW] = rstd; } } }
        if (BOTH(0) && rep_ == REPS(0) - 1) { xcd_barrier(bar);
#ifndef NO_TEAM
            team = xcc_team_setup(bar);
            if (team) { const int rank = (int)bar.st[2]; bxv = rank * 8 + (int)bar.x; F.vcu = (int)bar.x * (F.G / 8) + rank;
#if defined(STAGGER_TICKS) && STAGGER_TICKS > 0
                { const unsigned long long t0 = __builtin_amdgcn_s_memrealtime(), dt = (unsigned long long)bar.x * STAGGER_TICKS; while (__builtin_amdgcn_s_memrealtime() - t0 < dt) __builtin_amdgcn_s_sleep(8); }
#endif
            }
#endif
        }
        if (PROBE_REPEAT == 9 && rep_ == 0) { _Pragma("nounroll") for (int q_ = 0; q_ < 4 * reps2; ++q_) GRID_BAR(); }
    }
    if (IN(1)) _Pragma("nounroll") for (int rep_ = 0; rep_ < REPS(1); ++rep_) {
        PH_BEGIN();
        pg8::Gemm g{XN, Win_t, M_TOK, 2048, D_MODEL}; pg8::StaticOrder S; S.init(M_TOK, 2048, F.G, bxv);
        pg8::EpiInProj E{CQKV, KR, DQ, DK, DVb, SSQ_Q, SSQ_KV, ROPE, RSTDX, 0.125f * 1.4426950408889634f};
        pg8::gemm_phase<pg8::EpiInProj, pg8::StaticOrder, true, true>(F.lds + RING_OFF, g, S, E);
        if (BOTH(1) && rep_ == REPS(1) - 1) GRID_BAR();
    }
    if (IN(2)) _Pragma("nounroll") for (int rep_ = 0; rep_ < REPS(2); ++rep_) {
        PH_BEGIN();
        int kq_ = 384; asm volatile("" : "+s"(kq_));
        pg8::Gemm g{CQKV, Wqkv_t, M_TOK, 1792, kq_}; pg8::SplitOrder S; S.init(M_TOK, 1792, F.G, bxv);
        pg8::EpiQKV E{QA, KN, VA, SSQ_Q, SSQ_KV, ROPE, 0.10206207261596575f * 1.4426950408889634f};
        pg8::gemm_phase<pg8::EpiQKV, pg8::SplitOrder, true, true>(F.lds + RING_OFF, g, S, E);
        if (BOTH(2) && rep_ == REPS(2) - 1) GRID_BAR();
    }
    if (IN(3)) _Pragma("nounroll") for (int rep_ = 0; rep_ < REPS(3); ++rep_) {
        PH_BEGIN();
        const float* lam_q1 = INP(7); const float* lam_k1 = INP(8); const float* lam_q2 = INP(9); const float* lam_k2 = INP(10); const float* g_subln = INP(11); const float* rel_bias = INP(12);
        char* shm = (char*)lds + RING_OFF;
#ifndef ATT_ONLY
#define ATT_ONLY 3
#endif
        if (ATT_ONLY & 1) { const att::MlaT T{QA, KN, KR, VA, MIX}; const int bb = F.vcu >> 5, v = F.vcu & 31;
          for (int i = 0; i < 4; ++i) { const int qb = (i & 1) ? 15 - (v & 15) : (v & 15); att::mla_unit(bb, 2 * i + (v >> 4), qb, T, shm); } }
        if (ATT_ONLY & 2) { float lam;
          { const float a = wave_sum(lam_q1[att::otid() & 63] * lam_k1[att::otid() & 63]), b2 = wave_sum(lam_q2[att::otid() & 63] * lam_k2[att::otid() & 63]); lam = __expf(a) - __expf(b2) + 0.2f; }
          const att::DiffT T{DQ, DK, DVb, MIX, OB, rel_bias, g_subln, lam}; const int bb = F.vcu >> 5, v = F.vcu & 31;
          for (int i = 0; i < 2; ++i) { const int qb = (i & 1) ? 15 - (v & 15) : (v & 15); att::diff_unit(bb, 2 * i + (v >> 4), qb, T, shm); } }
        if (BOTH(3) && rep_ == REPS(3) - 1) GRID_BAR();
    }
    if (IN(4)) _Pragma("nounroll") for (int rep_ = 0; rep_ < REPS(4); ++rep_) {
        PH_BEGIN();
        pg8::Gemm g{MIX, Wo_t, M_TOK, D_MODEL, D_MODEL}; pg8::StaticOrder S; S.init(M_TOK, D_MODEL, F.G, bxv);
        pg8::EpiOutProj E{XN, X1B, SSQ_X1};
        pg8::gemm_phase<pg8::EpiOutProj, pg8::StaticOrder, true, true>(F.lds + RING_OFF, g, S, E);
        if (BOTH(4) && rep_ == REPS(4) - 1) GRID_BAR();
    }
    if (IN(5)) _Pragma("nounroll") for (int rep_ = 0; rep_ < REPS(5); ++rep_) {
        PH_BEGIN();
        pg8::Gemm g{X1B, Wgu_t, M_TOK, 2 * FFN_H, D_MODEL}; pg8::StaticOrder S; S.init(M_TOK, 2 * FFN_H, F.G, bxv);
        const pg8::HMap hm{ws, WS_XN, WS_MIX, WS_DQ, WS_DK, WS_DV}; pg8::EpiGateUp E{hm, SSQ_X1};
        pg8::gemm_phase<pg8::EpiGateUp, pg8::StaticOrder, true, true>(F.lds + RING_OFF, g, S, E);
        if (BOTH(5) && rep_ == REPS(5) - 1) GRID_BAR();
    }
    if (IN(6)) _Pragma("nounroll") for (int rep_ = 0; rep_ < REPS(6); ++rep_) {
        PH_BEGIN(); float* out = OUTP(); const float* g_final = INP(18);
        pg8::Gemm g{HB, Wd_t, M_TOK, D_MODEL, FFN_H}; pg8::PanelOrder S; S.init(M_TOK, D_MODEL, F.G, bxv); S.hm = pg8::HMap{ws, WS_XN, WS_MIX, WS_DQ, WS_DK, WS_DV};
        pg8::EpiDownNorm E{X1B, out, g_final, (unsigned*)(ws + WS_XCH), (unsigned*)(F.ctl + CW_SEAM), F.lds + XL_OFF};
        pg8::gemm_phase<pg8::EpiDownNorm, pg8::PanelOrder, true, true>(F.lds + RING_OFF, g, S, E);
    }
#undef IN
#undef BOTH
#undef GRID_BAR
}

#ifndef MK_N_LAUNCHES
#define MK_N_LAUNCHES 1
#endif
extern "C" void kernel_launch(void* const* d_in, const int* in_sizes, int n_in, void* d_out, int out_size, void* d_ws, size_t ws_size, hipStream_t stream) {
    static int grid = 0;
    if (grid == 0) {
        if (n_in != 19 || in_sizes[0] != M_TOK * D_MODEL || out_size != M_TOK * D_MODEL || ws_size < WS_END) { fprintf(stderr, "kernel_launch: unexpected shapes (n_in %d, in0 %d, out %d, ws %zu)\n", n_in, n_in > 0 ? in_sizes[0] : -1, out_size, ws_size); grid = -1; return; }
        int dev = 0, cus = 0, per_cu = 0;
        if (hipGetDevice(&dev) != hipSuccess || hipDeviceGetAttribute(&cus, hipDeviceAttributeMultiprocessorCount, dev) != hipSuccess) { grid = -1; return; }
        if (hipFuncSetAttribute((const void*)hyb_fwd, hipFuncAttributeMaxDynamicSharedMemorySize, LDS_BYTES) != hipSuccess) { fprintf(stderr, "kernel_launch: hipFuncSetAttribute failed\n"); grid = -1; return; }
        if (hipOccupancyMaxActiveBlocksPerMultiprocessor(&per_cu, (const void*)hyb_fwd, NWAVES * 64, LDS_BYTES) != hipSuccess || per_cu < 1) fprintf(stderr, "kernel_launch: occupancy query reports %d\n", per_cu);
        (void)hipGetLastError();
        grid = cus;
        if (grid != 256) fprintf(stderr, "kernel_launch: %d CUs (built for 256)\n", grid);
    }
    if (grid < 0) return;
    if (hipMemsetAsync((char*)d_ws + WS_CTL, 0, CTL_ZERO_BYTES, stream) != hipSuccess) return;
    Args a{};
    for (int i = 0; i < 19; ++i) a.in[i] = (const float*)d_in[i];
    a.out = (float*)d_out; a.ws = (unsigned char*)d_ws;
    if (MK_N_LAUNCHES == 1) { a.ph_lo = 0; a.ph_hi = 7; hipLaunchKernelGGL(hyb_fwd, dim3(grid), dim3(NWAVES * 64), LDS_BYTES, stream, a); }
    else { for (int p = 0; p < 7; ++p) { a.ph_lo = p; a.ph_hi = p + 1; hipLaunchKernelGGL(hyb_fwd, dim3(grid), dim3(NWAVES * 64), LDS_BYTES, stream, a); } }
}
```

```cpp
#include <hip/hip_runtime.h>
#include <cstdio>
#include <cstdint>
namespace pg8 {
#define PG8_LAS __attribute__((address_space(3)))
typedef unsigned short bf16_t;
typedef short bf16x8 __attribute__((ext_vector_type(8)));
typedef float f32x4 __attribute__((ext_vector_type(4)));
typedef unsigned u32x4 __attribute__((ext_vector_type(4)));
constexpr int BM = 256, BK = 64, HALF = 128, HTB = HALF * BK * 2  , STAGE_BYTES = 8 * HTB, NXCD = 8, WGM = 8;

__host__ __device__ __forceinline__ int lds_byte(int r, int c) { const int st = (r >> 4) * 2 + (c >> 5), rr = r & 15, cc = c & 31, ob = rr * 64 + cc * 2; return st * 1024 + (ob ^ (((ob >> 9) & 1) << 5)); }
__host__ __device__ __forceinline__ void stage_rc(int b, int& R, int& C) { const int st = b / 1024, sb = b % 1024, swz = sb ^ (((sb >> 9) & 1) << 5); R = (st >> 1) * 16 + swz / 64; C = (st & 1) * 32 + (swz % 64) / 2; }
__host__ __device__ __forceinline__ int perm32(int rho) { const int n = rho >> 4, i = rho & 15; return 8 * (i >> 2) + 4 * n + (i & 3); }

struct Unit { int pm, pn; int kofs, nt; };
struct Gemm { const bf16_t* A; const bf16_t* Bt; int M, N, K; };

struct StaticOrder {
    static constexpr bool KSPLIT = false, APANEL = false;
    int nM, nN, nwg, G, c;
    __host__ __device__ void init(int M, int N, int G_, int c_) { nM = M / BM; nN = N / BM; nwg = nM * nN; G = G_; c = c_; }
    __host__ __device__ bool next(int i, Unit& u) const {
        const long L = (long)i * G + c; if (L >= nwg) return false;
        int wgid = (int)L; { const int q = nwg / NXCD, r = nwg % NXCD, xcd = wgid % NXCD, off = wgid / NXCD; wgid = (xcd < r ? xcd * (q + 1) : r * (q + 1) + (xcd - r) * q) + off; }
        const int nig = WGM * nN, gid = wgid / nig, fm = gid * WGM, gsz = (nM - fm) < WGM ? (nM - fm) : WGM;
        u.pm = fm + ((wgid % nig) % gsz); u.pn = (wgid % nig) / gsz; return true;
    }
    __device__ __forceinline__ void a_ready(const Unit&) const {}
    __device__ __forceinline__ void done(const Unit&) const {}
};

typedef float f32x2p __attribute__((ext_vector_type(2))); typedef __bf16 bf16x2p __attribute__((ext_vector_type(2)));
__device__ __forceinline__ unsigned cvt_pk_bf16(float lo, float hi) { f32x2p v = {lo, hi}; bf16x2p b = __builtin_convertvector(v, bf16x2p); return __builtin_bit_cast(unsigned, b); }
typedef float f32x2 __attribute__((ext_vector_type(2)));
__device__ __forceinline__ u32x4 pack8(const f32x4 a, const f32x4 b) { u32x4 w; w.x = cvt_pk_bf16(a[0], a[1]); w.y = cvt_pk_bf16(a[2], a[3]); w.z = cvt_pk_bf16(b[0], b[1]); w.w = cvt_pk_bf16(b[2], b[3]); return w; }
__device__ __forceinline__ float sq8(const f32x4 a, const f32x4 b) { return ((a[0] * a[0] + a[1] * a[1]) + (a[2] * a[2] + a[3] * a[3])) + ((b[0] * b[0] + b[1] * b[1]) + (b[2] * b[2] + b[3] * b[3])); }
__device__ __forceinline__ float fq_sum(float s) {
    s += __int_as_float(__builtin_amdgcn_ds_swizzle(__float_as_int(s), (16 << 10) | 0x1f));
    auto rr = __builtin_amdgcn_permlane32_swap(__float_as_uint(s), __float_as_uint(s), false, false); return __uint_as_float(rr[0]) + __uint_as_float(rr[1]); }
__device__ __forceinline__ void rope8(f32x4& v0, f32x4& v1, const f32x4 cs0, const f32x4 cs1) {
    const float a0 = v0[0] * cs0[0] - v0[1] * cs0[1], b0 = v0[1] * cs0[0] + v0[0] * cs0[1];
    const float a1 = v0[2] * cs0[2] - v0[3] * cs0[3], b1 = v0[3] * cs0[2] + v0[2] * cs0[3];
    const float a2 = v1[0] * cs1[0] - v1[1] * cs1[1], b2 = v1[1] * cs1[0] + v1[0] * cs1[1];
    const float a3 = v1[2] * cs1[2] - v1[3] * cs1[3], b3 = v1[3] * cs1[2] + v1[2] * cs1[3];
    v0 = (f32x4){a0, b0, a1, b1}; v1 = (f32x4){a2, b2, a3, b3};
}
constexpr int SEQ_LEN = 4096;
constexpr float RMS_EPS = 1e-6f;

__device__ __forceinline__ u32x4 tr16x4(const u32x4 w, const int bidx) { u32x4 r; r.x = __builtin_amdgcn_ds_bpermute(bidx, w.x); r.y = __builtin_amdgcn_ds_bpermute(bidx, w.y); r.z = __builtin_amdgcn_ds_bpermute(bidx, w.z); r.w = __builtin_amdgcn_ds_bpermute(bidx, w.w); return r; }
#define EPI_LANE_T() const int bidx = (((t2_ & 3) * 16) + ((t2_ >> 2) & 15)) * 4, fr2 = (t2_ >> 2) & 15, fq2 = t2_ & 3
#define EPI_LANE() { int t_ = threadIdx.x; asm volatile("" : "+v"(t_)); fr = t_ & 15; fq = (t_ >> 4) & 3; }
struct EpiInProj {
    static constexpr bool PERM = true, AFTER_DRAIN = false;
    bf16_t *CQKV, *KR, *DQ, *DK, *DV; float *SSQ_Q, *SSQ_KV; const float* rope; const float* rstdx; float c2d;
    __device__ __forceinline__ void operator()(f32x4 (&acc)[2][2][4][2], const Unit& u, int wr, int wc, int fr, int fq) const {
        EPI_LANE(); int t2_ = threadIdx.x; asm volatile("" : "+v"(t2_)); EPI_LANE_T(); const int row2 = u.pm * BM + wr * 64 + fr2, cw2 = wc * 32 + 8 * fq2;
        const int row0 = u.pm * BM + wr * 64 + fr, cw = wc * 32 + 8 * fq;
        { float rx[2][4];
#pragma unroll
          for (int ai = 0; ai < 2; ++ai)
#pragma unroll
              for (int m = 0; m < 4; ++m) rx[ai][m] = rstdx[row0 + ai * HALF + m * 16];
#pragma unroll
          for (int ai = 0; ai < 2; ++ai)
#pragma unroll
              for (int m = 0; m < 4; ++m)
#pragma unroll
                  for (int bj = 0; bj < 2; ++bj) { acc[ai][bj][m][0] *= rx[ai][m]; acc[ai][bj][m][1] *= rx[ai][m]; } }
        if (u.pn == 0) {
#pragma unroll
            for (int ai = 0; ai < 2; ++ai)
#pragma unroll
                for (int m = 0; m < 4; ++m) { const size_t row = (size_t)(row0 + ai * HALF + m * 16); float s = 0.f;
#pragma unroll
                    for (int bj = 0; bj < 2; ++bj) { const f32x4 v0 = acc[ai][bj][m][0], v1 = acc[ai][bj][m][1]; s += sq8(v0, v1); *(u32x4*)(CQKV + (size_t)(row2 + ai * HALF + m * 16) * 384 + bj * HALF + cw2) = tr16x4(pack8(v0, v1), bidx); }
                    s = fq_sum(s); if (fq == 0) SSQ_Q[row * 4 + wc] = s; }
        } else if (u.pn == 1) {
            f32x4 cs[2][4][2];
            if (wc == 0) {
#pragma unroll
                for (int ai = 0; ai < 2; ++ai)
#pragma unroll
                    for (int m = 0; m < 4; ++m) { const float* t = rope + (size_t)((row0 + ai * HALF + m * 16) & (SEQ_LEN - 1)) * 32 + 8 * fq; cs[ai][m][0] = *(const f32x4*)t; cs[ai][m][1] = *(const f32x4*)(t + 4); }
            }
#pragma unroll
            for (int ai = 0; ai < 2; ++ai)
#pragma unroll
                for (int m = 0; m < 4; ++m) { const size_t row = (size_t)(row0 + ai * HALF + m * 16);
                    { const f32x4 v0 = acc[ai][0][m][0], v1 = acc[ai][0][m][1]; float s = sq8(v0, v1); *(u32x4*)(CQKV + (size_t)(row2 + ai * HALF + m * 16) * 384 + 256 + cw2) = tr16x4(pack8(v0, v1), bidx);
                      s = fq_sum(s); if (fq == 0) SSQ_KV[row * 4 + wc] = s; }
                    if (wc == 0) { f32x4 v0 = acc[ai][1][m][0], v1 = acc[ai][1][m][1]; rope8(v0, v1, cs[ai][m][0], cs[ai][m][1]); *(u32x4*)(KR + (size_t)(row2 + ai * HALF + m * 16) * 32 + 8 * fq2) = tr16x4(pack8(v0, v1), bidx); } }
        } else {
            bf16_t* dst = DQ + (size_t)((u.pn - 2) >> 1) * ((size_t)32768 * 512); const int cb2 = ((u.pn - 2) & 1) * 256 + cw2; const float sc = u.pn < 4 ? c2d : 1.f;
#pragma unroll
            for (int ai = 0; ai < 2; ++ai)
#pragma unroll
                for (int m = 0; m < 4; ++m) { const size_t row = (size_t)(row0 + ai * HALF + m * 16);
#pragma unroll
                    for (int bj = 0; bj < 2; ++bj) *(u32x4*)(dst + (size_t)(row2 + ai * HALF + m * 16) * 512 + cb2 + bj * HALF) = tr16x4(pack8(acc[ai][bj][m][0] * sc, acc[ai][bj][m][1] * sc), bidx); }
        }
    }
};
struct EpiQKV {
    static constexpr bool PERM = true, AFTER_DRAIN = false;
    bf16_t *QA, *KN, *VA; const float *SSQ_Q, *SSQ_KV; const float* rope; float c2a;
    __device__ __forceinline__ void rstd4(float (&rs)[4], const float* ssq, int rowb, float inv, float mul) const {
        f32x4 pp[4];
#pragma unroll
        for (int m = 0; m < 4; ++m) pp[m] = *(const f32x4*)(ssq + (size_t)(rowb + m * 16) * 4);
#pragma unroll
        for (int m = 0; m < 4; ++m) rs[m] = __builtin_amdgcn_rsqf(((pp[m][0] + pp[m][1]) + (pp[m][2] + pp[m][3])) * inv + RMS_EPS) * mul;
    }
    __device__ __forceinline__ void rstd8(float (&rs)[2][4], const float* ssq, int rowb, float inv, float mul) const {
        f32x4 pp[2][4];
#pragma unroll
        for (int ai = 0; ai < 2; ++ai)
#pragma unroll
            for (int m = 0; m < 4; ++m) pp[ai][m] = *(const f32x4*)(ssq + (size_t)(rowb + ai * HALF + m * 16) * 4);
#pragma unroll
        for (int ai = 0; ai < 2; ++ai)
#pragma unroll
            for (int m = 0; m < 4; ++m) rs[ai][m] = __builtin_amdgcn_rsqf(((pp[ai][m][0] + pp[ai][m][1]) + (pp[ai][m][2] + pp[ai][m][3])) * inv + RMS_EPS) * mul;
    }
    __device__ __forceinline__ void operator()(const f32x4 (&acc)[2][2][4][2], const Unit& u, int wr, int wc, int fr, int fq) const {
        EPI_LANE(); int t2_ = threadIdx.x; asm volatile("" : "+v"(t2_)); EPI_LANE_T(); const int row2 = u.pm * BM + wr * 64 + fr2, cw2 = wc * 32 + 8 * fq2;
        const int row0 = u.pm * BM + wr * 64 + fr, cw = wc * 32 + 8 * fq;
        if (u.pn < 2) {
            float rs2[2][4]; rstd8(rs2, SSQ_Q, row0, 1.f / 256.f, c2a);
#pragma unroll
            for (int ai = 0; ai < 2; ++ai) { const float (&rs)[4] = rs2[ai];
#pragma unroll
                for (int m = 0; m < 4; ++m) { const size_t row = (size_t)(row0 + ai * HALF + m * 16);
#pragma unroll
                    for (int bj = 0; bj < 2; ++bj) { const int n = u.pn * 256 + bj * HALF + cw2; *(u32x4*)(QA + (size_t)(row2 + ai * HALF + m * 16) * 768 + (n >> 6) * 96 + (n & 63)) = tr16x4(pack8(acc[ai][bj][m][0] * rs[m], acc[ai][bj][m][1] * rs[m]), bidx); } }
                asm volatile("" ::: "memory"); }
        } else if (u.pn == 2) {
            float rs2[2][4]; rstd8(rs2, SSQ_Q, row0, 1.f / 256.f, c2a);
            f32x4 cs[2][2][2];
#define QKV_CS_LOAD(B_, AI_, MP_) _Pragma("unroll") for (int mm = 0; mm < 2; ++mm) { const float* t = rope + (size_t)((row0 + (AI_) * HALF + (2 * (MP_) + mm) * 16) & (SEQ_LEN - 1)) * 32 + 8 * fq; cs[B_][mm][0] = *(const f32x4*)t; cs[B_][mm][1] = *(const f32x4*)(t + 4); }
            QKV_CS_LOAD(0, 0, 0);
#pragma unroll
            for (int ib = 0; ib < 4; ++ib) { const int ai = ib >> 1, mp = ib & 1, bb = ib & 1;
                if (ib + 1 < 4) { QKV_CS_LOAD((ib + 1) & 1, (ib + 1) >> 1, (ib + 1) & 1); }
#pragma unroll
                for (int mm = 0; mm < 2; ++mm) { const int m = 2 * mp + mm;
#pragma unroll
                    for (int bj = 0; bj < 2; ++bj) { f32x4 v0 = acc[ai][bj][m][0] * rs2[ai][m], v1 = acc[ai][bj][m][1] * rs2[ai][m]; rope8(v0, v1, cs[bb][mm][0], cs[bb][mm][1]); *(u32x4*)(QA + (size_t)(row2 + ai * HALF + m * 16) * 768 + (4 * bj + wc) * 96 + 64 + 8 * fq2) = tr16x4(pack8(v0, v1), bidx); } } }
#undef QKV_CS_LOAD
        } else {
            bf16_t* dst = KN + (size_t)((u.pn - 3) >> 1) * ((size_t)32768 * 512); const int cb2 = ((u.pn - 3) & 1) * 256 + cw2;
            float rs2[2][4]; rstd8(rs2, SSQ_KV, row0, 1.f / 128.f, 1.f);
#pragma unroll
            for (int ai = 0; ai < 2; ++ai) { const float (&rs)[4] = rs2[ai];
#pragma unroll
                for (int m = 0; m < 4; ++m) { const size_t row = (size_t)(row0 + ai * HALF + m * 16);
#pragma unroll
                    for (int bj = 0; bj < 2; ++bj) *(u32x4*)(dst + (size_t)(row2 + ai * HALF + m * 16) * 512 + cb2 + bj * HALF) = tr16x4(pack8(acc[ai][bj][m][0] * rs[m], acc[ai][bj][m][1] * rs[m]), bidx); }
                asm volatile("" ::: "memory"); }
        }
    }
};
struct EpiOutProj {
    static constexpr bool PERM = true, AFTER_DRAIN = false;
    const bf16_t* XB; bf16_t* X1B; float* SSQ;
    __device__ __forceinline__ void operator()(const f32x4 (&acc)[2][2][4][2], const Unit& u, int wr, int wc, int fr, int fq) const {
        EPI_LANE();
        int t2_ = threadIdx.x; asm volatile("" : "+v"(t2_)); EPI_LANE_T();
        const int row0 = u.pm * BM + wr * 64 + fr, cw = u.pn * BM + wc * 32 + 8 * fq;
        bf16_t* const st = X1B + (size_t)(u.pm * BM + wr * 64 + fr2) * 1024 + u.pn * BM + wc * 32 + 8 * fq2;
        u32x4 xb[2][4][2];
#pragma unroll
        for (int ai = 0; ai < 2; ++ai)
#pragma unroll
            for (int m = 0; m < 4; ++m)
#pragma unroll
                for (int bj = 0; bj < 2; ++bj) xb[ai][m][bj] = __builtin_nontemporal_load((const u32x4*)(XB + (size_t)(row0 + ai * HALF + m * 16) * 1024 + cw + bj * HALF));
#pragma unroll
        for (int ai = 0; ai < 2; ++ai)
#pragma unroll
            for (int m = 0; m < 4; ++m) { const size_t row = (size_t)(row0 + ai * HALF + m * 16); float s = 0.f;
#pragma unroll
                for (int bj = 0; bj < 2; ++bj) { const u32x4 w = xb[ai][m][bj];
                    const f32x4 v0 = acc[ai][bj][m][0] + (f32x4){__uint_as_float(w.x << 16), __uint_as_float(w.x & 0xffff0000u), __uint_as_float(w.y << 16), __uint_as_float(w.y & 0xffff0000u)};
                    const f32x4 v1 = acc[ai][bj][m][1] + (f32x4){__uint_as_float(w.z << 16), __uint_as_float(w.z & 0xffff0000u), __uint_as_float(w.w << 16), __uint_as_float(w.w & 0xffff0000u)};
                    s += sq8(v0, v1); *(u32x4*)(st + (size_t)(ai * HALF + m * 16) * 1024 + bj * HALF) = tr16x4(pack8(v0, v1), bidx); }
                s = fq_sum(s); if (fq == 0) SSQ[row * 16 + u.pn * 4 + wc] = s; }
    }
};
struct HMap { unsigned char* ws; size_t xn, mix, dq, dk, dv;
    __host__ __device__ __forceinline__ bf16_t* panel(int pm) const { const int b = pm >> 4, p = pm & 15; constexpr size_t PB = (size_t)256 * 2816 * 2, MB = (size_t)1 << 20;
        size_t off;
        if (p < 5) off = xn + (size_t)b * 8 * MB + (size_t)p * PB;
        else if (p < 10) off = mix + (size_t)b * 8 * MB + (size_t)(p - 5) * PB;
        else if (p < 12) off = dq + (size_t)b * 4 * MB + (size_t)(p - 10) * PB;
        else if (p < 14) off = dk + (size_t)b * 4 * MB + (size_t)(p - 12) * PB;
        else off = dv + (size_t)b * 4 * MB + (size_t)(p - 14) * PB;
        return (bf16_t*)(ws + off); } };
struct PanelOrder {
    static constexpr bool KSPLIT = false, APANEL = true;
    StaticOrder so; HMap hm;
    __host__ __device__ void init(int M, int N, int G_, int c_) { so.init(M, N, G_, c_); }
    __host__ __device__ bool next(int i, Unit& u) const { return so.next(i, u); }
    __device__ __forceinline__ const char* a_panel(int pm) const { return (const char*)hm.panel(pm); }
    __device__ __forceinline__ void a_ready(const Unit&) const {}
    __device__ __forceinline__ void done(const Unit&) const {}
};
struct EpiGateUp {
    static constexpr bool PERM = true, AFTER_DRAIN = false;
    HMap hm; const float* SSQ;
    __device__ __forceinline__ void operator()(const f32x4 (&acc)[2][2][4][2], const Unit& u, int wr, int wc, int fr, int fq) const {
        EPI_LANE(); int t2_ = threadIdx.x; asm volatile("" : "+v"(t2_)); EPI_LANE_T(); const int row2 = u.pm * BM + wr * 64 + fr2, cw2 = wc * 32 + 8 * fq2;
        const int row0 = u.pm * BM + wr * 64 + fr, cw = u.pn * HALF + wc * 32 + 8 * fq;
        bf16_t* const Hp = hm.panel(u.pm) + (size_t)(wr * 64 + fr2) * 2816 + u.pn * HALF + cw2;
        float rs[2][4];
        { f32x4 pp[2][4];
#pragma unroll
          for (int ai = 0; ai < 2; ++ai)
#pragma unroll
              for (int m = 0; m < 4; ++m) pp[ai][m] = *(const f32x4*)(SSQ + (size_t)(row0 + ai * HALF + m * 16) * 16 + 4 * fq);
#pragma unroll
          for (int ai = 0; ai < 2; ++ai)
#pragma unroll
              for (int m = 0; m < 4; ++m) rs[ai][m] = __builtin_amdgcn_rsqf(fq_sum((pp[ai][m][0] + pp[ai][m][1]) + (pp[ai][m][2] + pp[ai][m][3])) * (1.f / 1024.f) + RMS_EPS); }
#pragma unroll
        for (int ai = 0; ai < 2; ++ai)
#pragma unroll
            for (int m = 0; m < 4; ++m) { const size_t row = (size_t)(row0 + ai * HALF + m * 16); const float r = rs[ai][m];
                f32x4 hv[2];
#pragma unroll
                for (int n = 0; n < 2; ++n) { const f32x4 g = acc[ai][0][m][n] * r, up = acc[ai][1][m][n] * r;
#pragma unroll
                    for (int j = 0; j < 4; ++j) { const float e = __builtin_amdgcn_exp2f(g[j] * -1.4426950408889634f); hv[n][j] = g[j] * __builtin_amdgcn_rcpf(1.0f + e) * up[j]; } }
                *(u32x4*)(Hp + (size_t)(ai * HALF + m * 16) * 2816) = tr16x4(pack8(hv[0], hv[1]), bidx); }
    }
};
struct EpiDownNorm {
    static constexpr bool PERM = true, AFTER_DRAIN = false;
    const bf16_t* X1B; float* OUT; const float* G; unsigned* xbuf; unsigned* cnt; PG8_LAS unsigned char* xl;
    __device__ __forceinline__ void operator()(f32x4 (&acc)[2][2][4][2], const Unit& u, int wr, int wc, int fr, int fq) const {
        int t_ = threadIdx.x; asm volatile("" : "+v"(t_)); fr = t_ & 15; fq = (t_ >> 4) & 3; const int lane = t_ & 63, wid = wr * 4 + wc; const int t2_ = t_; EPI_LANE_T();
        PG8_LAS float* P = (PG8_LAS float*)xl; PG8_LAS float* S = (PG8_LAS float*)(xl + 4096); PG8_LAS unsigned* flag = (PG8_LAS unsigned*)(xl + 5120);
        const int row0 = u.pm * BM + wr * 64 + fr, cw = u.pn * BM + wc * 32 + 8 * fq;
        f32x4 gv[2][2];
#pragma unroll
        for (int bj = 0; bj < 2; ++bj) { gv[bj][0] = *(const f32x4*)(G + cw + bj * HALF); gv[bj][1] = *(const f32x4*)(G + cw + bj * HALF + 4); }
        u32x4 xb[2][4][2];
#pragma unroll
        for (int ai = 0; ai < 2; ++ai)
#pragma unroll
            for (int m = 0; m < 4; ++m)
#pragma unroll
                for (int bj = 0; bj < 2; ++bj) xb[ai][m][bj] = __builtin_nontemporal_load((const u32x4*)(X1B + (size_t)(row0 + ai * HALF + m * 16) * 1024 + cw + bj * HALF));
#pragma unroll
        for (int ai = 0; ai < 2; ++ai) {
#pragma unroll
            for (int m = 0; m < 4; ++m) { float s = 0.f;
#pragma unroll
                for (int bj = 0; bj < 2; ++bj) { const u32x4 w = xb[ai][m][bj];
                    const f32x4 a0 = (f32x4){__uint_as_float(w.x << 16), __uint_as_float(w.x & 0xffff0000u), __uint_as_float(w.y << 16), __uint_as_float(w.y & 0xffff0000u)};
                    const f32x4 a1 = (f32x4){__uint_as_float(w.z << 16), __uint_as_float(w.z & 0xffff0000u), __uint_as_float(w.w << 16), __uint_as_float(w.w & 0xffff0000u)};
                    acc[ai][bj][m][0] += a0; acc[ai][bj][m][1] += a1; s += sq8(acc[ai][bj][m][0], acc[ai][bj][m][1]); }
                s = fq_sum(s); if (fq == 0) P[(ai * HALF + wr * 64 + m * 16 + fr) * 4 + wc] = s; }
        }
        asm volatile("s_waitcnt lgkmcnt(0)" ::: "memory"); __builtin_amdgcn_s_barrier(); asm volatile("" ::: "memory");
        const int prow = wid * 32 + (lane & 31);
        if (lane < 32) { const float tot = (P[prow * 4 + 0] + P[prow * 4 + 1]) + (P[prow * 4 + 2] + P[prow * 4 + 3]);
            __hip_atomic_store(xbuf + ((size_t)(u.pm * BM + prow) * 4 + u.pn), __float_as_uint(tot), __ATOMIC_RELAXED, __HIP_MEMORY_SCOPE_AGENT); }
        asm volatile("s_waitcnt vmcnt(0)" ::: "memory");
        if (lane == 0) __hip_atomic_fetch_add(cnt + 64 * u.pm, 1u, __ATOMIC_RELAXED, __HIP_MEMORY_SCOPE_AGENT);
        if (wid == 0) { unsigned sp = 0;
            while ((unsigned)__builtin_amdgcn_readfirstlane(__hip_atomic_load(cnt + 64 * u.pm, __ATOMIC_RELAXED, __HIP_MEMORY_SCOPE_AGENT)) < 32u) { __builtin_amdgcn_s_sleep(2); if (++sp > (1u << 22)) break; }
            __builtin_amdgcn_fence(__ATOMIC_ACQUIRE, "agent");
            if (lane == 0) flag[0] = sp; }
        asm volatile("s_waitcnt vmcnt(0) lgkmcnt(0)" ::: "memory"); __builtin_amdgcn_s_barrier(); asm volatile("" ::: "memory");
        if (lane < 32) { const unsigned* slot = xbuf + (size_t)(u.pm * BM + prow) * 4; float q = 0.f;
#pragma unroll
            for (int t = 0; t < 4; ++t) q += __uint_as_float(__hip_atomic_load(slot + t, __ATOMIC_RELAXED, __HIP_MEMORY_SCOPE_AGENT));
            S[prow] = __builtin_amdgcn_rsqf(q * (1.f / 1024.f) + RMS_EPS); }
        asm volatile("s_waitcnt lgkmcnt(0)" ::: "memory"); __builtin_amdgcn_s_barrier(); asm volatile("" ::: "memory");
#pragma unroll
        for (int ai = 0; ai < 2; ++ai)
#pragma unroll
            for (int m = 0; m < 4; ++m) { const int r = ai * HALF + wr * 64 + m * 16 + fr; const float rs = S[r]; const size_t off = (size_t)(u.pm * BM + r) * 1024 + cw;
#pragma unroll
                for (int bj = 0; bj < 2; ++bj) { const f32x4 o0 = acc[ai][bj][m][0] * rs * gv[bj][0], o1 = acc[ai][bj][m][1] * rs * gv[bj][1]; float* const op = OUT + (size_t)(u.pm * BM + ai * HALF + wr * 64 + m * 16 + fr2) * 1024 + u.pn * BM + wc * 32 + 8 * fq2 + bj * HALF;
                    *(u32x4*)op = tr16x4(__builtin_bit_cast(u32x4, o0), bidx); *(u32x4*)(op + 4) = tr16x4(__builtin_bit_cast(u32x4, o1), bidx); } }
    }
};

struct SplitOrder {
    static constexpr bool KSPLIT = true, APANEL = false;
    StaticOrder so;
    __host__ __device__ void init(int M, int N, int G_, int c_) { so.init(M, N, G_, c_); }
    __host__ __device__ bool next(int i, Unit& u) const { if (!so.next(i, u)) return false;
        u.pn = (u.pn == 0) ? 0 : (u.pn == 1) ? 3 : (u.pn == 2) ? 1 : (u.pn == 3) ? 2 : u.pn;
        if (u.pn < 3) { u.kofs = 0; u.nt = 4; } else { u.kofs = 256 * 2; u.nt = 2; } return true; }
    __device__ __forceinline__ void a_ready(const Unit&) const {}
    __device__ __forceinline__ void done(const Unit&) const {}
};
template <class Epi, class Sched, bool ALIGN_EPI = false, bool SP2 = false>
__device__ __forceinline__ void gemm_phase(PG8_LAS unsigned char* lds, const Gemm g, const Sched& S, const Epi& E) {
    const int tid = threadIdx.x, wid = __builtin_amdgcn_readfirstlane(tid >> 6), lane = tid & 63, wr = wid >> 2, wc = wid & 3, fr = lane & 15, fq = lane >> 4;
    const int K = g.K; int nt = K / BK;
    unsigned voffA[2], voffB[2];
#pragma unroll
    for (int i = 0; i < 2; ++i) { int R, C; stage_rc(tid * 16 + i * 8192, R, C); const int Rb = Epi::PERM ? ((R & ~31) + perm32(R & 31)) : R;
        voffA[i] = (unsigned)(R * K + C) * 2u; voffB[i] = (unsigned)(Rb * K + C) * 2u; }
    const size_t kstep = (size_t)(BK * 2);
    const size_t hstep = (size_t)HALF * K * 2;
    const size_t tstep = 2 * hstep;
    const unsigned ldsw = (unsigned)wid * 1024u;
    const int aoff = lds_byte(wr * 64 + fr, fq * 8), boff = lds_byte(wc * 32 + fr, fq * 8);
#define PG8_SA(b, h) (((b) * 2 + (h)) * HTB)
#define PG8_SB(b, h) ((4 + (b) * 2 + (h)) * HTB)
#define PG8_STAGE(bufoff, gbase, voff) do { _Pragma("unroll") for (int _i = 0; _i < 2; ++_i) \
        __builtin_amdgcn_global_load_lds((const unsigned*)((const char*)(gbase) + (voff)[_i]), (PG8_LAS unsigned*)(lds + (bufoff) + ldsw + _i * 8192), 16, 0, 0); } while (0)
#define PG8_LDA(dst, b, h) do { _Pragma("unroll") for (int m = 0; m < 4; ++m) _Pragma("unroll") for (int k = 0; k < 2; ++k) dst[m][k] = *(const PG8_LAS bf16x8*)(lds + PG8_SA(b, h) + aoff + m * 2048 + k * 1024); } while (0)
#define PG8_LDB(dst, b, h) do { _Pragma("unroll") for (int n = 0; n < 2; ++n) _Pragma("unroll") for (int k = 0; k < 2; ++k) dst[n][k] = *(const PG8_LAS bf16x8*)(lds + PG8_SB(b, h) + boff + n * 2048 + k * 1024); } while (0)
#define PG8_MMA(ai, bj, At, Bt) do { __builtin_amdgcn_s_setprio(1); _Pragma("unroll") for (int m = 0; m < 4; ++m) _Pragma("unroll") for (int n = 0; n < 2; ++n) _Pragma("unroll") for (int k = 0; k < 2; ++k) \
        acc[ai][bj][m][n] = __builtin_amdgcn_mfma_f32_16x16x32_bf16(Bt[n][k], At[m][k], acc[ai][bj][m][n], 0, 0, 0); __builtin_amdgcn_s_setprio(0); } while (0)
#define PG8_WAIT_V(n) asm volatile("s_waitcnt vmcnt(" #n ")" ::: "memory")
#define PG8_WAIT_L(n) asm volatile("s_waitcnt lgkmcnt(" #n ")" ::: "memory")
#define PG8_BAR __builtin_amdgcn_s_barrier()
#define PG8_SCHED __builtin_amdgcn_sched_barrier(0)
    Unit cur, nxt; int ui = 0;
    if (!S.next(0, cur)) return;
    f32x4 acc[2][2][4][2];
#pragma unroll
    for (int a = 0; a < 2; ++a)
#pragma unroll
        for (int b = 0; b < 2; ++b)
#pragma unroll
            for (int m = 0; m < 4; ++m)
#pragma unroll
                for (int n = 0; n < 2; ++n) acc[a][b][m][n] = (f32x4){0.f, 0.f, 0.f, 0.f};
    bf16x8 At[4][2], B0[2][2], B1[2][2];
    const char* cA; if constexpr (Sched::APANEL) cA = S.a_panel(cur.pm); else cA = (const char*)g.A + (size_t)cur.pm * tstep + (Sched::KSPLIT ? cur.kofs : 0);
    const char* cB = (const char*)g.Bt + (size_t)cur.pn * tstep + (Sched::KSPLIT ? cur.kofs : 0);
    S.a_ready(cur);
    if constexpr (SP2) {
        PG8_STAGE(PG8_SB(0, 0), cB, voffB); PG8_STAGE(PG8_SB(0, 1), cB + hstep, voffB); PG8_STAGE(PG8_SA(0, 0), cA, voffA); PG8_STAGE(PG8_SA(0, 1), cA + hstep, voffA);
        if (wr == 1) PG8_BAR;
        PG8_WAIT_V(2); PG8_BAR;
        PG8_STAGE(PG8_SB(1, 0), cB + kstep, voffB); PG8_STAGE(PG8_SA(1, 0), cA + kstep, voffA); PG8_STAGE(PG8_SB(1, 1), cB + hstep + kstep, voffB);
        PG8_WAIT_V(6); PG8_BAR;
    } else {
        PG8_STAGE(PG8_SB(0, 0), cB, voffB); PG8_STAGE(PG8_SA(0, 0), cA, voffA); PG8_STAGE(PG8_SB(0, 1), cB + hstep, voffB); PG8_STAGE(PG8_SA(0, 1), cA + hstep, voffA);
        if (wr == 1) PG8_BAR;
        PG8_WAIT_V(4); PG8_BAR;
        PG8_STAGE(PG8_SB(1, 0), cB + kstep, voffB); PG8_STAGE(PG8_SA(1, 0), cA + kstep, voffA); PG8_STAGE(PG8_SB(1, 1), cB + hstep + kstep, voffB);
        PG8_WAIT_V(6); PG8_BAR;
    }
    for (;;) {
        const bool has_next = S.next(ui + 1, nxt);
        const char* nA; if constexpr (Sched::APANEL) nA = has_next ? S.a_panel(nxt.pm) : cA; else nA = has_next ? (const char*)g.A + (size_t)nxt.pm * tstep + (Sched::KSPLIT ? nxt.kofs : 0) : cA;
        const char* nB = has_next ? (const char*)g.Bt + (size_t)nxt.pn * tstep + (Sched::KSPLIT ? nxt.kofs : 0) : cB;
        if constexpr (Sched::KSPLIT) nt = cur.nt;
        for (int t = 0; t < nt; t += 2) {
            const bool last = (t == nt - 2);
            const char* a1 = cA + (size_t)(t + 1) * kstep;
            const char* a2 = last ? nA : cA + (size_t)(t + 2) * kstep; const char* b2 = last ? nB : cB + (size_t)(t + 2) * kstep;
            const char* a3 = a2 + kstep; const char* b3 = b2 + kstep;
            if (last && has_next) S.a_ready(nxt);
            if constexpr (SP2) {
            PG8_LDB(B0, 0, 0); PG8_LDB(B1, 0, 1); PG8_SCHED; PG8_LDA(At, 0, 0); PG8_STAGE(PG8_SA(1, 1), a1 + hstep, voffA);
            PG8_WAIT_V(8); PG8_WAIT_L(0); PG8_BAR; PG8_MMA(0, 0, At, B0); PG8_MMA(0, 1, At, B1); PG8_BAR; PG8_SCHED;
            PG8_LDA(At, 0, 1); PG8_STAGE(PG8_SB(0, 0), b2, voffB); PG8_STAGE(PG8_SB(0, 1), b2 + hstep, voffB); PG8_STAGE(PG8_SA(0, 0), a2, voffA);
            PG8_WAIT_V(8); PG8_WAIT_L(0); PG8_BAR; PG8_MMA(1, 0, At, B0); PG8_MMA(1, 1, At, B1); PG8_BAR; PG8_SCHED;
            PG8_LDB(B0, 1, 0); PG8_LDB(B1, 1, 1); PG8_SCHED; PG8_LDA(At, 1, 0); PG8_STAGE(PG8_SA(0, 1), a2 + hstep, voffA);
            PG8_WAIT_V(8); PG8_WAIT_L(0); PG8_BAR; PG8_MMA(0, 0, At, B0); PG8_MMA(0, 1, At, B1); PG8_BAR; PG8_SCHED;
            PG8_LDA(At, 1, 1); PG8_STAGE(PG8_SB(1, 0), b3, voffB); PG8_STAGE(PG8_SB(1, 1), b3 + hstep, voffB); PG8_STAGE(PG8_SA(1, 0), a3, voffA);
            PG8_WAIT_V(8); PG8_WAIT_L(0); PG8_BAR; PG8_MMA(1, 0, At, B0); PG8_MMA(1, 1, At, B1); PG8_BAR; PG8_SCHED;
            } else {
            PG8_LDB(B0, 0, 0); PG8_SCHED; PG8_LDA(At, 0, 0); PG8_STAGE(PG8_SA(1, 1), a1 + hstep, voffA);
            PG8_WAIT_L(8); PG8_BAR; PG8_WAIT_L(0); PG8_MMA(0, 0, At, B0); PG8_BAR; PG8_SCHED;
            PG8_LDB(B1, 0, 1); PG8_STAGE(PG8_SB(0, 0), b2, voffB);
            PG8_BAR; PG8_WAIT_L(0); PG8_MMA(0, 1, At, B1); PG8_BAR;
            PG8_LDA(At, 0, 1); PG8_STAGE(PG8_SA(0, 0), a2, voffA);
            PG8_BAR; PG8_WAIT_L(0); PG8_MMA(1, 0, At, B0); PG8_BAR; PG8_SCHED;
            PG8_STAGE(PG8_SB(0, 1), b2 + hstep, voffB);
            PG8_WAIT_V(6); PG8_BAR; PG8_MMA(1, 1, At, B1); PG8_BAR;
            PG8_LDB(B0, 1, 0); PG8_SCHED; PG8_LDA(At, 1, 0); PG8_STAGE(PG8_SA(0, 1), a2 + hstep, voffA);
            PG8_WAIT_L(8); PG8_BAR; PG8_WAIT_L(0); PG8_MMA(0, 0, At, B0); PG8_BAR; PG8_SCHED;
            PG8_LDB(B1, 1, 1); PG8_STAGE(PG8_SB(1, 0), b3, voffB);
            PG8_BAR; PG8_WAIT_L(0); PG8_MMA(0, 1, At, B1); PG8_BAR;
            PG8_LDA(At, 1, 1); PG8_STAGE(PG8_SA(1, 0), a3, voffA);
            PG8_BAR; PG8_WAIT_L(0); PG8_MMA(1, 0, At, B0); PG8_BAR; PG8_SCHED;
            PG8_STAGE(PG8_SB(1, 1), b3 + hstep, voffB);
            PG8_WAIT_V(6); PG8_BAR; PG8_MMA(1, 1, At, B1); PG8_BAR;
            }
        }
        if constexpr (ALIGN_EPI) { if (wr == 0) PG8_BAR; }
        if constexpr (!Epi::AFTER_DRAIN) { E(acc, cur, wr, wc, fr, fq); S.done(cur); }
        if (!has_next) break;
#pragma unroll
        for (int a = 0; a < 2; ++a)
#pragma unroll
            for (int b = 0; b < 2; ++b)
#pragma unroll
                for (int m = 0; m < 4; ++m)
#pragma unroll
                    for (int n = 0; n < 2; ++n) acc[a][b][m][n] = (f32x4){0.f, 0.f, 0.f, 0.f};
        cur = nxt; cA = nA; cB = nB; ++ui;
        if constexpr (ALIGN_EPI) { if (wr == 1) PG8_BAR; }
    }
    PG8_WAIT_V(0);
    if constexpr (!ALIGN_EPI) { if (wr == 0) PG8_BAR; }
    PG8_BAR;
    if constexpr (Epi::AFTER_DRAIN) { E.fused(acc, cur, wr, wc, fr, fq, lds, wid, lane); S.done(cur); }
#undef PG8_SA
#undef PG8_SB
#undef PG8_STAGE
#undef PG8_LDA
#undef PG8_LDB
#undef PG8_MMA
#undef PG8_WAIT_V
#undef PG8_WAIT_L
#undef PG8_BAR
#undef PG8_SCHED
}
}
namespace att {
using bf16x8 = __attribute__((ext_vector_type(8))) short;
using s16x4 = __attribute__((ext_vector_type(4))) short;
using f32x16 = __attribute__((ext_vector_type(16))) float;
using u32x4 = __attribute__((ext_vector_type(4))) unsigned;
typedef unsigned short bf16;
constexpr int SEQ = 4096, NW = 8, QB = 256, KVBLK = 64, NSLOT = 3;
#ifndef ATT_THRL
#define ATT_THRL 8
#endif
constexpr int THRL = ATT_THRL;
__device__ __forceinline__ int otid() { int t = threadIdx.x; asm volatile("" : "+v"(t)); return t; }
template <int PAT> __device__ __forceinline__ float swz_xor(float v) { return __int_as_float(__builtin_amdgcn_ds_swizzle(__float_as_int(v), PAT)); }
__device__ __forceinline__ int crow(int r, int hi) { return (r & 3) + 8 * (r >> 2) + 4 * hi; }
#define SBAR() __builtin_amdgcn_sched_barrier(0)
#define PIN(x) asm volatile("" : "+v"(x))
#define WAIT_BAR(N) asm volatile("s_waitcnt vmcnt(" #N ") lgkmcnt(0)\n\ts_barrier" ::: "memory")
#define MFMA32(a, b, c) __builtin_amdgcn_mfma_f32_32x32x16_bf16(a, b, c, 0, 0, 0)
#define EX(v) __builtin_amdgcn_exp2f(v)
#define MX3(a, b, c) __builtin_fmaxf(__builtin_fmaxf((a), (b)), (c))
__device__ __forceinline__ void glds16(const void* gsrc, unsigned lds_dst) { unsigned keep;
    asm volatile("s_mov_b32 %0, m0\n\ts_mov_b32 m0, %2\n\ts_nop 0\n\tglobal_load_lds_dwordx4 %1, off\n\ts_mov_b32 m0, %0" : "=&s"(keep) : "v"(gsrc), "s"(lds_dst) : "memory"); }
typedef float f32x2_t __attribute__((ext_vector_type(2))); typedef __bf16 bf16x2_t __attribute__((ext_vector_type(2)));
__device__ __forceinline__ unsigned cvtpk_s(float lo, float hi) { f32x2_t v = {lo, hi}; bf16x2_t b = __builtin_convertvector(v, bf16x2_t); return __builtin_bit_cast(unsigned, b); }
typedef __attribute__((address_space(3))) const char* lds_cptr;
typedef short v4i16_t __attribute__((ext_vector_type(4)));
__device__ __forceinline__ s16x4 vtr(lds_cptr p) { return __builtin_bit_cast(s16x4, __builtin_amdgcn_ds_read_tr16_b64_v4i16((__attribute__((address_space(3))) v4i16_t*)p)); }
__device__ __forceinline__ bf16x8 kld(lds_cptr p) { return *(const __attribute__((address_space(3))) bf16x8*)p; }
__device__ __forceinline__ float rowmax(const f32x16& p0, const f32x16& p1) {
    float a = MX3(p0[0], p0[1], p1[0]), b = MX3(p0[2], p0[3], p1[1]); a = MX3(a, p1[2], p1[3]);
#pragma unroll
    for (int r = 4; r < 16; r += 4) { a = MX3(a, p0[r], p0[r + 1]); b = MX3(b, p0[r + 2], p0[r + 3]); a = MX3(a, p1[r], p1[r + 1]); b = MX3(b, p1[r + 2], p1[r + 3]); }
    const float m = __builtin_fmaxf(a, b);
    auto rr = __builtin_amdgcn_permlane32_swap(__float_as_uint(m), __float_as_uint(m), false, false);
    return __builtin_fmaxf(__uint_as_float(rr[0]), __uint_as_float(rr[1]));
}
template <int DQK, int DV> struct Lay {
    static constexpr int KB = 64 * DQK * 2, VB = 64 * DV * 2;
    static constexpr int LDS_K = 0, LDS_V = NSLOT * KB, LDS_WS = NSLOT * (KB + VB), OSTW = (DV == 128) ? 8192 : 4096, LDS_OST = LDS_WS + NW * 256, LDS_BT = LDS_OST + NW * OSTW, LDS_END = LDS_BT + 2048;
};
#define STEP_MLA(C0, C1, P0, P1, t, BAND, GK, GV, GL) do { SBAR(); \
    const lds_cptr vp_ = vp0 + sl_prev * L::VB; \
      \
    float sacc = P0[0] + P0[1]; \
    VRD(0, 0); SBAR(); C0 = MFMA32(kf[0], qr[0], negm); sacc += P0[2]; sacc += P0[3]; sacc += P0[4]; PIN(sacc); pw0[0] = PKW(P0, 0); pw0[1] = PKW(P0, 2); PIN(pw0); SBAR(); \
    VRD(4, 4); SBAR(); C1 = MFMA32(kf[1], qr[0], negm); sacc += P0[5]; sacc += P0[6]; sacc += P0[7]; PIN(sacc); pw0[2] = PKW(P0, 4); pw0[3] = PKW(P0, 6); PIN(pw0); SBAR(); \
    VRD(1, 1); SBAR(); C0 = MFMA32(kf[2], qr[1], C0); sacc += P0[8]; sacc += P0[9]; sacc += P0[10]; PIN(sacc); pw1[0] = PKW(P0, 8); pw1[1] = PKW(P0, 10); PIN(pw1); SBAR(); \
    VRD(5, 5); SBAR(); C1 = MFMA32(kf[3], qr[1], C1); sacc += P0[11]; sacc += P0[12]; sacc += P0[13]; PIN(sacc); pw1[2] = PKW(P0, 12); pw1[3] = PKW(P0, 14); PIN(pw1); SBAR(); \
    VRD(2, 2); SBAR(); C0 = MFMA32(kf[4], qr[2], C0); sacc += P0[14]; sacc += P0[15]; sacc += P1[0]; PIN(sacc); pw2[0] = PKW(P1, 0); PIN(pw2); SBAR(); \
    VRD(6, 6); SBAR(); C1 = MFMA32(kf[5], qr[2], C1); sacc += P1[1]; sacc += P1[2]; sacc += P1[3]; PIN(sacc); pw2[1] = PKW(P1, 2); PIN(pw2); SBAR(); \
    VRD(3, 3); SBAR(); C0 = MFMA32(kf[6], qr[3], C0); sacc += P1[4]; sacc += P1[5]; PIN(sacc); pw2[2] = PKW(P1, 4); PIN(pw2); SBAR(); \
    VRD(7, 7); SBAR(); C1 = MFMA32(kf[7], qr[3], C1); sacc += P1[6]; sacc += P1[7]; PIN(sacc); pw2[3] = PKW(P1, 6); PIN(pw2); SBAR(); \
    C0 = MFMA32(kf[8], qr[4], C0); sacc += P1[8]; sacc += P1[9]; PIN(sacc); pw3[0] = PKW(P1, 8); PIN(pw3); SBAR(); \
    C1 = MFMA32(kf[9], qr[4], C1); sacc += P1[10]; sacc += P1[11]; PIN(sacc); pw3[1] = PKW(P1, 10); PIN(pw3); SBAR(); \
    C0 = MFMA32(kf[10], qr[5], C0); sacc += P1[12]; sacc += P1[13]; PIN(sacc); pw3[2] = PKW(P1, 12); PIN(pw3); SBAR(); \
    C1 = MFMA32(kf[11], qr[5], C1); sacc += P1[14]; sacc += P1[15]; PIN(sacc); pw3[3] = PKW(P1, 14); PIN(pw3); SBAR(); \
    l_reg += sacc; \
    MIDDLE(C0, C1, t, BAND); \
    SBAR(); \
    o[0] = MFMA32(PAF(0), VFR(0), o[0]); if (GK) DMA_K((t) + 3, sl_cur); if (GV) DMA_V((t) + 1, sl_next); C0[0] = EX(C0[0]); C0[1] = EX(C0[1]); C0[2] = EX(C0[2]); C0[3] = EX(C0[3]); PIN(C0); SBAR(); \
    KRD(GL, 0); o[1] = MFMA32(PAF(0), VFR(4), o[1]); C0[4] = EX(C0[4]); C0[5] = EX(C0[5]); C0[6] = EX(C0[6]); C0[7] = EX(C0[7]); PIN(C0); SBAR(); \
    KRD(GL, 1); o[0] = MFMA32(PAF(1), VFR(1), o[0]); C0[8] = EX(C0[8]); C0[9] = EX(C0[9]); C0[10] = EX(C0[10]); C0[11] = EX(C0[11]); PIN(C0); SBAR(); \
    KRD(GL, 2); o[1] = MFMA32(PAF(1), VFR(5), o[1]); C0[12] = EX(C0[12]); C0[13] = EX(C0[13]); C0[14] = EX(C0[14]); C0[15] = EX(C0[15]); PIN(C0); SBAR(); \
    KRD(GL, 3); o[0] = MFMA32(PAF(2), VFR(2), o[0]); C1[0] = EX(C1[0]); C1[1] = EX(C1[1]); C1[2] = EX(C1[2]); C1[3] = EX(C1[3]); PIN(C1); SBAR(); \
    KRD(GL, 4); o[1] = MFMA32(PAF(2), VFR(6), o[1]); C1[4] = EX(C1[4]); C1[5] = EX(C1[5]); C1[6] = EX(C1[6]); C1[7] = EX(C1[7]); PIN(C1); SBAR(); \
    KRD(GL, 5); o[0] = MFMA32(PAF(3), VFR(3), o[0]); C1[8] = EX(C1[8]); C1[9] = EX(C1[9]); C1[10] = EX(C1[10]); C1[11] = EX(C1[11]); PIN(C1); SBAR(); \
    o[1] = MFMA32(PAF(3), VFR(7), o[1]); C1[12] = EX(C1[12]); C1[13] = EX(C1[13]); C1[14] = EX(C1[14]); C1[15] = EX(C1[15]); PIN(C1); SBAR(); \
    } while (0)
#define STEP_DIF(C0, C1, P0, P1, t, BAND, GK, GV, GL) do { SBAR(); \
    const lds_cptr vp_ = vp0 + sl_prev * L::VB; \
      \
    float sacc = P0[0] + P0[1]; \
    C0 = MFMA32(kf[0], qr[0], inin); sacc += P0[2]; sacc += P0[3]; sacc += P0[4]; sacc += P0[5]; PIN(sacc); pw0[0] = PKW(P0, 0); pw0[1] = PKW(P0, 2); PIN(pw0); SBAR(); \
    C1 = MFMA32(kf[1], qr[0], inin); sacc += P0[6]; sacc += P0[7]; sacc += P0[8]; sacc += P0[9]; PIN(sacc); pw0[2] = PKW(P0, 4); pw0[3] = PKW(P0, 6); PIN(pw0); SBAR(); \
    C0 = MFMA32(kf[2], qr[1], C0); sacc += P0[10]; sacc += P0[11]; sacc += P0[12]; sacc += P0[13]; PIN(sacc); pw1[0] = PKW(P0, 8); pw1[1] = PKW(P0, 10); PIN(pw1); SBAR(); \
    C1 = MFMA32(kf[3], qr[1], C1); sacc += P0[14]; sacc += P0[15]; sacc += P1[0]; sacc += P1[1]; PIN(sacc); pw1[2] = PKW(P0, 12); pw1[3] = PKW(P0, 14); PIN(pw1); SBAR(); \
    VRD(0, 0); SBAR(); C0 = MFMA32(kf[4], qr[2], C0); sacc += P1[2]; sacc += P1[3]; sacc += P1[4]; sacc += P1[5]; PIN(sacc); pw2[0] = PKW(P1, 0); pw2[1] = PKW(P1, 2); PIN(pw2); SBAR(); \
    VRD(1, 4); SBAR(); C1 = MFMA32(kf[5], qr[2], C1); sacc += P1[6]; sacc += P1[7]; sacc += P1[8]; sacc += P1[9]; PIN(sacc); pw2[2] = PKW(P1, 4); pw2[3] = PKW(P1, 6); PIN(pw2); SBAR(); \
    VRD(2, 8); SBAR(); C0 = MFMA32(kf[6], qr[3], C0); sacc += P1[10]; sacc += P1[11]; sacc += P1[12]; sacc += P1[13]; PIN(sacc); pw3[0] = PKW(P1, 8); pw3[1] = PKW(P1, 10); PIN(pw3); SBAR(); \
    VRD(3, 12); SBAR(); C1 = MFMA32(kf[7], qr[3], C1); sacc += P1[14]; sacc += P1[15]; PIN(sacc); pw3[2] = PKW(P1, 12); pw3[3] = PKW(P1, 14); PIN(pw3); SBAR(); \
    l_reg += sacc; \
    MIDDLE(C0, C1, t, BAND); \
    SBAR(); \
    o[0] = MFMA32(PAF(0), VFR(0), o[0]); if (GK) DMA_K((t) + 3, sl_cur); if (GV) DMA_V((t) + 1, sl_next); VRD(0, 1); C0[0] = EX(C0[0]); C0[1] = EX(C0[1]); PIN(C0); SBAR(); \
    o[1] = MFMA32(PAF(0), VFR(1), o[1]); VRD(1, 5); C0[2] = EX(C0[2]); C0[3] = EX(C0[3]); PIN(C0); SBAR(); \
    o[2] = MFMA32(PAF(0), VFR(2), o[2]); VRD(2, 9); C0[4] = EX(C0[4]); C0[5] = EX(C0[5]); PIN(C0); SBAR(); \
    o[3] = MFMA32(PAF(0), VFR(3), o[3]); VRD(3, 13); C0[6] = EX(C0[6]); C0[7] = EX(C0[7]); PIN(C0); SBAR(); \
    o[0] = MFMA32(PAF(1), VFR(0), o[0]); VRD(0, 2); C0[8] = EX(C0[8]); C0[9] = EX(C0[9]); PIN(C0); SBAR(); \
    o[1] = MFMA32(PAF(1), VFR(1), o[1]); VRD(1, 6); C0[10] = EX(C0[10]); C0[11] = EX(C0[11]); PIN(C0); SBAR(); \
    o[2] = MFMA32(PAF(1), VFR(2), o[2]); VRD(2, 10); C0[12] = EX(C0[12]); C0[13] = EX(C0[13]); PIN(C0); SBAR(); \
    o[3] = MFMA32(PAF(1), VFR(3), o[3]); VRD(3, 14); C0[14] = EX(C0[14]); C0[15] = EX(C0[15]); PIN(C0); SBAR(); \
    o[0] = MFMA32(PAF(2), VFR(0), o[0]); VRD(0, 3); C1[0] = EX(C1[0]); C1[1] = EX(C1[1]); PIN(C1); SBAR(); \
    KRD(GL, 0); o[1] = MFMA32(PAF(2), VFR(1), o[1]); VRD(1, 7); C1[2] = EX(C1[2]); C1[3] = EX(C1[3]); PIN(C1); SBAR(); \
    KRD(GL, 1); o[2] = MFMA32(PAF(2), VFR(2), o[2]); VRD(2, 11); C1[4] = EX(C1[4]); C1[5] = EX(C1[5]); PIN(C1); SBAR(); \
    KRD(GL, 2); o[3] = MFMA32(PAF(2), VFR(3), o[3]); VRD(3, 15); C1[6] = EX(C1[6]); C1[7] = EX(C1[7]); PIN(C1); SBAR(); \
    KRD(GL, 3); o[0] = MFMA32(PAF(3), VFR(0), o[0]); C1[8] = EX(C1[8]); C1[9] = EX(C1[9]); PIN(C1); SBAR(); \
    o[1] = MFMA32(PAF(3), VFR(1), o[1]); C1[10] = EX(C1[10]); C1[11] = EX(C1[11]); PIN(C1); SBAR(); \
    o[2] = MFMA32(PAF(3), VFR(2), o[2]); C1[12] = EX(C1[12]); C1[13] = EX(C1[13]); PIN(C1); SBAR(); \
    o[3] = MFMA32(PAF(3), VFR(3), o[3]); C1[14] = EX(C1[14]); C1[15] = EX(C1[15]); PIN(C1); { float iv_ = INI_ADD((t) + 1) - mhat; _Pragma("unroll") for (int r_ = 0; r_ < 16; ++r_) inin[r_] = iv_; } PIN(inin); SBAR(); \
    } while (0)
#define PKW(P, i) cvtpk_s(P[i], P[i + 1])
#define PAF(k) __builtin_bit_cast(bf16x8, pw##k)
#define VFR(i) (bf16x8){vlo[i][0], vlo[i][1], vlo[i][2], vlo[i][3], vhi[i][0], vhi[i][1], vhi[i][2], vhi[i][3]}
#define VRD(s, f) do { vlo[s] = vtr(vp_ + (((f) >> 2) * 4096 + ((f) & 3) * 1024)); vhi[s] = vtr(vp_ + (((f) >> 2) * 4096 + ((f) & 3) * 1024 + 512)); } while (0)
#define KRD(G, j) do { if (G) { const lds_cptr kq_ = kp0 + sl_next * L::KB + (j) * 2048; kf[2 * (j)] = kld(kq_); kf[2 * (j) + 1] = kld(kq_ + 512); SBAR(); } } while (0)
#define ROT() do { sl_prev = sl_cur; sl_cur = sl_next; sl_next = (sl_next == NSLOT - 1) ? 0 : sl_next + 1; } while (0)
#define CMASK(C0, C1, t) do { } while (0)
#define DECIDE(C0, C1) do { float a_ = MX3(C0[0], C0[1], C1[0]), b_ = MX3(C0[2], C0[3], C1[1]); a_ = MX3(a_, C1[2], C1[3]); \
      _Pragma("unroll") for (int r_ = 4; r_ < 16; r_ += 4) { a_ = MX3(a_, C0[r_], C0[r_ + 1]); b_ = MX3(b_, C0[r_ + 2], C0[r_ + 3]); a_ = MX3(a_, C1[r_], C1[r_ + 1]); b_ = MX3(b_, C1[r_ + 2], C1[r_ + 3]); } \
      float rm_ = __builtin_fmaxf(a_, b_); { auto rr_ = __builtin_amdgcn_permlane32_swap(__float_as_uint(rm_), __float_as_uint(rm_), false, false); rm_ = __builtin_fmaxf(__uint_as_float(rr_[0]), __uint_as_float(rr_[1])); } \
      resc = false; \
      if (__builtin_expect(__any(rm_ > (float)THRL), 0)) { const float dl_ = __builtin_fmaxf(rm_, 0.f); mhat += dl_; NEGM_UPDATE(); \
        _Pragma("unroll") for (int r_ = 0; r_ < 16; ++r_) { C0[r_] -= dl_; C1[r_] -= dl_; } \
        const float f_ = __builtin_amdgcn_exp2f(-dl_); l_reg *= f_; if (hi == 0) wsf[r32] = f_; resc = true; } } while (0)
#define RESC(NO_) do { if (resc) { asm volatile("s_waitcnt lgkmcnt(0)" ::: "memory"); \
      _Pragma("unroll") for (int r_ = 0; r_ < 16; ++r_) { const float f_ = wsf[crow(r_, hi)]; _Pragma("unroll") for (int d_ = 0; d_ < NO_; ++d_) o[d_][r_] *= f_; } } } while (0)
#define ENDW(tt, W2, W1) do { if ((tt) + 3 < NT) { WAIT_BAR(W2); } else if ((tt) + 2 < NT) { WAIT_BAR(W1); } else { WAIT_BAR(0); } } while (0)
#define DRAIN_PV(P0, P1, slot_, NO_) do { float sacc_ = P0[0] + P0[1]; \
      _Pragma("unroll") for (int r_ = 2; r_ < 16; ++r_) sacc_ += P0[r_]; \
      _Pragma("unroll") for (int r_ = 0; r_ < 16; ++r_) sacc_ += P1[r_]; \
      l_reg += sacc_; \
      pw0 = (u32x4){PKW(P0, 0), PKW(P0, 2), PKW(P0, 4), PKW(P0, 6)}; pw1 = (u32x4){PKW(P0, 8), PKW(P0, 10), PKW(P0, 12), PKW(P0, 14)}; \
      pw2 = (u32x4){PKW(P1, 0), PKW(P1, 2), PKW(P1, 4), PKW(P1, 6)}; pw3 = (u32x4){PKW(P1, 8), PKW(P1, 10), PKW(P1, 12), PKW(P1, 14)}; \
      const lds_cptr vp_ = vp0 + (slot_) * L::VB; \
      _Pragma("unroll") for (int d_ = 0; d_ < NO_; ++d_) { \
          VRD(0, d_ * 4 + 0); VRD(1, d_ * 4 + 1); VRD(2, d_ * 4 + 2); VRD(3, d_ * 4 + 3); \
          o[d_] = MFMA32(PAF(0), VFR(0), o[d_]); o[d_] = MFMA32(PAF(1), VFR(1), o[d_]); o[d_] = MFMA32(PAF(2), VFR(2), o[d_]); o[d_] = MFMA32(PAF(3), VFR(3), o[d_]); SBAR(); } } while (0)
#define BSTEP(STEPX, NO_, C0, C1, P0, P1, t, GK, GV, GL) do { \
      if ((t) <= Lw) { STEPX(C0, C1, P0, P1, t, false, GK, GV, ((GL) && ((t) + 1 <= Lw))); } \
      else { resc = false; if (GK) DMA_K((t) + 3, sl_cur); if (GV) DMA_V((t) + 1, sl_next); \
             if ((t) == Lw + 1) DRAIN_PV(P0, P1, sl_prev, NO_); } } while (0)

template <int DQK, int DV>
__device__ __forceinline__ void store_rows(const f32x16 (&y)[DV / 32], bf16* dst, int pitch, char* shm) {
    typedef Lay<DQK, DV> L;
    const int tid_ = otid(), lane = tid_ & 63, r32 = lane & 31, hi = lane >> 5; const int wid = __builtin_amdgcn_readfirstlane(tid_ >> 6);
    bf16* stg = (bf16*)(shm + L::LDS_OST + wid * L::OSTW);
#pragma unroll
    for (int half = 0; half < DV / 64; ++half) {
#pragma unroll
        for (int r = 0; r < 16; ++r) { const int orow = crow(r, hi);
#pragma unroll
            for (int d0 = 0; d0 < 2; ++d0) { const unsigned pk = cvtpk_s(y[2 * half + d0][r], 0.f); stg[orow * 64 + d0 * 32 + r32] = (bf16)(pk & 0xffffu); } }
        asm volatile("s_waitcnt lgkmcnt(0)" ::: "memory");
#pragma unroll
        for (int i = 0; i < 4; ++i) { const int row = i * 8 + (lane >> 3), ch = lane & 7; const u32x4 v = *(const u32x4*)(stg + row * 64 + ch * 8);
            *(u32x4*)(dst + (long)(32 * wid + i * 8 + (lane >> 3)) * pitch + half * 64 + ch * 8) = v; }
        asm volatile("s_waitcnt lgkmcnt(0)" ::: "memory");
    }
}
template <int DQK, int DV>
__device__ __forceinline__ void row_rcp(float (&rli)[16], float l_reg, char* shm) {
    typedef Lay<DQK, DV> L;
    const int tid_ = otid(), lane = tid_ & 63, r32 = lane & 31, hi = lane >> 5; const int wid = __builtin_amdgcn_readfirstlane(tid_ >> 6);
    float* wsf = (float*)(shm + L::LDS_WS) + wid * 64;
    { auto rr = __builtin_amdgcn_permlane32_swap(__float_as_uint(l_reg), __float_as_uint(l_reg), false, false); l_reg = __uint_as_float(rr[0]) + __uint_as_float(rr[1]); }
    if (hi == 0) wsf[32 + r32] = l_reg;
    asm volatile("s_waitcnt lgkmcnt(0)" ::: "memory");
#pragma unroll
    for (int r = 0; r < 16; ++r) rli[r] = __builtin_amdgcn_rcpf(wsf[32 + crow(r, hi)]);
}

struct MlaT { const bf16 *QA, *KN, *KR, *VA; bf16* MIX; };
__device__ __forceinline__ void mla_unit(int b, int h, int qb, const MlaT& T, char* shm) {
    typedef Lay<96, 64> L;
    const int tid = otid(), lane = tid & 63, r32 = lane & 31, hi = lane >> 5; const int wid = __builtin_amdgcn_readfirstlane(tid >> 6);
    const long rowbase = (long)b * SEQ; const int q0 = qb * QB, NT = 4 * qb + 4; const int Lw = NT - 4 + (wid >> 1);
    const bf16* Qrow = T.QA + (rowbase + q0 + 32 * wid + r32) * 768 + h * 96;
    const unsigned lds0 = (unsigned)(uintptr_t)shm; float* wsf = (float*)(shm + L::LDS_WS) + wid * 64;
    const bf16* ksrc = T.KN + rowbase * 512 + h * 64 + (long)lane * 512 + wid * 8;
    const bf16* k2src = T.KR + rowbase * 32 + (long)lane * 32 + (wid & 3) * 8;
    const bf16* vsrc = T.VA + rowbase * 512 + h * 64 + (long)(16 * (wid & 3) + (lane >> 2)) * 512 + (wid >> 2) * 32 + (lane & 3) * 8;
    const unsigned kdst = lds0 + L::LDS_K + wid * 1024, k2dst = lds0 + L::LDS_K + (8 + (wid & 3)) * 1024, vdst = lds0 + L::LDS_V + wid * 1024;
#define DMA_K(t, slot) do { glds16(ksrc + (long)(t) * KVBLK * 512, (unsigned)__builtin_amdgcn_readfirstlane(kdst + (slot) * L::KB)); glds16(k2src + (long)(t) * KVBLK * 32, (unsigned)__builtin_amdgcn_readfirstlane(k2dst + (slot) * L::KB)); } while (0)
#define DMA_V(t, slot) glds16(vsrc + (long)(t) * KVBLK * 512, (unsigned)__builtin_amdgcn_readfirstlane(vdst + (slot) * L::VB))
#define INI_ADD(t) 0.f
#define NEGM_UPDATE() do { _Pragma("unroll") for (int r_ = 0; r_ < 16; ++r_) negm[r_] = -mhat; } while (0)
#define MIDDLE(C0, C1, t, BAND) do { if (BAND) CMASK(C0, C1, t); DECIDE(C0, C1); } while (0)
    const lds_cptr shm3 = (lds_cptr)shm;
    const lds_cptr vp0 = shm3 + L::LDS_V + ((lane >> 4) & 1) * 32 + (lane & 3) * 8 + (4 * hi + ((lane & 15) >> 2)) * 64;
    const lds_cptr kp0 = shm3 + L::LDS_K + hi * 1024 + r32 * 16;
    DMA_K(0, 0); DMA_V(0, 0); DMA_K(1, 1);
    bf16x8 qr[6];
#pragma unroll
    for (int d0 = 0; d0 < 6; ++d0) qr[d0] = __builtin_nontemporal_load(reinterpret_cast<const bf16x8*>(&Qrow[d0 * 16 + hi * 8]));
    float mhat = 0.f, l_reg = 0.f; f32x16 o[2]; o[0] = f32x16{}; o[1] = f32x16{};
    bool resc = false;
    f32x16 pA0, pA1, pB0, pB1; bf16x8 kf[12]; s16x4 vlo[8], vhi[8]; u32x4 pw0, pw1, pw2, pw3;
    int sl_prev = 0, sl_cur = 0, sl_next = 1;
    DMA_K(2, 2);
    WAIT_BAR(5);
    { f32x16 z = f32x16{};
#pragma unroll
      for (int d0 = 0; d0 < 6; ++d0) { const bf16x8 b0 = kld(kp0 + d0 * 2048), b1 = kld(kp0 + d0 * 2048 + 512);
          if (d0 == 0) { pA0 = MFMA32(b0, qr[0], z); pA1 = MFMA32(b1, qr[0], z); } else { pA0 = MFMA32(b0, qr[d0], pA0); pA1 = MFMA32(b1, qr[d0], pA1); } }
      const float rm = rowmax(pA0, pA1); mhat = rm;
#pragma unroll
      for (int r = 0; r < 16; ++r) { pA0[r] = EX(pA0[r] - rm); pA1[r] = EX(pA1[r] - rm); } }
    f32x16 negm; NEGM_UPDATE(); asm volatile("" : "+v"(negm));
    WAIT_BAR(0);
    DMA_K(3, 0); DMA_V(1, 1); ROT();
#pragma unroll
    for (int j = 0; j < 6; ++j) { const lds_cptr kq = kp0 + sl_cur * L::KB + j * 2048; kf[2 * j] = kld(kq); kf[2 * j + 1] = kld(kq + 512); }
    WAIT_BAR(3);
    int t = 1;
    for (; t + 5 < NT; t += 2) {
        STEP_MLA(pB0, pB1, pA0, pA1, t, false, true, true, true);     WAIT_BAR(3); RESC(2); ROT();
        STEP_MLA(pA0, pA1, pB0, pB1, t + 1, false, true, true, true); WAIT_BAR(3); RESC(2); ROT();
    }
#pragma nounroll
    for (; t <= Lw; ++t) {
        STEP_MLA(pB0, pB1, pA0, pA1, t, false, (t + 3 < NT), (t + 1 < NT), (t + 1 <= Lw));
        if (t + 1 < NT) { ENDW(t, 3, 1); }
        RESC(2);
        if (t + 1 < NT) ROT();
        pA0 = pB0; pA1 = pB1;
    }
    if (t < NT) {
        if (t + 3 < NT) DMA_K(t + 3, sl_cur); if (t + 1 < NT) DMA_V(t + 1, sl_next);
        DRAIN_PV(pA0, pA1, sl_prev, 2);
        if (t + 1 < NT) { ENDW(t, 3, 1); ROT(); }
        ++t;
#pragma nounroll
        for (; t < NT; ++t) {
            if (t + 3 < NT) DMA_K(t + 3, sl_cur); if (t + 1 < NT) DMA_V(t + 1, sl_next);
            if (t + 1 < NT) { ENDW(t, 3, 1); ROT(); }
        }
    } else { DRAIN_PV(pA0, pA1, sl_cur, 2); }
    float rli[16]; row_rcp<96, 64>(rli, l_reg, shm);
#pragma unroll
    for (int d = 0; d < 2; ++d)
#pragma unroll
        for (int r = 0; r < 16; ++r) o[d][r] *= rli[r];
    store_rows<96, 64>(o, T.MIX + (rowbase + q0) * 1024 + h * 64, 1024, shm);
    asm volatile("s_waitcnt vmcnt(0) lgkmcnt(0)\n\ts_barrier" ::: "memory");
#undef DMA_K
#undef DMA_V
#undef INI_ADD
#undef NEGM_UPDATE
#undef MIDDLE
}

struct DiffT { const bf16 *DQ, *DK, *DV; bf16* MIX; float* OB; const float *rel_bias, *g_subln; float lam; };
__device__ __forceinline__ int t5_bucket(int rel) {
    const int n = rel < 0 ? -rel : rel; int bk = n;
    if (n >= 8) { bk = 2 + (31 - __clz(n * n)); bk = bk > 15 ? 15 : bk; }
    return (rel > 0 ? 16 : 0) + bk;
}
__device__ __forceinline__ void diff_pass(f32x16 (&o)[4], float& l_out, int b, int h, int qb, int mo, const DiffT& T, char* shm, float cfar) {
    typedef Lay<64, 128> L;
    const int tid = otid(), lane = tid & 63, r32 = lane & 31, hi = lane >> 5; const int wid = __builtin_amdgcn_readfirstlane(tid >> 6);
    const long rowbase = (long)b * SEQ; const int q0 = qb * QB, NT = 4 * qb + 4; const int Lw = NT - 4 + (wid >> 1);
    const int urow = 32 * wid + r32;
    const bf16* Qrow = T.DQ + (rowbase + q0 + urow) * 512 + h * 128 + mo;
    const unsigned lds0 = (unsigned)(uintptr_t)shm; float* wsf = (float*)(shm + L::LDS_WS) + wid * 64;
    const float* bt = (const float*)(shm + L::LDS_BT);
    const bf16* ksrc = T.DK + rowbase * 512 + h * 128 + mo + (long)lane * 512 + wid * 8;
    const bf16* vsrc = T.DV + rowbase * 512 + h * 128 + (long)(16 * (wid & 3) + (lane >> 2)) * 512 + (wid >> 2) * 32 + (lane & 3) * 8;
    const unsigned kdst = lds0 + L::LDS_K + wid * 1024, vdst = lds0 + L::LDS_V + wid * 1024;
#define DMA_K(t, slot) glds16(ksrc + (long)(t) * KVBLK * 512, (unsigned)__builtin_amdgcn_readfirstlane(kdst + (slot) * L::KB))
#define DMA_V(t, slot) do { glds16(vsrc + (long)(t) * KVBLK * 512, (unsigned)__builtin_amdgcn_readfirstlane(vdst + (slot) * L::VB)); glds16(vsrc + (long)(t) * KVBLK * 512 + 64, (unsigned)__builtin_amdgcn_readfirstlane(vdst + (slot) * L::VB + 8192)); } while (0)
#define INI_ADD(t) (((t) < NT - 6) ? cfar : 0.f)
#define NEGM_UPDATE() do { } while (0)
#define BIAS_ADD(C0, C1, t) do { if ((t) >= NT - 6) { const float* bp_ = bt + (64 * (t) - (q0 + urow) + 384 + 4 * hi); \
      _Pragma("unroll") for (int r_ = 0; r_ < 16; ++r_) { C0[r_] += bp_[(r_ & 3) + 8 * (r_ >> 2)]; C1[r_] += bp_[32 + (r_ & 3) + 8 * (r_ >> 2)]; } } } while (0)
#define MIDDLE(C0, C1, t, BAND) do { BIAS_ADD(C0, C1, t); if (BAND) CMASK(C0, C1, t); DECIDE(C0, C1); } while (0)
    const lds_cptr shm3 = (lds_cptr)shm;
    const lds_cptr vp0 = shm3 + L::LDS_V + ((lane >> 4) & 1) * 32 + (lane & 3) * 8 + (4 * hi + ((lane & 15) >> 2)) * 64;
    const lds_cptr kp0 = shm3 + L::LDS_K + hi * 1024 + r32 * 16;
    DMA_K(0, 0); DMA_V(0, 0); DMA_K(1, 1);
    bf16x8 qr[4];
#pragma unroll
    for (int d0 = 0; d0 < 4; ++d0) qr[d0] = __builtin_nontemporal_load(reinterpret_cast<const bf16x8*>(&Qrow[d0 * 16 + hi * 8]));
    float mhat = 0.f, l_reg = 0.f;
#pragma unroll
    for (int d = 0; d < 4; ++d) o[d] = f32x16{};
    bool resc = false;
    f32x16 pA0, pA1, pB0, pB1; bf16x8 kf[8]; s16x4 vlo[8], vhi[8]; u32x4 pw0, pw1, pw2, pw3;
    int sl_prev = 0, sl_cur = 0, sl_next = 1;
    DMA_K(2, 2);
    WAIT_BAR(4);
    { f32x16 z; { const float iv = INI_ADD(0);
#pragma unroll
        for (int r = 0; r < 16; ++r) z[r] = iv; }
#pragma unroll
      for (int d0 = 0; d0 < 4; ++d0) { const bf16x8 b0 = kld(kp0 + d0 * 2048), b1 = kld(kp0 + d0 * 2048 + 512);
          if (d0 == 0) { pA0 = MFMA32(b0, qr[0], z); pA1 = MFMA32(b1, qr[0], z); } else { pA0 = MFMA32(b0, qr[d0], pA0); pA1 = MFMA32(b1, qr[d0], pA1); } }
      BIAS_ADD(pA0, pA1, 0);
      const float rm = rowmax(pA0, pA1); mhat = rm;
#pragma unroll
      for (int r = 0; r < 16; ++r) { pA0[r] = EX(pA0[r] - rm); pA1[r] = EX(pA1[r] - rm); } }
    f32x16 inin; { const float iv = INI_ADD(1) - mhat;
#pragma unroll
        for (int r = 0; r < 16; ++r) inin[r] = iv; }
    asm volatile("" : "+v"(inin));
    WAIT_BAR(0);
    DMA_K(3, 0); DMA_V(1, 1); ROT();
#pragma unroll
    for (int j = 0; j < 4; ++j) { const lds_cptr kq = kp0 + sl_cur * L::KB + j * 2048; kf[2 * j] = kld(kq); kf[2 * j + 1] = kld(kq + 512); }
    WAIT_BAR(3);
    int t = 1;
    for (; t + 5 < NT; t += 2) {
        STEP_DIF(pB0, pB1, pA0, pA1, t, false, true, true, true);     WAIT_BAR(3); RESC(4); ROT();
        STEP_DIF(pA0, pA1, pB0, pB1, t + 1, false, true, true, true); WAIT_BAR(3); RESC(4); ROT();
    }
#pragma nounroll
    for (; t <= Lw; ++t) {
        STEP_DIF(pB0, pB1, pA0, pA1, t, false, (t + 3 < NT), (t + 1 < NT), (t + 1 <= Lw));
        if (t + 1 < NT) { ENDW(t, 3, 2); }
        RESC(4);
        if (t + 1 < NT) ROT();
        pA0 = pB0; pA1 = pB1;
    }
    if (t < NT) {
        if (t + 3 < NT) DMA_K(t + 3, sl_cur); if (t + 1 < NT) DMA_V(t + 1, sl_next);
        DRAIN_PV(pA0, pA1, sl_prev, 4);
        if (t + 1 < NT) { ENDW(t, 3, 2); ROT(); }
        ++t;
#pragma nounroll
        for (; t < NT; ++t) {
            if (t + 3 < NT) DMA_K(t + 3, sl_cur); if (t + 1 < NT) DMA_V(t + 1, sl_next);
            if (t + 1 < NT) { ENDW(t, 3, 2); ROT(); }
        }
    } else { DRAIN_PV(pA0, pA1, sl_cur, 4); }
    l_out = l_reg;
    asm volatile("s_waitcnt lgkmcnt(0)\n\ts_barrier" ::: "memory");
#undef DMA_K
#undef DMA_V
#undef INI_ADD
#undef NEGM_UPDATE
#undef BIAS_ADD
#undef MIDDLE
}
__device__ __forceinline__ void diff_unit(int b, int h, int qb, const DiffT& T, char* shm) {
    typedef Lay<64, 128> L;
    const int tid = otid(); const int wid = __builtin_amdgcn_readfirstlane(tid >> 6);
    const long rowbase = (long)b * SEQ; const int q0 = qb * QB;
    constexpr float LOG2E = 1.4426950408889634f;
    { float* bt = (float*)(shm + L::LDS_BT); if (tid < 448) bt[tid] = T.rel_bias[t5_bucket(tid - 384) * 4 + h] * LOG2E; }
    const float cfar = T.rel_bias[15 * 4 + h] * LOG2E;
    asm volatile("s_waitcnt lgkmcnt(0)\n\ts_barrier" ::: "memory");
    unsigned* const obw = (unsigned*)(shm + L::LDS_OST + wid * L::OSTW);
    f32x16 o[4]; float l_reg; float rli[16];
    const float lam = T.lam;
#pragma nounroll
    for (int pass = 0; pass < 2; ++pass) {
        diff_pass(o, l_reg, b, h, qb, (pass == 0) ? 64 : 0, T, shm, cfar);
        row_rcp<64, 128>(rli, l_reg, shm);
        if (pass == 0) { unsigned* ob = obw + (otid() & 63);
#pragma unroll
            for (int d = 0; d < 4; ++d)
#pragma unroll
                for (int r = 0; r < 16; r += 2) ob[(d * 8 + (r >> 1)) * 64] = cvtpk_s(o[d][r] * rli[r], o[d][r + 1] * rli[r + 1]);
        }
    }
    float ss[16]; const int lane2 = otid() & 63, r32 = lane2 & 31; const unsigned* ob = obw + lane2;
    unsigned pk2_[4][8];
#pragma unroll
    for (int d = 0; d < 4; ++d)
#pragma unroll
        for (int j = 0; j < 8; ++j) pk2_[d][j] = ob[(d * 8 + j) * 64];
    asm volatile("s_waitcnt lgkmcnt(0)" ::: "memory");
#pragma unroll
    for (int r = 0; r < 16; ++r) { float s = 0.f;
#pragma unroll
        for (int d = 0; d < 4; ++d) { const unsigned w = pk2_[d][r >> 1]; const float o2 = __uint_as_float((r & 1) ? (w & 0xffff0000u) : (w << 16));
            const float y = o[d][r] * rli[r] - lam * o2; o[d][r] = y; s += y * y; }
        ss[r] = s; }
#define SWZ_STEP(K) _Pragma("unroll") for (int r = 0; r < 16; ++r) ss[r] += swz_xor<((K) << 10) | 0x1f>(ss[r]);
    SWZ_STEP(1) SWZ_STEP(2) SWZ_STEP(4) SWZ_STEP(8) SWZ_STEP(16)
#undef SWZ_STEP
#pragma unroll
    for (int d = 0; d < 4; ++d) { const float g = T.g_subln[d * 32 + r32] * 0.8f;
#pragma unroll
        for (int r = 0; r < 16; ++r) o[d][r] *= g * __builtin_amdgcn_rsqf(ss[r] * (1.f / 128.f) + 1e-6f); }
    store_rows<64, 128>(o, T.MIX + (rowbase + q0) * 1024 + 512 + h * 128, 1024, shm);
    asm volatile("s_waitcnt vmcnt(0) lgkmcnt(0)\n\ts_barrier" ::: "memory");
}
#undef SBAR
#undef PIN
#undef WAIT_BAR
#undef MFMA32
#undef EX
#undef MX3
}
#define GAS __attribute__((address_space(1)))
#define LAS __attribute__((address_space(3)))
typedef unsigned short bf16;
typedef unsigned v4u __attribute__((ext_vector_type(4)));
typedef float f32x4 __attribute__((ext_vector_type(4)));
typedef short bf16x8 __attribute__((ext_vector_type(8)));
typedef GAS unsigned gu32;
typedef GAS unsigned long long gu64;
#define RLX_AGENT __ATOMIC_RELAXED, __HIP_MEMORY_SCOPE_AGENT
#define LDS_WAIT() asm volatile("s_waitcnt lgkmcnt(0)" ::: "memory")
#define VM_WAIT() asm volatile("s_waitcnt vmcnt(0)" ::: "memory")
__device__ __forceinline__ unsigned long long rt() { return __builtin_amdgcn_s_memrealtime(); }
__device__ __forceinline__ unsigned f2bf(float f) { unsigned u = __builtin_bit_cast(unsigned, f); return (u + 0x7fffu + ((u >> 16) & 1u)) >> 16; }
__device__ __forceinline__ unsigned pk2(float lo, float hi) { return f2bf(lo) | (f2bf(hi) << 16); }

#define XB_TMO      128
#define XB_XCNT(j)  (256  + 64 * (j))
#define XB_XSUB(j)  (1280 + 64 * (j))
#define XB_XGEN(j)  (2304 + 64 * (j))
#define XB_TOP      3328
#define XB_TOPGEN   3392
#define XCD_BAR_WORDS 3456
#define XB_SPIN_CAP (1u << 18)

__device__ __forceinline__ unsigned xb_ld(unsigned* p)              { return __hip_atomic_load(p, __ATOMIC_RELAXED, __HIP_MEMORY_SCOPE_AGENT); }
__device__ __forceinline__ unsigned xb_add(unsigned* p, unsigned v) { return __hip_atomic_fetch_add(p, v, __ATOMIC_RELAXED, __HIP_MEMORY_SCOPE_AGENT); }
__device__ __forceinline__ unsigned xb_xcc_id() { return (unsigned)__builtin_amdgcn_s_getreg((3 << 11) | 20) & 0xFu; }
#define XB_SPIN(cond, bar) do { unsigned _sp = 0; while (cond) { __builtin_amdgcn_s_sleep(1); \
    if ((++_sp & 255u) == 0u) { if (xb_ld(&(bar)[XB_TMO])) break; if (_sp > XB_SPIN_CAP) { atomicAdd(&(bar)[XB_TMO], 1u); break; } } } } while (0)

struct XcdBarrier {
    unsigned* bar; unsigned x;
    volatile LAS unsigned* st;
};

__device__ __forceinline__ XcdBarrier xcd_barrier_post(unsigned* bar, volatile LAS unsigned* st) {
    XcdBarrier b; b.bar = bar; b.x = xb_xcc_id(); b.st = st;
    if (threadIdx.x == 0) st[2] = xb_add(&bar[XB_XCNT(b.x)], 1u);
    return b;
}
__device__ __forceinline__ void xcd_barrier_complete(unsigned* bar, unsigned x, unsigned& nloc, unsigned& nx) {
    const unsigned G = gridDim.x * gridDim.y * gridDim.z;
    unsigned sum, cnt, mine, sp = 0u;
    for (;;) {
        sum = 0u; cnt = 0u; mine = 0u;
#pragma unroll
        for (unsigned j = 0; j < 16; ++j) { const unsigned c = xb_ld(&bar[XB_XCNT(j)]); sum += c; cnt += (c > 0u) ? 1u : 0u; mine = (j == x) ? c : mine; }
        if (sum == G) break;
        __builtin_amdgcn_s_sleep(1);
        if ((++sp & 255u) == 0u) { if (xb_ld(&bar[XB_TMO])) break; if (sp > XB_SPIN_CAP) { atomicAdd(&bar[XB_TMO], 1u); break; } }
    }
    nloc = mine > 0u ? mine : 1u; nx = cnt > 0u ? cnt : 1u;
}

__device__ __forceinline__ void xcd_barrier(const XcdBarrier& b) {
    asm volatile("s_waitcnt vmcnt(0)" ::: "memory");
    __syncthreads();
    if (threadIdx.x == 0) {
        unsigned* bar = b.bar;
        __builtin_amdgcn_s_waitcnt(0);
        unsigned nloc = b.st[0], nx = b.st[1];
        if (nloc == 0u) { xcd_barrier_complete(bar, b.x, nloc, nx); b.st[0] = nloc; b.st[1] = nx; }
        const unsigned old = xb_add(&bar[XB_XSUB(b.x)], 1u);
        const unsigned gen = old / nloc;
        if (old + 1u == (gen + 1u) * nloc) {
            __builtin_amdgcn_fence(__ATOMIC_RELEASE, "agent");
            asm volatile("s_waitcnt vmcnt(0)" ::: "memory");
            const unsigned og = xb_add(&bar[XB_TOP], 1u);
            const unsigned tg = og / nx;
            if (og + 1u == (tg + 1u) * nx) xb_add(&bar[XB_TOPGEN], 1u);
            else XB_SPIN(xb_ld(&bar[XB_TOPGEN]) == tg, bar);
            __builtin_amdgcn_fence(__ATOMIC_ACQUIRE, "agent");
            xb_add(&bar[XB_XGEN(b.x)], 1u);
            asm volatile("s_waitcnt vmcnt(0)" ::: "memory");
        } else {
            XB_SPIN(xb_ld(&bar[XB_XGEN(b.x)]) == gen, bar);
            __builtin_amdgcn_fence(__ATOMIC_ACQUIRE, "agent");
            asm volatile("s_waitcnt vmcnt(0)" ::: "memory");
        }
    }
    __syncthreads();
}

__device__ __forceinline__ void xcc_barrier(const XcdBarrier& b) {
    asm volatile("s_waitcnt vmcnt(0)" ::: "memory");
    __syncthreads();
    if (threadIdx.x == 0) {
        unsigned* bar = b.bar;
        __builtin_amdgcn_s_waitcnt(0);
        const unsigned nloc = b.st[0];
        const unsigned old = xb_add(&bar[XB_XSUB(b.x)], 1u);
        const unsigned gen = old / nloc;
        if (old + 1u == (gen + 1u) * nloc) xb_add(&bar[XB_XGEN(b.x)], 1u);
        else XB_SPIN(xb_ld(&bar[XB_XGEN(b.x)]) == gen, bar);
        __builtin_amdgcn_fence(__ATOMIC_ACQUIRE, "agent");
        asm volatile("s_waitcnt vmcnt(0)" ::: "memory");
    }
    __syncthreads();
}
__device__ __forceinline__ bool xcc_team_setup(const XcdBarrier& b) {
    if (threadIdx.x < 64) { const unsigned G = gridDim.x, j = threadIdx.x & 15u;
        const unsigned c = xb_ld(&b.bar[XB_XCNT(j)]);
        const bool okl = (j < 8u) ? (c == G / 8u) : (c == 0u);
        const bool ok = ((G % 8u) == 0u) && (__all(okl ? 1 : 0) != 0);
        if (threadIdx.x == 0) b.st[3] = ok ? 1u : 0u; }
    __syncthreads();
    return b.st[3] != 0u;
}

constexpr int NWAVES = 8;
constexpr int M_TOK = 32768, D_MODEL = 1024, SEQ_L = 4096, FFN_H = 2816, IN_COLS = 1952;
constexpr size_t MiB = 1u << 20;
constexpr size_t WS_CTL = 0, CTL_ZERO_BYTES = 128 * 1024;
constexpr size_t WS_WIN = 2 * MiB;
constexpr size_t WS_WQKV = 6 * MiB;
constexpr size_t WS_WO = 8 * MiB;
constexpr size_t WS_WGU = 10 * MiB;
constexpr size_t WS_WD = 22 * MiB;
constexpr size_t WS_XCH = 27 * MiB + 512 * 1024;
constexpr size_t WS_ROPE = 28 * MiB;
constexpr size_t WS_RSTDX = 28 * MiB + 512 * 1024;
constexpr size_t WS_SSQQ = 29 * MiB;
constexpr size_t WS_SSQKV = 29 * MiB + 512 * 1024;
constexpr size_t WS_SSQX1 = 30 * MiB;
constexpr size_t WS_XN = 32 * MiB;
constexpr size_t WS_CQKV = 96 * MiB;
constexpr size_t WS_KR = 120 * MiB;
constexpr size_t WS_DQ = 128 * MiB, WS_DK = 160 * MiB, WS_DV = 192 * MiB;
constexpr size_t WS_QA = 224 * MiB;
constexpr size_t WS_KN = 272 * MiB, WS_VA = 304 * MiB;
constexpr size_t WS_MIX = 336 * MiB;
constexpr size_t WS_OB = 400 * MiB;
constexpr size_t WS_H = 96 * MiB;
constexpr size_t WS_END = 464 * MiB;
static_assert(WS_H + (size_t)M_TOK * FFN_H * 2 <= WS_MIX, "h overlay");
constexpr int CW_TMO = 0, CW_CODE = 1, CW_BAR = 4096, CW_SEAM = 16384;
constexpr int RING_OFF = 0, RING_BYTES = 131072;
constexpr int LDS_BYTES = 147456;
constexpr int XL_OFF = RING_BYTES;
constexpr int LDSCTL_OFF = LDS_BYTES - 1024, MISC_OFF = LDSCTL_OFF + 320;
static_assert(att::Lay<64, 128>::LDS_END <= LDSCTL_OFF && att::Lay<96, 64>::LDS_END <= LDSCTL_OFF, "attention scratch stays below the control words");

struct Args { const float* in[19]; float* out; unsigned char* ws; int ph_lo, ph_hi; };
static_assert(sizeof(Args) == 19 * 8 + 8 + 8 + 8, "no padding in Args");

__device__ __forceinline__ float wave_sum(float v) {
#pragma unroll
    for (int o = 1; o < 64; o <<= 1) v += __shfl_xor(v, o);
    return v;
}
__device__ __forceinline__ void transpose_item(const float* W, int ldw, const float* gain, bf16* WT, int ldt, LAS float* scr, int ks0, int kd0, int drow0, int srccol, int lane) {
    float v[32]; const int sc = srccol < 0 ? 0 : srccol;
#pragma unroll
    for (int i = 0; i < 32; ++i) { const int kk = 2 * i + (lane >> 5); v[i] = __builtin_nontemporal_load(&W[(size_t)(ks0 + kk) * ldw + sc]); }
    if (gain) {
        float gg[32];
#pragma unroll
        for (int i = 0; i < 32; ++i) { const int kk = 2 * i + (lane >> 5); gg[i] = gain[ks0 + kk]; }
#pragma unroll
        for (int i = 0; i < 32; ++i) v[i] *= gg[i];
    }
#pragma unroll
    for (int i = 0; i < 32; ++i) { const int kk = 2 * i + (lane >> 5); scr[kk * 33 + (lane & 31)] = srccol < 0 ? 0.f : v[i]; }
    LDS_WAIT(); asm volatile("" ::: "memory");
    const int c = lane & 7;
#pragma unroll
    for (int j = 0; j < 4; ++j) { const int n = (lane >> 3) + 8 * j; const LAS float* s = scr + (8 * c) * 33 + n;
        v4u o; o.x = pk2(s[0 * 33], s[1 * 33]); o.y = pk2(s[2 * 33], s[3 * 33]); o.z = pk2(s[4 * 33], s[5 * 33]); o.w = pk2(s[6 * 33], s[7 * 33]);
        *(GAS v4u*)(WT + (size_t)(drow0 + n) * ldt + kd0 + 8 * c) = o; }
    LDS_WAIT(); asm volatile("" ::: "memory");
}
__device__ __forceinline__ int map_win(int n) {
    if (n < 256) return n;
    if (n < 512) { const int j = n - 256; if (j < 128) return 256 + j; if (j < 160) { const int p = j - 128; return 384 + (p >> 1) + 16 * (p & 1); } return -1; }
    return 416 + (n - 512);
}
__device__ __forceinline__ int map_wq(int n) {
    if (n < 512) return (n >> 6) * 96 + (n & 63);
    const int j = n - 512, h = j >> 5, p = j & 31; return h * 96 + 64 + (p >> 1) + 16 * (p & 1);
}
__device__ __forceinline__ int map_wkv(int n) {
    if (n < 512) return (n >> 6) * 128 + (n & 63);
    const int j = n - 512; return (j >> 6) * 128 + 64 + (j & 63);
}

__constant__ float ROPE_INV_FREQ[16] = {1.0f, 0.5623413324356079f, 0.3162277638912201f, 0.17782793939113617f, 0.10000000149011612f, 0.05623413249850273f, 0.03162277489900589f, 0.017782794311642647f,
    0.009999999776482582f, 0.005623413249850273f, 0.003162277629598975f, 0.0017782794311642647f, 0.0010000000474974513f, 0.000562341301701963f, 0.0003162277571391314f, 0.00017782794020604342f};

struct Frame {
    LAS unsigned char* lds; volatile LAS unsigned* MISC; gu32* ctl;
    int wave, vcu, G;
};

__global__ void __launch_bounds__(NWAVES * 64, 2) hyb_fwd(Args args) {
    extern __shared__ __attribute__((aligned(16))) unsigned char lds[];
    Frame F;
    F.lds = (LAS unsigned char*)lds; F.MISC = (volatile LAS unsigned*)(F.lds + MISC_OFF);
    F.wave = __builtin_amdgcn_readfirstlane((int)threadIdx.x >> 6);
    F.G = gridDim.x; { const int bx = blockIdx.x; F.vcu = (F.G % 8 == 0) ? (bx % 8) * (F.G / 8) + bx / 8 : bx; }
    F.ctl = (gu32*)(args.ws + WS_CTL);
#define CAS __attribute__((address_space(4)))
#define PH_BEGIN() const CAS char* kap_ = (const CAS char*)__builtin_amdgcn_kernarg_segment_ptr(); asm volatile("" : "+s"(kap_)); unsigned char* const ws = *(unsigned char* const CAS*)(kap_ + 160)
#define INP(k) (*(const float* const CAS*)(kap_ + 8 * (k)))
#define OUTP() (*(float* const CAS*)(kap_ + 152))
#define Win_t ((bf16*)(ws + WS_WIN))
#define Wqkv_t ((bf16*)(ws + WS_WQKV))
#define Wo_t ((bf16*)(ws + WS_WO))
#define Wgu_t ((bf16*)(ws + WS_WGU))
#define Wd_t ((bf16*)(ws + WS_WD))
#define ROPE ((float*)(ws + WS_ROPE))
#define RSTDX ((float*)(ws + WS_RSTDX))
#define SSQ_Q ((float*)(ws + WS_SSQQ))
#define SSQ_KV ((float*)(ws + WS_SSQKV))
#define SSQ_X1 ((float*)(ws + WS_SSQX1))
#define XN ((bf16*)(ws + WS_XN))
#define CQKV ((bf16*)(ws + WS_CQKV))
#define KR ((bf16*)(ws + WS_KR))
#define DQ ((bf16*)(ws + WS_DQ))
#define DK ((bf16*)(ws + WS_DK))
#define DVb ((bf16*)(ws + WS_DV))
#define QA ((bf16*)(ws + WS_QA))
#define KN ((bf16*)(ws + WS_KN))
#define VA ((bf16*)(ws + WS_VA))
#define MIX ((bf16*)(ws + WS_MIX))
#define OB ((float*)(ws + WS_OB))
#define X1B ((bf16*)(ws + WS_OB))
#define HB ((bf16*)(ws + WS_H))
    for (int u = threadIdx.x; u < (LDS_BYTES - LDSCTL_OFF) / 4; u += NWAVES * 64) ((LAS unsigned*)(F.lds + LDSCTL_OFF))[u] = 0u;
    __syncthreads();
    XcdBarrier bar = xcd_barrier_post((unsigned*)(F.ctl + CW_BAR), F.MISC + 8);
    const int lo = args.ph_lo, hi = args.ph_hi;
#ifndef PHASES
#define PHASES 0xFF
#endif
#define IN(k) (((PHASES >> (k)) & 1) && lo <= (k) && (k) < hi)
#define BOTH(k) (IN(k) && IN((k) + 1))
#define GRID_BAR() do { if (team) xcc_barrier(bar); else xcd_barrier(bar); } while (0)
    bool team = false; int bxv = (int)blockIdx.x;
#ifndef PROBE_REPEAT
#define PROBE_REPEAT -1
#endif
#define REPS(k) ((PROBE_REPEAT == (k)) ? reps2 : 1)
    int reps2 = 2; asm volatile("" : "+s"(reps2));
    const int gw = F.vcu * NWAVES + F.wave, NGW = F.G * NWAVES;

    if (IN(0)) _Pragma("nounroll") for (int rep_ = 0; rep_ < REPS(0); ++rep_) {
        PH_BEGIN(); const int tid_ = att::otid(), lane_ = tid_ & 63;
        const float* x = INP(0); const float* w_in = INP(1); const float* g_attn = INP(2); const float* g_q_a = INP(3); const float* w_q_b = INP(4); const float* g_kv_a = INP(5); const float* w_kv_b = INP(6);
        const float* w_o = INP(13); const float* g_ffn = INP(14); const float* w_gate = INP(15); const float* w_up = INP(16); const float* w_down = INP(17);
        LAS float* scr = (LAS float*)(F.lds + RING_OFF + F.wave * 16384);
        constexpr int I_IN = 16 * 64, I_Q = 4 * 24, I_KV = 2 * 32, I_O = 16 * 32, I_GU = 16 * 176, I_D = 44 * 32;
        constexpr int NITEMS = I_IN + I_Q + I_KV + I_O + I_GU + I_D;
        for (int it = gw; it < NITEMS; it += NGW) {
            int r = it; const int l31 = lane_ & 31;
            if (r < I_IN) { const int kb = r / 64, nb = r % 64; transpose_item(w_in, IN_COLS, g_attn, Win_t, 1024, scr, 64 * kb, 64 * kb, 32 * nb, map_win(32 * nb + l31), lane_); continue; } r -= I_IN;
            if (r < I_Q) { const int kb = r / 24, nb = r % 24; transpose_item(w_q_b, 768, g_q_a, Wqkv_t, 384, scr, 64 * kb, 64 * kb, 32 * nb, map_wq(32 * nb + l31), lane_); continue; } r -= I_Q;
            if (r < I_KV) { const int kb = r / 32, nb = r % 32; transpose_item(w_kv_b, 1024, g_kv_a, Wqkv_t, 384, scr, 64 * kb, 256 + 64 * kb, 768 + 32 * nb, map_wkv(32 * nb + l31), lane_); continue; } r -= I_KV;
            if (r < I_O) { const int kb = r / 32, nb = r % 32; transpose_item(w_o, 1024, nullptr, Wo_t, 1024, scr, 64 * kb, 64 * kb, 32 * nb, 32 * nb + l31, lane_); continue; } r -= I_O;
            if (r < I_GU) { const int kb = r / 176, nb = r % 176; const int n = 32 * nb + l31, pn = n >> 8, j = n & 255; const bool up = j >= 128;
                transpose_item(up ? w_up : w_gate, FFN_H, g_ffn, Wgu_t, 1024, scr, 64 * kb, 64 * kb, 32 * nb, 128 * pn + (j & 127), lane_); continue; } r -= I_GU;
            { const int kb = r / 32, nb = r % 32; transpose_item(w_down, 1024, nullptr, Wd_t, FFN_H, scr, 64 * kb, 64 * kb, 32 * nb, 32 * nb + l31, lane_); }
        }
        { const int gt = F.vcu * (NWAVES * 64) + tid_, NGT = F.G * NWAVES * 64; const v4u z = (v4u){0u, 0u, 0u, 0u};
          for (int i = gt; i < 768 * 16; i += NGT) *(GAS v4u*)(Wqkv_t + (size_t)(i >> 4) * 384 + 256 + (i & 15) * 8) = z;
          for (int i = gt; i < 1024 * 32; i += NGT) *(GAS v4u*)(Wqkv_t + (size_t)(768 + (i >> 5)) * 384 + (i & 31) * 8) = z;
          for (int i = gt; i < SEQ_L * 16; i += NGT) { const int pos = i >> 4, k = i & 15; const float ang = (float)pos * ROPE_INV_FREQ[k];
              const double t = (double)ang * 0.15915494309189535; const float fr = (float)(t - __builtin_rint(t));
              ROPE[2 * i] = __builtin_amdgcn_cosf(fr); ROPE[2 * i + 1] = __builtin_amdgcn_sinf(fr); } }
        { for (int m = gw; m < M_TOK; m += 4 * NGW) { f32x4 v[4][4]; float s[4];
#pragma unroll
              for (int q = 0; q < 4; ++q) { const GAS f32x4* xr = (const GAS f32x4*)(x + (size_t)(m + q * NGW) * D_MODEL) + lane_;
#pragma unroll
                  for (int j = 0; j < 4; ++j) v[q][j] = __builtin_nontemporal_load(&xr[64 * j]); }
#pragma unroll
              for (int q = 0; q < 4; ++q) { float t = 0.f;
#pragma unroll
                  for (int j = 0; j < 4; ++j) t += (v[q][j].x * v[q][j].x + v[q][j].y * v[q][j].y) + (v[q][j].z * v[q][j].z + v[q][j].w * v[q][j].w);
                  s[q] = t; }
#pragma unroll
              for (int o = 1; o < 64; o <<= 1)
#pragma unroll
                  for (int q = 0; q < 4; ++q) s[q] += __shfl_xor(s[q], o);
#pragma unroll
              for (int q = 0; q < 4; ++q) { const float rstd = __builtin_amdgcn_rsqf(s[q] * (1.f / D_MODEL) + 1e-6f);
                  GAS unsigned long long* o8 = (GAS unsigned long long*)(XN + (size_t)(m + q * NGW) * D_MODEL) + lane_;
#pragma unroll
                  for (int j = 0; j < 4; ++j) { const f32x4 y = v[q][j]; o8[64 * j] = (unsigned long long)pk2(y.x, y.y) | ((unsigned long long)pk2(y.z, y.w) << 32); }
                  if (lane_ == 0) RSTDX[m + q * NGW] = rstd; } } }
        if (BOTH(0) && rep_ == REPS(0) - 1) { xcd_barrier(bar);
#ifndef NO_TEAM
            team = xcc_team_setup(bar);
            if (team) { const int rank = (int)bar.st[2]; bxv = rank * 8 + (int)bar.x; F.vcu = (int)bar.x * (F.G / 8) + rank;
#if defined(STAGGER_TICKS) && STAGGER_TICKS > 0
                { const unsigned long long t0 = __builtin_amdgcn_s_memrealtime(), dt = (unsigned long long)bar.x * STAGGER_TICKS; while (__builtin_amdgcn_s_memrealtime() - t0 < dt) __builtin_amdgcn_s_sleep(8); }
#endif
            }
#endif
        }
        if (PROBE_REPEAT == 9 && rep_ == 0) { _Pragma("nounroll") for (int q_ = 0; q_ < 4 * reps2; ++q_) GRID_BAR(); }
    }
    if (IN(1)) _Pragma("nounroll") for (int rep_ = 0; rep_ < REPS(1); ++rep_) {
        PH_BEGIN();
        pg8::Gemm g{XN, Win_t, M_TOK, 2048, D_MODEL}; pg8::StaticOrder S; S.init(M_TOK, 2048, F.G, bxv);
        pg8::EpiInProj E{CQKV, KR, DQ, DK, DVb, SSQ_Q, SSQ_KV, ROPE, RSTDX, 0.125f * 1.4426950408889634f};
        pg8::gemm_phase<pg8::EpiInProj, pg8::StaticOrder, true, true>(F.lds + RING_OFF, g, S, E);
        if (BOTH(1) && rep_ == REPS(1) - 1) GRID_BAR();
    }
    if (IN(2)) _Pragma("nounroll") for (int rep_ = 0; rep_ < REPS(2); ++rep_) {
        PH_BEGIN();
        int kq_ = 384; asm volatile("" : "+s"(kq_));
        pg8::Gemm g{CQKV, Wqkv_t, M_TOK, 1792, kq_}; pg8::SplitOrder S; S.init(M_TOK, 1792, F.G, bxv);
        pg8::EpiQKV E{QA, KN, VA, SSQ_Q, SSQ_KV, ROPE, 0.10206207261596575f * 1.4426950408889634f};
        pg8::gemm_phase<pg8::EpiQKV, pg8::SplitOrder, true, true>(F.lds + RING_OFF, g, S, E);
        if (BOTH(2) && rep_ == REPS(2) - 1) GRID_BAR();
    }
    if (IN(3)) _Pragma("nounroll") for (int rep_ = 0; rep_ < REPS(3); ++rep_) {
        PH_BEGIN();
        const float* lam_q1 = INP(7); const float* lam_k1 = INP(8); const float* lam_q2 = INP(9); const float* lam_k2 = INP(10); const float* g_subln = INP(11); const float* rel_bias = INP(12);
        char* shm = (char*)lds + RING_OFF;
#ifndef ATT_ONLY
#define ATT_ONLY 3
#endif
        if (ATT_ONLY & 1) { const att::MlaT T{QA, KN, KR, VA, MIX}; const int bb = F.vcu >> 5, v = F.vcu & 31;
          for (int i = 0; i < 4; ++i) { const int qb = (i & 1) ? 15 - (v & 15) : (v & 15); att::mla_unit(bb, 2 * i + (v >> 4), qb, T, shm); } }
        if (ATT_ONLY & 2) { float lam;
          { const float a = wave_sum(lam_q1[att::otid() & 63] * lam_k1[att::otid() & 63]), b2 = wave_sum(lam_q2[att::otid() & 63] * lam_k2[att::otid() & 63]); lam = __expf(a) - __expf(b2) + 0.2f; }
          const att::DiffT T{DQ, DK, DVb, MIX, OB, rel_bias, g_subln, lam}; const int bb = F.vcu >> 5, v = F.vcu & 31;
          for (int i = 0; i < 2; ++i) { const int qb = (i & 1) ? 15 - (v & 15) : (v & 15); att::diff_unit(bb, 2 * i + (v >> 4), qb, T, shm); } }
        if (BOTH(3) && rep_ == REPS(3) - 1) GRID_BAR();
    }
    if (IN(4)) _Pragma("nounroll") for (int rep_ = 0; rep_ < REPS(4); ++rep_) {
        PH_BEGIN();
        pg8::Gemm g{MIX, Wo_t, M_TOK, D_MODEL, D_MODEL}; pg8::StaticOrder S; S.init(M_TOK, D_MODEL, F.G, bxv);
        pg8::EpiOutProj E{XN, X1B, SSQ_X1};
        pg8::gemm_phase<pg8::EpiOutProj, pg8::StaticOrder, true, true>(F.lds + RING_OFF, g, S, E);
        if (BOTH(4) && rep_ == REPS(4) - 1) GRID_BAR();
    }
    if (IN(5)) _Pragma("nounroll") for (int rep_ = 0; rep_ < REPS(5); ++rep_) {
        PH_BEGIN();
        pg8::Gemm g{X1B, Wgu_t, M_TOK, 2 * FFN_H, D_MODEL}; pg8::StaticOrder S; S.init(M_TOK, 2 * FFN_H, F.G, bxv);
        const pg8::HMap hm{ws, WS_XN, WS_MIX, WS_DQ, WS_DK, WS_DV}; pg8::EpiGateUp E{hm, SSQ_X1};
        pg8::gemm_phase<pg8::EpiGateUp, pg8::StaticOrder, true, true>(F.lds + RING_OFF, g, S, E);
        if (BOTH(5) && rep_ == REPS(5) - 1) GRID_BAR();
    }
    if (IN(6)) _Pragma("nounroll") for (int rep_ = 0; rep_ < REPS(6); ++rep_) {
        PH_BEGIN(); float* out = OUTP(); const float* g_final = INP(18);
        pg8::Gemm g{HB, Wd_t, M_TOK, D_MODEL, FFN_H}; pg8::PanelOrder S; S.init(M_TOK, D_MODEL, F.G, bxv); S.hm = pg8::HMap{ws, WS_XN, WS_MIX, WS_DQ, WS_DK, WS_DV};
        pg8::EpiDownNorm E{X1B, out, g_final, (unsigned*)(ws + WS_XCH), (unsigned*)(F.ctl + CW_SEAM), F.lds + XL_OFF};
        pg8::gemm_phase<pg8::EpiDownNorm, pg8::PanelOrder, true, true>(F.lds + RING_OFF, g, S, E);
    }
#undef IN
#undef BOTH
#undef GRID_BAR
}

#ifndef MK_N_LAUNCHES
#define MK_N_LAUNCHES 1
#endif
extern "C" void kernel_launch(void* const* d_in, const int* in_sizes, int n_in, void* d_out, int out_size, void* d_ws, size_t ws_size, hipStream_t stream) {
    static int grid = 0;
    if (grid == 0) {
        if (n_in != 19 || in_sizes[0] != M_TOK * D_MODEL || out_size != M_TOK * D_MODEL || ws_size < WS_END) { fprintf(stderr, "kernel_launch: unexpected shapes (n_in %d, in0 %d, out %d, ws %zu)\n", n_in, n_in > 0 ? in_sizes[0] : -1, out_size, ws_size); grid = -1; return; }
        int dev = 0, cus = 0, per_cu = 0;
        if (hipGetDevice(&dev) != hipSuccess || hipDeviceGetAttribute(&cus, hipDeviceAttributeMultiprocessorCount, dev) != hipSuccess) { grid = -1; return; }
        if (hipFuncSetAttribute((const void*)hyb_fwd, hipFuncAttributeMaxDynamicSharedMemorySize, LDS_BYTES) != hipSuccess) { fprintf(stderr, "kernel_launch: hipFuncSetAttribute failed\n"); grid = -1; return; }
        if (hipOccupancyMaxActiveBlocksPerMultiprocessor(&per_cu, (const void*)hyb_fwd, NWAVES * 64, LDS_BYTES) != hipSuccess || per_cu < 1) fprintf(stderr, "kernel_launch: occupancy query reports %d\n", per_cu);
        (void)hipGetLastError();
        grid = cus;
        if (grid != 256) fprintf(stderr, "kernel_launch: %d CUs (built for 256)\n", grid);
    }
    if (grid < 0) return;
    if (hipMemsetAsync((char*)d_ws + WS_CTL, 0, CTL_ZERO_BYTES, stream) != hipSuccess) return;
    Args a{};
    for (int i = 0; i < 19; ++i) a.in[i] = (const float*)d_in[i];
    a.out = (float*)d_out; a.ws = (unsigned char*)d_ws;
    if (MK_N_LAUNCHES == 1) { a.ph_lo = 0; a.ph_hi = 7; hipLaunchKernelGGL(hyb_fwd, dim3(grid), dim3(NWAVES * 64), LDS_BYTES, stream, a); }
    else { for (int p = 0; p < 7; ++p) { a.ph_lo = p; a.ph_hi = p + 1; hipLaunchKernelGGL(hyb_fwd, dim3(grid), dim3(NWAVES * 64), LDS_BYTES, stream, a); } }
}
```

```cpp
#include <hip/hip_runtime.h>
#include <cstdio>
#include <cstdint>
namespace pg8 {
#define PG8_LAS __attribute__((address_space(3)))
typedef unsigned short bf16_t;
typedef short bf16x8 __attribute__((ext_vector_type(8)));
typedef float f32x4 __attribute__((ext_vector_type(4)));
typedef unsigned u32x4 __attribute__((ext_vector_type(4)));
constexpr int BM = 256, BK = 64, HALF = 128, HTB = HALF * BK * 2  , STAGE_BYTES = 8 * HTB, NXCD = 8, WGM = 8;

__host__ __device__ __forceinline__ int lds_byte(int r, int c) { const int st = (r >> 4) * 2 + (c >> 5), rr = r & 15, cc = c & 31, ob = rr * 64 + cc * 2; return st * 1024 + (ob ^ (((ob >> 9) & 1) << 5)); }
__host__ __device__ __forceinline__ void stage_rc(int b, int& R, int& C) { const int st = b / 1024, sb = b % 1024, swz = sb ^ (((sb >> 9) & 1) << 5); R = (st >> 1) * 16 + swz / 64; C = (st & 1) * 32 + (swz % 64) / 2; }
__host__ __device__ __forceinline__ int perm32(int rho) { const int n = rho >> 4, i = rho & 15; return 8 * (i >> 2) + 4 * n + (i & 3); }

struct Unit { int pm, pn; int kofs, nt; };
struct Gemm { const bf16_t* A; const bf16_t* Bt; int M, N, K; };

struct StaticOrder {
    static constexpr bool KSPLIT = false, APANEL = false;
    int nM, nN, nwg, G, c;
    __host__ __device__ void init(int M, int N, int G_, int c_) { nM = M / BM; nN = N / BM; nwg = nM * nN; G = G_; c = c_; }
    __host__ __device__ bool next(int i, Unit& u) const {
        const long L = (long)i * G + c; if (L >= nwg) return false;
        int wgid = (int)L; { const int q = nwg / NXCD, r = nwg % NXCD, xcd = wgid % NXCD, off = wgid / NXCD; wgid = (xcd < r ? xcd * (q + 1) : r * (q + 1) + (xcd - r) * q) + off; }
        const int nig = WGM * nN, gid = wgid / nig, fm = gid * WGM, gsz = (nM - fm) < WGM ? (nM - fm) : WGM;
        u.pm = fm + ((wgid % nig) % gsz); u.pn = (wgid % nig) / gsz; return true;
    }
    __device__ __forceinline__ void a_ready(const Unit&) const {}
    __device__ __forceinline__ void done(const Unit&) const {}
};

typedef float f32x2p __attribute__((ext_vector_type(2))); typedef __bf16 bf16x2p __attribute__((ext_vector_type(2)));
__device__ __forceinline__ unsigned cvt_pk_bf16(float lo, float hi) { f32x2p v = {lo, hi}; bf16x2p b = __builtin_convertvector(v, bf16x2p); return __builtin_bit_cast(unsigned, b); }
typedef float f32x2 __attribute__((ext_vector_type(2)));
__device__ __forceinline__ u32x4 pack8(const f32x4 a, const f32x4 b) { u32x4 w; w.x = cvt_pk_bf16(a[0], a[1]); w.y = cvt_pk_bf16(a[2], a[3]); w.z = cvt_pk_bf16(b[0], b[1]); w.w = cvt_pk_bf16(b[2], b[3]); return w; }
__device__ __forceinline__ float sq8(const f32x4 a, const f32x4 b) { return ((a[0] * a[0] + a[1] * a[1]) + (a[2] * a[2] + a[3] * a[3])) + ((b[0] * b[0] + b[1] * b[1]) + (b[2] * b[2] + b[3] * b[3])); }
__device__ __forceinline__ float fq_sum(float s) {
    s += __int_as_float(__builtin_amdgcn_ds_swizzle(__float_as_int(s), (16 << 10) | 0x1f));
    auto rr = __builtin_amdgcn_permlane32_swap(__float_as_uint(s), __float_as_uint(s), false, false); return __uint_as_float(rr[0]) + __uint_as_float(rr[1]); }
__device__ __forceinline__ void rope8(f32x4& v0, f32x4& v1, const f32x4 cs0, const f32x4 cs1) {
    const float a0 = v0[0] * cs0[0] - v0[1] * cs0[1], b0 = v0[1] * cs0[0] + v0[0] * cs0[1];
    const float a1 = v0[2] * cs0[2] - v0[3] * cs0[3], b1 = v0[3] * cs0[2] + v0[2] * cs0[3];
    const float a2 = v1[0] * cs1[0] - v1[1] * cs1[1], b2 = v1[1] * cs1[0] + v1[0] * cs1[1];
    const float a3 = v1[2] * cs1[2] - v1[3] * cs1[3], b3 = v1[3] * cs1[2] + v1[2] * cs1[3];
    v0 = (f32x4){a0, b0, a1, b1}; v1 = (f32x4){a2, b2, a3, b3};
}
constexpr int SEQ_LEN = 4096;
constexpr float RMS_EPS = 1e-6f;

__device__ __forceinline__ u32x4 tr16x4(const u32x4 w, const int bidx) { u32x4 r; r.x = __builtin_amdgcn_ds_bpermute(bidx, w.x); r.y = __builtin_amdgcn_ds_bpermute(bidx, w.y); r.z = __builtin_amdgcn_ds_bpermute(bidx, w.z); r.w = __builtin_amdgcn_ds_bpermute(bidx, w.w); return r; }
#define EPI_LANE_T() const int bidx = (((t2_ & 3) * 16) + ((t2_ >> 2) & 15)) * 4, fr2 = (t2_ >> 2) & 15, fq2 = t2_ & 3
#define EPI_LANE() { int t_ = threadIdx.x; asm volatile("" : "+v"(t_)); fr = t_ & 15; fq = (t_ >> 4) & 3; }
struct EpiInProj {
    static constexpr bool PERM = true, AFTER_DRAIN = false;
    bf16_t *CQKV, *KR, *DQ, *DK, *DV; float *SSQ_Q, *SSQ_KV; const float* rope; const float* rstdx; float c2d;
    __device__ __forceinline__ void operator()(f32x4 (&acc)[2][2][4][2], const Unit& u, int wr, int wc, int fr, int fq) const {
        EPI_LANE(); int t2_ = threadIdx.x; asm volatile("" : "+v"(t2_)); EPI_LANE_T(); const int row2 = u.pm * BM + wr * 64 + fr2, cw2 = wc * 32 + 8 * fq2;
        const int row0 = u.pm * BM + wr * 64 + fr, cw = wc * 32 + 8 * fq;
        { float rx[2][4];
#pragma unroll
          for (int ai = 0; ai < 2; ++ai)
#pragma unroll
              for (int m = 0; m < 4; ++m) rx[ai][m] = rstdx[row0 + ai * HALF + m * 16];
#pragma unroll
          for (int ai = 0; ai < 2; ++ai)
#pragma unroll
              for (int m = 0; m < 4; ++m)
#pragma unroll
                  for (int bj = 0; bj < 2; ++bj) { acc[ai][bj][m][0] *= rx[ai][m]; acc[ai][bj][m][1] *= rx[ai][m]; } }
        if (u.pn == 0) {
#pragma unroll
            for (int ai = 0; ai < 2; ++ai)
#pragma unroll
                for (int m = 0; m < 4; ++m) { const size_t row = (size_t)(row0 + ai * HALF + m * 16); float s = 0.f;
#pragma unroll
                    for (int bj = 0; bj < 2; ++bj) { const f32x4 v0 = acc[ai][bj][m][0], v1 = acc[ai][bj][m][1]; s += sq8(v0, v1); *(u32x4*)(CQKV + (size_t)(row2 + ai * HALF + m * 16) * 384 + bj * HALF + cw2) = tr16x4(pack8(v0, v1), bidx); }
                    s = fq_sum(s); if (fq == 0) SSQ_Q[row * 4 + wc] = s; }
        } else if (u.pn == 1) {
            f32x4 cs[2][4][2];
            if (wc == 0) {
#pragma unroll
                for (int ai = 0; ai < 2; ++ai)
#pragma unroll
                    for (int m = 0; m < 4; ++m) { const float* t = rope + (size_t)((row0 + ai * HALF + m * 16) & (SEQ_LEN - 1)) * 32 + 8 * fq; cs[ai][m][0] = *(const f32x4*)t; cs[ai][m][1] = *(const f32x4*)(t + 4); }
            }
#pragma unroll
            for (int ai = 0; ai < 2; ++ai)
#pragma unroll
                for (int m = 0; m < 4; ++m) { const size_t row = (size_t)(row0 + ai * HALF + m * 16);
                    { const f32x4 v0 = acc[ai][0][m][0], v1 = acc[ai][0][m][1]; float s = sq8(v0, v1); *(u32x4*)(CQKV + (size_t)(row2 + ai * HALF + m * 16) * 384 + 256 + cw2) = tr16x4(pack8(v0, v1), bidx);
                      s = fq_sum(s); if (fq == 0) SSQ_KV[row * 4 + wc] = s; }
                    if (wc == 0) { f32x4 v0 = acc[ai][1][m][0], v1 = acc[ai][1][m][1]; rope8(v0, v1, cs[ai][m][0], cs[ai][m][1]); *(u32x4*)(KR + (size_t)(row2 + ai * HALF + m * 16) * 32 + 8 * fq2) = tr16x4(pack8(v0, v1), bidx); } }
        } else {
            bf16_t* dst = DQ + (size_t)((u.pn - 2) >> 1) * ((size_t)32768 * 512); const int cb2 = ((u.pn - 2) & 1) * 256 + cw2; const float sc = u.pn < 4 ? c2d : 1.f;
#pragma unroll
            for (int ai = 0; ai < 2; ++ai)
#pragma unroll
                for (int m = 0; m < 4; ++m) { const size_t row = (size_t)(row0 + ai * HALF + m * 16);
#pragma unroll
                    for (int bj = 0; bj < 2; ++bj) *(u32x4*)(dst + (size_t)(row2 + ai * HALF + m * 16) * 512 + cb2 + bj * HALF) = tr16x4(pack8(acc[ai][bj][m][0] * sc, acc[ai][bj][m][1] * sc), bidx); }
        }
    }
};
struct EpiQKV {
    static constexpr bool PERM = true, AFTER_DRAIN = false;
    bf16_t *QA, *KN, *VA; const float *SSQ_Q, *SSQ_KV; const float* rope; float c2a;
    __device__ __forceinline__ void rstd4(float (&rs)[4], const float* ssq, int rowb, float inv, float mul) const {
        f32x4 pp[4];
#pragma unroll
        for (int m = 0; m < 4; ++m) pp[m] = *(const f32x4*)(ssq + (size_t)(rowb + m * 16) * 4);
#pragma unroll
        for (int m = 0; m < 4; ++m) rs[m] = __builtin_amdgcn_rsqf(((pp[m][0] + pp[m][1]) + (pp[m][2] + pp[m][3])) * inv + RMS_EPS) * mul;
    }
    __device__ __forceinline__ void rstd8(float (&rs)[2][4], const float* ssq, int rowb, float inv, float mul) const {
        f32x4 pp[2][4];
#pragma unroll
        for (int ai = 0; ai < 2; ++ai)
#pragma unroll
            for (int m = 0; m < 4; ++m) pp[ai][m] = *(const f32x4*)(ssq + (size_t)(rowb + ai * HALF + m * 16) * 4);
#pragma unroll
        for (int ai = 0; ai < 2; ++ai)
#pragma unroll
            for (int m = 0; m < 4; ++m) rs[ai][m] = __builtin_amdgcn_rsqf(((pp[ai][m][0] + pp[ai][m][1]) + (pp[ai][m][2] + pp[ai][m][3])) * inv + RMS_EPS) * mul;
    }
    __device__ __forceinline__ void operator()(const f32x4 (&acc)[2][2][4][2], const Unit& u, int wr, int wc, int fr, int fq) const {
        EPI_LANE(); int t2_ = threadIdx.x; asm volatile("" : "+v"(t2_)); EPI_LANE_T(); const int row2 = u.pm * BM + wr * 64 + fr2, cw2 = wc * 32 + 8 * fq2;
        const int row0 = u.pm * BM + wr * 64 + fr, cw = wc * 32 + 8 * fq;
        if (u.pn < 2) {
            float rs2[2][4]; rstd8(rs2, SSQ_Q, row0, 1.f / 256.f, c2a);
#pragma unroll
            for (int ai = 0; ai < 2; ++ai) { const float (&rs)[4] = rs2[ai];
#pragma unroll
                for (int m = 0; m < 4; ++m) { const size_t row = (size_t)(row0 + ai * HALF + m * 16);
#pragma unroll
                    for (int bj = 0; bj < 2; ++bj) { const int n = u.pn * 256 + bj * HALF + cw2; *(u32x4*)(QA + (size_t)(row2 + ai * HALF + m * 16) * 768 + (n >> 6) * 96 + (n & 63)) = tr16x4(pack8(acc[ai][bj][m][0] * rs[m], acc[ai][bj][m][1] * rs[m]), bidx); } }
                asm volatile("" ::: "memory"); }
        } else if (u.pn == 2) {
            float rs2[2][4]; rstd8(rs2, SSQ_Q, row0, 1.f / 256.f, c2a);
            f32x4 cs[2][2][2];
#define QKV_CS_LOAD(B_, AI_, MP_) _Pragma("unroll") for (int mm = 0; mm < 2; ++mm) { const float* t = rope + (size_t)((row0 + (AI_) * HALF + (2 * (MP_) + mm) * 16) & (SEQ_LEN - 1)) * 32 + 8 * fq; cs[B_][mm][0] = *(const f32x4*)t; cs[B_][mm][1] = *(const f32x4*)(t + 4); }
            QKV_CS_LOAD(0, 0, 0);
#pragma unroll
            for (int ib = 0; ib < 4; ++ib) { const int ai = ib >> 1, mp = ib & 1, bb = ib & 1;
                if (ib + 1 < 4) { QKV_CS_LOAD((ib + 1) & 1, (ib + 1) >> 1, (ib + 1) & 1); }
#pragma unroll
                for (int mm = 0; mm < 2; ++mm) { const int m = 2 * mp + mm;
#pragma unroll
                    for (int bj = 0; bj < 2; ++bj) { f32x4 v0 = acc[ai][bj][m][0] * rs2[ai][m], v1 = acc[ai][bj][m][1] * rs2[ai][m]; rope8(v0, v1, cs[bb][mm][0], cs[bb][mm][1]); *(u32x4*)(QA + (size_t)(row2 + ai * HALF + m * 16) * 768 + (4 * bj + wc) * 96 + 64 + 8 * fq2) = tr16x4(pack8(v0, v1), bidx); } } }
#undef QKV_CS_LOAD
        } else {
            bf16_t* dst = KN + (size_t)((u.pn - 3) >> 1) * ((size_t)32768 * 512); const int cb2 = ((u.pn - 3) & 1) * 256 + cw2;
            float rs2[2][4]; rstd8(rs2, SSQ_KV, row0, 1.f / 128.f, 1.f);
#pragma unroll
            for (int ai = 0; ai < 2; ++ai) { const float (&rs)[4] = rs2[ai];
#pragma unroll
                for (int m = 0; m < 4; ++m) { const size_t row = (size_t)(row0 + ai * HALF + m * 16);
#pragma unroll
                    for (int bj = 0; bj < 2; ++bj) *(u32x4*)(dst + (size_t)(row2 + ai * HALF + m * 16) * 512 + cb2 + bj * HALF) = tr16x4(pack8(acc[ai][bj][m][0] * rs[m], acc[ai][bj][m][1] * rs[m]), bidx); }
                asm volatile("" ::: "memory"); }
        }
    }
};
struct EpiOutProj {
    static constexpr bool PERM = true, AFTER_DRAIN = false;
    const bf16_t* XB; bf16_t* X1B; float* SSQ;
    __device__ __forceinline__ void operator()(const f32x4 (&acc)[2][2][4][2], const Unit& u, int wr, int wc, int fr, int fq) const {
        EPI_LANE();
        int t2_ = threadIdx.x; asm volatile("" : "+v"(t2_)); EPI_LANE_T();
        const int row0 = u.pm * BM + wr * 64 + fr, cw = u.pn * BM + wc * 32 + 8 * fq;
        bf16_t* const st = X1B + (size_t)(u.pm * BM + wr * 64 + fr2) * 1024 + u.pn * BM + wc * 32 + 8 * fq2;
        u32x4 xb[2][4][2];
#pragma unroll
        for (int ai = 0; ai < 2; ++ai)
#pragma unroll
            for (int m = 0; m < 4; ++m)
#pragma unroll
                for (int bj = 0; bj < 2; ++bj) xb[ai][m][bj] = __builtin_nontemporal_load((const u32x4*)(XB + (size_t)(row0 + ai * HALF + m * 16) * 1024 + cw + bj * HALF));
#pragma unroll
        for (int ai = 0; ai < 2; ++ai)
#pragma unroll
            for (int m = 0; m < 4; ++m) { const size_t row = (size_t)(row0 + ai * HALF + m * 16); float s = 0.f;
#pragma unroll
                for (int bj = 0; bj < 2; ++bj) { const u32x4 w = xb[ai][m][bj];
                    const f32x4 v0 = acc[ai][bj][m][0] + (f32x4){__uint_as_float(w.x << 16), __uint_as_float(w.x & 0xffff0000u), __uint_as_float(w.y << 16), __uint_as_float(w.y & 0xffff0000u)};
                    const f32x4 v1 = acc[ai][bj][m][1] + (f32x4){__uint_as_float(w.z << 16), __uint_as_float(w.z & 0xffff0000u), __uint_as_float(w.w << 16), __uint_as_float(w.w & 0xffff0000u)};
                    s += sq8(v0, v1); *(u32x4*)(st + (size_t)(ai * HALF + m * 16) * 1024 + bj * HALF) = tr16x4(pack8(v0, v1), bidx); }
                s = fq_sum(s); if (fq == 0) SSQ[row * 16 + u.pn * 4 + wc] = s; }
    }
};
struct HMap { unsigned char* ws; size_t xn, mix, dq, dk, dv;
    __host__ __device__ __forceinline__ bf16_t* panel(int pm) const { const int b = pm >> 4, p = pm & 15; constexpr size_t PB = (size_t)256 * 2816 * 2, MB = (size_t)1 << 20;
        size_t off;
        if (p < 5) off = xn + (size_t)b * 8 * MB + (size_t)p * PB;
        else if (p < 10) off = mix + (size_t)b * 8 * MB + (size_t)(p - 5) * PB;
        else if (p < 12) off = dq + (size_t)b * 4 * MB + (size_t)(p - 10) * PB;
        else if (p < 14) off = dk + (size_t)b * 4 * MB + (size_t)(p - 12) * PB;
        else off = dv + (size_t)b * 4 * MB + (size_t)(p - 14) * PB;
        return (bf16_t*)(ws + off); } };
struct PanelOrder {
    static constexpr bool KSPLIT = false, APANEL = true;
    StaticOrder so; HMap hm;
    __host__ __device__ void init(int M, int N, int G_, int c_) { so.init(M, N, G_, c_); }
    __host__ __device__ bool next(int i, Unit& u) const { return so.next(i, u); }
    __device__ __forceinline__ const char* a_panel(int pm) const { return (const char*)hm.panel(pm); }
    __device__ __forceinline__ void a_ready(const Unit&) const {}
    __device__ __forceinline__ void done(const Unit&) const {}
};
struct EpiGateUp {
    static constexpr bool PERM = true, AFTER_DRAIN = false;
    HMap hm; const float* SSQ;
    __device__ __forceinline__ void operator()(const f32x4 (&acc)[2][2][4][2], const Unit& u, int wr, int wc, int fr, int fq) const {
        EPI_LANE(); int t2_ = threadIdx.x; asm volatile("" : "+v"(t2_)); EPI_LANE_T(); const int row2 = u.pm * BM + wr * 64 + fr2, cw2 = wc * 32 + 8 * fq2;
        const int row0 = u.pm * BM + wr * 64 + fr, cw = u.pn * HALF + wc * 32 + 8 * fq;
        bf16_t* const Hp = hm.panel(u.pm) + (size_t)(wr * 64 + fr2) * 2816 + u.pn * HALF + cw2;
        float rs[2][4];
        { f32x4 pp[2][4];
#pragma unroll
          for (int ai = 0; ai < 2; ++ai)
#pragma unroll
              for (int m = 0; m < 4; ++m) pp[ai][m] = *(const f32x4*)(SSQ + (size_t)(row0 + ai * HALF + m * 16) * 16 + 4 * fq);
#pragma unroll
          for (int ai = 0; ai < 2; ++ai)
#pragma unroll
              for (int m = 0; m < 4; ++m) rs[ai][m] = __builtin_amdgcn_rsqf(fq_sum((pp[ai][m][0] + pp[ai][m][1]) + (pp[ai][m][2] + pp[ai][m][3])) * (1.f / 1024.f) + RMS_EPS); }
#pragma unroll
        for (int ai = 0; ai < 2; ++ai)
#pragma unroll
            for (int m = 0; m < 4; ++m) { const size_t row = (size_t)(row0 + ai * HALF + m * 16); const float r = rs[ai][m];
                f32x4 hv[2];
#pragma unroll
                for (int n = 0; n < 2; ++n) { const f32x4 g = acc[ai][0][m][n] * r, up = acc[ai][1][m][n] * r;
#pragma unroll
                    for (int j = 0; j < 4; ++j) { const float e = __builtin_amdgcn_exp2f(g[j] * -1.4426950408889634f); hv[n][j] = g[j] * __builtin_amdgcn_rcpf(1.0f + e) * up[j]; } }
                *(u32x4*)(Hp + (size_t)(ai * HALF + m * 16) * 2816) = tr16x4(pack8(hv[0], hv[1]), bidx); }
    }
};
struct EpiDownNorm {
    static constexpr bool PERM = true, AFTER_DRAIN = false;
    const bf16_t* X1B; float* OUT; const float* G; unsigned* xbuf; unsigned* cnt; PG8_LAS unsigned char* xl;
    __device__ __forceinline__ void operator()(f32x4 (&acc)[2][2][4][2], const Unit& u, int wr, int wc, int fr, int fq) const {
        int t_ = threadIdx.x; asm volatile("" : "+v"(t_)); fr = t_ & 15; fq = (t_ >> 4) & 3; const int lane = t_ & 63, wid = wr * 4 + wc; const int t2_ = t_; EPI_LANE_T();
        PG8_LAS float* P = (PG8_LAS float*)xl; PG8_LAS float* S = (PG8_LAS float*)(xl + 4096); PG8_LAS unsigned* flag = (PG8_LAS unsigned*)(xl + 5120);
        const int row0 = u.pm * BM + wr * 64 + fr, cw = u.pn * BM + wc * 32 + 8 * fq;
        f32x4 gv[2][2];
#pragma unroll
        for (int bj = 0; bj < 2; ++bj) { gv[bj][0] = *(const f32x4*)(G + cw + bj * HALF); gv[bj][1] = *(const f32x4*)(G + cw + bj * HALF + 4); }
        u32x4 xb[2][4][2];
#pragma unroll
        for (int ai = 0; ai < 2; ++ai)
#pragma unroll
            for (int m = 0; m < 4; ++m)
#pragma unroll
                for (int bj = 0; bj < 2; ++bj) xb[ai][m][bj] = __builtin_nontemporal_load((const u32x4*)(X1B + (size_t)(row0 + ai * HALF + m * 16) * 1024 + cw + bj * HALF));
#pragma unroll
        for (int ai = 0; ai < 2; ++ai) {
#pragma unroll
            for (int m = 0; m < 4; ++m) { float s = 0.f;
#pragma unroll
                for (int bj = 0; bj < 2; ++bj) { const u32x4 w = xb[ai][m][bj];
                    const f32x4 a0 = (f32x4){__uint_as_float(w.x << 16), __uint_as_float(w.x & 0xffff0000u), __uint_as_float(w.y << 16), __uint_as_float(w.y & 0xffff0000u)};
                    const f32x4 a1 = (f32x4){__uint_as_float(w.z << 16), __uint_as_float(w.z & 0xffff0000u), __uint_as_float(w.w << 16), __uint_as_float(w.w & 0xffff0000u)};
                    acc[ai][bj][m][0] += a0; acc[ai][bj][m][1] += a1; s += sq8(acc[ai][bj][m][0], acc[ai][bj][m][1]); }
                s = fq_sum(s); if (fq == 0) P[(ai * HALF + wr * 64 + m * 16 + fr) * 4 + wc] = s; }
        }
        asm volatile("s_waitcnt lgkmcnt(0)" ::: "memory"); __builtin_amdgcn_s_barrier(); asm volatile("" ::: "memory");
        const int prow = wid * 32 + (lane & 31);
        if (lane < 32) { const float tot = (P[prow * 4 + 0] + P[prow * 4 + 1]) + (P[prow * 4 + 2] + P[prow * 4 + 3]);
            __hip_atomic_store(xbuf + ((size_t)(u.pm * BM + prow) * 4 + u.pn), __float_as_uint(tot), __ATOMIC_RELAXED, __HIP_MEMORY_SCOPE_AGENT); }
        asm volatile("s_waitcnt vmcnt(0)" ::: "memory");
        if (lane == 0) __hip_atomic_fetch_add(cnt + 64 * u.pm, 1u, __ATOMIC_RELAXED, __HIP_MEMORY_SCOPE_AGENT);
        if (wid == 0) { unsigned sp = 0;
            while ((unsigned)__builtin_amdgcn_readfirstlane(__hip_atomic_load(cnt + 64 * u.pm, __ATOMIC_RELAXED, __HIP_MEMORY_SCOPE_AGENT)) < 32u) { __builtin_amdgcn_s_sleep(2); if (++sp > (1u << 22)) break; }
            __builtin_amdgcn_fence(__ATOMIC_ACQUIRE, "agent");
            if (lane == 0) flag[0] = sp; }
        asm volatile("s_waitcnt vmcnt(0) lgkmcnt(0)" ::: "memory"); __builtin_amdgcn_s_barrier(); asm volatile("" ::: "memory");
        if (lane < 32) { const unsigned* slot = xbuf + (size_t)(u.pm * BM + prow) * 4; float q = 0.f;
#pragma unroll
            for (int t = 0; t < 4; ++t) q += __uint_as_float(__hip_atomic_load(slot + t, __ATOMIC_RELAXED, __HIP_MEMORY_SCOPE_AGENT));
            S[prow] = __builtin_amdgcn_rsqf(q * (1.f / 1024.f) + RMS_EPS); }
        asm volatile("s_waitcnt lgkmcnt(0)" ::: "memory"); __builtin_amdgcn_s_barrier(); asm volatile("" ::: "memory");
#pragma unroll
        for (int ai = 0; ai < 2; ++ai)
#pragma unroll
            for (int m = 0; m < 4; ++m) { const int r = ai * HALF + wr * 64 + m * 16 + fr; const float rs = S[r]; const size_t off = (size_t)(u.pm * BM + r) * 1024 + cw;
#pragma unroll
                for (int bj = 0; bj < 2; ++bj) { const f32x4 o0 = acc[ai][bj][m][0] * rs * gv[bj][0], o1 = acc[ai][bj][m][1] * rs * gv[bj][1]; float* const op = OUT + (size_t)(u.pm * BM + ai * HALF + wr * 64 + m * 16 + fr2) * 1024 + u.pn * BM + wc * 32 + 8 * fq2 + bj * HALF;
                    *(u32x4*)op = tr16x4(__builtin_bit_cast(u32x4, o0), bidx); *(u32x4*)(op + 4) = tr16x4(__builtin_bit_cast(u32x4, o1), bidx); } }
    }
};

struct SplitOrder {
    static constexpr bool KSPLIT = true, APANEL = false;
    StaticOrder so;
    __host__ __device__ void init(int M, int N, int G_, int c_) { so.init(M, N, G_, c_); }
    __host__ __device__ bool next(int i, Unit& u) const { if (!so.next(i, u)) return false; if (u.pn < 3) { u.kofs = 0; u.nt = 4; } else { u.kofs = 256 * 2; u.nt = 2; } return true; }
    __device__ __forceinline__ void a_ready(const Unit&) const {}
    __device__ __forceinline__ void done(const Unit&) const {}
};
template <class Epi, class Sched, bool ALIGN_EPI = false, bool SP2 = false>
__device__ __forceinline__ void gemm_phase(PG8_LAS unsigned char* lds, const Gemm g, const Sched& S, const Epi& E) {
    const int tid = threadIdx.x, wid = __builtin_amdgcn_readfirstlane(tid >> 6), lane = tid & 63, wr = wid >> 2, wc = wid & 3, fr = lane & 15, fq = lane >> 4;
    const int K = g.K; int nt = K / BK;
    unsigned voffA[2], voffB[2];
#pragma unroll
    for (int i = 0; i < 2; ++i) { int R, C; stage_rc(tid * 16 + i * 8192, R, C); const int Rb = Epi::PERM ? ((R & ~31) + perm32(R & 31)) : R;
        voffA[i] = (unsigned)(R * K + C) * 2u; voffB[i] = (unsigned)(Rb * K + C) * 2u; }
    const size_t kstep = (size_t)(BK * 2);
    const size_t hstep = (size_t)HALF * K * 2;
    const size_t tstep = 2 * hstep;
    const unsigned ldsw = (unsigned)wid * 1024u;
    const int aoff = lds_byte(wr * 64 + fr, fq * 8), boff = lds_byte(wc * 32 + fr, fq * 8);
#define PG8_SA(b, h) (((b) * 2 + (h)) * HTB)
#define PG8_SB(b, h) ((4 + (b) * 2 + (h)) * HTB)
#define PG8_STAGE(bufoff, gbase, voff) do { _Pragma("unroll") for (int _i = 0; _i < 2; ++_i) \
        __builtin_amdgcn_global_load_lds((const unsigned*)((const char*)(gbase) + (voff)[_i]), (PG8_LAS unsigned*)(lds + (bufoff) + ldsw + _i * 8192), 16, 0, 0); } while (0)
#define PG8_LDA(dst, b, h) do { _Pragma("unroll") for (int m = 0; m < 4; ++m) _Pragma("unroll") for (int k = 0; k < 2; ++k) dst[m][k] = *(const PG8_LAS bf16x8*)(lds + PG8_SA(b, h) + aoff + m * 2048 + k * 1024); } while (0)
#define PG8_LDB(dst, b, h) do { _Pragma("unroll") for (int n = 0; n < 2; ++n) _Pragma("unroll") for (int k = 0; k < 2; ++k) dst[n][k] = *(const PG8_LAS bf16x8*)(lds + PG8_SB(b, h) + boff + n * 2048 + k * 1024); } while (0)
#define PG8_MMA(ai, bj, At, Bt) do { __builtin_amdgcn_s_setprio(1); _Pragma("unroll") for (int m = 0; m < 4; ++m) _Pragma("unroll") for (int n = 0; n < 2; ++n) _Pragma("unroll") for (int k = 0; k < 2; ++k) \
        acc[ai][bj][m][n] = __builtin_amdgcn_mfma_f32_16x16x32_bf16(Bt[n][k], At[m][k], acc[ai][bj][m][n], 0, 0, 0); __builtin_amdgcn_s_setprio(0); } while (0)
#define PG8_WAIT_V(n) asm volatile("s_waitcnt vmcnt(" #n ")" ::: "memory")
#define PG8_WAIT_L(n) asm volatile("s_waitcnt lgkmcnt(" #n ")" ::: "memory")
#define PG8_BAR __builtin_amdgcn_s_barrier()
#define PG8_SCHED __builtin_amdgcn_sched_barrier(0)
    Unit cur, nxt; int ui = 0;
    if (!S.next(0, cur)) return;
    f32x4 acc[2][2][4][2];
#pragma unroll
    for (int a = 0; a < 2; ++a)
#pragma unroll
        for (int b = 0; b < 2; ++b)
#pragma unroll
            for (int m = 0; m < 4; ++m)
#pragma unroll
                for (int n = 0; n < 2; ++n) acc[a][b][m][n] = (f32x4){0.f, 0.f, 0.f, 0.f};
    bf16x8 At[4][2], B0[2][2], B1[2][2];
    const char* cA; if constexpr (Sched::APANEL) cA = S.a_panel(cur.pm); else cA = (const char*)g.A + (size_t)cur.pm * tstep + (Sched::KSPLIT ? cur.kofs : 0);
    const char* cB = (const char*)g.Bt + (size_t)cur.pn * tstep + (Sched::KSPLIT ? cur.kofs : 0);
    S.a_ready(cur);
    if constexpr (SP2) {
        PG8_STAGE(PG8_SB(0, 0), cB, voffB); PG8_STAGE(PG8_SB(0, 1), cB + hstep, voffB); PG8_STAGE(PG8_SA(0, 0), cA, voffA); PG8_STAGE(PG8_SA(0, 1), cA + hstep, voffA);
        if (wr == 1) PG8_BAR;
        PG8_WAIT_V(2); PG8_BAR;
        PG8_STAGE(PG8_SB(1, 0), cB + kstep, voffB); PG8_STAGE(PG8_SA(1, 0), cA + kstep, voffA); PG8_STAGE(PG8_SB(1, 1), cB + hstep + kstep, voffB);
        PG8_WAIT_V(6); PG8_BAR;
    } else {
        PG8_STAGE(PG8_SB(0, 0), cB, voffB); PG8_STAGE(PG8_SA(0, 0), cA, voffA); PG8_STAGE(PG8_SB(0, 1), cB + hstep, voffB); PG8_STAGE(PG8_SA(0, 1), cA + hstep, voffA);
        if (wr == 1) PG8_BAR;
        PG8_WAIT_V(4); PG8_BAR;
        PG8_STAGE(PG8_SB(1, 0), cB + kstep, voffB); PG8_STAGE(PG8_SA(1, 0), cA + kstep, voffA); PG8_STAGE(PG8_SB(1, 1), cB + hstep + kstep, voffB);
        PG8_WAIT_V(6); PG8_BAR;
    }
    for (;;) {
        const bool has_next = S.next(ui + 1, nxt);
        const char* nA; if constexpr (Sched::APANEL) nA = has_next ? S.a_panel(nxt.pm) : cA; else nA = has_next ? (const char*)g.A + (size_t)nxt.pm * tstep + (Sched::KSPLIT ? nxt.kofs : 0) : cA;
        const char* nB = has_next ? (const char*)g.Bt + (size_t)nxt.pn * tstep + (Sched::KSPLIT ? nxt.kofs : 0) : cB;
        if constexpr (Sched::KSPLIT) nt = cur.nt;
        for (int t = 0; t < nt; t += 2) {
            const bool last = (t == nt - 2);
            const char* a1 = cA + (size_t)(t + 1) * kstep;
            const char* a2 = last ? nA : cA + (size_t)(t + 2) * kstep; const char* b2 = last ? nB : cB + (size_t)(t + 2) * kstep;
            const char* a3 = a2 + kstep; const char* b3 = b2 + kstep;
            if (last && has_next) S.a_ready(nxt);
            if constexpr (SP2) {
            PG8_LDB(B0, 0, 0); PG8_LDB(B1, 0, 1); PG8_SCHED; PG8_LDA(At, 0, 0); PG8_STAGE(PG8_SA(1, 1), a1 + hstep, voffA);
            PG8_WAIT_V(8); PG8_WAIT_L(0); PG8_BAR; PG8_MMA(0, 0, At, B0); PG8_MMA(0, 1, At, B1); PG8_BAR; PG8_SCHED;
            PG8_LDA(At, 0, 1); PG8_STAGE(PG8_SB(0, 0), b2, voffB); PG8_STAGE(PG8_SB(0, 1), b2 + hstep, voffB); PG8_STAGE(PG8_SA(0, 0), a2, voffA);
            PG8_WAIT_V(8); PG8_WAIT_L(0); PG8_BAR; PG8_MMA(1, 0, At, B0); PG8_MMA(1, 1, At, B1); PG8_BAR; PG8_SCHED;
            PG8_LDB(B0, 1, 0); PG8_LDB(B1, 1, 1); PG8_SCHED; PG8_LDA(At, 1, 0); PG8_STAGE(PG8_SA(0, 1), a2 + hstep, voffA);
            PG8_WAIT_V(8); PG8_WAIT_L(0); PG8_BAR; PG8_MMA(0, 0, At, B0); PG8_MMA(0, 1, At, B1); PG8_BAR; PG8_SCHED;
            PG8_LDA(At, 1, 1); PG8_STAGE(PG8_SB(1, 0), b3, voffB); PG8_STAGE(PG8_SB(1, 1), b3 + hstep, voffB); PG8_STAGE(PG8_SA(1, 0), a3, voffA);
            PG8_WAIT_V(8); PG8_WAIT_L(0); PG8_BAR; PG8_MMA(1, 0, At, B0); PG8_MMA(1, 1, At, B1); PG8_BAR; PG8_SCHED;
            } else {
            PG8_LDB(B0, 0, 0); PG8_SCHED; PG8_LDA(At, 0, 0); PG8_STAGE(PG8_SA(1, 1), a1 + hstep, voffA);
            PG8_WAIT_L(8); PG8_BAR; PG8_WAIT_L(0); PG8_MMA(0, 0, At, B0); PG8_BAR; PG8_SCHED;
            PG8_LDB(B1, 0, 1); PG8_STAGE(PG8_SB(0, 0), b2, voffB);
            PG8_BAR; PG8_WAIT_L(0); PG8_MMA(0, 1, At, B1); PG8_BAR;
            PG8_LDA(At, 0, 1); PG8_STAGE(PG8_SA(0, 0), a2, voffA);
            PG8_BAR; PG8_WAIT_L(0); PG8_MMA(1, 0, At, B0); PG8_BAR; PG8_SCHED;
            PG8_STAGE(PG8_SB(0, 1), b2 + hstep, voffB);
            PG8_WAIT_V(6); PG8_BAR; PG8_MMA(1, 1, At, B1); PG8_BAR;
            PG8_LDB(B0, 1, 0); PG8_SCHED; PG8_LDA(At, 1, 0); PG8_STAGE(PG8_SA(0, 1), a2 + hstep, voffA);
            PG8_WAIT_L(8); PG8_BAR; PG8_WAIT_L(0); PG8_MMA(0, 0, At, B0); PG8_BAR; PG8_SCHED;
            PG8_LDB(B1, 1, 1); PG8_STAGE(PG8_SB(1, 0), b3, voffB);
            PG8_BAR; PG8_WAIT_L(0); PG8_MMA(0, 1, At, B1); PG8_BAR;
            PG8_LDA(At, 1, 1); PG8_STAGE(PG8_SA(1, 0), a3, voffA);
            PG8_BAR; PG8_WAIT_L(0); PG8_MMA(1, 0, At, B0); PG8_BAR; PG8_SCHED;
            PG8_STAGE(PG8_SB(1, 1), b3 + hstep, voffB);
            PG8_WAIT_V(6); PG8_BAR; PG8_MMA(1, 1, At, B1); PG8_BAR;
            }
        }
        if constexpr (ALIGN_EPI) { if (wr == 0) PG8_BAR; }
        if constexpr (!Epi::AFTER_DRAIN) { E(acc, cur, wr, wc, fr, fq); S.done(cur); }
        if (!has_next) break;
#pragma unroll
        for (int a = 0; a < 2; ++a)
#pragma unroll
            for (int b = 0; b < 2; ++b)
#pragma unroll
                for (int m = 0; m < 4; ++m)
#pragma unroll
                    for (int n = 0; n < 2; ++n) acc[a][b][m][n] = (f32x4){0.f, 0.f, 0.f, 0.f};
        cur = nxt; cA = nA; cB = nB; ++ui;
        if constexpr (ALIGN_EPI) { if (wr == 1) PG8_BAR; }
    }
    PG8_WAIT_V(0);
    if constexpr (!ALIGN_EPI) { if (wr == 0) PG8_BAR; }
    PG8_BAR;
    if constexpr (Epi::AFTER_DRAIN) { E.fused(acc, cur, wr, wc, fr, fq, lds, wid, lane); S.done(cur); }
#undef PG8_SA
#undef PG8_SB
#undef PG8_STAGE
#undef PG8_LDA
#undef PG8_LDB
#undef PG8_MMA
#undef PG8_WAIT_V
#undef PG8_WAIT_L
#undef PG8_BAR
#undef PG8_SCHED
}
}
namespace att {
using bf16x8 = __attribute__((ext_vector_type(8))) short;
using s16x4 = __attribute__((ext_vector_type(4))) short;
using f32x16 = __attribute__((ext_vector_type(16))) float;
using u32x4 = __attribute__((ext_vector_type(4))) unsigned;
typedef unsigned short bf16;
constexpr int SEQ = 4096, NW = 8, QB = 256, KVBLK = 64, NSLOT = 3;
#ifndef ATT_THRL
#define ATT_THRL 8
#endif
constexpr int THRL = ATT_THRL;
__device__ __forceinline__ int otid() { int t = threadIdx.x; asm volatile("" : "+v"(t)); return t; }
template <int PAT> __device__ __forceinline__ float swz_xor(float v) { return __int_as_float(__builtin_amdgcn_ds_swizzle(__float_as_int(v), PAT)); }
__device__ __forceinline__ int crow(int r, int hi) { return (r & 3) + 8 * (r >> 2) + 4 * hi; }
#define SBAR() __builtin_amdgcn_sched_barrier(0)
#define PIN(x) asm volatile("" : "+v"(x))
#define WAIT_BAR(N) asm volatile("s_waitcnt vmcnt(" #N ") lgkmcnt(0)\n\ts_barrier" ::: "memory")
#define MFMA32(a, b, c) __builtin_amdgcn_mfma_f32_32x32x16_bf16(a, b, c, 0, 0, 0)
#define EX(v) __builtin_amdgcn_exp2f(v)
#define MX3(a, b, c) __builtin_fmaxf(__builtin_fmaxf((a), (b)), (c))
#define IMX3(a, b, c) imax_(imax_((a), (b)), (c))
__device__ __forceinline__ int imax_(int a, int b) { return a > b ? a : b; }
#define FBITS(x) __float_as_int(x)
__device__ __forceinline__ void glds16(const void* gsrc, unsigned lds_dst) { unsigned keep;
    asm volatile("s_mov_b32 %0, m0\n\ts_mov_b32 m0, %2\n\ts_nop 0\n\tglobal_load_lds_dwordx4 %1, off\n\ts_mov_b32 m0, %0" : "=&s"(keep) : "v"(gsrc), "s"(lds_dst) : "memory"); }
typedef float f32x2_t __attribute__((ext_vector_type(2))); typedef __bf16 bf16x2_t __attribute__((ext_vector_type(2)));
__device__ __forceinline__ unsigned cvtpk_s(float lo, float hi) { f32x2_t v = {lo, hi}; bf16x2_t b = __builtin_convertvector(v, bf16x2_t); return __builtin_bit_cast(unsigned, b); }
typedef __attribute__((address_space(3))) const char* lds_cptr;
typedef short v4i16_t __attribute__((ext_vector_type(4)));
__device__ __forceinline__ s16x4 vtr(lds_cptr p) { return __builtin_bit_cast(s16x4, __builtin_amdgcn_ds_read_tr16_b64_v4i16((__attribute__((address_space(3))) v4i16_t*)p)); }
__device__ __forceinline__ bf16x8 kld(lds_cptr p) { return *(const __attribute__((address_space(3))) bf16x8*)p; }
__device__ __forceinline__ float rowmax(const f32x16& p0, const f32x16& p1) {
    float a = MX3(p0[0], p0[1], p1[0]), b = MX3(p0[2], p0[3], p1[1]); a = MX3(a, p1[2], p1[3]);
#pragma unroll
    for (int r = 4; r < 16; r += 4) { a = MX3(a, p0[r], p0[r + 1]); b = MX3(b, p0[r + 2], p0[r + 3]); a = MX3(a, p1[r], p1[r + 1]); b = MX3(b, p1[r + 2], p1[r + 3]); }
    const float m = __builtin_fmaxf(a, b);
    auto rr = __builtin_amdgcn_permlane32_swap(__float_as_uint(m), __float_as_uint(m), false, false);
    return __builtin_fmaxf(__uint_as_float(rr[0]), __uint_as_float(rr[1]));
}
template <int DQK, int DV> struct Lay {
    static constexpr int KB = 64 * DQK * 2, VB = 64 * DV * 2;
    static constexpr int LDS_K = 0, LDS_V = NSLOT * KB, LDS_WS = NSLOT * (KB + VB), OSTW = (DV == 128) ? 8192 : 4096, LDS_OST = LDS_WS + NW * 256, LDS_BT = LDS_OST + NW * OSTW, LDS_END = LDS_BT + 2048;
};
#define STEP_MLA(C0, C1, P0, P1, t, BAND, GK, GV, GL) do { SBAR(); \
    const lds_cptr vp_ = vp0 + sl_prev * L::VB; \
      \
    float sacc = P0[0] + P0[1]; \
    VRD(0, 0); SBAR(); C0 = MFMA32(kf[0], qr[0], negm); sacc += P0[2]; sacc += P0[3]; sacc += P0[4]; PIN(sacc); pw0[0] = PKW(P0, 0); pw0[1] = PKW(P0, 2); PIN(pw0); SBAR(); \
    VRD(4, 4); SBAR(); C1 = MFMA32(kf[1], qr[0], negm); sacc += P0[5]; sacc += P0[6]; sacc += P0[7]; PIN(sacc); pw0[2] = PKW(P0, 4); pw0[3] = PKW(P0, 6); PIN(pw0); SBAR(); \
    VRD(1, 1); SBAR(); C0 = MFMA32(kf[2], qr[1], C0); sacc += P0[8]; sacc += P0[9]; sacc += P0[10]; PIN(sacc); pw1[0] = PKW(P0, 8); pw1[1] = PKW(P0, 10); PIN(pw1); SBAR(); \
    VRD(5, 5); SBAR(); C1 = MFMA32(kf[3], qr[1], C1); sacc += P0[11]; sacc += P0[12]; sacc += P0[13]; PIN(sacc); pw1[2] = PKW(P0, 12); pw1[3] = PKW(P0, 14); PIN(pw1); SBAR(); \
    VRD(2, 2); SBAR(); C0 = MFMA32(kf[4], qr[2], C0); sacc += P0[14]; sacc += P0[15]; sacc += P1[0]; PIN(sacc); pw2[0] = PKW(P1, 0); PIN(pw2); SBAR(); \
    VRD(6, 6); SBAR(); C1 = MFMA32(kf[5], qr[2], C1); sacc += P1[1]; sacc += P1[2]; sacc += P1[3]; PIN(sacc); pw2[1] = PKW(P1, 2); PIN(pw2); SBAR(); \
    VRD(3, 3); SBAR(); C0 = MFMA32(kf[6], qr[3], C0); sacc += P1[4]; sacc += P1[5]; PIN(sacc); pw2[2] = PKW(P1, 4); PIN(pw2); SBAR(); \
    VRD(7, 7); SBAR(); C1 = MFMA32(kf[7], qr[3], C1); sacc += P1[6]; sacc += P1[7]; PIN(sacc); pw2[3] = PKW(P1, 6); PIN(pw2); SBAR(); \
    C0 = MFMA32(kf[8], qr[4], C0); sacc += P1[8]; sacc += P1[9]; PIN(sacc); pw3[0] = PKW(P1, 8); PIN(pw3); SBAR(); \
    C1 = MFMA32(kf[9], qr[4], C1); sacc += P1[10]; sacc += P1[11]; PIN(sacc); pw3[1] = PKW(P1, 10); PIN(pw3); SBAR(); \
    C0 = MFMA32(kf[10], qr[5], C0); sacc += P1[12]; sacc += P1[13]; PIN(sacc); pw3[2] = PKW(P1, 12); PIN(pw3); SBAR(); \
    C1 = MFMA32(kf[11], qr[5], C1); sacc += P1[14]; sacc += P1[15]; PIN(sacc); pw3[3] = PKW(P1, 14); PIN(pw3); SBAR(); \
    l_reg += sacc; \
    MIDDLE(C0, C1, t, BAND); \
    SBAR(); \
    o[0] = MFMA32(PAF(0), VFR(0), o[0]); if (GK) DMA_K((t) + 3, sl_cur); if (GV) DMA_V((t) + 1, sl_next); C0[0] = EX(C0[0]); C0[1] = EX(C0[1]); C0[2] = EX(C0[2]); C0[3] = EX(C0[3]); PIN(C0); SBAR(); \
    KRD(GL, 0); o[1] = MFMA32(PAF(0), VFR(4), o[1]); C0[4] = EX(C0[4]); C0[5] = EX(C0[5]); C0[6] = EX(C0[6]); C0[7] = EX(C0[7]); PIN(C0); SBAR(); \
    KRD(GL, 1); o[0] = MFMA32(PAF(1), VFR(1), o[0]); C0[8] = EX(C0[8]); C0[9] = EX(C0[9]); C0[10] = EX(C0[10]); C0[11] = EX(C0[11]); PIN(C0); SBAR(); \
    KRD(GL, 2); o[1] = MFMA32(PAF(1), VFR(5), o[1]); C0[12] = EX(C0[12]); C0[13] = EX(C0[13]); C0[14] = EX(C0[14]); C0[15] = EX(C0[15]); PIN(C0); SBAR(); \
    KRD(GL, 3); o[0] = MFMA32(PAF(2), VFR(2), o[0]); C1[0] = EX(C1[0]); C1[1] = EX(C1[1]); C1[2] = EX(C1[2]); C1[3] = EX(C1[3]); PIN(C1); SBAR(); \
    KRD(GL, 4); o[1] = MFMA32(PAF(2), VFR(6), o[1]); C1[4] = EX(C1[4]); C1[5] = EX(C1[5]); C1[6] = EX(C1[6]); C1[7] = EX(C1[7]); PIN(C1); SBAR(); \
    KRD(GL, 5); o[0] = MFMA32(PAF(3), VFR(3), o[0]); C1[8] = EX(C1[8]); C1[9] = EX(C1[9]); C1[10] = EX(C1[10]); C1[11] = EX(C1[11]); PIN(C1); SBAR(); \
    o[1] = MFMA32(PAF(3), VFR(7), o[1]); C1[12] = EX(C1[12]); C1[13] = EX(C1[13]); C1[14] = EX(C1[14]); C1[15] = EX(C1[15]); PIN(C1); SBAR(); \
    } while (0)
#define STEP_DIF(C0, C1, P0, P1, t, BAND, GK, GV, GL) do { SBAR(); \
    const lds_cptr vp_ = vp0 + sl_prev * L::VB; \
      \
    float sacc = P0[0] + P0[1]; \
    C0 = MFMA32(kf[0], qr[0], inin); sacc += P0[2]; sacc += P0[3]; sacc += P0[4]; sacc += P0[5]; PIN(sacc); pw0[0] = PKW(P0, 0); pw0[1] = PKW(P0, 2); PIN(pw0); SBAR(); \
    C1 = MFMA32(kf[1], qr[0], inin); sacc += P0[6]; sacc += P0[7]; sacc += P0[8]; sacc += P0[9]; PIN(sacc); pw0[2] = PKW(P0, 4); pw0[3] = PKW(P0, 6); PIN(pw0); SBAR(); \
    C0 = MFMA32(kf[2], qr[1], C0); sacc += P0[10]; sacc += P0[11]; sacc += P0[12]; sacc += P0[13]; PIN(sacc); pw1[0] = PKW(P0, 8); pw1[1] = PKW(P0, 10); PIN(pw1); SBAR(); \
    C1 = MFMA32(kf[3], qr[1], C1); sacc += P0[14]; sacc += P0[15]; sacc += P1[0]; sacc += P1[1]; PIN(sacc); pw1[2] = PKW(P0, 12); pw1[3] = PKW(P0, 14); PIN(pw1); SBAR(); \
    VRD(0, 0); SBAR(); C0 = MFMA32(kf[4], qr[2], C0); sacc += P1[2]; sacc += P1[3]; sacc += P1[4]; sacc += P1[5]; PIN(sacc); pw2[0] = PKW(P1, 0); pw2[1] = PKW(P1, 2); PIN(pw2); SBAR(); \
    VRD(1, 4); SBAR(); C1 = MFMA32(kf[5], qr[2], C1); sacc += P1[6]; sacc += P1[7]; sacc += P1[8]; sacc += P1[9]; PIN(sacc); pw2[2] = PKW(P1, 4); pw2[3] = PKW(P1, 6); PIN(pw2); SBAR(); \
    VRD(2, 8); SBAR(); C0 = MFMA32(kf[6], qr[3], C0); sacc += P1[10]; sacc += P1[11]; sacc += P1[12]; sacc += P1[13]; PIN(sacc); pw3[0] = PKW(P1, 8); pw3[1] = PKW(P1, 10); PIN(pw3); SBAR(); \
    VRD(3, 12); SBAR(); C1 = MFMA32(kf[7], qr[3], C1); sacc += P1[14]; sacc += P1[15]; PIN(sacc); pw3[2] = PKW(P1, 12); pw3[3] = PKW(P1, 14); PIN(pw3); SBAR(); \
    l_reg += sacc; \
    MIDDLE(C0, C1, t, BAND); \
    SBAR(); \
    o[0] = MFMA32(PAF(0), VFR(0), o[0]); if (GK) DMA_K((t) + 3, sl_cur); if (GV) DMA_V((t) + 1, sl_next); VRD(0, 1); C0[0] = EX(C0[0]); C0[1] = EX(C0[1]); PIN(C0); SBAR(); \
    o[1] = MFMA32(PAF(0), VFR(1), o[1]); VRD(1, 5); C0[2] = EX(C0[2]); C0[3] = EX(C0[3]); PIN(C0); SBAR(); \
    o[2] = MFMA32(PAF(0), VFR(2), o[2]); VRD(2, 9); C0[4] = EX(C0[4]); C0[5] = EX(C0[5]); PIN(C0); SBAR(); \
    o[3] = MFMA32(PAF(0), VFR(3), o[3]); VRD(3, 13); C0[6] = EX(C0[6]); C0[7] = EX(C0[7]); PIN(C0); SBAR(); \
    o[0] = MFMA32(PAF(1), VFR(0), o[0]); VRD(0, 2); C0[8] = EX(C0[8]); C0[9] = EX(C0[9]); PIN(C0); SBAR(); \
    o[1] = MFMA32(PAF(1), VFR(1), o[1]); VRD(1, 6); C0[10] = EX(C0[10]); C0[11] = EX(C0[11]); PIN(C0); SBAR(); \
    o[2] = MFMA32(PAF(1), VFR(2), o[2]); VRD(2, 10); C0[12] = EX(C0[12]); C0[13] = EX(C0[13]); PIN(C0); SBAR(); \
    o[3] = MFMA32(PAF(1), VFR(3), o[3]); VRD(3, 14); C0[14] = EX(C0[14]); C0[15] = EX(C0[15]); PIN(C0); SBAR(); \
    o[0] = MFMA32(PAF(2), VFR(0), o[0]); VRD(0, 3); C1[0] = EX(C1[0]); C1[1] = EX(C1[1]); PIN(C1); SBAR(); \
    KRD(GL, 0); o[1] = MFMA32(PAF(2), VFR(1), o[1]); VRD(1, 7); C1[2] = EX(C1[2]); C1[3] = EX(C1[3]); PIN(C1); SBAR(); \
    KRD(GL, 1); o[2] = MFMA32(PAF(2), VFR(2), o[2]); VRD(2, 11); C1[4] = EX(C1[4]); C1[5] = EX(C1[5]); PIN(C1); SBAR(); \
    KRD(GL, 2); o[3] = MFMA32(PAF(2), VFR(3), o[3]); VRD(3, 15); C1[6] = EX(C1[6]); C1[7] = EX(C1[7]); PIN(C1); SBAR(); \
    KRD(GL, 3); o[0] = MFMA32(PAF(3), VFR(0), o[0]); C1[8] = EX(C1[8]); C1[9] = EX(C1[9]); PIN(C1); SBAR(); \
    o[1] = MFMA32(PAF(3), VFR(1), o[1]); C1[10] = EX(C1[10]); C1[11] = EX(C1[11]); PIN(C1); SBAR(); \
    o[2] = MFMA32(PAF(3), VFR(2), o[2]); C1[12] = EX(C1[12]); C1[13] = EX(C1[13]); PIN(C1); SBAR(); \
    o[3] = MFMA32(PAF(3), VFR(3), o[3]); C1[14] = EX(C1[14]); C1[15] = EX(C1[15]); PIN(C1); { float iv_ = INI_ADD((t) + 1) - mhat; _Pragma("unroll") for (int r_ = 0; r_ < 16; ++r_) inin[r_] = iv_; } PIN(inin); SBAR(); \
    } while (0)
#define PKW(P, i) cvtpk_s(P[i], P[i + 1])
#define PAF(k) __builtin_bit_cast(bf16x8, pw##k)
#define VFR(i) (bf16x8){vlo[i][0], vlo[i][1], vlo[i][2], vlo[i][3], vhi[i][0], vhi[i][1], vhi[i][2], vhi[i][3]}
#define VRD(s, f) do { vlo[s] = vtr(vp_ + (((f) >> 2) * 4096 + ((f) & 3) * 1024)); vhi[s] = vtr(vp_ + (((f) >> 2) * 4096 + ((f) & 3) * 1024 + 512)); } while (0)
#define KRD(G, j) do { if (G) { const lds_cptr kq_ = kp0 + sl_next * L::KB + (j) * 2048; kf[2 * (j)] = kld(kq_); kf[2 * (j) + 1] = kld(kq_ + 512); SBAR(); } } while (0)
#define ROT() do { sl_prev = sl_cur; sl_cur = sl_next; sl_next = (sl_next == NSLOT - 1) ? 0 : sl_next + 1; } while (0)
#define CMASK(C0, C1, t) do { } while (0)
#define DECIDE(C0, C1) do { int a_ = IMX3(FBITS(C0[0]), FBITS(C0[1]), FBITS(C1[0])), b_ = IMX3(FBITS(C0[2]), FBITS(C0[3]), FBITS(C1[1])); a_ = IMX3(a_, FBITS(C1[2]), FBITS(C1[3])); \
      _Pragma("unroll") for (int r_ = 4; r_ < 16; r_ += 4) { a_ = IMX3(a_, FBITS(C0[r_]), FBITS(C0[r_ + 1])); b_ = IMX3(b_, FBITS(C0[r_ + 2]), FBITS(C0[r_ + 3])); a_ = IMX3(a_, FBITS(C1[r_]), FBITS(C1[r_ + 1])); b_ = IMX3(b_, FBITS(C1[r_ + 2]), FBITS(C1[r_ + 3])); } \
      float rm_; { const int im_ = imax_(a_, b_); auto rr_ = __builtin_amdgcn_permlane32_swap((unsigned)im_, (unsigned)im_, false, false); rm_ = __int_as_float(imax_((int)rr_[0], (int)rr_[1])); } \
      resc = false; \
      if (__builtin_expect(__any(rm_ > (float)THRL), 0)) { const float dl_ = __builtin_fmaxf(rm_, 0.f); mhat += dl_; NEGM_UPDATE(); \
        _Pragma("unroll") for (int r_ = 0; r_ < 16; ++r_) { C0[r_] -= dl_; C1[r_] -= dl_; } \
        const float f_ = __builtin_amdgcn_exp2f(-dl_); l_reg *= f_; if (hi == 0) wsf[r32] = f_; resc = true; } } while (0)
#define RESC(NO_) do { if (resc) { asm volatile("s_waitcnt lgkmcnt(0)" ::: "memory"); \
      _Pragma("unroll") for (int r_ = 0; r_ < 16; ++r_) { const float f_ = wsf[crow(r_, hi)]; _Pragma("unroll") for (int d_ = 0; d_ < NO_; ++d_) o[d_][r_] *= f_; } } } while (0)
#define ENDW(tt, W2, W1) do { if ((tt) + 3 < NT) { WAIT_BAR(W2); } else if ((tt) + 2 < NT) { WAIT_BAR(W1); } else { WAIT_BAR(0); } } while (0)
#define DRAIN_PV(P0, P1, slot_, NO_) do { float sacc_ = P0[0] + P0[1]; \
      _Pragma("unroll") for (int r_ = 2; r_ < 16; ++r_) sacc_ += P0[r_]; \
      _Pragma("unroll") for (int r_ = 0; r_ < 16; ++r_) sacc_ += P1[r_]; \
      l_reg += sacc_; \
      pw0 = (u32x4){PKW(P0, 0), PKW(P0, 2), PKW(P0, 4), PKW(P0, 6)}; pw1 = (u32x4){PKW(P0, 8), PKW(P0, 10), PKW(P0, 12), PKW(P0, 14)}; \
      pw2 = (u32x4){PKW(P1, 0), PKW(P1, 2), PKW(P1, 4), PKW(P1, 6)}; pw3 = (u32x4){PKW(P1, 8), PKW(P1, 10), PKW(P1, 12), PKW(P1, 14)}; \
      const lds_cptr vp_ = vp0 + (slot_) * L::VB; \
      _Pragma("unroll") for (int d_ = 0; d_ < NO_; ++d_) { \
          VRD(0, d_ * 4 + 0); VRD(1, d_ * 4 + 1); VRD(2, d_ * 4 + 2); VRD(3, d_ * 4 + 3); \
          o[d_] = MFMA32(PAF(0), VFR(0), o[d_]); o[d_] = MFMA32(PAF(1), VFR(1), o[d_]); o[d_] = MFMA32(PAF(2), VFR(2), o[d_]); o[d_] = MFMA32(PAF(3), VFR(3), o[d_]); SBAR(); } } while (0)
#define BSTEP(STEPX, NO_, C0, C1, P0, P1, t, GK, GV, GL) do { \
      if ((t) <= Lw) { STEPX(C0, C1, P0, P1, t, false, GK, GV, ((GL) && ((t) + 1 <= Lw))); } \
      else { resc = false; if (GK) DMA_K((t) + 3, sl_cur); if (GV) DMA_V((t) + 1, sl_next); \
             if ((t) == Lw + 1) DRAIN_PV(P0, P1, sl_prev, NO_); } } while (0)

template <int DQK, int DV>
__device__ __forceinline__ void store_rows(const f32x16 (&y)[DV / 32], bf16* dst, int pitch, char* shm) {
    typedef Lay<DQK, DV> L;
    const int tid_ = otid(), lane = tid_ & 63, r32 = lane & 31, hi = lane >> 5; const int wid = __builtin_amdgcn_readfirstlane(tid_ >> 6);
    bf16* stg = (bf16*)(shm + L::LDS_OST + wid * L::OSTW);
#pragma unroll
    for (int half = 0; half < DV / 64; ++half) {
#pragma unroll
        for (int r = 0; r < 16; ++r) { const int orow = crow(r, hi);
#pragma unroll
            for (int d0 = 0; d0 < 2; ++d0) { const unsigned pk = cvtpk_s(y[2 * half + d0][r], 0.f); stg[orow * 64 + d0 * 32 + r32] = (bf16)(pk & 0xffffu); } }
        asm volatile("s_waitcnt lgkmcnt(0)" ::: "memory");
#pragma unroll
        for (int i = 0; i < 4; ++i) { const int row = i * 8 + (lane >> 3), ch = lane & 7; const u32x4 v = *(const u32x4*)(stg + row * 64 + ch * 8);
            *(u32x4*)(dst + (long)(32 * wid + i * 8 + (lane >> 3)) * pitch + half * 64 + ch * 8) = v; }
        asm volatile("s_waitcnt lgkmcnt(0)" ::: "memory");
    }
}
template <int DQK, int DV>
__device__ __forceinline__ void row_rcp(float (&rli)[16], float l_reg, char* shm) {
    typedef Lay<DQK, DV> L;
    const int tid_ = otid(), lane = tid_ & 63, r32 = lane & 31, hi = lane >> 5; const int wid = __builtin_amdgcn_readfirstlane(tid_ >> 6);
    float* wsf = (float*)(shm + L::LDS_WS) + wid * 64;
    { auto rr = __builtin_amdgcn_permlane32_swap(__float_as_uint(l_reg), __float_as_uint(l_reg), false, false); l_reg = __uint_as_float(rr[0]) + __uint_as_float(rr[1]); }
    if (hi == 0) wsf[32 + r32] = l_reg;
    asm volatile("s_waitcnt lgkmcnt(0)" ::: "memory");
#pragma unroll
    for (int r = 0; r < 16; ++r) rli[r] = __builtin_amdgcn_rcpf(wsf[32 + crow(r, hi)]);
}

struct MlaT { const bf16 *QA, *KN, *KR, *VA; bf16* MIX; };
__device__ __forceinline__ void mla_unit(int b, int h, int qb, const MlaT& T, char* shm) {
    typedef Lay<96, 64> L;
    const int tid = otid(), lane = tid & 63, r32 = lane & 31, hi = lane >> 5; const int wid = __builtin_amdgcn_readfirstlane(tid >> 6);
    const long rowbase = (long)b * SEQ; const int q0 = qb * QB, NT = 4 * qb + 4; const int Lw = NT - 4 + (wid >> 1);
    const bf16* Qrow = T.QA + (rowbase + q0 + 32 * wid + r32) * 768 + h * 96;
    const unsigned lds0 = (unsigned)(uintptr_t)shm; float* wsf = (float*)(shm + L::LDS_WS) + wid * 64;
    const bf16* ksrc = T.KN + rowbase * 512 + h * 64 + (long)lane * 512 + wid * 8;
    const bf16* k2src = T.KR + rowbase * 32 + (long)lane * 32 + (wid & 3) * 8;
    const bf16* vsrc = T.VA + rowbase * 512 + h * 64 + (long)(16 * (wid & 3) + (lane >> 2)) * 512 + (wid >> 2) * 32 + (lane & 3) * 8;
    const unsigned kdst = lds0 + L::LDS_K + wid * 1024, k2dst = lds0 + L::LDS_K + (8 + (wid & 3)) * 1024, vdst = lds0 + L::LDS_V + wid * 1024;
#define DMA_K(t, slot) do { glds16(ksrc + (long)(t) * KVBLK * 512, (unsigned)__builtin_amdgcn_readfirstlane(kdst + (slot) * L::KB)); glds16(k2src + (long)(t) * KVBLK * 32, (unsigned)__builtin_amdgcn_readfirstlane(k2dst + (slot) * L::KB)); } while (0)
#define DMA_V(t, slot) glds16(vsrc + (long)(t) * KVBLK * 512, (unsigned)__builtin_amdgcn_readfirstlane(vdst + (slot) * L::VB))
#define INI_ADD(t) 0.f
#define NEGM_UPDATE() do { _Pragma("unroll") for (int r_ = 0; r_ < 16; ++r_) negm[r_] = -mhat; } while (0)
#define MIDDLE(C0, C1, t, BAND) do { if (BAND) CMASK(C0, C1, t); DECIDE(C0, C1); } while (0)
    const lds_cptr shm3 = (lds_cptr)shm;
    const lds_cptr vp0 = shm3 + L::LDS_V + ((lane >> 4) & 1) * 32 + (lane & 3) * 8 + (4 * hi + ((lane & 15) >> 2)) * 64;
    const lds_cptr kp0 = shm3 + L::LDS_K + hi * 1024 + r32 * 16;
    DMA_K(0, 0); DMA_V(0, 0); DMA_K(1, 1);
    bf16x8 qr[6];
#pragma unroll
    for (int d0 = 0; d0 < 6; ++d0) qr[d0] = *reinterpret_cast<const bf16x8*>(&Qrow[d0 * 16 + hi * 8]);
    float mhat = 0.f, l_reg = 0.f; f32x16 o[2]; o[0] = f32x16{}; o[1] = f32x16{};
    bool resc = false;
    f32x16 pA0, pA1, pB0, pB1; bf16x8 kf[12]; s16x4 vlo[8], vhi[8]; u32x4 pw0, pw1, pw2, pw3;
    int sl_prev = 0, sl_cur = 0, sl_next = 1;
    DMA_K(2, 2);
    WAIT_BAR(5);
    { f32x16 z = f32x16{};
#pragma unroll
      for (int d0 = 0; d0 < 6; ++d0) { const bf16x8 b0 = kld(kp0 + d0 * 2048), b1 = kld(kp0 + d0 * 2048 + 512);
          if (d0 == 0) { pA0 = MFMA32(b0, qr[0], z); pA1 = MFMA32(b1, qr[0], z); } else { pA0 = MFMA32(b0, qr[d0], pA0); pA1 = MFMA32(b1, qr[d0], pA1); } }
      const float rm = rowmax(pA0, pA1); mhat = rm;
#pragma unroll
      for (int r = 0; r < 16; ++r) { pA0[r] = EX(pA0[r] - rm); pA1[r] = EX(pA1[r] - rm); } }
    f32x16 negm; NEGM_UPDATE(); asm volatile("" : "+v"(negm));
    WAIT_BAR(0);
    DMA_K(3, 0); DMA_V(1, 1); ROT();
#pragma unroll
    for (int j = 0; j < 6; ++j) { const lds_cptr kq = kp0 + sl_cur * L::KB + j * 2048; kf[2 * j] = kld(kq); kf[2 * j + 1] = kld(kq + 512); }
    WAIT_BAR(3);
    int t = 1;
    for (; t + 5 < NT; t += 2) {
        STEP_MLA(pB0, pB1, pA0, pA1, t, false, true, true, true);     WAIT_BAR(3); RESC(2); ROT();
        STEP_MLA(pA0, pA1, pB0, pB1, t + 1, false, true, true, true); WAIT_BAR(3); RESC(2); ROT();
    }
#pragma nounroll
    for (; t <= Lw; ++t) {
        STEP_MLA(pB0, pB1, pA0, pA1, t, false, (t + 3 < NT), (t + 1 < NT), (t + 1 <= Lw));
        if (t + 1 < NT) { ENDW(t, 3, 1); }
        RESC(2);
        if (t + 1 < NT) ROT();
        pA0 = pB0; pA1 = pB1;
    }
    if (t < NT) {
        if (t + 3 < NT) DMA_K(t + 3, sl_cur); if (t + 1 < NT) DMA_V(t + 1, sl_next);
        DRAIN_PV(pA0, pA1, sl_prev, 2);
        if (t + 1 < NT) { ENDW(t, 3, 1); ROT(); }
        ++t;
#pragma nounroll
        for (; t < NT; ++t) {
            if (t + 3 < NT) DMA_K(t + 3, sl_cur); if (t + 1 < NT) DMA_V(t + 1, sl_next);
            if (t + 1 < NT) { ENDW(t, 3, 1); ROT(); }
        }
    } else { DRAIN_PV(pA0, pA1, sl_cur, 2); }
    float rli[16]; row_rcp<96, 64>(rli, l_reg, shm);
#pragma unroll
    for (int d = 0; d < 2; ++d)
#pragma unroll
        for (int r = 0; r < 16; ++r) o[d][r] *= rli[r];
    store_rows<96, 64>(o, T.MIX + (rowbase + q0) * 1024 + h * 64, 1024, shm);
    asm volatile("s_waitcnt vmcnt(0) lgkmcnt(0)\n\ts_barrier" ::: "memory");
#undef DMA_K
#undef DMA_V
#undef INI_ADD
#undef NEGM_UPDATE
#undef MIDDLE
}

struct DiffT { const bf16 *DQ, *DK, *DV; bf16* MIX; float* OB; const float *rel_bias, *g_subln; float lam; };
__device__ __forceinline__ int t5_bucket(int rel) {
    const int n = rel < 0 ? -rel : rel; int bk = n;
    if (n >= 8) { bk = 2 + (31 - __clz(n * n)); bk = bk > 15 ? 15 : bk; }
    return (rel > 0 ? 16 : 0) + bk;
}
__device__ __forceinline__ void diff_pass(f32x16 (&o)[4], float& l_out, int b, int h, int qb, int mo, const DiffT& T, char* shm, float cfar) {
    typedef Lay<64, 128> L;
    const int tid = otid(), lane = tid & 63, r32 = lane & 31, hi = lane >> 5; const int wid = __builtin_amdgcn_readfirstlane(tid >> 6);
    const long rowbase = (long)b * SEQ; const int q0 = qb * QB, NT = 4 * qb + 4; const int Lw = NT - 4 + (wid >> 1);
    const int urow = 32 * wid + r32;
    const bf16* Qrow = T.DQ + (rowbase + q0 + urow) * 512 + h * 128 + mo;
    const unsigned lds0 = (unsigned)(uintptr_t)shm; float* wsf = (float*)(shm + L::LDS_WS) + wid * 64;
    const float* bt = (const float*)(shm + L::LDS_BT);
    const bf16* ksrc = T.DK + rowbase * 512 + h * 128 + mo + (long)lane * 512 + wid * 8;
    const bf16* vsrc = T.DV + rowbase * 512 + h * 128 + (long)(16 * (wid & 3) + (lane >> 2)) * 512 + (wid >> 2) * 32 + (lane & 3) * 8;
    const unsigned kdst = lds0 + L::LDS_K + wid * 1024, vdst = lds0 + L::LDS_V + wid * 1024;
#define DMA_K(t, slot) glds16(ksrc + (long)(t) * KVBLK * 512, (unsigned)__builtin_amdgcn_readfirstlane(kdst + (slot) * L::KB))
#define DMA_V(t, slot) do { glds16(vsrc + (long)(t) * KVBLK * 512, (unsigned)__builtin_amdgcn_readfirstlane(vdst + (slot) * L::VB)); glds16(vsrc + (long)(t) * KVBLK * 512 + 64, (unsigned)__builtin_amdgcn_readfirstlane(vdst + (slot) * L::VB + 8192)); } while (0)
#define INI_ADD(t) (((t) < NT - 6) ? cfar : 0.f)
#define NEGM_UPDATE() do { } while (0)
#define BIAS_ADD(C0, C1, t) do { if ((t) >= NT - 6) { const float* bp_ = bt + (64 * (t) - (q0 + urow) + 384 + 4 * hi); \
      _Pragma("unroll") for (int r_ = 0; r_ < 16; ++r_) { C0[r_] += bp_[(r_ & 3) + 8 * (r_ >> 2)]; C1[r_] += bp_[32 + (r_ & 3) + 8 * (r_ >> 2)]; } } } while (0)
#define MIDDLE(C0, C1, t, BAND) do { BIAS_ADD(C0, C1, t); if (BAND) CMASK(C0, C1, t); DECIDE(C0, C1); } while (0)
    const lds_cptr shm3 = (lds_cptr)shm;
    const lds_cptr vp0 = shm3 + L::LDS_V + ((lane >> 4) & 1) * 32 + (lane & 3) * 8 + (4 * hi + ((lane & 15) >> 2)) * 64;
    const lds_cptr kp0 = shm3 + L::LDS_K + hi * 1024 + r32 * 16;
    DMA_K(0, 0); DMA_V(0, 0); DMA_K(1, 1);
    bf16x8 qr[4];
#pragma unroll
    for (int d0 = 0; d0 < 4; ++d0) qr[d0] = *reinterpret_cast<const bf16x8*>(&Qrow[d0 * 16 + hi * 8]);
    float mhat = 0.f, l_reg = 0.f;
#pragma unroll
    for (int d = 0; d < 4; ++d) o[d] = f32x16{};
    bool resc = false;
    f32x16 pA0, pA1, pB0, pB1; bf16x8 kf[8]; s16x4 vlo[8], vhi[8]; u32x4 pw0, pw1, pw2, pw3;
    int sl_prev = 0, sl_cur = 0, sl_next = 1;
    DMA_K(2, 2);
    WAIT_BAR(4);
    { f32x16 z; { const float iv = INI_ADD(0);
#pragma unroll
        for (int r = 0; r < 16; ++r) z[r] = iv; }
#pragma unroll
      for (int d0 = 0; d0 < 4; ++d0) { const bf16x8 b0 = kld(kp0 + d0 * 2048), b1 = kld(kp0 + d0 * 2048 + 512);
          if (d0 == 0) { pA0 = MFMA32(b0, qr[0], z); pA1 = MFMA32(b1, qr[0], z); } else { pA0 = MFMA32(b0, qr[d0], pA0); pA1 = MFMA32(b1, qr[d0], pA1); } }
      BIAS_ADD(pA0, pA1, 0);
      const float rm = rowmax(pA0, pA1); mhat = rm;
#pragma unroll
      for (int r = 0; r < 16; ++r) { pA0[r] = EX(pA0[r] - rm); pA1[r] = EX(pA1[r] - rm); } }
    f32x16 inin; { const float iv = INI_ADD(1) - mhat;
#pragma unroll
        for (int r = 0; r < 16; ++r) inin[r] = iv; }
    asm volatile("" : "+v"(inin));
    WAIT_BAR(0);
    DMA_K(3, 0); DMA_V(1, 1); ROT();
#pragma unroll
    for (int j = 0; j < 4; ++j) { const lds_cptr kq = kp0 + sl_cur * L::KB + j * 2048; kf[2 * j] = kld(kq); kf[2 * j + 1] = kld(kq + 512); }
    WAIT_BAR(3);
    int t = 1;
    for (; t + 5 < NT; t += 2) {
        STEP_DIF(pB0, pB1, pA0, pA1, t, false, true, true, true);     WAIT_BAR(3); RESC(4); ROT();
        STEP_DIF(pA0, pA1, pB0, pB1, t + 1, false, true, true, true); WAIT_BAR(3); RESC(4); ROT();
    }
#pragma nounroll
    for (; t <= Lw; ++t) {
        STEP_DIF(pB0, pB1, pA0, pA1, t, false, (t + 3 < NT), (t + 1 < NT), (t + 1 <= Lw));
        if (t + 1 < NT) { ENDW(t, 3, 2); }
        RESC(4);
        if (t + 1 < NT) ROT();
        pA0 = pB0; pA1 = pB1;
    }
    if (t < NT) {
        if (t + 3 < NT) DMA_K(t + 3, sl_cur); if (t + 1 < NT) DMA_V(t + 1, sl_next);
        DRAIN_PV(pA0, pA1, sl_prev, 4);
        if (t + 1 < NT) { ENDW(t, 3, 2); ROT(); }
        ++t;
#pragma nounroll
        for (; t < NT; ++t) {
            if (t + 3 < NT) DMA_K(t + 3, sl_cur); if (t + 1 < NT) DMA_V(t + 1, sl_next);
            if (t + 1 < NT) { ENDW(t, 3, 2); ROT(); }
        }
    } else { DRAIN_PV(pA0, pA1, sl_cur, 4); }
    l_out = l_reg;
    asm volatile("s_waitcnt lgkmcnt(0)\n\ts_barrier" ::: "memory");
#undef DMA_K
#undef DMA_V
#undef INI_ADD
#undef NEGM_UPDATE
#undef BIAS_ADD
#undef MIDDLE
}
__device__ __forceinline__ void diff_unit(int b, int h, int qb, const DiffT& T, char* shm) {
    typedef Lay<64, 128> L;
    const int tid = otid(); const int wid = __builtin_amdgcn_readfirstlane(tid >> 6);
    const long rowbase = (long)b * SEQ; const int q0 = qb * QB;
    constexpr float LOG2E = 1.4426950408889634f;
    { float* bt = (float*)(shm + L::LDS_BT); if (tid < 448) bt[tid] = T.rel_bias[t5_bucket(tid - 384) * 4 + h] * LOG2E; }
    const float cfar = T.rel_bias[15 * 4 + h] * LOG2E;
    asm volatile("s_waitcnt lgkmcnt(0)\n\ts_barrier" ::: "memory");
    unsigned* const obw = (unsigned*)(shm + L::LDS_OST + wid * L::OSTW);
    f32x16 o[4]; float l_reg; float rli[16];
    const float lam = T.lam;
#pragma nounroll
    for (int pass = 0; pass < 2; ++pass) {
        diff_pass(o, l_reg, b, h, qb, (pass == 0) ? 64 : 0, T, shm, cfar);
        row_rcp<64, 128>(rli, l_reg, shm);
        if (pass == 0) { unsigned* ob = obw + (otid() & 63);
#pragma unroll
            for (int d = 0; d < 4; ++d)
#pragma unroll
                for (int r = 0; r < 16; r += 2) ob[(d * 8 + (r >> 1)) * 64] = cvtpk_s(o[d][r] * rli[r], o[d][r + 1] * rli[r + 1]);
        }
    }
    float ss[16]; const int lane2 = otid() & 63, r32 = lane2 & 31; const unsigned* ob = obw + lane2;
    unsigned pk2_[4][8];
#pragma unroll
    for (int d = 0; d < 4; ++d)
#pragma unroll
        for (int j = 0; j < 8; ++j) pk2_[d][j] = ob[(d * 8 + j) * 64];
    asm volatile("s_waitcnt lgkmcnt(0)" ::: "memory");
#pragma unroll
    for (int r = 0; r < 16; ++r) { float s = 0.f;
#pragma unroll
        for (int d = 0; d < 4; ++d) { const unsigned w = pk2_[d][r >> 1]; const float o2 = __uint_as_float((r & 1) ? (w & 0xffff0000u) : (w << 16));
            const float y = o[d][r] * rli[r] - lam * o2; o[d][r] = y; s += y * y; }
        ss[r] = s; }
#define SWZ_STEP(K) _Pragma("unroll") for (int r = 0; r < 16; ++r) ss[r] += swz_xor<((K) << 10) | 0x1f>(ss[r]);
    SWZ_STEP(1) SWZ_STEP(2) SWZ_STEP(4) SWZ_STEP(8) SWZ_STEP(16)
#undef SWZ_STEP
#pragma unroll
    for (int d = 0; d < 4; ++d) { const float g = T.g_subln[d * 32 + r32] * 0.8f;
#pragma unroll
        for (int r = 0; r < 16; ++r) o[d][r] *= g * __builtin_amdgcn_rsqf(ss[r] * (1.f / 128.f) + 1e-6f); }
    store_rows<64, 128>(o, T.MIX + (rowbase + q0) * 1024 + 512 + h * 128, 1024, shm);
    asm volatile("s_waitcnt vmcnt(0) lgkmcnt(0)\n\ts_barrier" ::: "memory");
}
#undef SBAR
#undef PIN
#undef WAIT_BAR
#undef MFMA32
#undef EX
#undef MX3
}
#define GAS __attribute__((address_space(1)))
#define LAS __attribute__((address_space(3)))
typedef unsigned short bf16;
typedef unsigned v4u __attribute__((ext_vector_type(4)));
typedef float f32x4 __attribute__((ext_vector_type(4)));
typedef short bf16x8 __attribute__((ext_vector_type(8)));
typedef GAS unsigned gu32;
typedef GAS unsigned long long gu64;
#define RLX_AGENT __ATOMIC_RELAXED, __HIP_MEMORY_SCOPE_AGENT
#define LDS_WAIT() asm volatile("s_waitcnt lgkmcnt(0)" ::: "memory")
#define VM_WAIT() asm volatile("s_waitcnt vmcnt(0)" ::: "memory")
__device__ __forceinline__ unsigned long long rt() { return __builtin_amdgcn_s_memrealtime(); }
__device__ __forceinline__ unsigned f2bf(float f) { unsigned u = __builtin_bit_cast(unsigned, f); return (u + 0x7fffu + ((u >> 16) & 1u)) >> 16; }
__device__ __forceinline__ unsigned pk2(float lo, float hi) { return f2bf(lo) | (f2bf(hi) << 16); }

#define XB_TMO      128
#define XB_XCNT(j)  (256  + 64 * (j))
#define XB_XSUB(j)  (1280 + 64 * (j))
#define XB_XGEN(j)  (2304 + 64 * (j))
#define XB_TOP      3328
#define XB_TOPGEN   3392
#define XCD_BAR_WORDS 3456
#define XB_SPIN_CAP (1u << 18)

__device__ __forceinline__ unsigned xb_ld(unsigned* p)              { return __hip_atomic_load(p, __ATOMIC_RELAXED, __HIP_MEMORY_SCOPE_AGENT); }
__device__ __forceinline__ unsigned xb_add(unsigned* p, unsigned v) { return __hip_atomic_fetch_add(p, v, __ATOMIC_RELAXED, __HIP_MEMORY_SCOPE_AGENT); }
__device__ __forceinline__ unsigned xb_xcc_id() { return (unsigned)__builtin_amdgcn_s_getreg((3 << 11) | 20) & 0xFu; }
#define XB_SPIN(cond, bar) do { unsigned _sp = 0; while (cond) { __builtin_amdgcn_s_sleep(1); \
    if ((++_sp & 255u) == 0u) { if (xb_ld(&(bar)[XB_TMO])) break; if (_sp > XB_SPIN_CAP) { atomicAdd(&(bar)[XB_TMO], 1u); break; } } } } while (0)

struct XcdBarrier {
    unsigned* bar; unsigned x;
    volatile LAS unsigned* st;
};

__device__ __forceinline__ XcdBarrier xcd_barrier_post(unsigned* bar, volatile LAS unsigned* st) {
    XcdBarrier b; b.bar = bar; b.x = xb_xcc_id(); b.st = st;
    if (threadIdx.x == 0) st[2] = xb_add(&bar[XB_XCNT(b.x)], 1u);
    return b;
}
__device__ __forceinline__ void xcd_barrier_complete(unsigned* bar, unsigned x, unsigned& nloc, unsigned& nx) {
    const unsigned G = gridDim.x * gridDim.y * gridDim.z;
    unsigned sum, cnt, mine, sp = 0u;
    for (;;) {
        sum = 0u; cnt = 0u; mine = 0u;
#pragma unroll
        for (unsigned j = 0; j < 16; ++j) { const unsigned c = xb_ld(&bar[XB_XCNT(j)]); sum += c; cnt += (c > 0u) ? 1u : 0u; mine = (j == x) ? c : mine; }
        if (sum == G) break;
        __builtin_amdgcn_s_sleep(1);
        if ((++sp & 255u) == 0u) { if (xb_ld(&bar[XB_TMO])) break; if (sp > XB_SPIN_CAP) { atomicAdd(&bar[XB_TMO], 1u); break; } }
    }
    nloc = mine > 0u ? mine : 1u; nx = cnt > 0u ? cnt : 1u;
}

__device__ __forceinline__ void xcd_barrier(const XcdBarrier& b) {
    asm volatile("s_waitcnt vmcnt(0)" ::: "memory");
    __syncthreads();
    if (threadIdx.x == 0) {
        unsigned* bar = b.bar;
        __builtin_amdgcn_s_waitcnt(0);
        unsigned nloc = b.st[0], nx = b.st[1];
        if (nloc == 0u) { xcd_barrier_complete(bar, b.x, nloc, nx); b.st[0] = nloc; b.st[1] = nx; }
        const unsigned old = xb_add(&bar[XB_XSUB(b.x)], 1u);
        const unsigned gen = old / nloc;
        if (old + 1u == (gen + 1u) * nloc) {
            __builtin_amdgcn_fence(__ATOMIC_RELEASE, "agent");
            asm volatile("s_waitcnt vmcnt(0)" ::: "memory");
            const unsigned og = xb_add(&bar[XB_TOP], 1u);
            const unsigned tg = og / nx;
            if (og + 1u == (tg + 1u) * nx) xb_add(&bar[XB_TOPGEN], 1u);
            else XB_SPIN(xb_ld(&bar[XB_TOPGEN]) == tg, bar);
            __builtin_amdgcn_fence(__ATOMIC_ACQUIRE, "agent");
            xb_add(&bar[XB_XGEN(b.x)], 1u);
            asm volatile("s_waitcnt vmcnt(0)" ::: "memory");
        } else {
            XB_SPIN(xb_ld(&bar[XB_XGEN(b.x)]) == gen, bar);
            __builtin_amdgcn_fence(__ATOMIC_ACQUIRE, "agent");
            asm volatile("s_waitcnt vmcnt(0)" ::: "memory");
        }
    }
    __syncthreads();
}

__device__ __forceinline__ void xcc_barrier(const XcdBarrier& b) {
    asm volatile("s_waitcnt vmcnt(0)" ::: "memory");
    __syncthreads();
    if (threadIdx.x == 0) {
        unsigned* bar = b.bar;
        __builtin_amdgcn_s_waitcnt(0);
        const unsigned nloc = b.st[0];
        const unsigned old = xb_add(&bar[XB_XSUB(b.x)], 1u);
        const unsigned gen = old / nloc;
        if (old + 1u == (gen + 1u) * nloc) xb_add(&bar[XB_XGEN(b.x)], 1u);
        else XB_SPIN(xb_ld(&bar[XB_XGEN(b.x)]) == gen, bar);
        __builtin_amdgcn_fence(__ATOMIC_ACQUIRE, "agent");
        asm volatile("s_waitcnt vmcnt(0)" ::: "memory");
    }
    __syncthreads();
}
__device__ __forceinline__ bool xcc_team_setup(const XcdBarrier& b) {
    if (threadIdx.x < 64) { const unsigned G = gridDim.x, j = threadIdx.x & 15u;
        const unsigned c = xb_ld(&b.bar[XB_XCNT(j)]);
        const bool okl = (j < 8u) ? (c == G / 8u) : (c == 0u);
        const bool ok = ((G % 8u) == 0u) && (__all(okl ? 1 : 0) != 0);
        if (threadIdx.x == 0) b.st[3] = ok ? 1u : 0u; }
    __syncthreads();
    return b.st[3] != 0u;
}

constexpr int NWAVES = 8;
constexpr int M_TOK = 32768, D_MODEL = 1024, SEQ_L = 4096, FFN_H = 2816, IN_COLS = 1952;
constexpr size_t MiB = 1u << 20;
constexpr size_t WS_CTL = 0, CTL_ZERO_BYTES = 128 * 1024;
constexpr size_t WS_WIN = 2 * MiB;
constexpr size_t WS_WQKV = 6 * MiB;
constexpr size_t WS_WO = 8 * MiB;
constexpr size_t WS_WGU = 10 * MiB;
constexpr size_t WS_WD = 22 * MiB;
constexpr size_t WS_XCH = 27 * MiB + 512 * 1024;
constexpr size_t WS_ROPE = 28 * MiB;
constexpr size_t WS_RSTDX = 28 * MiB + 512 * 1024;
constexpr size_t WS_SSQQ = 29 * MiB;
constexpr size_t WS_SSQKV = 29 * MiB + 512 * 1024;
constexpr size_t WS_SSQX1 = 30 * MiB;
constexpr size_t WS_XN = 32 * MiB;
constexpr size_t WS_CQKV = 96 * MiB;
constexpr size_t WS_KR = 120 * MiB;
constexpr size_t WS_DQ = 128 * MiB, WS_DK = 160 * MiB, WS_DV = 192 * MiB;
constexpr size_t WS_QA = 224 * MiB;
constexpr size_t WS_KN = 272 * MiB, WS_VA = 304 * MiB;
constexpr size_t WS_MIX = 336 * MiB;
constexpr size_t WS_OB = 400 * MiB;
constexpr size_t WS_H = 96 * MiB;
constexpr size_t WS_END = 464 * MiB;
static_assert(WS_H + (size_t)M_TOK * FFN_H * 2 <= WS_MIX, "h overlay");
constexpr int CW_TMO = 0, CW_CODE = 1, CW_BAR = 4096, CW_SEAM = 16384;
constexpr int RING_OFF = 0, RING_BYTES = 131072;
constexpr int LDS_BYTES = 147456;
constexpr int XL_OFF = RING_BYTES;
constexpr int LDSCTL_OFF = LDS_BYTES - 1024, MISC_OFF = LDSCTL_OFF + 320;
static_assert(att::Lay<64, 128>::LDS_END <= LDSCTL_OFF && att::Lay<96, 64>::LDS_END <= LDSCTL_OFF, "attention scratch stays below the control words");

struct Args { const float* in[19]; float* out; unsigned char* ws; int ph_lo, ph_hi; };
static_assert(sizeof(Args) == 19 * 8 + 8 + 8 + 8, "no padding in Args");

__device__ __forceinline__ float wave_sum(float v) {
#pragma unroll
    for (int o = 1; o < 64; o <<= 1) v += __shfl_xor(v, o);
    return v;
}
__device__ __forceinline__ void transpose_item(const float* W, int ldw, const float* gain, bf16* WT, int ldt, LAS float* scr, int ks0, int kd0, int drow0, int srccol, int lane) {
    float v[32]; const int sc = srccol < 0 ? 0 : srccol;
#pragma unroll
    for (int i = 0; i < 32; ++i) { const int kk = 2 * i + (lane >> 5); v[i] = __builtin_nontemporal_load(&W[(size_t)(ks0 + kk) * ldw + sc]); }
    if (gain) {
        float gg[32];
#pragma unroll
        for (int i = 0; i < 32; ++i) { const int kk = 2 * i + (lane >> 5); gg[i] = gain[ks0 + kk]; }
#pragma unroll
        for (int i = 0; i < 32; ++i) v[i] *= gg[i];
    }
#pragma unroll
    for (int i = 0; i < 32; ++i) { const int kk = 2 * i + (lane >> 5); scr[kk * 33 + (lane & 31)] = srccol < 0 ? 0.f : v[i]; }
    LDS_WAIT(); asm volatile("" ::: "memory");
    const int c = lane & 7;
#pragma unroll
    for (int j = 0; j < 4; ++j) { const int n = (lane >> 3) + 8 * j; const LAS float* s = scr + (8 * c) * 33 + n;
        v4u o; o.x = pk2(s[0 * 33], s[1 * 33]); o.y = pk2(s[2 * 33], s[3 * 33]); o.z = pk2(s[4 * 33], s[5 * 33]); o.w = pk2(s[6 * 33], s[7 * 33]);
        *(GAS v4u*)(WT + (size_t)(drow0 + n) * ldt + kd0 + 8 * c) = o; }
    LDS_WAIT(); asm volatile("" ::: "memory");
}
__device__ __forceinline__ int map_win(int n) {
    if (n < 256) return n;
    if (n < 512) { const int j = n - 256; if (j < 128) return 256 + j; if (j < 160) { const int p = j - 128; return 384 + (p >> 1) + 16 * (p & 1); } return -1; }
    return 416 + (n - 512);
}
__device__ __forceinline__ int map_wq(int n) {
    if (n < 512) return (n >> 6) * 96 + (n & 63);
    const int j = n - 512, h = j >> 5, p = j & 31; return h * 96 + 64 + (p >> 1) + 16 * (p & 1);
}
__device__ __forceinline__ int map_wkv(int n) {
    if (n < 512) return (n >> 6) * 128 + (n & 63);
    const int j = n - 512; return (j >> 6) * 128 + 64 + (j & 63);
}

__constant__ float ROPE_INV_FREQ[16] = {1.0f, 0.5623413324356079f, 0.3162277638912201f, 0.17782793939113617f, 0.10000000149011612f, 0.05623413249850273f, 0.03162277489900589f, 0.017782794311642647f,
    0.009999999776482582f, 0.005623413249850273f, 0.003162277629598975f, 0.0017782794311642647f, 0.0010000000474974513f, 0.000562341301701963f, 0.0003162277571391314f, 0.00017782794020604342f};

struct Frame {
    LAS unsigned char* lds; volatile LAS unsigned* MISC; gu32* ctl;
    int wave, vcu, G;
};

__global__ void __launch_bounds__(NWAVES * 64, 2) hyb_fwd(Args args) {
    extern __shared__ __attribute__((aligned(16))) unsigned char lds[];
    Frame F;
    F.lds = (LAS unsigned char*)lds; F.MISC = (volatile LAS unsigned*)(F.lds + MISC_OFF);
    F.wave = __builtin_amdgcn_readfirstlane((int)threadIdx.x >> 6);
    F.G = gridDim.x; { const int bx = blockIdx.x; F.vcu = (F.G % 8 == 0) ? (bx % 8) * (F.G / 8) + bx / 8 : bx; }
    F.ctl = (gu32*)(args.ws + WS_CTL);
#define CAS __attribute__((address_space(4)))
#define PH_BEGIN() const CAS char* kap_ = (const CAS char*)__builtin_amdgcn_kernarg_segment_ptr(); asm volatile("" : "+s"(kap_)); unsigned char* const ws = *(unsigned char* const CAS*)(kap_ + 160)
#define INP(k) (*(const float* const CAS*)(kap_ + 8 * (k)))
#define OUTP() (*(float* const CAS*)(kap_ + 152))
#define Win_t ((bf16*)(ws + WS_WIN))
#define Wqkv_t ((bf16*)(ws + WS_WQKV))
#define Wo_t ((bf16*)(ws + WS_WO))
#define Wgu_t ((bf16*)(ws + WS_WGU))
#define Wd_t ((bf16*)(ws + WS_WD))
#define ROPE ((float*)(ws + WS_ROPE))
#define RSTDX ((float*)(ws + WS_RSTDX))
#define SSQ_Q ((float*)(ws + WS_SSQQ))
#define SSQ_KV ((float*)(ws + WS_SSQKV))
#define SSQ_X1 ((float*)(ws + WS_SSQX1))
#define XN ((bf16*)(ws + WS_XN))
#define CQKV ((bf16*)(ws + WS_CQKV))
#define KR ((bf16*)(ws + WS_KR))
#define DQ ((bf16*)(ws + WS_DQ))
#define DK ((bf16*)(ws + WS_DK))
#define DVb ((bf16*)(ws + WS_DV))
#define QA ((bf16*)(ws + WS_QA))
#define KN ((bf16*)(ws + WS_KN))
#define VA ((bf16*)(ws + WS_VA))
#define MIX ((bf16*)(ws + WS_MIX))
#define OB ((float*)(ws + WS_OB))
#define X1B ((bf16*)(ws + WS_OB))
#define HB ((bf16*)(ws + WS_H))
    for (int u = threadIdx.x; u < (LDS_BYTES - LDSCTL_OFF) / 4; u += NWAVES * 64) ((LAS unsigned*)(F.lds + LDSCTL_OFF))[u] = 0u;
    __syncthreads();
    XcdBarrier bar = xcd_barrier_post((unsigned*)(F.ctl + CW_BAR), F.MISC + 8);
    const int lo = args.ph_lo, hi = args.ph_hi;
#ifndef PHASES
#define PHASES 0xFF
#endif
#define IN(k) (((PHASES >> (k)) & 1) && lo <= (k) && (k) < hi)
#define BOTH(k) (IN(k) && IN((k) + 1))
#define GRID_BAR() do { if (team) xcc_barrier(bar); else xcd_barrier(bar); } while (0)
    bool team = false; int bxv = (int)blockIdx.x;
#ifndef PROBE_REPEAT
#define PROBE_REPEAT -1
#endif
#define REPS(k) ((PROBE_REPEAT == (k)) ? reps2 : 1)
    int reps2 = 2; asm volatile("" : "+s"(reps2));
    const int gw = F.vcu * NWAVES + F.wave, NGW = F.G * NWAVES;

    if (IN(0)) _Pragma("nounroll") for (int rep_ = 0; rep_ < REPS(0); ++rep_) {
        PH_BEGIN(); const int tid_ = att::otid(), lane_ = tid_ & 63;
        const float* x = INP(0); const float* w_in = INP(1); const float* g_attn = INP(2); const float* g_q_a = INP(3); const float* w_q_b = INP(4); const float* g_kv_a = INP(5); const float* w_kv_b = INP(6);
        const float* w_o = INP(13); const float* g_ffn = INP(14); const float* w_gate = INP(15); const float* w_up = INP(16); const float* w_down = INP(17);
        LAS float* scr = (LAS float*)(F.lds + RING_OFF + F.wave * 16384);
        constexpr int I_IN = 16 * 64, I_Q = 4 * 24, I_KV = 2 * 32, I_O = 16 * 32, I_GU = 16 * 176, I_D = 44 * 32;
        constexpr int NITEMS = I_IN + I_Q + I_KV + I_O + I_GU + I_D;
        for (int it = gw; it < NITEMS; it += NGW) {
            int r = it; const int l31 = lane_ & 31;
            if (r < I_IN) { const int kb = r / 64, nb = r % 64; transpose_item(w_in, IN_COLS, g_attn, Win_t, 1024, scr, 64 * kb, 64 * kb, 32 * nb, map_win(32 * nb + l31), lane_); continue; } r -= I_IN;
            if (r < I_Q) { const int kb = r / 24, nb = r % 24; transpose_item(w_q_b, 768, g_q_a, Wqkv_t, 384, scr, 64 * kb, 64 * kb, 32 * nb, map_wq(32 * nb + l31), lane_); continue; } r -= I_Q;
            if (r < I_KV) { const int kb = r / 32, nb = r % 32; transpose_item(w_kv_b, 1024, g_kv_a, Wqkv_t, 384, scr, 64 * kb, 256 + 64 * kb, 768 + 32 * nb, map_wkv(32 * nb + l31), lane_); continue; } r -= I_KV;
            if (r < I_O) { const int kb = r / 32, nb = r % 32; transpose_item(w_o, 1024, nullptr, Wo_t, 1024, scr, 64 * kb, 64 * kb, 32 * nb, 32 * nb + l31, lane_); continue; } r -= I_O;
            if (r < I_GU) { const int kb = r / 176, nb = r % 176; const int n = 32 * nb + l31, pn = n >> 8, j = n & 255; const bool up = j >= 128;
                transpose_item(up ? w_up : w_gate, FFN_H, g_ffn, Wgu_t, 1024, scr, 64 * kb, 64 * kb, 32 * nb, 128 * pn + (j & 127), lane_); continue; } r -= I_GU;
            { const int kb = r / 32, nb = r % 32; transpose_item(w_down, 1024, nullptr, Wd_t, FFN_H, scr, 64 * kb, 64 * kb, 32 * nb, 32 * nb + l31, lane_); }
        }
        { const int gt = F.vcu * (NWAVES * 64) + tid_, NGT = F.G * NWAVES * 64; const v4u z = (v4u){0u, 0u, 0u, 0u};
          for (int i = gt; i < 768 * 16; i += NGT) *(GAS v4u*)(Wqkv_t + (size_t)(i >> 4) * 384 + 256 + (i & 15) * 8) = z;
          for (int i = gt; i < 1024 * 32; i += NGT) *(GAS v4u*)(Wqkv_t + (size_t)(768 + (i >> 5)) * 384 + (i & 31) * 8) = z;
          for (int i = gt; i < SEQ_L * 16; i += NGT) { const int pos = i >> 4, k = i & 15; const float ang = (float)pos * ROPE_INV_FREQ[k];
              const double t = (double)ang * 0.15915494309189535; const float fr = (float)(t - __builtin_rint(t));
              ROPE[2 * i] = __builtin_amdgcn_cosf(fr); ROPE[2 * i + 1] = __builtin_amdgcn_sinf(fr); } }
        { for (int m = gw; m < M_TOK; m += 4 * NGW) { f32x4 v[4][4]; float s[4];
#pragma unroll
              for (int q = 0; q < 4; ++q) { const GAS f32x4* xr = (const GAS f32x4*)(x + (size_t)(m + q * NGW) * D_MODEL) + lane_;
#pragma unroll
                  for (int j = 0; j < 4; ++j) v[q][j] = __builtin_nontemporal_load(&xr[64 * j]); }
#pragma unroll
              for (int q = 0; q < 4; ++q) { float t = 0.f;
#pragma unroll
                  for (int j = 0; j < 4; ++j) t += (v[q][j].x * v[q][j].x + v[q][j].y * v[q][j].y) + (v[q][j].z * v[q][j].z + v[q][j].w * v[q][j].w);
                  s[q] = t; }
#pragma unroll
              for (int o = 1; o < 64; o <<= 1)
#pragma unroll
                  for (int q = 0; q < 4; ++q) s[q] += __shfl_xor(s[q], o);
#pragma unroll
              for (int q = 0; q < 4; ++q) { const float rstd = __builtin_amdgcn_rsqf(s[q] * (1.f / D_MODEL) + 1e-6f);
                  GAS unsigned long long* o8 = (GAS unsigned long long*)(XN + (size_t)(m + q * NGW) * D_MODEL) + lane_;
#pragma unroll
                  for (int j = 0; j < 4; ++j) { const f32x4 y = v[q][j]; o8[64 * j] = (unsigned long long)pk2(y.x, y.y) | ((unsigned long long)pk2(y.z, y.w) << 32); }
                  if (lane_ == 0) RSTDX[m + q * NGW] = rstd; } } }
        if (BOTH(0) && rep_ == REPS(0) - 1) { xcd_barrier(bar);
#ifndef NO_TEAM
            team = xcc_team_setup(bar);
            if (team) { const int rank = (int)bar.st[2]; bxv = rank * 8 + (int)bar.x; F.vcu = (int)bar.x * (F.G / 8) + rank;
#if defined(STAGGER_TICKS) && STAGGER_TICKS > 0
                { const unsigned long long t0 = __builtin_amdgcn_s_memrealtime(), dt = (unsigned long long)bar.x * STAGGER_TICKS; while (__builtin_amdgcn_s_memrealtime() - t0 < dt) __builtin_amdgcn_s_sleep(8); }
#endif
            }
#endif
        }
        if (PROBE_REPEAT == 9 && rep_ == 0) { _Pragma("nounroll") for (int q_ = 0; q_ < 4 * reps2; ++q_) GRID_BAR(); }
    }
    if (IN(1)) _Pragma("nounroll") for (int rep_ = 0; rep_ < REPS(1); ++rep_) {
        PH_BEGIN();
        pg8::Gemm g{XN, Win_t, M_TOK, 2048, D_MODEL}; pg8::StaticOrder S; S.init(M_TOK, 2048, F.G, bxv);
        pg8::EpiInProj E{CQKV, KR, DQ, DK, DVb, SSQ_Q, SSQ_KV, ROPE, RSTDX, 0.125f * 1.4426950408889634f};
        pg8::gemm_phase<pg8::EpiInProj, pg8::StaticOrder, true, true>(F.lds + RING_OFF, g, S, E);
        if (BOTH(1) && rep_ == REPS(1) - 1) GRID_BAR();
    }
    if (IN(2)) _Pragma("nounroll") for (int rep_ = 0; rep_ < REPS(2); ++rep_) {
        PH_BEGIN();
        int kq_ = 384; asm volatile("" : "+s"(kq_));
        pg8::Gemm g{CQKV, Wqkv_t, M_TOK, 1792, kq_}; pg8::SplitOrder S; S.init(M_TOK, 1792, F.G, bxv);
        pg8::EpiQKV E{QA, KN, VA, SSQ_Q, SSQ_KV, ROPE, 0.10206207261596575f * 1.4426950408889634f};
        pg8::gemm_phase<pg8::EpiQKV, pg8::SplitOrder, true, true>(F.lds + RING_OFF, g, S, E);
        if (BOTH(2) && rep_ == REPS(2) - 1) GRID_BAR();
    }
    if (IN(3)) _Pragma("nounroll") for (int rep_ = 0; rep_ < REPS(3); ++rep_) {
        PH_BEGIN();
        const float* lam_q1 = INP(7); const float* lam_k1 = INP(8); const float* lam_q2 = INP(9); const float* lam_k2 = INP(10); const float* g_subln = INP(11); const float* rel_bias = INP(12);
        char* shm = (char*)lds + RING_OFF;
#ifndef ATT_ONLY
#define ATT_ONLY 3
#endif
        if (ATT_ONLY & 1) { const att::MlaT T{QA, KN, KR, VA, MIX}; const int bb = F.vcu >> 5, v = F.vcu & 31;
          for (int i = 0; i < 4; ++i) { const int qb = (i & 1) ? 15 - (v & 15) : (v & 15); att::mla_unit(bb, 2 * i + (v >> 4), qb, T, shm); } }
        if (ATT_ONLY & 2) { float lam;
          { const float a = wave_sum(lam_q1[att::otid() & 63] * lam_k1[att::otid() & 63]), b2 = wave_sum(lam_q2[att::otid() & 63] * lam_k2[att::otid() & 63]); lam = __expf(a) - __expf(b2) + 0.2f; }
          const att::DiffT T{DQ, DK, DVb, MIX, OB, rel_bias, g_subln, lam}; const int bb = F.vcu >> 5, v = F.vcu & 31;
          for (int i = 0; i < 2; ++i) { const int qb = (i & 1) ? 15 - (v & 15) : (v & 15); att::diff_unit(bb, 2 * i + (v >> 4), qb, T, shm); } }
        if (BOTH(3) && rep_ == REPS(3) - 1) GRID_BAR();
    }
    if (IN(4)) _Pragma("nounroll") for (int rep_ = 0; rep_ < REPS(4); ++rep_) {
        PH_BEGIN();
        pg8::Gemm g{MIX, Wo_t, M_TOK, D_MODEL, D_MODEL}; pg8::StaticOrder S; S.init(M_TOK, D_MODEL, F.G, bxv);
        pg8::EpiOutProj E{XN, X1B, SSQ_X1};
        pg8::gemm_phase<pg8::EpiOutProj, pg8::StaticOrder, true, true>(F.lds + RING_OFF, g, S, E);
        if (BOTH(4) && rep_ == REPS(4) - 1) GRID_BAR();
    }
    if (IN(5)) _Pragma("nounroll") for (int rep_ = 0; rep_ < REPS(5); ++rep_) {
        PH_BEGIN();
        pg8::Gemm g{X1B, Wgu_t, M_TOK, 2 * FFN_H, D_MODEL}; pg8::StaticOrder S; S.init(M_TOK, 2 * FFN_H, F.G, bxv);
        const pg8::HMap hm{ws, WS_XN, WS_MIX, WS_DQ, WS_DK, WS_DV}; pg8::EpiGateUp E{hm, SSQ_X1};
        pg8::gemm_phase<pg8::EpiGateUp, pg8::StaticOrder, true, true>(F.lds + RING_OFF, g, S, E);
        if (BOTH(5) && rep_ == REPS(5) - 1) GRID_BAR();
    }
    if (IN(6)) _Pragma("nounroll") for (int rep_ = 0; rep_ < REPS(6); ++rep_) {
        PH_BEGIN(); float* out = OUTP(); const float* g_final = INP(18);
        pg8::Gemm g{HB, Wd_t, M_TOK, D_MODEL, FFN_H}; pg8::PanelOrder S; S.init(M_TOK, D_MODEL, F.G, bxv); S.hm = pg8::HMap{ws, WS_XN, WS_MIX, WS_DQ, WS_DK, WS_DV};
        pg8::EpiDownNorm E{X1B, out, g_final, (unsigned*)(ws + WS_XCH), (unsigned*)(F.ctl + CW_SEAM), F.lds + XL_OFF};
        pg8::gemm_phase<pg8::EpiDownNorm, pg8::PanelOrder, true, true>(F.lds + RING_OFF, g, S, E);
    }
#undef IN
#undef BOTH
#undef GRID_BAR
}

#ifndef MK_N_LAUNCHES
#define MK_N_LAUNCHES 1
#endif
extern "C" void kernel_launch(void* const* d_in, const int* in_sizes, int n_in, void* d_out, int out_size, void* d_ws, size_t ws_size, hipStream_t stream) {
    static int grid = 0;
    if (grid == 0) {
        if (n_in != 19 || in_sizes[0] != M_TOK * D_MODEL || out_size != M_TOK * D_MODEL || ws_size < WS_END) { fprintf(stderr, "kernel_launch: unexpected shapes (n_in %d, in0 %d, out %d, ws %zu)\n", n_in, n_in > 0 ? in_sizes[0] : -1, out_size, ws_size); grid = -1; return; }
        int dev = 0, cus = 0, per_cu = 0;
        if (hipGetDevice(&dev) != hipSuccess || hipDeviceGetAttribute(&cus, hipDeviceAttributeMultiprocessorCount, dev) != hipSuccess) { grid = -1; return; }
        if (hipFuncSetAttribute((const void*)hyb_fwd, hipFuncAttributeMaxDynamicSharedMemorySize, LDS_BYTES) != hipSuccess) { fprintf(stderr, "kernel_launch: hipFuncSetAttribute failed\n"); grid = -1; return; }
        if (hipOccupancyMaxActiveBlocksPerMultiprocessor(&per_cu, (const void*)hyb_fwd, NWAVES * 64, LDS_BYTES) != hipSuccess || per_cu < 1) fprintf(stderr, "kernel_launch: occupancy query reports %d\n", per_cu);
        (void)hipGetLastError();
        grid = cus;
        if (grid != 256) fprintf(stderr, "kernel_launch: %d CUs (built for 256)\n", grid);
    }
    if (grid < 0) return;
    if (hipMemsetAsync((char*)d_ws + WS_CTL, 0, CTL_ZERO_BYTES, stream) != hipSuccess) return;
    Args a{};
    for (int i = 0; i < 19; ++i) a.in[i] = (const float*)d_in[i];
    a.out = (float*)d_out; a.ws = (unsigned char*)d_ws;
    if (MK_N_LAUNCHES == 1) { a.ph_lo = 0; a.ph_hi = 7; hipLaunchKernelGGL(hyb_fwd, dim3(grid), dim3(NWAVES * 64), LDS_BYTES, stream, a); }
    else { for (int p = 0; p < 7; ++p) { a.ph_lo = p; a.ph_hi = p + 1; hipLaunchKernelGGL(hyb_fwd, dim3(grid), dim3(NWAVES * 64), LDS_BYTES, stream, a); } }
}
```

```cpp
#include <hip/hip_runtime.h>
#include <cstdio>
#include <cstdint>
namespace pg8 {
#define PG8_LAS __attribute__((address_space(3)))
typedef unsigned short bf16_t;
typedef short bf16x8 __attribute__((ext_vector_type(8)));
typedef float f32x4 __attribute__((ext_vector_type(4)));
typedef unsigned u32x4 __attribute__((ext_vector_type(4)));
constexpr int BM = 256, BK = 64, HALF = 128, HTB = HALF * BK * 2  , STAGE_BYTES = 8 * HTB, NXCD = 8, WGM = 8;

__host__ __device__ __forceinline__ int lds_byte(int r, int c) { const int st = (r >> 4) * 2 + (c >> 5), rr = r & 15, cc = c & 31, ob = rr * 64 + cc * 2; return st * 1024 + (ob ^ (((ob >> 9) & 1) << 5)); }
__host__ __device__ __forceinline__ void stage_rc(int b, int& R, int& C) { const int st = b / 1024, sb = b % 1024, swz = sb ^ (((sb >> 9) & 1) << 5); R = (st >> 1) * 16 + swz / 64; C = (st & 1) * 32 + (swz % 64) / 2; }
__host__ __device__ __forceinline__ int perm32(int rho) { const int n = rho >> 4, i = rho & 15; return 8 * (i >> 2) + 4 * n + (i & 3); }

struct Unit { int pm, pn; int kofs, nt; };
struct Gemm { const bf16_t* A; const bf16_t* Bt; int M, N, K; };

struct StaticOrder {
    static constexpr bool KSPLIT = false, APANEL = false;
    int nM, nN, nwg, G, c;
    __host__ __device__ void init(int M, int N, int G_, int c_) { nM = M / BM; nN = N / BM; nwg = nM * nN; G = G_; c = c_; }
    __host__ __device__ bool next(int i, Unit& u) const {
        const long L = (long)i * G + c; if (L >= nwg) return false;
        int wgid = (int)L; { const int q = nwg / NXCD, r = nwg % NXCD, xcd = wgid % NXCD, off = wgid / NXCD; wgid = (xcd < r ? xcd * (q + 1) : r * (q + 1) + (xcd - r) * q) + off; }
        const int nig = WGM * nN, gid = wgid / nig, fm = gid * WGM, gsz = (nM - fm) < WGM ? (nM - fm) : WGM;
        u.pm = fm + ((wgid % nig) % gsz); u.pn = (wgid % nig) / gsz; return true;
    }
    __device__ __forceinline__ void a_ready(const Unit&) const {}
    __device__ __forceinline__ void done(const Unit&) const {}
};

typedef float f32x2p __attribute__((ext_vector_type(2))); typedef __bf16 bf16x2p __attribute__((ext_vector_type(2)));
__device__ __forceinline__ unsigned cvt_pk_bf16(float lo, float hi) { f32x2p v = {lo, hi}; bf16x2p b = __builtin_convertvector(v, bf16x2p); return __builtin_bit_cast(unsigned, b); }
typedef float f32x2 __attribute__((ext_vector_type(2)));
__device__ __forceinline__ u32x4 pack8(const f32x4 a, const f32x4 b) { u32x4 w; w.x = cvt_pk_bf16(a[0], a[1]); w.y = cvt_pk_bf16(a[2], a[3]); w.z = cvt_pk_bf16(b[0], b[1]); w.w = cvt_pk_bf16(b[2], b[3]); return w; }
__device__ __forceinline__ float sq8(const f32x4 a, const f32x4 b) { return ((a[0] * a[0] + a[1] * a[1]) + (a[2] * a[2] + a[3] * a[3])) + ((b[0] * b[0] + b[1] * b[1]) + (b[2] * b[2] + b[3] * b[3])); }
__device__ __forceinline__ float fq_sum(float s) {
    s += __int_as_float(__builtin_amdgcn_ds_swizzle(__float_as_int(s), (16 << 10) | 0x1f));
    auto rr = __builtin_amdgcn_permlane32_swap(__float_as_uint(s), __float_as_uint(s), false, false); return __uint_as_float(rr[0]) + __uint_as_float(rr[1]); }
__device__ __forceinline__ void rope8(f32x4& v0, f32x4& v1, const f32x4 cs0, const f32x4 cs1) {
    const float a0 = v0[0] * cs0[0] - v0[1] * cs0[1], b0 = v0[1] * cs0[0] + v0[0] * cs0[1];
    const float a1 = v0[2] * cs0[2] - v0[3] * cs0[3], b1 = v0[3] * cs0[2] + v0[2] * cs0[3];
    const float a2 = v1[0] * cs1[0] - v1[1] * cs1[1], b2 = v1[1] * cs1[0] + v1[0] * cs1[1];
    const float a3 = v1[2] * cs1[2] - v1[3] * cs1[3], b3 = v1[3] * cs1[2] + v1[2] * cs1[3];
    v0 = (f32x4){a0, b0, a1, b1}; v1 = (f32x4){a2, b2, a3, b3};
}
constexpr int SEQ_LEN = 4096;
constexpr float RMS_EPS = 1e-6f;

__device__ __forceinline__ u32x4 tr16x4(const u32x4 w, const int bidx) { u32x4 r; r.x = __builtin_amdgcn_ds_bpermute(bidx, w.x); r.y = __builtin_amdgcn_ds_bpermute(bidx, w.y); r.z = __builtin_amdgcn_ds_bpermute(bidx, w.z); r.w = __builtin_amdgcn_ds_bpermute(bidx, w.w); return r; }
#define EPI_LANE_T() const int bidx = (((t2_ & 3) * 16) + ((t2_ >> 2) & 15)) * 4, fr2 = (t2_ >> 2) & 15, fq2 = t2_ & 3
#define EPI_LANE() { int t_ = threadIdx.x; asm volatile("" : "+v"(t_)); fr = t_ & 15; fq = (t_ >> 4) & 3; }
struct EpiInProj {
    static constexpr bool PERM = true, AFTER_DRAIN = false;
    bf16_t *CQKV, *KR, *DQ, *DK, *DV; float *SSQ_Q, *SSQ_KV; const float* rope; const float* rstdx; float c2d;
    __device__ __forceinline__ void operator()(f32x4 (&acc)[2][2][4][2], const Unit& u, int wr, int wc, int fr, int fq) const {
        EPI_LANE(); int t2_ = threadIdx.x; asm volatile("" : "+v"(t2_)); EPI_LANE_T(); const int row2 = u.pm * BM + wr * 64 + fr2, cw2 = wc * 32 + 8 * fq2;
        const int row0 = u.pm * BM + wr * 64 + fr, cw = wc * 32 + 8 * fq;
        { float rx[2][4];
#pragma unroll
          for (int ai = 0; ai < 2; ++ai)
#pragma unroll
              for (int m = 0; m < 4; ++m) rx[ai][m] = rstdx[row0 + ai * HALF + m * 16];
#pragma unroll
          for (int ai = 0; ai < 2; ++ai)
#pragma unroll
              for (int m = 0; m < 4; ++m)
#pragma unroll
                  for (int bj = 0; bj < 2; ++bj) { acc[ai][bj][m][0] *= rx[ai][m]; acc[ai][bj][m][1] *= rx[ai][m]; } }
        if (u.pn == 0) {
#pragma unroll
            for (int ai = 0; ai < 2; ++ai)
#pragma unroll
                for (int m = 0; m < 4; ++m) { const size_t row = (size_t)(row0 + ai * HALF + m * 16); float s = 0.f;
#pragma unroll
                    for (int bj = 0; bj < 2; ++bj) { const f32x4 v0 = acc[ai][bj][m][0], v1 = acc[ai][bj][m][1]; s += sq8(v0, v1); *(u32x4*)(CQKV + (size_t)(row2 + ai * HALF + m * 16) * 384 + bj * HALF + cw2) = tr16x4(pack8(v0, v1), bidx); }
                    s = fq_sum(s); if (fq == 0) SSQ_Q[row * 4 + wc] = s; }
        } else if (u.pn == 1) {
            f32x4 cs[2][4][2];
            if (wc == 0) {
#pragma unroll
                for (int ai = 0; ai < 2; ++ai)
#pragma unroll
                    for (int m = 0; m < 4; ++m) { const float* t = rope + (size_t)((row0 + ai * HALF + m * 16) & (SEQ_LEN - 1)) * 32 + 8 * fq; cs[ai][m][0] = *(const f32x4*)t; cs[ai][m][1] = *(const f32x4*)(t + 4); }
            }
#pragma unroll
            for (int ai = 0; ai < 2; ++ai)
#pragma unroll
                for (int m = 0; m < 4; ++m) { const size_t row = (size_t)(row0 + ai * HALF + m * 16);
                    { const f32x4 v0 = acc[ai][0][m][0], v1 = acc[ai][0][m][1]; float s = sq8(v0, v1); *(u32x4*)(CQKV + (size_t)(row2 + ai * HALF + m * 16) * 384 + 256 + cw2) = tr16x4(pack8(v0, v1), bidx);
                      s = fq_sum(s); if (fq == 0) SSQ_KV[row * 4 + wc] = s; }
                    if (wc == 0) { f32x4 v0 = acc[ai][1][m][0], v1 = acc[ai][1][m][1]; rope8(v0, v1, cs[ai][m][0], cs[ai][m][1]); *(u32x4*)(KR + (size_t)(row2 + ai * HALF + m * 16) * 32 + 8 * fq2) = tr16x4(pack8(v0, v1), bidx); } }
        } else {
            bf16_t* dst = DQ + (size_t)((u.pn - 2) >> 1) * ((size_t)32768 * 512); const int cb2 = ((u.pn - 2) & 1) * 256 + cw2; const float sc = u.pn < 4 ? c2d : 1.f;
#pragma unroll
            for (int ai = 0; ai < 2; ++ai)
#pragma unroll
                for (int m = 0; m < 4; ++m) { const size_t row = (size_t)(row0 + ai * HALF + m * 16);
#pragma unroll
                    for (int bj = 0; bj < 2; ++bj) *(u32x4*)(dst + (size_t)(row2 + ai * HALF + m * 16) * 512 + cb2 + bj * HALF) = tr16x4(pack8(acc[ai][bj][m][0] * sc, acc[ai][bj][m][1] * sc), bidx); }
        }
    }
};
struct EpiQKV {
    static constexpr bool PERM = true, AFTER_DRAIN = false;
    bf16_t *QA, *KN, *VA; const float *SSQ_Q, *SSQ_KV; const float* rope; float c2a;
    __device__ __forceinline__ void rstd4(float (&rs)[4], const float* ssq, int rowb, float inv, float mul) const {
        f32x4 pp[4];
#pragma unroll
        for (int m = 0; m < 4; ++m) pp[m] = *(const f32x4*)(ssq + (size_t)(rowb + m * 16) * 4);
#pragma unroll
        for (int m = 0; m < 4; ++m) rs[m] = __builtin_amdgcn_rsqf(((pp[m][0] + pp[m][1]) + (pp[m][2] + pp[m][3])) * inv + RMS_EPS) * mul;
    }
    __device__ __forceinline__ void rstd8(float (&rs)[2][4], const float* ssq, int rowb, float inv, float mul) const {
        f32x4 pp[2][4];
#pragma unroll
        for (int ai = 0; ai < 2; ++ai)
#pragma unroll
            for (int m = 0; m < 4; ++m) pp[ai][m] = *(const f32x4*)(ssq + (size_t)(rowb + ai * HALF + m * 16) * 4);
#pragma unroll
        for (int ai = 0; ai < 2; ++ai)
#pragma unroll
            for (int m = 0; m < 4; ++m) rs[ai][m] = __builtin_amdgcn_rsqf(((pp[ai][m][0] + pp[ai][m][1]) + (pp[ai][m][2] + pp[ai][m][3])) * inv + RMS_EPS) * mul;
    }
    __device__ __forceinline__ void operator()(const f32x4 (&acc)[2][2][4][2], const Unit& u, int wr, int wc, int fr, int fq) const {
        EPI_LANE(); int t2_ = threadIdx.x; asm volatile("" : "+v"(t2_)); EPI_LANE_T(); const int row2 = u.pm * BM + wr * 64 + fr2, cw2 = wc * 32 + 8 * fq2;
        const int row0 = u.pm * BM + wr * 64 + fr, cw = wc * 32 + 8 * fq;
        if (u.pn < 2) {
            float rs2[2][4]; rstd8(rs2, SSQ_Q, row0, 1.f / 256.f, c2a);
#pragma unroll
            for (int ai = 0; ai < 2; ++ai) { const float (&rs)[4] = rs2[ai];
#pragma unroll
                for (int m = 0; m < 4; ++m) { const size_t row = (size_t)(row0 + ai * HALF + m * 16);
#pragma unroll
                    for (int bj = 0; bj < 2; ++bj) { const int n = u.pn * 256 + bj * HALF + cw2; *(u32x4*)(QA + (size_t)(row2 + ai * HALF + m * 16) * 768 + (n >> 6) * 96 + (n & 63)) = tr16x4(pack8(acc[ai][bj][m][0] * rs[m], acc[ai][bj][m][1] * rs[m]), bidx); } }
                asm volatile("" ::: "memory"); }
        } else if (u.pn == 2) {
            float rs2[2][4]; rstd8(rs2, SSQ_Q, row0, 1.f / 256.f, c2a);
            f32x4 cs[2][2][2];
#define QKV_CS_LOAD(B_, AI_, MP_) _Pragma("unroll") for (int mm = 0; mm < 2; ++mm) { const float* t = rope + (size_t)((row0 + (AI_) * HALF + (2 * (MP_) + mm) * 16) & (SEQ_LEN - 1)) * 32 + 8 * fq; cs[B_][mm][0] = *(const f32x4*)t; cs[B_][mm][1] = *(const f32x4*)(t + 4); }
            QKV_CS_LOAD(0, 0, 0);
#pragma unroll
            for (int ib = 0; ib < 4; ++ib) { const int ai = ib >> 1, mp = ib & 1, bb = ib & 1;
                if (ib + 1 < 4) { QKV_CS_LOAD((ib + 1) & 1, (ib + 1) >> 1, (ib + 1) & 1); }
#pragma unroll
                for (int mm = 0; mm < 2; ++mm) { const int m = 2 * mp + mm;
#pragma unroll
                    for (int bj = 0; bj < 2; ++bj) { f32x4 v0 = acc[ai][bj][m][0] * rs2[ai][m], v1 = acc[ai][bj][m][1] * rs2[ai][m]; rope8(v0, v1, cs[bb][mm][0], cs[bb][mm][1]); *(u32x4*)(QA + (size_t)(row2 + ai * HALF + m * 16) * 768 + (4 * bj + wc) * 96 + 64 + 8 * fq2) = tr16x4(pack8(v0, v1), bidx); } } }
#undef QKV_CS_LOAD
        } else {
            bf16_t* dst = KN + (size_t)((u.pn - 3) >> 1) * ((size_t)32768 * 512); const int cb2 = ((u.pn - 3) & 1) * 256 + cw2;
            float rs2[2][4]; rstd8(rs2, SSQ_KV, row0, 1.f / 128.f, 1.f);
#pragma unroll
            for (int ai = 0; ai < 2; ++ai) { const float (&rs)[4] = rs2[ai];
#pragma unroll
                for (int m = 0; m < 4; ++m) { const size_t row = (size_t)(row0 + ai * HALF + m * 16);
#pragma unroll
                    for (int bj = 0; bj < 2; ++bj) *(u32x4*)(dst + (size_t)(row2 + ai * HALF + m * 16) * 512 + cb2 + bj * HALF) = tr16x4(pack8(acc[ai][bj][m][0] * rs[m], acc[ai][bj][m][1] * rs[m]), bidx); }
                asm volatile("" ::: "memory"); }
        }
    }
};
struct EpiOutProj {
    static constexpr bool PERM = true, AFTER_DRAIN = false;
    const bf16_t* XB; bf16_t* X1B; float* SSQ;
    __device__ __forceinline__ void operator()(const f32x4 (&acc)[2][2][4][2], const Unit& u, int wr, int wc, int fr, int fq) const {
        EPI_LANE();
        int t2_ = threadIdx.x; asm volatile("" : "+v"(t2_)); EPI_LANE_T();
        const int row0 = u.pm * BM + wr * 64 + fr, cw = u.pn * BM + wc * 32 + 8 * fq;
        bf16_t* const st = X1B + (size_t)(u.pm * BM + wr * 64 + fr2) * 1024 + u.pn * BM + wc * 32 + 8 * fq2;
        u32x4 xb[2][4][2];
#pragma unroll
        for (int ai = 0; ai < 2; ++ai)
#pragma unroll
            for (int m = 0; m < 4; ++m)
#pragma unroll
                for (int bj = 0; bj < 2; ++bj) xb[ai][m][bj] = __builtin_nontemporal_load((const u32x4*)(XB + (size_t)(row0 + ai * HALF + m * 16) * 1024 + cw + bj * HALF));
#pragma unroll
        for (int ai = 0; ai < 2; ++ai)
#pragma unroll
            for (int m = 0; m < 4; ++m) { const size_t row = (size_t)(row0 + ai * HALF + m * 16); float s = 0.f;
#pragma unroll
                for (int bj = 0; bj < 2; ++bj) { const u32x4 w = xb[ai][m][bj];
                    const f32x4 v0 = acc[ai][bj][m][0] + (f32x4){__uint_as_float(w.x << 16), __uint_as_float(w.x & 0xffff0000u), __uint_as_float(w.y << 16), __uint_as_float(w.y & 0xffff0000u)};
                    const f32x4 v1 = acc[ai][bj][m][1] + (f32x4){__uint_as_float(w.z << 16), __uint_as_float(w.z & 0xffff0000u), __uint_as_float(w.w << 16), __uint_as_float(w.w & 0xffff0000u)};
                    s += sq8(v0, v1); *(u32x4*)(st + (size_t)(ai * HALF + m * 16) * 1024 + bj * HALF) = tr16x4(pack8(v0, v1), bidx); }
                s = fq_sum(s); if (fq == 0) SSQ[row * 16 + u.pn * 4 + wc] = s; }
    }
};
struct HMap { unsigned char* ws; size_t xn, mix, dq, dk, dv;
    __host__ __device__ __forceinline__ bf16_t* panel(int pm) const { const int b = pm >> 4, p = pm & 15; constexpr size_t PB = (size_t)256 * 2816 * 2, MB = (size_t)1 << 20;
        size_t off;
        if (p < 5) off = xn + (size_t)b * 8 * MB + (size_t)p * PB;
        else if (p < 10) off = mix + (size_t)b * 8 * MB + (size_t)(p - 5) * PB;
        else if (p < 12) off = dq + (size_t)b * 4 * MB + (size_t)(p - 10) * PB;
        else if (p < 14) off = dk + (size_t)b * 4 * MB + (size_t)(p - 12) * PB;
        else off = dv + (size_t)b * 4 * MB + (size_t)(p - 14) * PB;
        return (bf16_t*)(ws + off); } };
struct PanelOrder {
    static constexpr bool KSPLIT = false, APANEL = true;
    StaticOrder so; HMap hm;
    __host__ __device__ void init(int M, int N, int G_, int c_) { so.init(M, N, G_, c_); }
    __host__ __device__ bool next(int i, Unit& u) const { return so.next(i, u); }
    __device__ __forceinline__ const char* a_panel(int pm) const { return (const char*)hm.panel(pm); }
    __device__ __forceinline__ void a_ready(const Unit&) const {}
    __device__ __forceinline__ void done(const Unit&) const {}
};
struct EpiGateUp {
    static constexpr bool PERM = true, AFTER_DRAIN = false;
    HMap hm; const float* SSQ;
    __device__ __forceinline__ void operator()(const f32x4 (&acc)[2][2][4][2], const Unit& u, int wr, int wc, int fr, int fq) const {
        EPI_LANE(); int t2_ = threadIdx.x; asm volatile("" : "+v"(t2_)); EPI_LANE_T(); const int row2 = u.pm * BM + wr * 64 + fr2, cw2 = wc * 32 + 8 * fq2;
        const int row0 = u.pm * BM + wr * 64 + fr, cw = u.pn * HALF + wc * 32 + 8 * fq;
        bf16_t* const Hp = hm.panel(u.pm) + (size_t)(wr * 64 + fr2) * 2816 + u.pn * HALF + cw2;
        float rs[2][4];
        { f32x4 pp[2][4];
#pragma unroll
          for (int ai = 0; ai < 2; ++ai)
#pragma unroll
              for (int m = 0; m < 4; ++m) pp[ai][m] = *(const f32x4*)(SSQ + (size_t)(row0 + ai * HALF + m * 16) * 16 + 4 * fq);
#pragma unroll
          for (int ai = 0; ai < 2; ++ai)
#pragma unroll
              for (int m = 0; m < 4; ++m) rs[ai][m] = __builtin_amdgcn_rsqf(fq_sum((pp[ai][m][0] + pp[ai][m][1]) + (pp[ai][m][2] + pp[ai][m][3])) * (1.f / 1024.f) + RMS_EPS); }
#pragma unroll
        for (int ai = 0; ai < 2; ++ai)
#pragma unroll
            for (int m = 0; m < 4; ++m) { const size_t row = (size_t)(row0 + ai * HALF + m * 16); const float r = rs[ai][m];
                f32x4 hv[2];
#pragma unroll
                for (int n = 0; n < 2; ++n) { const f32x4 g = acc[ai][0][m][n] * r, up = acc[ai][1][m][n] * r;
#pragma unroll
                    for (int j = 0; j < 4; ++j) { const float e = __builtin_amdgcn_exp2f(g[j] * -1.4426950408889634f); hv[n][j] = g[j] * __builtin_amdgcn_rcpf(1.0f + e) * up[j]; } }
                *(u32x4*)(Hp + (size_t)(ai * HALF + m * 16) * 2816) = tr16x4(pack8(hv[0], hv[1]), bidx); }
    }
};
struct EpiDownNorm {
    static constexpr bool PERM = true, AFTER_DRAIN = false;
    const bf16_t* X1B; float* OUT; const float* G; unsigned* xbuf; unsigned* cnt; PG8_LAS unsigned char* xl;
    __device__ __forceinline__ void operator()(f32x4 (&acc)[2][2][4][2], const Unit& u, int wr, int wc, int fr, int fq) const {
        int t_ = threadIdx.x; asm volatile("" : "+v"(t_)); fr = t_ & 15; fq = (t_ >> 4) & 3; const int lane = t_ & 63, wid = wr * 4 + wc; const int t2_ = t_; EPI_LANE_T();
        PG8_LAS float* P = (PG8_LAS float*)xl; PG8_LAS float* S = (PG8_LAS float*)(xl + 4096); PG8_LAS unsigned* flag = (PG8_LAS unsigned*)(xl + 5120);
        const int row0 = u.pm * BM + wr * 64 + fr, cw = u.pn * BM + wc * 32 + 8 * fq;
        f32x4 gv[2][2];
#pragma unroll
        for (int bj = 0; bj < 2; ++bj) { gv[bj][0] = *(const f32x4*)(G + cw + bj * HALF); gv[bj][1] = *(const f32x4*)(G + cw + bj * HALF + 4); }
        u32x4 xb[2][4][2];
#pragma unroll
        for (int ai = 0; ai < 2; ++ai)
#pragma unroll
            for (int m = 0; m < 4; ++m)
#pragma unroll
                for (int bj = 0; bj < 2; ++bj) xb[ai][m][bj] = __builtin_nontemporal_load((const u32x4*)(X1B + (size_t)(row0 + ai * HALF + m * 16) * 1024 + cw + bj * HALF));
#pragma unroll
        for (int ai = 0; ai < 2; ++ai) {
#pragma unroll
            for (int m = 0; m < 4; ++m) { float s = 0.f;
#pragma unroll
                for (int bj = 0; bj < 2; ++bj) { const u32x4 w = xb[ai][m][bj];
                    const f32x4 a0 = (f32x4){__uint_as_float(w.x << 16), __uint_as_float(w.x & 0xffff0000u), __uint_as_float(w.y << 16), __uint_as_float(w.y & 0xffff0000u)};
                    const f32x4 a1 = (f32x4){__uint_as_float(w.z << 16), __uint_as_float(w.z & 0xffff0000u), __uint_as_float(w.w << 16), __uint_as_float(w.w & 0xffff0000u)};
                    acc[ai][bj][m][0] += a0; acc[ai][bj][m][1] += a1; s += sq8(acc[ai][bj][m][0], acc[ai][bj][m][1]); }
                s = fq_sum(s); if (fq == 0) P[(ai * HALF + wr * 64 + m * 16 + fr) * 4 + wc] = s; }
        }
        asm volatile("s_waitcnt lgkmcnt(0)" ::: "memory"); __builtin_amdgcn_s_barrier(); asm volatile("" ::: "memory");
        const int prow = wid * 32 + (lane & 31);
        if (lane < 32) { const float tot = (P[prow * 4 + 0] + P[prow * 4 + 1]) + (P[prow * 4 + 2] + P[prow * 4 + 3]);
            __hip_atomic_store(xbuf + ((size_t)(u.pm * BM + prow) * 4 + u.pn), __float_as_uint(tot), __ATOMIC_RELAXED, __HIP_MEMORY_SCOPE_AGENT); }
        asm volatile("s_waitcnt vmcnt(0)" ::: "memory");
        if (lane == 0) __hip_atomic_fetch_add(cnt + 64 * u.pm, 1u, __ATOMIC_RELAXED, __HIP_MEMORY_SCOPE_AGENT);
        if (wid == 0) { unsigned sp = 0;
            while ((unsigned)__builtin_amdgcn_readfirstlane(__hip_atomic_load(cnt + 64 * u.pm, __ATOMIC_RELAXED, __HIP_MEMORY_SCOPE_AGENT)) < 32u) { __builtin_amdgcn_s_sleep(2); if (++sp > (1u << 22)) break; }
            __builtin_amdgcn_fence(__ATOMIC_ACQUIRE, "agent");
            if (lane == 0) flag[0] = sp; }
        asm volatile("s_waitcnt vmcnt(0) lgkmcnt(0)" ::: "memory"); __builtin_amdgcn_s_barrier(); asm volatile("" ::: "memory");
        if (lane < 32) { const unsigned* slot = xbuf + (size_t)(u.pm * BM + prow) * 4; float q = 0.f;
#pragma unroll
            for (int t = 0; t < 4; ++t) q += __uint_as_float(__hip_atomic_load(slot + t, __ATOMIC_RELAXED, __HIP_MEMORY_SCOPE_AGENT));
            S[prow] = __builtin_amdgcn_rsqf(q * (1.f / 1024.f) + RMS_EPS); }
        asm volatile("s_waitcnt lgkmcnt(0)" ::: "memory"); __builtin_amdgcn_s_barrier(); asm volatile("" ::: "memory");
#pragma unroll
        for (int ai = 0; ai < 2; ++ai)
#pragma unroll
            for (int m = 0; m < 4; ++m) { const int r = ai * HALF + wr * 64 + m * 16 + fr; const float rs = S[r]; const size_t off = (size_t)(u.pm * BM + r) * 1024 + cw;
#pragma unroll
                for (int bj = 0; bj < 2; ++bj) { const f32x4 o0 = acc[ai][bj][m][0] * rs * gv[bj][0], o1 = acc[ai][bj][m][1] * rs * gv[bj][1]; float* const op = OUT + (size_t)(u.pm * BM + ai * HALF + wr * 64 + m * 16 + fr2) * 1024 + u.pn * BM + wc * 32 + 8 * fq2 + bj * HALF;
                    *(u32x4*)op = tr16x4(__builtin_bit_cast(u32x4, o0), bidx); *(u32x4*)(op + 4) = tr16x4(__builtin_bit_cast(u32x4, o1), bidx); } }
    }
};

struct SplitOrder {
    static constexpr bool KSPLIT = true, APANEL = false;
    StaticOrder so;
    __host__ __device__ void init(int M, int N, int G_, int c_) { so.init(M, N, G_, c_); }
    __host__ __device__ bool next(int i, Unit& u) const { if (!so.next(i, u)) return false; if (u.pn < 3) { u.kofs = 0; u.nt = 4; } else { u.kofs = 256 * 2; u.nt = 2; } return true; }
    __device__ __forceinline__ void a_ready(const Unit&) const {}
    __device__ __forceinline__ void done(const Unit&) const {}
};
template <class Epi, class Sched, bool ALIGN_EPI = false, bool SP2 = false>
__device__ __forceinline__ void gemm_phase(PG8_LAS unsigned char* lds, const Gemm g, const Sched& S, const Epi& E) {
    const int tid = threadIdx.x, wid = __builtin_amdgcn_readfirstlane(tid >> 6), lane = tid & 63, wr = wid >> 2, wc = wid & 3, fr = lane & 15, fq = lane >> 4;
    const int K = g.K; int nt = K / BK;
    unsigned voffA[2], voffB[2];
#pragma unroll
    for (int i = 0; i < 2; ++i) { int R, C; stage_rc(tid * 16 + i * 8192, R, C); const int Rb = Epi::PERM ? ((R & ~31) + perm32(R & 31)) : R;
        voffA[i] = (unsigned)(R * K + C) * 2u; voffB[i] = (unsigned)(Rb * K + C) * 2u; }
    const size_t kstep = (size_t)(BK * 2);
    const size_t hstep = (size_t)HALF * K * 2;
    const size_t tstep = 2 * hstep;
    const unsigned ldsw = (unsigned)wid * 1024u;
    const int aoff = lds_byte(wr * 64 + fr, fq * 8), boff = lds_byte(wc * 32 + fr, fq * 8);
#define PG8_SA(b, h) (((b) * 2 + (h)) * HTB)
#define PG8_SB(b, h) ((4 + (b) * 2 + (h)) * HTB)
#define PG8_STAGE(bufoff, gbase, voff) do { _Pragma("unroll") for (int _i = 0; _i < 2; ++_i) \
        __builtin_amdgcn_global_load_lds((const unsigned*)((const char*)(gbase) + (voff)[_i]), (PG8_LAS unsigned*)(lds + (bufoff) + ldsw + _i * 8192), 16, 0, 0); } while (0)
#define PG8_LDA(dst, b, h) do { _Pragma("unroll") for (int m = 0; m < 4; ++m) _Pragma("unroll") for (int k = 0; k < 2; ++k) dst[m][k] = *(const PG8_LAS bf16x8*)(lds + PG8_SA(b, h) + aoff + m * 2048 + k * 1024); } while (0)
#define PG8_LDB(dst, b, h) do { _Pragma("unroll") for (int n = 0; n < 2; ++n) _Pragma("unroll") for (int k = 0; k < 2; ++k) dst[n][k] = *(const PG8_LAS bf16x8*)(lds + PG8_SB(b, h) + boff + n * 2048 + k * 1024); } while (0)
#define PG8_MMA(ai, bj, At, Bt) do { __builtin_amdgcn_s_setprio(1); _Pragma("unroll") for (int m = 0; m < 4; ++m) _Pragma("unroll") for (int n = 0; n < 2; ++n) _Pragma("unroll") for (int k = 0; k < 2; ++k) \
        acc[ai][bj][m][n] = __builtin_amdgcn_mfma_f32_16x16x32_bf16(Bt[n][k], At[m][k], acc[ai][bj][m][n], 0, 0, 0); __builtin_amdgcn_s_setprio(0); } while (0)
#define PG8_WAIT_V(n) asm volatile("s_waitcnt vmcnt(" #n ")" ::: "memory")
#define PG8_WAIT_L(n) asm volatile("s_waitcnt lgkmcnt(" #n ")" ::: "memory")
#define PG8_BAR __builtin_amdgcn_s_barrier()
#define PG8_SCHED __builtin_amdgcn_sched_barrier(0)
    Unit cur, nxt; int ui = 0;
    if (!S.next(0, cur)) return;
    f32x4 acc[2][2][4][2];
#pragma unroll
    for (int a = 0; a < 2; ++a)
#pragma unroll
        for (int b = 0; b < 2; ++b)
#pragma unroll
            for (int m = 0; m < 4; ++m)
#pragma unroll
                for (int n = 0; n < 2; ++n) acc[a][b][m][n] = (f32x4){0.f, 0.f, 0.f, 0.f};
    bf16x8 At[4][2], B0[2][2], B1[2][2];
    const char* cA; if constexpr (Sched::APANEL) cA = S.a_panel(cur.pm); else cA = (const char*)g.A + (size_t)cur.pm * tstep + (Sched::KSPLIT ? cur.kofs : 0);
    const char* cB = (const char*)g.Bt + (size_t)cur.pn * tstep + (Sched::KSPLIT ? cur.kofs : 0);
    S.a_ready(cur);
    if constexpr (SP2) {
        PG8_STAGE(PG8_SB(0, 0), cB, voffB); PG8_STAGE(PG8_SB(0, 1), cB + hstep, voffB); PG8_STAGE(PG8_SA(0, 0), cA, voffA); PG8_STAGE(PG8_SA(0, 1), cA + hstep, voffA);
        if (wr == 1) PG8_BAR;
        PG8_WAIT_V(2); PG8_BAR;
        PG8_STAGE(PG8_SB(1, 0), cB + kstep, voffB); PG8_STAGE(PG8_SA(1, 0), cA + kstep, voffA); PG8_STAGE(PG8_SB(1, 1), cB + hstep + kstep, voffB);
        PG8_WAIT_V(6); PG8_BAR;
    } else {
        PG8_STAGE(PG8_SB(0, 0), cB, voffB); PG8_STAGE(PG8_SA(0, 0), cA, voffA); PG8_STAGE(PG8_SB(0, 1), cB + hstep, voffB); PG8_STAGE(PG8_SA(0, 1), cA + hstep, voffA);
        if (wr == 1) PG8_BAR;
        PG8_WAIT_V(4); PG8_BAR;
        PG8_STAGE(PG8_SB(1, 0), cB + kstep, voffB); PG8_STAGE(PG8_SA(1, 0), cA + kstep, voffA); PG8_STAGE(PG8_SB(1, 1), cB + hstep + kstep, voffB);
        PG8_WAIT_V(6); PG8_BAR;
    }
    for (;;) {
        const bool has_next = S.next(ui + 1, nxt);
        const char* nA; if constexpr (Sched::APANEL) nA = has_next ? S.a_panel(nxt.pm) : cA; else nA = has_next ? (const char*)g.A + (size_t)nxt.pm * tstep + (Sched::KSPLIT ? nxt.kofs : 0) : cA;
        const char* nB = has_next ? (const char*)g.Bt + (size_t)nxt.pn * tstep + (Sched::KSPLIT ? nxt.kofs : 0) : cB;
        if constexpr (Sched::KSPLIT) nt = cur.nt;
        for (int t = 0; t < nt; t += 2) {
            const bool last = (t == nt - 2);
            const char* a1 = cA + (size_t)(t + 1) * kstep;
            const char* a2 = last ? nA : cA + (size_t)(t + 2) * kstep; const char* b2 = last ? nB : cB + (size_t)(t + 2) * kstep;
            const char* a3 = a2 + kstep; const char* b3 = b2 + kstep;
            if (last && has_next) S.a_ready(nxt);
            if constexpr (SP2) {
            PG8_LDB(B0, 0, 0); PG8_LDB(B1, 0, 1); PG8_SCHED; PG8_LDA(At, 0, 0); PG8_STAGE(PG8_SA(1, 1), a1 + hstep, voffA);
            PG8_WAIT_V(8); PG8_WAIT_L(0); PG8_BAR; PG8_MMA(0, 0, At, B0); PG8_MMA(0, 1, At, B1); PG8_BAR; PG8_SCHED;
            PG8_LDA(At, 0, 1); PG8_STAGE(PG8_SB(0, 0), b2, voffB); PG8_STAGE(PG8_SB(0, 1), b2 + hstep, voffB); PG8_STAGE(PG8_SA(0, 0), a2, voffA);
            PG8_WAIT_V(8); PG8_WAIT_L(0); PG8_BAR; PG8_MMA(1, 0, At, B0); PG8_MMA(1, 1, At, B1); PG8_BAR; PG8_SCHED;
            PG8_LDB(B0, 1, 0); PG8_LDB(B1, 1, 1); PG8_SCHED; PG8_LDA(At, 1, 0); PG8_STAGE(PG8_SA(0, 1), a2 + hstep, voffA);
            PG8_WAIT_V(8); PG8_WAIT_L(0); PG8_BAR; PG8_MMA(0, 0, At, B0); PG8_MMA(0, 1, At, B1); PG8_BAR; PG8_SCHED;
            PG8_LDA(At, 1, 1); PG8_STAGE(PG8_SB(1, 0), b3, voffB); PG8_STAGE(PG8_SB(1, 1), b3 + hstep, voffB); PG8_STAGE(PG8_SA(1, 0), a3, voffA);
            PG8_WAIT_V(8); PG8_WAIT_L(0); PG8_BAR; PG8_MMA(1, 0, At, B0); PG8_MMA(1, 1, At, B1); PG8_BAR; PG8_SCHED;
            } else {
            PG8_LDB(B0, 0, 0); PG8_SCHED; PG8_LDA(At, 0, 0); PG8_STAGE(PG8_SA(1, 1), a1 + hstep, voffA);
            PG8_WAIT_L(8); PG8_BAR; PG8_WAIT_L(0); PG8_MMA(0, 0, At, B0); PG8_BAR; PG8_SCHED;
            PG8_LDB(B1, 0, 1); PG8_STAGE(PG8_SB(0, 0), b2, voffB);
            PG8_BAR; PG8_WAIT_L(0); PG8_MMA(0, 1, At, B1); PG8_BAR;
            PG8_LDA(At, 0, 1); PG8_STAGE(PG8_SA(0, 0), a2, voffA);
            PG8_BAR; PG8_WAIT_L(0); PG8_MMA(1, 0, At, B0); PG8_BAR; PG8_SCHED;
            PG8_STAGE(PG8_SB(0, 1), b2 + hstep, voffB);
            PG8_WAIT_V(6); PG8_BAR; PG8_MMA(1, 1, At, B1); PG8_BAR;
            PG8_LDB(B0, 1, 0); PG8_SCHED; PG8_LDA(At, 1, 0); PG8_STAGE(PG8_SA(0, 1), a2 + hstep, voffA);
            PG8_WAIT_L(8); PG8_BAR; PG8_WAIT_L(0); PG8_MMA(0, 0, At, B0); PG8_BAR; PG8_SCHED;
            PG8_LDB(B1, 1, 1); PG8_STAGE(PG8_SB(1, 0), b3, voffB);
            PG8_BAR; PG8_WAIT_L(0); PG8_MMA(0, 1, At, B1); PG8_BAR;
            PG8_LDA(At, 1, 1); PG8_STAGE(PG8_SA(1, 0), a3, voffA);
            PG8_BAR; PG8_WAIT_L(0); PG8_MMA(1, 0, At, B0); PG8_BAR; PG8_SCHED;
            PG8_STAGE(PG8_SB(1, 1), b3 + hstep, voffB);
            PG8_WAIT_V(6); PG8_BAR; PG8_MMA(1, 1, At, B1); PG8_BAR;
            }
        }
        if constexpr (ALIGN_EPI) { if (wr == 0) PG8_BAR; }
        if constexpr (!Epi::AFTER_DRAIN) { E(acc, cur, wr, wc, fr, fq); S.done(cur); }
        if (!has_next) break;
#pragma unroll
        for (int a = 0; a < 2; ++a)
#pragma unroll
            for (int b = 0; b < 2; ++b)
#pragma unroll
                for (int m = 0; m < 4; ++m)
#pragma unroll
                    for (int n = 0; n < 2; ++n) acc[a][b][m][n] = (f32x4){0.f, 0.f, 0.f, 0.f};
        cur = nxt; cA = nA; cB = nB; ++ui;
        if constexpr (ALIGN_EPI) { if (wr == 1) PG8_BAR; }
    }
    PG8_WAIT_V(0);
    if constexpr (!ALIGN_EPI) { if (wr == 0) PG8_BAR; }
    PG8_BAR;
    if constexpr (Epi::AFTER_DRAIN) { E.fused(acc, cur, wr, wc, fr, fq, lds, wid, lane); S.done(cur); }
#undef PG8_SA
#undef PG8_SB
#undef PG8_STAGE
#undef PG8_LDA
#undef PG8_LDB
#undef PG8_MMA
#undef PG8_WAIT_V
#undef PG8_WAIT_L
#undef PG8_BAR
#undef PG8_SCHED
}
}
namespace att {
using bf16x8 = __attribute__((ext_vector_type(8))) short;
using s16x4 = __attribute__((ext_vector_type(4))) short;
using f32x16 = __attribute__((ext_vector_type(16))) float;
using u32x4 = __attribute__((ext_vector_type(4))) unsigned;
typedef unsigned short bf16;
constexpr int SEQ = 4096, NW = 8, QB = 256, KVBLK = 64, NSLOT = 3;
#ifndef ATT_THRL
#define ATT_THRL 8
#endif
constexpr int THRL = ATT_THRL;
__device__ __forceinline__ int otid() { int t = threadIdx.x; asm volatile("" : "+v"(t)); return t; }
template <int PAT> __device__ __forceinline__ float swz_xor(float v) { return __int_as_float(__builtin_amdgcn_ds_swizzle(__float_as_int(v), PAT)); }
__device__ __forceinline__ int crow(int r, int hi) { return (r & 3) + 8 * (r >> 2) + 4 * hi; }
#define SBAR() __builtin_amdgcn_sched_barrier(0)
#define PIN(x) asm volatile("" : "+v"(x))
#define WAIT_BAR(N) asm volatile("s_waitcnt vmcnt(" #N ") lgkmcnt(0)\n\ts_barrier" ::: "memory")
#define MFMA32(a, b, c) __builtin_amdgcn_mfma_f32_32x32x16_bf16(a, b, c, 0, 0, 0)
#define EX(v) __builtin_amdgcn_exp2f(v)
#define MX3(a, b, c) __builtin_fmaxf(__builtin_fmaxf((a), (b)), (c))
#define IMX3(a, b, c) imax_(imax_((a), (b)), (c))
__device__ __forceinline__ int imax_(int a, int b) { return a > b ? a : b; }
#define FBITS(x) __float_as_int(x)
__device__ __forceinline__ void glds16(const void* gsrc, unsigned lds_dst) { unsigned keep;
    asm volatile("s_mov_b32 %0, m0\n\ts_mov_b32 m0, %2\n\ts_nop 0\n\tglobal_load_lds_dwordx4 %1, off\n\ts_mov_b32 m0, %0" : "=&s"(keep) : "v"(gsrc), "s"(lds_dst) : "memory"); }
typedef float f32x2_t __attribute__((ext_vector_type(2))); typedef __bf16 bf16x2_t __attribute__((ext_vector_type(2)));
__device__ __forceinline__ unsigned cvtpk_s(float lo, float hi) { f32x2_t v = {lo, hi}; bf16x2_t b = __builtin_convertvector(v, bf16x2_t); return __builtin_bit_cast(unsigned, b); }
typedef __attribute__((address_space(3))) const char* lds_cptr;
typedef short v4i16_t __attribute__((ext_vector_type(4)));
__device__ __forceinline__ s16x4 vtr(lds_cptr p) { return __builtin_bit_cast(s16x4, __builtin_amdgcn_ds_read_tr16_b64_v4i16((__attribute__((address_space(3))) v4i16_t*)p)); }
__device__ __forceinline__ bf16x8 kld(lds_cptr p) { return *(const __attribute__((address_space(3))) bf16x8*)p; }
__device__ __forceinline__ float rowmax(const f32x16& p0, const f32x16& p1) {
    float a = MX3(p0[0], p0[1], p1[0]), b = MX3(p0[2], p0[3], p1[1]); a = MX3(a, p1[2], p1[3]);
#pragma unroll
    for (int r = 4; r < 16; r += 4) { a = MX3(a, p0[r], p0[r + 1]); b = MX3(b, p0[r + 2], p0[r + 3]); a = MX3(a, p1[r], p1[r + 1]); b = MX3(b, p1[r + 2], p1[r + 3]); }
    const float m = __builtin_fmaxf(a, b);
    auto rr = __builtin_amdgcn_permlane32_swap(__float_as_uint(m), __float_as_uint(m), false, false);
    return __builtin_fmaxf(__uint_as_float(rr[0]), __uint_as_float(rr[1]));
}
template <int DQK, int DV> struct Lay {
    static constexpr int KB = 64 * DQK * 2, VB = 64 * DV * 2;
    static constexpr int LDS_K = 0, LDS_V = NSLOT * KB, LDS_WS = NSLOT * (KB + VB), OSTW = (DV == 128) ? 8192 : 4096, LDS_OST = LDS_WS + NW * 256, LDS_BT = LDS_OST + NW * OSTW, LDS_END = LDS_BT + 2048;
};
#define STEP_MLA(C0, C1, P0, P1, t, BAND, GK, GV, GL) do { SBAR(); \
    const lds_cptr vp_ = vp0 + sl_prev * L::VB; \
      \
    float sacc = P0[0] + P0[1]; \
    VRD(0, 0); SBAR(); C0 = MFMA32(kf[0], qr[0], negm); sacc += P0[2]; sacc += P0[3]; sacc += P0[4]; PIN(sacc); pw0[0] = PKW(P0, 0); pw0[1] = PKW(P0, 2); PIN(pw0); SBAR(); \
    VRD(4, 4); SBAR(); C1 = MFMA32(kf[1], qr[0], negm); sacc += P0[5]; sacc += P0[6]; sacc += P0[7]; PIN(sacc); pw0[2] = PKW(P0, 4); pw0[3] = PKW(P0, 6); PIN(pw0); SBAR(); \
    VRD(1, 1); SBAR(); C0 = MFMA32(kf[2], qr[1], C0); sacc += P0[8]; sacc += P0[9]; sacc += P0[10]; PIN(sacc); pw1[0] = PKW(P0, 8); pw1[1] = PKW(P0, 10); PIN(pw1); SBAR(); \
    VRD(5, 5); SBAR(); C1 = MFMA32(kf[3], qr[1], C1); sacc += P0[11]; sacc += P0[12]; sacc += P0[13]; PIN(sacc); pw1[2] = PKW(P0, 12); pw1[3] = PKW(P0, 14); PIN(pw1); SBAR(); \
    VRD(2, 2); SBAR(); C0 = MFMA32(kf[4], qr[2], C0); sacc += P0[14]; sacc += P0[15]; sacc += P1[0]; PIN(sacc); pw2[0] = PKW(P1, 0); PIN(pw2); SBAR(); \
    VRD(6, 6); SBAR(); C1 = MFMA32(kf[5], qr[2], C1); sacc += P1[1]; sacc += P1[2]; sacc += P1[3]; PIN(sacc); pw2[1] = PKW(P1, 2); PIN(pw2); SBAR(); \
    VRD(3, 3); SBAR(); C0 = MFMA32(kf[6], qr[3], C0); sacc += P1[4]; sacc += P1[5]; PIN(sacc); pw2[2] = PKW(P1, 4); PIN(pw2); SBAR(); \
    VRD(7, 7); SBAR(); C1 = MFMA32(kf[7], qr[3], C1); sacc += P1[6]; sacc += P1[7]; PIN(sacc); pw2[3] = PKW(P1, 6); PIN(pw2); SBAR(); \
    C0 = MFMA32(kf[8], qr[4], C0); sacc += P1[8]; sacc += P1[9]; PIN(sacc); pw3[0] = PKW(P1, 8); PIN(pw3); SBAR(); \
    C1 = MFMA32(kf[9], qr[4], C1); sacc += P1[10]; sacc += P1[11]; PIN(sacc); pw3[1] = PKW(P1, 10); PIN(pw3); SBAR(); \
    C0 = MFMA32(kf[10], qr[5], C0); sacc += P1[12]; sacc += P1[13]; PIN(sacc); pw3[2] = PKW(P1, 12); PIN(pw3); SBAR(); \
    C1 = MFMA32(kf[11], qr[5], C1); sacc += P1[14]; sacc += P1[15]; PIN(sacc); pw3[3] = PKW(P1, 14); PIN(pw3); SBAR(); \
    l_reg += sacc; \
    MIDDLE(C0, C1, t, BAND); \
    SBAR(); \
    o[0] = MFMA32(PAF(0), VFR(0), o[0]); if (GK) DMA_K((t) + 3, sl_cur); if (GV) DMA_V((t) + 1, sl_next); C0[0] = EX(C0[0]); C0[1] = EX(C0[1]); C0[2] = EX(C0[2]); C0[3] = EX(C0[3]); PIN(C0); SBAR(); \
    KRD(GL, 0); o[1] = MFMA32(PAF(0), VFR(4), o[1]); C0[4] = EX(C0[4]); C0[5] = EX(C0[5]); C0[6] = EX(C0[6]); C0[7] = EX(C0[7]); PIN(C0); SBAR(); \
    KRD(GL, 1); o[0] = MFMA32(PAF(1), VFR(1), o[0]); C0[8] = EX(C0[8]); C0[9] = EX(C0[9]); C0[10] = EX(C0[10]); C0[11] = EX(C0[11]); PIN(C0); SBAR(); \
    KRD(GL, 2); o[1] = MFMA32(PAF(1), VFR(5), o[1]); C0[12] = EX(C0[12]); C0[13] = EX(C0[13]); C0[14] = EX(C0[14]); C0[15] = EX(C0[15]); PIN(C0); SBAR(); \
    KRD(GL, 3); o[0] = MFMA32(PAF(2), VFR(2), o[0]); C1[0] = EX(C1[0]); C1[1] = EX(C1[1]); C1[2] = EX(C1[2]); C1[3] = EX(C1[3]); PIN(C1); SBAR(); \
    KRD(GL, 4); o[1] = MFMA32(PAF(2), VFR(6), o[1]); C1[4] = EX(C1[4]); C1[5] = EX(C1[5]); C1[6] = EX(C1[6]); C1[7] = EX(C1[7]); PIN(C1); SBAR(); \
    KRD(GL, 5); o[0] = MFMA32(PAF(3), VFR(3), o[0]); C1[8] = EX(C1[8]); C1[9] = EX(C1[9]); C1[10] = EX(C1[10]); C1[11] = EX(C1[11]); PIN(C1); SBAR(); \
    o[1] = MFMA32(PAF(3), VFR(7), o[1]); C1[12] = EX(C1[12]); C1[13] = EX(C1[13]); C1[14] = EX(C1[14]); C1[15] = EX(C1[15]); PIN(C1); SBAR(); \
    } while (0)
#define STEP_DIF(C0, C1, P0, P1, t, BAND, GK, GV, GL) do { SBAR(); \
    const lds_cptr vp_ = vp0 + sl_prev * L::VB; \
      \
    float sacc = P0[0] + P0[1]; \
    C0 = MFMA32(kf[0], qr[0], inin); sacc += P0[2]; sacc += P0[3]; sacc += P0[4]; sacc += P0[5]; PIN(sacc); pw0[0] = PKW(P0, 0); pw0[1] = PKW(P0, 2); PIN(pw0); SBAR(); \
    C1 = MFMA32(kf[1], qr[0], inin); sacc += P0[6]; sacc += P0[7]; sacc += P0[8]; sacc += P0[9]; PIN(sacc); pw0[2] = PKW(P0, 4); pw0[3] = PKW(P0, 6); PIN(pw0); SBAR(); \
    C0 = MFMA32(kf[2], qr[1], C0); sacc += P0[10]; sacc += P0[11]; sacc += P0[12]; sacc += P0[13]; PIN(sacc); pw1[0] = PKW(P0, 8); pw1[1] = PKW(P0, 10); PIN(pw1); SBAR(); \
    C1 = MFMA32(kf[3], qr[1], C1); sacc += P0[14]; sacc += P0[15]; sacc += P1[0]; sacc += P1[1]; PIN(sacc); pw1[2] = PKW(P0, 12); pw1[3] = PKW(P0, 14); PIN(pw1); SBAR(); \
    VRD(0, 0); SBAR(); C0 = MFMA32(kf[4], qr[2], C0); sacc += P1[2]; sacc += P1[3]; sacc += P1[4]; sacc += P1[5]; PIN(sacc); pw2[0] = PKW(P1, 0); pw2[1] = PKW(P1, 2); PIN(pw2); SBAR(); \
    VRD(1, 4); SBAR(); C1 = MFMA32(kf[5], qr[2], C1); sacc += P1[6]; sacc += P1[7]; sacc += P1[8]; sacc += P1[9]; PIN(sacc); pw2[2] = PKW(P1, 4); pw2[3] = PKW(P1, 6); PIN(pw2); SBAR(); \
    VRD(2, 8); SBAR(); C0 = MFMA32(kf[6], qr[3], C0); sacc += P1[10]; sacc += P1[11]; sacc += P1[12]; sacc += P1[13]; PIN(sacc); pw3[0] = PKW(P1, 8); pw3[1] = PKW(P1, 10); PIN(pw3); SBAR(); \
    VRD(3, 12); SBAR(); C1 = MFMA32(kf[7], qr[3], C1); sacc += P1[14]; sacc += P1[15]; PIN(sacc); pw3[2] = PKW(P1, 12); pw3[3] = PKW(P1, 14); PIN(pw3); SBAR(); \
    l_reg += sacc; \
    MIDDLE(C0, C1, t, BAND); \
    SBAR(); \
    o[0] = MFMA32(PAF(0), VFR(0), o[0]); if (GK) DMA_K((t) + 3, sl_cur); if (GV) DMA_V((t) + 1, sl_next); VRD(0, 1); C0[0] = EX(C0[0]); C0[1] = EX(C0[1]); PIN(C0); SBAR(); \
    o[1] = MFMA32(PAF(0), VFR(1), o[1]); VRD(1, 5); C0[2] = EX(C0[2]); C0[3] = EX(C0[3]); PIN(C0); SBAR(); \
    o[2] = MFMA32(PAF(0), VFR(2), o[2]); VRD(2, 9); C0[4] = EX(C0[4]); C0[5] = EX(C0[5]); PIN(C0); SBAR(); \
    o[3] = MFMA32(PAF(0), VFR(3), o[3]); VRD(3, 13); C0[6] = EX(C0[6]); C0[7] = EX(C0[7]); PIN(C0); SBAR(); \
    o[0] = MFMA32(PAF(1), VFR(0), o[0]); VRD(0, 2); C0[8] = EX(C0[8]); C0[9] = EX(C0[9]); PIN(C0); SBAR(); \
    o[1] = MFMA32(PAF(1), VFR(1), o[1]); VRD(1, 6); C0[10] = EX(C0[10]); C0[11] = EX(C0[11]); PIN(C0); SBAR(); \
    o[2] = MFMA32(PAF(1), VFR(2), o[2]); VRD(2, 10); C0[12] = EX(C0[12]); C0[13] = EX(C0[13]); PIN(C0); SBAR(); \
    o[3] = MFMA32(PAF(1), VFR(3), o[3]); VRD(3, 14); C0[14] = EX(C0[14]); C0[15] = EX(C0[15]); PIN(C0); SBAR(); \
    o[0] = MFMA32(PAF(2), VFR(0), o[0]); VRD(0, 3); C1[0] = EX(C1[0]); C1[1] = EX(C1[1]); PIN(C1); SBAR(); \
    KRD(GL, 0); o[1] = MFMA32(PAF(2), VFR(1), o[1]); VRD(1, 7); C1[2] = EX(C1[2]); C1[3] = EX(C1[3]); PIN(C1); SBAR(); \
    KRD(GL, 1); o[2] = MFMA32(PAF(2), VFR(2), o[2]); VRD(2, 11); C1[4] = EX(C1[4]); C1[5] = EX(C1[5]); PIN(C1); SBAR(); \
    KRD(GL, 2); o[3] = MFMA32(PAF(2), VFR(3), o[3]); VRD(3, 15); C1[6] = EX(C1[6]); C1[7] = EX(C1[7]); PIN(C1); SBAR(); \
    KRD(GL, 3); o[0] = MFMA32(PAF(3), VFR(0), o[0]); C1[8] = EX(C1[8]); C1[9] = EX(C1[9]); PIN(C1); SBAR(); \
    o[1] = MFMA32(PAF(3), VFR(1), o[1]); C1[10] = EX(C1[10]); C1[11] = EX(C1[11]); PIN(C1); SBAR(); \
    o[2] = MFMA32(PAF(3), VFR(2), o[2]); C1[12] = EX(C1[12]); C1[13] = EX(C1[13]); PIN(C1); SBAR(); \
    o[3] = MFMA32(PAF(3), VFR(3), o[3]); C1[14] = EX(C1[14]); C1[15] = EX(C1[15]); PIN(C1); { float iv_ = INI_ADD((t) + 1) - mhat; _Pragma("unroll") for (int r_ = 0; r_ < 16; ++r_) inin[r_] = iv_; } PIN(inin); SBAR(); \
    } while (0)
#define PKW(P, i) cvtpk_s(P[i], P[i + 1])
#define PAF(k) __builtin_bit_cast(bf16x8, pw##k)
#define VFR(i) (bf16x8){vlo[i][0], vlo[i][1], vlo[i][2], vlo[i][3], vhi[i][0], vhi[i][1], vhi[i][2], vhi[i][3]}
#define VRD(s, f) do { vlo[s] = vtr(vp_ + (((f) >> 2) * 4096 + ((f) & 3) * 1024)); vhi[s] = vtr(vp_ + (((f) >> 2) * 4096 + ((f) & 3) * 1024 + 512)); } while (0)
#define KRD(G, j) do { if (G) { const lds_cptr kq_ = kp0 + sl_next * L::KB + (j) * 2048; kf[2 * (j)] = kld(kq_); kf[2 * (j) + 1] = kld(kq_ + 512); SBAR(); } } while (0)
#define ROT() do { sl_prev = sl_cur; sl_cur = sl_next; sl_next = (sl_next == NSLOT - 1) ? 0 : sl_next + 1; } while (0)
#define CMASK(C0, C1, t) do { } while (0)
#define DECIDE(C0, C1) do { int a_ = IMX3(FBITS(C0[0]), FBITS(C0[1]), FBITS(C0[2])), b_ = IMX3(FBITS(C0[3]), FBITS(C0[4]), FBITS(C0[5])), c_ = IMX3(FBITS(C1[0]), FBITS(C1[1]), FBITS(C1[2])), d_ = IMX3(FBITS(C1[3]), FBITS(C1[4]), FBITS(C1[5])); \
      a_ = IMX3(a_, FBITS(C0[6]), FBITS(C0[7])); b_ = IMX3(b_, FBITS(C0[8]), FBITS(C0[9])); c_ = IMX3(c_, FBITS(C1[6]), FBITS(C1[7])); d_ = IMX3(d_, FBITS(C1[8]), FBITS(C1[9])); \
      a_ = IMX3(a_, FBITS(C0[10]), FBITS(C0[11])); b_ = IMX3(b_, FBITS(C0[12]), FBITS(C0[13])); c_ = IMX3(c_, FBITS(C1[10]), FBITS(C1[11])); d_ = IMX3(d_, FBITS(C1[12]), FBITS(C1[13])); \
      a_ = IMX3(a_, FBITS(C0[14]), FBITS(C0[15])); c_ = IMX3(c_, FBITS(C1[14]), FBITS(C1[15])); a_ = IMX3(a_, b_, c_); b_ = d_;     \
      float rm_; { const int im_ = imax_(a_, b_); auto rr_ = __builtin_amdgcn_permlane32_swap((unsigned)im_, (unsigned)im_, false, false); rm_ = __int_as_float(imax_((int)rr_[0], (int)rr_[1])); } \
      resc = false; \
      if (__builtin_expect(__any(rm_ > (float)THRL), 0)) { const float dl_ = __builtin_fmaxf(rm_, 0.f); mhat += dl_; NEGM_UPDATE(); \
        _Pragma("unroll") for (int r_ = 0; r_ < 16; ++r_) { C0[r_] -= dl_; C1[r_] -= dl_; } \
        const float f_ = __builtin_amdgcn_exp2f(-dl_); l_reg *= f_; if (hi == 0) wsf[r32] = f_; resc = true; } } while (0)
#define RESC(NO_) do { if (resc) { asm volatile("s_waitcnt lgkmcnt(0)" ::: "memory"); \
      _Pragma("unroll") for (int r_ = 0; r_ < 16; ++r_) { const float f_ = wsf[crow(r_, hi)]; _Pragma("unroll") for (int d_ = 0; d_ < NO_; ++d_) o[d_][r_] *= f_; } } } while (0)
#define ENDW(tt, W2, W1) do { if ((tt) + 3 < NT) { WAIT_BAR(W2); } else if ((tt) + 2 < NT) { WAIT_BAR(W1); } else { WAIT_BAR(0); } } while (0)
#define DRAIN_PV(P0, P1, slot_, NO_) do { float sacc_ = P0[0] + P0[1]; \
      _Pragma("unroll") for (int r_ = 2; r_ < 16; ++r_) sacc_ += P0[r_]; \
      _Pragma("unroll") for (int r_ = 0; r_ < 16; ++r_) sacc_ += P1[r_]; \
      l_reg += sacc_; \
      pw0 = (u32x4){PKW(P0, 0), PKW(P0, 2), PKW(P0, 4), PKW(P0, 6)}; pw1 = (u32x4){PKW(P0, 8), PKW(P0, 10), PKW(P0, 12), PKW(P0, 14)}; \
      pw2 = (u32x4){PKW(P1, 0), PKW(P1, 2), PKW(P1, 4), PKW(P1, 6)}; pw3 = (u32x4){PKW(P1, 8), PKW(P1, 10), PKW(P1, 12), PKW(P1, 14)}; \
      const lds_cptr vp_ = vp0 + (slot_) * L::VB; \
      _Pragma("unroll") for (int d_ = 0; d_ < NO_; ++d_) { \
          VRD(0, d_ * 4 + 0); VRD(1, d_ * 4 + 1); VRD(2, d_ * 4 + 2); VRD(3, d_ * 4 + 3); \
          o[d_] = MFMA32(PAF(0), VFR(0), o[d_]); o[d_] = MFMA32(PAF(1), VFR(1), o[d_]); o[d_] = MFMA32(PAF(2), VFR(2), o[d_]); o[d_] = MFMA32(PAF(3), VFR(3), o[d_]); SBAR(); } } while (0)
#define BSTEP(STEPX, NO_, C0, C1, P0, P1, t, GK, GV, GL) do { \
      if ((t) <= Lw) { STEPX(C0, C1, P0, P1, t, false, GK, GV, ((GL) && ((t) + 1 <= Lw))); } \
      else { resc = false; if (GK) DMA_K((t) + 3, sl_cur); if (GV) DMA_V((t) + 1, sl_next); \
             if ((t) == Lw + 1) DRAIN_PV(P0, P1, sl_prev, NO_); } } while (0)

template <int DQK, int DV>
__device__ __forceinline__ void store_rows(const f32x16 (&y)[DV / 32], bf16* dst, int pitch, char* shm) {
    typedef Lay<DQK, DV> L;
    const int tid_ = otid(), lane = tid_ & 63, r32 = lane & 31, hi = lane >> 5; const int wid = __builtin_amdgcn_readfirstlane(tid_ >> 6);
    bf16* stg = (bf16*)(shm + L::LDS_OST + wid * L::OSTW);
#pragma unroll
    for (int half = 0; half < DV / 64; ++half) {
#pragma unroll
        for (int r = 0; r < 16; ++r) { const int orow = crow(r, hi);
#pragma unroll
            for (int d0 = 0; d0 < 2; ++d0) { const unsigned pk = cvtpk_s(y[2 * half + d0][r], 0.f); stg[orow * 64 + d0 * 32 + r32] = (bf16)(pk & 0xffffu); } }
        asm volatile("s_waitcnt lgkmcnt(0)" ::: "memory");
#pragma unroll
        for (int i = 0; i < 4; ++i) { const int row = i * 8 + (lane >> 3), ch = lane & 7; const u32x4 v = *(const u32x4*)(stg + row * 64 + ch * 8);
            *(u32x4*)(dst + (long)(32 * wid + i * 8 + (lane >> 3)) * pitch + half * 64 + ch * 8) = v; }
        asm volatile("s_waitcnt lgkmcnt(0)" ::: "memory");
    }
}
template <int DQK, int DV>
__device__ __forceinline__ void row_rcp(float (&rli)[16], float l_reg, char* shm) {
    typedef Lay<DQK, DV> L;
    const int tid_ = otid(), lane = tid_ & 63, r32 = lane & 31, hi = lane >> 5; const int wid = __builtin_amdgcn_readfirstlane(tid_ >> 6);
    float* wsf = (float*)(shm + L::LDS_WS) + wid * 64;
    { auto rr = __builtin_amdgcn_permlane32_swap(__float_as_uint(l_reg), __float_as_uint(l_reg), false, false); l_reg = __uint_as_float(rr[0]) + __uint_as_float(rr[1]); }
    if (hi == 0) wsf[32 + r32] = l_reg;
    asm volatile("s_waitcnt lgkmcnt(0)" ::: "memory");
#pragma unroll
    for (int r = 0; r < 16; ++r) rli[r] = __builtin_amdgcn_rcpf(wsf[32 + crow(r, hi)]);
}

struct MlaT { const bf16 *QA, *KN, *KR, *VA; bf16* MIX; };
__device__ __forceinline__ void mla_unit(int b, int h, int qb, const MlaT& T, char* shm) {
    typedef Lay<96, 64> L;
    const int tid = otid(), lane = tid & 63, r32 = lane & 31, hi = lane >> 5; const int wid = __builtin_amdgcn_readfirstlane(tid >> 6);
    const long rowbase = (long)b * SEQ; const int q0 = qb * QB, NT = 4 * qb + 4; const int Lw = NT - 4 + (wid >> 1);
    const bf16* Qrow = T.QA + (rowbase + q0 + 32 * wid + r32) * 768 + h * 96;
    const unsigned lds0 = (unsigned)(uintptr_t)shm; float* wsf = (float*)(shm + L::LDS_WS) + wid * 64;
    const bf16* ksrc = T.KN + rowbase * 512 + h * 64 + (long)lane * 512 + wid * 8;
    const bf16* k2src = T.KR + rowbase * 32 + (long)lane * 32 + (wid & 3) * 8;
    const bf16* vsrc = T.VA + rowbase * 512 + h * 64 + (long)(16 * (wid & 3) + (lane >> 2)) * 512 + (wid >> 2) * 32 + (lane & 3) * 8;
    const unsigned kdst = lds0 + L::LDS_K + wid * 1024, k2dst = lds0 + L::LDS_K + (8 + (wid & 3)) * 1024, vdst = lds0 + L::LDS_V + wid * 1024;
#define DMA_K(t, slot) do { glds16(ksrc + (long)(t) * KVBLK * 512, (unsigned)__builtin_amdgcn_readfirstlane(kdst + (slot) * L::KB)); glds16(k2src + (long)(t) * KVBLK * 32, (unsigned)__builtin_amdgcn_readfirstlane(k2dst + (slot) * L::KB)); } while (0)
#define DMA_V(t, slot) glds16(vsrc + (long)(t) * KVBLK * 512, (unsigned)__builtin_amdgcn_readfirstlane(vdst + (slot) * L::VB))
#define INI_ADD(t) 0.f
#define NEGM_UPDATE() do { _Pragma("unroll") for (int r_ = 0; r_ < 16; ++r_) negm[r_] = -mhat; } while (0)
#define MIDDLE(C0, C1, t, BAND) do { if (BAND) CMASK(C0, C1, t); DECIDE(C0, C1); } while (0)
    const lds_cptr shm3 = (lds_cptr)shm;
    const lds_cptr vp0 = shm3 + L::LDS_V + ((lane >> 4) & 1) * 32 + (lane & 3) * 8 + (4 * hi + ((lane & 15) >> 2)) * 64;
    const lds_cptr kp0 = shm3 + L::LDS_K + hi * 1024 + r32 * 16;
    DMA_K(0, 0); DMA_V(0, 0); DMA_K(1, 1);
    bf16x8 qr[6];
#pragma unroll
    for (int d0 = 0; d0 < 6; ++d0) qr[d0] = *reinterpret_cast<const bf16x8*>(&Qrow[d0 * 16 + hi * 8]);
    float mhat = 0.f, l_reg = 0.f; f32x16 o[2]; o[0] = f32x16{}; o[1] = f32x16{};
    bool resc = false;
    f32x16 pA0, pA1, pB0, pB1; bf16x8 kf[12]; s16x4 vlo[8], vhi[8]; u32x4 pw0, pw1, pw2, pw3;
    int sl_prev = 0, sl_cur = 0, sl_next = 1;
    DMA_K(2, 2);
    WAIT_BAR(5);
    { f32x16 z = f32x16{};
#pragma unroll
      for (int d0 = 0; d0 < 6; ++d0) { const bf16x8 b0 = kld(kp0 + d0 * 2048), b1 = kld(kp0 + d0 * 2048 + 512);
          if (d0 == 0) { pA0 = MFMA32(b0, qr[0], z); pA1 = MFMA32(b1, qr[0], z); } else { pA0 = MFMA32(b0, qr[d0], pA0); pA1 = MFMA32(b1, qr[d0], pA1); } }
      const float rm = rowmax(pA0, pA1); mhat = rm;
#pragma unroll
      for (int r = 0; r < 16; ++r) { pA0[r] = EX(pA0[r] - rm); pA1[r] = EX(pA1[r] - rm); } }
    f32x16 negm; NEGM_UPDATE(); asm volatile("" : "+v"(negm));
    WAIT_BAR(0);
    DMA_K(3, 0); DMA_V(1, 1); ROT();
#pragma unroll
    for (int j = 0; j < 6; ++j) { const lds_cptr kq = kp0 + sl_cur * L::KB + j * 2048; kf[2 * j] = kld(kq); kf[2 * j + 1] = kld(kq + 512); }
    WAIT_BAR(3);
    int t = 1;
    for (; t + 5 < NT; t += 2) {
        STEP_MLA(pB0, pB1, pA0, pA1, t, false, true, true, true);     WAIT_BAR(3); RESC(2); ROT();
        STEP_MLA(pA0, pA1, pB0, pB1, t + 1, false, true, true, true); WAIT_BAR(3); RESC(2); ROT();
    }
#pragma nounroll
    for (; t <= Lw; ++t) {
        STEP_MLA(pB0, pB1, pA0, pA1, t, false, (t + 3 < NT), (t + 1 < NT), (t + 1 <= Lw));
        if (t + 1 < NT) { ENDW(t, 3, 1); }
        RESC(2);
        if (t + 1 < NT) ROT();
        pA0 = pB0; pA1 = pB1;
    }
    if (t < NT) {
        if (t + 3 < NT) DMA_K(t + 3, sl_cur); if (t + 1 < NT) DMA_V(t + 1, sl_next);
        DRAIN_PV(pA0, pA1, sl_prev, 2);
        if (t + 1 < NT) { ENDW(t, 3, 1); ROT(); }
        ++t;
#pragma nounroll
        for (; t < NT; ++t) {
            if (t + 3 < NT) DMA_K(t + 3, sl_cur); if (t + 1 < NT) DMA_V(t + 1, sl_next);
            if (t + 1 < NT) { ENDW(t, 3, 1); ROT(); }
        }
    } else { DRAIN_PV(pA0, pA1, sl_cur, 2); }
    float rli[16]; row_rcp<96, 64>(rli, l_reg, shm);
#pragma unroll
    for (int d = 0; d < 2; ++d)
#pragma unroll
        for (int r = 0; r < 16; ++r) o[d][r] *= rli[r];
    store_rows<96, 64>(o, T.MIX + (rowbase + q0) * 1024 + h * 64, 1024, shm);
    asm volatile("s_waitcnt vmcnt(0) lgkmcnt(0)\n\ts_barrier" ::: "memory");
#undef DMA_K
#undef DMA_V
#undef INI_ADD
#undef NEGM_UPDATE
#undef MIDDLE
}

struct DiffT { const bf16 *DQ, *DK, *DV; bf16* MIX; float* OB; const float *rel_bias, *g_subln; float lam; };
__device__ __forceinline__ int t5_bucket(int rel) {
    const int n = rel < 0 ? -rel : rel; int bk = n;
    if (n >= 8) { bk = 2 + (31 - __clz(n * n)); bk = bk > 15 ? 15 : bk; }
    return (rel > 0 ? 16 : 0) + bk;
}
__device__ __forceinline__ void diff_pass(f32x16 (&o)[4], float& l_out, int b, int h, int qb, int mo, const DiffT& T, char* shm, float cfar) {
    typedef Lay<64, 128> L;
    const int tid = otid(), lane = tid & 63, r32 = lane & 31, hi = lane >> 5; const int wid = __builtin_amdgcn_readfirstlane(tid >> 6);
    const long rowbase = (long)b * SEQ; const int q0 = qb * QB, NT = 4 * qb + 4; const int Lw = NT - 4 + (wid >> 1);
    const int urow = 32 * wid + r32;
    const bf16* Qrow = T.DQ + (rowbase + q0 + urow) * 512 + h * 128 + mo;
    const unsigned lds0 = (unsigned)(uintptr_t)shm; float* wsf = (float*)(shm + L::LDS_WS) + wid * 64;
    const float* bt = (const float*)(shm + L::LDS_BT);
    const bf16* ksrc = T.DK + rowbase * 512 + h * 128 + mo + (long)lane * 512 + wid * 8;
    const bf16* vsrc = T.DV + rowbase * 512 + h * 128 + (long)(16 * (wid & 3) + (lane >> 2)) * 512 + (wid >> 2) * 32 + (lane & 3) * 8;
    const unsigned kdst = lds0 + L::LDS_K + wid * 1024, vdst = lds0 + L::LDS_V + wid * 1024;
#define DMA_K(t, slot) glds16(ksrc + (long)(t) * KVBLK * 512, (unsigned)__builtin_amdgcn_readfirstlane(kdst + (slot) * L::KB))
#define DMA_V(t, slot) do { glds16(vsrc + (long)(t) * KVBLK * 512, (unsigned)__builtin_amdgcn_readfirstlane(vdst + (slot) * L::VB)); glds16(vsrc + (long)(t) * KVBLK * 512 + 64, (unsigned)__builtin_amdgcn_readfirstlane(vdst + (slot) * L::VB + 8192)); } while (0)
#define INI_ADD(t) (((t) < NT - 6) ? cfar : 0.f)
#define NEGM_UPDATE() do { } while (0)
#define BIAS_ADD(C0, C1, t) do { if ((t) >= NT - 6) { const float* bp_ = bt + (64 * (t) - (q0 + urow) + 384 + 4 * hi); \
      _Pragma("unroll") for (int r_ = 0; r_ < 16; ++r_) { C0[r_] += bp_[(r_ & 3) + 8 * (r_ >> 2)]; C1[r_] += bp_[32 + (r_ & 3) + 8 * (r_ >> 2)]; } } } while (0)
#define MIDDLE(C0, C1, t, BAND) do { BIAS_ADD(C0, C1, t); if (BAND) CMASK(C0, C1, t); DECIDE(C0, C1); } while (0)
    const lds_cptr shm3 = (lds_cptr)shm;
    const lds_cptr vp0 = shm3 + L::LDS_V + ((lane >> 4) & 1) * 32 + (lane & 3) * 8 + (4 * hi + ((lane & 15) >> 2)) * 64;
    const lds_cptr kp0 = shm3 + L::LDS_K + hi * 1024 + r32 * 16;
    DMA_K(0, 0); DMA_V(0, 0); DMA_K(1, 1);
    bf16x8 qr[4];
#pragma unroll
    for (int d0 = 0; d0 < 4; ++d0) qr[d0] = *reinterpret_cast<const bf16x8*>(&Qrow[d0 * 16 + hi * 8]);
    float mhat = 0.f, l_reg = 0.f;
#pragma unroll
    for (int d = 0; d < 4; ++d) o[d] = f32x16{};
    bool resc = false;
    f32x16 pA0, pA1, pB0, pB1; bf16x8 kf[8]; s16x4 vlo[8], vhi[8]; u32x4 pw0, pw1, pw2, pw3;
    int sl_prev = 0, sl_cur = 0, sl_next = 1;
    DMA_K(2, 2);
    WAIT_BAR(4);
    { f32x16 z; { const float iv = INI_ADD(0);
#pragma unroll
        for (int r = 0; r < 16; ++r) z[r] = iv; }
#pragma unroll
      for (int d0 = 0; d0 < 4; ++d0) { const bf16x8 b0 = kld(kp0 + d0 * 2048), b1 = kld(kp0 + d0 * 2048 + 512);
          if (d0 == 0) { pA0 = MFMA32(b0, qr[0], z); pA1 = MFMA32(b1, qr[0], z); } else { pA0 = MFMA32(b0, qr[d0], pA0); pA1 = MFMA32(b1, qr[d0], pA1); } }
      BIAS_ADD(pA0, pA1, 0);
      const float rm = rowmax(pA0, pA1); mhat = rm;
#pragma unroll
      for (int r = 0; r < 16; ++r) { pA0[r] = EX(pA0[r] - rm); pA1[r] = EX(pA1[r] - rm); } }
    f32x16 inin; { const float iv = INI_ADD(1) - mhat;
#pragma unroll
        for (int r = 0; r < 16; ++r) inin[r] = iv; }
    asm volatile("" : "+v"(inin));
    WAIT_BAR(0);
    DMA_K(3, 0); DMA_V(1, 1); ROT();
#pragma unroll
    for (int j = 0; j < 4; ++j) { const lds_cptr kq = kp0 + sl_cur * L::KB + j * 2048; kf[2 * j] = kld(kq); kf[2 * j + 1] = kld(kq + 512); }
    WAIT_BAR(3);
    int t = 1;
    for (; t + 5 < NT; t += 2) {
        STEP_DIF(pB0, pB1, pA0, pA1, t, false, true, true, true);     WAIT_BAR(3); RESC(4); ROT();
        STEP_DIF(pA0, pA1, pB0, pB1, t + 1, false, true, true, true); WAIT_BAR(3); RESC(4); ROT();
    }
#pragma nounroll
    for (; t <= Lw; ++t) {
        STEP_DIF(pB0, pB1, pA0, pA1, t, false, (t + 3 < NT), (t + 1 < NT), (t + 1 <= Lw));
        if (t + 1 < NT) { ENDW(t, 3, 2); }
        RESC(4);
        if (t + 1 < NT) ROT();
        pA0 = pB0; pA1 = pB1;
    }
    if (t < NT) {
        if (t + 3 < NT) DMA_K(t + 3, sl_cur); if (t + 1 < NT) DMA_V(t + 1, sl_next);
        DRAIN_PV(pA0, pA1, sl_prev, 4);
        if (t + 1 < NT) { ENDW(t, 3, 2); ROT(); }
        ++t;
#pragma nounroll
        for (; t < NT; ++t) {
            if (t + 3 < NT) DMA_K(t + 3, sl_cur); if (t + 1 < NT) DMA_V(t + 1, sl_next);
            if (t + 1 < NT) { ENDW(t, 3, 2); ROT(); }
        }
    } else { DRAIN_PV(pA0, pA1, sl_cur, 4); }
    l_out = l_reg;
    asm volatile("s_waitcnt lgkmcnt(0)\n\ts_barrier" ::: "memory");
#undef DMA_K
#undef DMA_V
#undef INI_ADD
#undef NEGM_UPDATE
#undef BIAS_ADD
#undef MIDDLE
}
__device__ __forceinline__ void diff_unit(int b, int h, int qb, const DiffT& T, char* shm) {
    typedef Lay<64, 128> L;
    const int tid = otid(); const int wid = __builtin_amdgcn_readfirstlane(tid >> 6);
    const long rowbase = (long)b * SEQ; const int q0 = qb * QB;
    constexpr float LOG2E = 1.4426950408889634f;
    { float* bt = (float*)(shm + L::LDS_BT); if (tid < 448) bt[tid] = T.rel_bias[t5_bucket(tid - 384) * 4 + h] * LOG2E; }
    const float cfar = T.rel_bias[15 * 4 + h] * LOG2E;
    asm volatile("s_waitcnt lgkmcnt(0)\n\ts_barrier" ::: "memory");
    unsigned* const obw = (unsigned*)(shm + L::LDS_OST + wid * L::OSTW);
    f32x16 o[4]; float l_reg; float rli[16];
    const float lam = T.lam;
#pragma nounroll
    for (int pass = 0; pass < 2; ++pass) {
        diff_pass(o, l_reg, b, h, qb, (pass == 0) ? 64 : 0, T, shm, cfar);
        row_rcp<64, 128>(rli, l_reg, shm);
        if (pass == 0) { unsigned* ob = obw + (otid() & 63);
#pragma unroll
            for (int d = 0; d < 4; ++d)
#pragma unroll
                for (int r = 0; r < 16; r += 2) ob[(d * 8 + (r >> 1)) * 64] = cvtpk_s(o[d][r] * rli[r], o[d][r + 1] * rli[r + 1]);
        }
    }
    float ss[16]; const int lane2 = otid() & 63, r32 = lane2 & 31; const unsigned* ob = obw + lane2;
    unsigned pk2_[4][8];
#pragma unroll
    for (int d = 0; d < 4; ++d)
#pragma unroll
        for (int j = 0; j < 8; ++j) pk2_[d][j] = ob[(d * 8 + j) * 64];
    asm volatile("s_waitcnt lgkmcnt(0)" ::: "memory");
#pragma unroll
    for (int r = 0; r < 16; ++r) { float s = 0.f;
#pragma unroll
        for (int d = 0; d < 4; ++d) { const unsigned w = pk2_[d][r >> 1]; const float o2 = __uint_as_float((r & 1) ? (w & 0xffff0000u) : (w << 16));
            const float y = o[d][r] * rli[r] - lam * o2; o[d][r] = y; s += y * y; }
        ss[r] = s; }
#define SWZ_STEP(K) _Pragma("unroll") for (int r = 0; r < 16; ++r) ss[r] += swz_xor<((K) << 10) | 0x1f>(ss[r]);
    SWZ_STEP(1) SWZ_STEP(2) SWZ_STEP(4) SWZ_STEP(8) SWZ_STEP(16)
#undef SWZ_STEP
#pragma unroll
    for (int d = 0; d < 4; ++d) { const float g = T.g_subln[d * 32 + r32] * 0.8f;
#pragma unroll
        for (int r = 0; r < 16; ++r) o[d][r] *= g * __builtin_amdgcn_rsqf(ss[r] * (1.f / 128.f) + 1e-6f); }
    store_rows<64, 128>(o, T.MIX + (rowbase + q0) * 1024 + 512 + h * 128, 1024, shm);
    asm volatile("s_waitcnt vmcnt(0) lgkmcnt(0)\n\ts_barrier" ::: "memory");
}
#undef SBAR
#undef PIN
#undef WAIT_BAR
#undef MFMA32
#undef EX
#undef MX3
}
#define GAS __attribute__((address_space(1)))
#define LAS __attribute__((address_space(3)))
typedef unsigned short bf16;
typedef unsigned v4u __attribute__((ext_vector_type(4)));
typedef float f32x4 __attribute__((ext_vector_type(4)));
typedef short bf16x8 __attribute__((ext_vector_type(8)));
typedef GAS unsigned gu32;
typedef GAS unsigned long long gu64;
#define RLX_AGENT __ATOMIC_RELAXED, __HIP_MEMORY_SCOPE_AGENT
#define LDS_WAIT() asm volatile("s_waitcnt lgkmcnt(0)" ::: "memory")
#define VM_WAIT() asm volatile("s_waitcnt vmcnt(0)" ::: "memory")
__device__ __forceinline__ unsigned long long rt() { return __builtin_amdgcn_s_memrealtime(); }
__device__ __forceinline__ unsigned f2bf(float f) { unsigned u = __builtin_bit_cast(unsigned, f); return (u + 0x7fffu + ((u >> 16) & 1u)) >> 16; }
__device__ __forceinline__ unsigned pk2(float lo, float hi) { return f2bf(lo) | (f2bf(hi) << 16); }

#define XB_TMO      128
#define XB_XCNT(j)  (256  + 64 * (j))
#define XB_XSUB(j)  (1280 + 64 * (j))
#define XB_XGEN(j)  (2304 + 64 * (j))
#define XB_TOP      3328
#define XB_TOPGEN   3392
#define XCD_BAR_WORDS 3456
#define XB_SPIN_CAP (1u << 18)

__device__ __forceinline__ unsigned xb_ld(unsigned* p)              { return __hip_atomic_load(p, __ATOMIC_RELAXED, __HIP_MEMORY_SCOPE_AGENT); }
__device__ __forceinline__ unsigned xb_add(unsigned* p, unsigned v) { return __hip_atomic_fetch_add(p, v, __ATOMIC_RELAXED, __HIP_MEMORY_SCOPE_AGENT); }
__device__ __forceinline__ unsigned xb_xcc_id() { return (unsigned)__builtin_amdgcn_s_getreg((3 << 11) | 20) & 0xFu; }
#define XB_SPIN(cond, bar) do { unsigned _sp = 0; while (cond) { __builtin_amdgcn_s_sleep(1); \
    if ((++_sp & 255u) == 0u) { if (xb_ld(&(bar)[XB_TMO])) break; if (_sp > XB_SPIN_CAP) { atomicAdd(&(bar)[XB_TMO], 1u); break; } } } } while (0)

struct XcdBarrier {
    unsigned* bar; unsigned x;
    volatile LAS unsigned* st;
};

__device__ __forceinline__ XcdBarrier xcd_barrier_post(unsigned* bar, volatile LAS unsigned* st) {
    XcdBarrier b; b.bar = bar; b.x = xb_xcc_id(); b.st = st;
    if (threadIdx.x == 0) st[2] = xb_add(&bar[XB_XCNT(b.x)], 1u);
    return b;
}
__device__ __forceinline__ void xcd_barrier_complete(unsigned* bar, unsigned x, unsigned& nloc, unsigned& nx) {
    const unsigned G = gridDim.x * gridDim.y * gridDim.z;
    unsigned sum, cnt, mine, sp = 0u;
    for (;;) {
        sum = 0u; cnt = 0u; mine = 0u;
#pragma unroll
        for (unsigned j = 0; j < 16; ++j) { const unsigned c = xb_ld(&bar[XB_XCNT(j)]); sum += c; cnt += (c > 0u) ? 1u : 0u; mine = (j == x) ? c : mine; }
        if (sum == G) break;
        __builtin_amdgcn_s_sleep(1);
        if ((++sp & 255u) == 0u) { if (xb_ld(&bar[XB_TMO])) break; if (sp > XB_SPIN_CAP) { atomicAdd(&bar[XB_TMO], 1u); break; } }
    }
    nloc = mine > 0u ? mine : 1u; nx = cnt > 0u ? cnt : 1u;
}

__device__ __forceinline__ void xcd_barrier(const XcdBarrier& b) {
    asm volatile("s_waitcnt vmcnt(0)" ::: "memory");
    __syncthreads();
    if (threadIdx.x == 0) {
        unsigned* bar = b.bar;
        __builtin_amdgcn_s_waitcnt(0);
        unsigned nloc = b.st[0], nx = b.st[1];
        if (nloc == 0u) { xcd_barrier_complete(bar, b.x, nloc, nx); b.st[0] = nloc; b.st[1] = nx; }
        const unsigned old = xb_add(&bar[XB_XSUB(b.x)], 1u);
        const unsigned gen = old / nloc;
        if (old + 1u == (gen + 1u) * nloc) {
            __builtin_amdgcn_fence(__ATOMIC_RELEASE, "agent");
            asm volatile("s_waitcnt vmcnt(0)" ::: "memory");
            const unsigned og = xb_add(&bar[XB_TOP], 1u);
            const unsigned tg = og / nx;
            if (og + 1u == (tg + 1u) * nx) xb_add(&bar[XB_TOPGEN], 1u);
            else XB_SPIN(xb_ld(&bar[XB_TOPGEN]) == tg, bar);
            __builtin_amdgcn_fence(__ATOMIC_ACQUIRE, "agent");
            xb_add(&bar[XB_XGEN(b.x)], 1u);
            asm volatile("s_waitcnt vmcnt(0)" ::: "memory");
        } else {
            XB_SPIN(xb_ld(&bar[XB_XGEN(b.x)]) == gen, bar);
            __builtin_amdgcn_fence(__ATOMIC_ACQUIRE, "agent");
            asm volatile("s_waitcnt vmcnt(0)" ::: "memory");
        }
    }
    __syncthreads();
}

__device__ __forceinline__ void xcc_barrier(const XcdBarrier& b) {
    asm volatile("s_waitcnt vmcnt(0)" ::: "memory");
    __syncthreads();
    if (threadIdx.x == 0) {
        unsigned* bar = b.bar;
        __builtin_amdgcn_s_waitcnt(0);
        const unsigned nloc = b.st[0];
        const unsigned old = xb_add(&bar[XB_XSUB(b.x)], 1u);
        const unsigned gen = old / nloc;
        if (old + 1u == (gen + 1u) * nloc) xb_add(&bar[XB_XGEN(b.x)], 1u);
        else XB_SPIN(xb_ld(&bar[XB_XGEN(b.x)]) == gen, bar);
        __builtin_amdgcn_fence(__ATOMIC_ACQUIRE, "agent");
        asm volatile("s_waitcnt vmcnt(0)" ::: "memory");
    }
    __syncthreads();
}
__device__ __forceinline__ bool xcc_team_setup(const XcdBarrier& b) {
    if (threadIdx.x < 64) { const unsigned G = gridDim.x, j = threadIdx.x & 15u;
        const unsigned c = xb_ld(&b.bar[XB_XCNT(j)]);
        const bool okl = (j < 8u) ? (c == G / 8u) : (c == 0u);
        const bool ok = ((G % 8u) == 0u) && (__all(okl ? 1 : 0) != 0);
        if (threadIdx.x == 0) b.st[3] = ok ? 1u : 0u; }
    __syncthreads();
    return b.st[3] != 0u;
}

constexpr int NWAVES = 8;
constexpr int M_TOK = 32768, D_MODEL = 1024, SEQ_L = 4096, FFN_H = 2816, IN_COLS = 1952;
constexpr size_t MiB = 1u << 20;
constexpr size_t WS_CTL = 0, CTL_ZERO_BYTES = 128 * 1024;
constexpr size_t WS_WIN = 2 * MiB;
constexpr size_t WS_WQKV = 6 * MiB;
constexpr size_t WS_WO = 8 * MiB;
constexpr size_t WS_WGU = 10 * MiB;
constexpr size_t WS_WD = 22 * MiB;
constexpr size_t WS_XCH = 27 * MiB + 512 * 1024;
constexpr size_t WS_ROPE = 28 * MiB;
constexpr size_t WS_RSTDX = 28 * MiB + 512 * 1024;
constexpr size_t WS_SSQQ = 29 * MiB;
constexpr size_t WS_SSQKV = 29 * MiB + 512 * 1024;
constexpr size_t WS_SSQX1 = 30 * MiB;
constexpr size_t WS_XN = 32 * MiB;
constexpr size_t WS_CQKV = 96 * MiB;
constexpr size_t WS_KR = 120 * MiB;
constexpr size_t WS_DQ = 128 * MiB, WS_DK = 160 * MiB, WS_DV = 192 * MiB;
constexpr size_t WS_QA = 224 * MiB;
constexpr size_t WS_KN = 272 * MiB, WS_VA = 304 * MiB;
constexpr size_t WS_MIX = 336 * MiB;
constexpr size_t WS_OB = 400 * MiB;
constexpr size_t WS_H = 96 * MiB;
constexpr size_t WS_END = 464 * MiB;
static_assert(WS_H + (size_t)M_TOK * FFN_H * 2 <= WS_MIX, "h overlay");
constexpr int CW_TMO = 0, CW_CODE = 1, CW_BAR = 4096, CW_SEAM = 16384;
constexpr int RING_OFF = 0, RING_BYTES = 131072;
constexpr int LDS_BYTES = 147456;
constexpr int XL_OFF = RING_BYTES;
constexpr int LDSCTL_OFF = LDS_BYTES - 1024, MISC_OFF = LDSCTL_OFF + 320;
static_assert(att::Lay<64, 128>::LDS_END <= LDSCTL_OFF && att::Lay<96, 64>::LDS_END <= LDSCTL_OFF, "attention scratch stays below the control words");

struct Args { const float* in[19]; float* out; unsigned char* ws; int ph_lo, ph_hi; };
static_assert(sizeof(Args) == 19 * 8 + 8 + 8 + 8, "no padding in Args");

__device__ __forceinline__ float wave_sum(float v) {
#pragma unroll
    for (int o = 1; o < 64; o <<= 1) v += __shfl_xor(v, o);
    return v;
}
__device__ __forceinline__ void transpose_item(const float* W, int ldw, const float* gain, bf16* WT, int ldt, LAS float* scr, int ks0, int kd0, int drow0, int srccol, int lane) {
    float v[32]; const int sc = srccol < 0 ? 0 : srccol;
#pragma unroll
    for (int i = 0; i < 32; ++i) { const int kk = 2 * i + (lane >> 5); v[i] = __builtin_nontemporal_load(&W[(size_t)(ks0 + kk) * ldw + sc]); }
    if (gain) {
        float gg[32];
#pragma unroll
        for (int i = 0; i < 32; ++i) { const int kk = 2 * i + (lane >> 5); gg[i] = gain[ks0 + kk]; }
#pragma unroll
        for (int i = 0; i < 32; ++i) v[i] *= gg[i];
    }
#pragma unroll
    for (int i = 0; i < 32; ++i) { const int kk = 2 * i + (lane >> 5); scr[kk * 33 + (lane & 31)] = srccol < 0 ? 0.f : v[i]; }
    LDS_WAIT(); asm volatile("" ::: "memory");
    const int c = lane & 7;
#pragma unroll
    for (int j = 0; j < 4; ++j) { const int n = (lane >> 3) + 8 * j; const LAS float* s = scr + (8 * c) * 33 + n;
        v4u o; o.x = pk2(s[0 * 33], s[1 * 33]); o.y = pk2(s[2 * 33], s[3 * 33]); o.z = pk2(s[4 * 33], s[5 * 33]); o.w = pk2(s[6 * 33], s[7 * 33]);
        *(GAS v4u*)(WT + (size_t)(drow0 + n) * ldt + kd0 + 8 * c) = o; }
    LDS_WAIT(); asm volatile("" ::: "memory");
}
__device__ __forceinline__ int map_win(int n) {
    if (n < 256) return n;
    if (n < 512) { const int j = n - 256; if (j < 128) return 256 + j; if (j < 160) { const int p = j - 128; return 384 + (p >> 1) + 16 * (p & 1); } return -1; }
    return 416 + (n - 512);
}
__device__ __forceinline__ int map_wq(int n) {
    if (n < 512) return (n >> 6) * 96 + (n & 63);
    const int j = n - 512, h = j >> 5, p = j & 31; return h * 96 + 64 + (p >> 1) + 16 * (p & 1);
}
__device__ __forceinline__ int map_wkv(int n) {
    if (n < 512) return (n >> 6) * 128 + (n & 63);
    const int j = n - 512; return (j >> 6) * 128 + 64 + (j & 63);
}

__constant__ float ROPE_INV_FREQ[16] = {1.0f, 0.5623413324356079f, 0.3162277638912201f, 0.17782793939113617f, 0.10000000149011612f, 0.05623413249850273f, 0.03162277489900589f, 0.017782794311642647f,
    0.009999999776482582f, 0.005623413249850273f, 0.003162277629598975f, 0.0017782794311642647f, 0.0010000000474974513f, 0.000562341301701963f, 0.0003162277571391314f, 0.00017782794020604342f};

struct Frame {
    LAS unsigned char* lds; volatile LAS unsigned* MISC; gu32* ctl;
    int wave, vcu, G;
};

__global__ void __launch_bounds__(NWAVES * 64, 2) hyb_fwd(Args args) {
    extern __shared__ __attribute__((aligned(16))) unsigned char lds[];
    Frame F;
    F.lds = (LAS unsigned char*)lds; F.MISC = (volatile LAS unsigned*)(F.lds + MISC_OFF);
    F.wave = __builtin_amdgcn_readfirstlane((int)threadIdx.x >> 6);
    F.G = gridDim.x; { const int bx = blockIdx.x; F.vcu = (F.G % 8 == 0) ? (bx % 8) * (F.G / 8) + bx / 8 : bx; }
    F.ctl = (gu32*)(args.ws + WS_CTL);
#define CAS __attribute__((address_space(4)))
#define PH_BEGIN() const CAS char* kap_ = (const CAS char*)__builtin_amdgcn_kernarg_segment_ptr(); asm volatile("" : "+s"(kap_)); unsigned char* const ws = *(unsigned char* const CAS*)(kap_ + 160)
#define INP(k) (*(const float* const CAS*)(kap_ + 8 * (k)))
#define OUTP() (*(float* const CAS*)(kap_ + 152))
#define Win_t ((bf16*)(ws + WS_WIN))
#define Wqkv_t ((bf16*)(ws + WS_WQKV))
#define Wo_t ((bf16*)(ws + WS_WO))
#define Wgu_t ((bf16*)(ws + WS_WGU))
#define Wd_t ((bf16*)(ws + WS_WD))
#define ROPE ((float*)(ws + WS_ROPE))
#define RSTDX ((float*)(ws + WS_RSTDX))
#define SSQ_Q ((float*)(ws + WS_SSQQ))
#define SSQ_KV ((float*)(ws + WS_SSQKV))
#define SSQ_X1 ((float*)(ws + WS_SSQX1))
#define XN ((bf16*)(ws + WS_XN))
#define CQKV ((bf16*)(ws + WS_CQKV))
#define KR ((bf16*)(ws + WS_KR))
#define DQ ((bf16*)(ws + WS_DQ))
#define DK ((bf16*)(ws + WS_DK))
#define DVb ((bf16*)(ws + WS_DV))
#define QA ((bf16*)(ws + WS_QA))
#define KN ((bf16*)(ws + WS_KN))
#define VA ((bf16*)(ws + WS_VA))
#define MIX ((bf16*)(ws + WS_MIX))
#define OB ((float*)(ws + WS_OB))
#define X1B ((bf16*)(ws + WS_OB))
#define HB ((bf16*)(ws + WS_H))
    for (int u = threadIdx.x; u < (LDS_BYTES - LDSCTL_OFF) / 4; u += NWAVES * 64) ((LAS unsigned*)(F.lds + LDSCTL_OFF))[u] = 0u;
    __syncthreads();
    XcdBarrier bar = xcd_barrier_post((unsigned*)(F.ctl + CW_BAR), F.MISC + 8);
    const int lo = args.ph_lo, hi = args.ph_hi;
#ifndef PHASES
#define PHASES 0xFF
#endif
#define IN(k) (((PHASES >> (k)) & 1) && lo <= (k) && (k) < hi)
#define BOTH(k) (IN(k) && IN((k) + 1))
#define GRID_BAR() do { if (team) xcc_barrier(bar); else xcd_barrier(bar); } while (0)
    bool team = false; int bxv = (int)blockIdx.x;
#ifndef PROBE_REPEAT
#define PROBE_REPEAT -1
#endif
#define REPS(k) ((PROBE_REPEAT == (k)) ? reps2 : 1)
    int reps2 = 2; asm volatile("" : "+s"(reps2));
    const int gw = F.vcu * NWAVES + F.wave, NGW = F.G * NWAVES;

    if (IN(0)) _Pragma("nounroll") for (int rep_ = 0; rep_ < REPS(0); ++rep_) {
        PH_BEGIN(); const int tid_ = att::otid(), lane_ = tid_ & 63;
        const float* x = INP(0); const float* w_in = INP(1); const float* g_attn = INP(2); const float* g_q_a = INP(3); const float* w_q_b = INP(4); const float* g_kv_a = INP(5); const float* w_kv_b = INP(6);
        const float* w_o = INP(13); const float* g_ffn = INP(14); const float* w_gate = INP(15); const float* w_up = INP(16); const float* w_down = INP(17);
        LAS float* scr = (LAS float*)(F.lds + RING_OFF + F.wave * 16384);
        constexpr int I_IN = 16 * 64, I_Q = 4 * 24, I_KV = 2 * 32, I_O = 16 * 32, I_GU = 16 * 176, I_D = 44 * 32;
        constexpr int NITEMS = I_IN + I_Q + I_KV + I_O + I_GU + I_D;
        for (int it = gw; it < NITEMS; it += NGW) {
            int r = it; const int l31 = lane_ & 31;
            if (r < I_IN) { const int kb = r / 64, nb = r % 64; transpose_item(w_in, IN_COLS, g_attn, Win_t, 1024, scr, 64 * kb, 64 * kb, 32 * nb, map_win(32 * nb + l31), lane_); continue; } r -= I_IN;
            if (r < I_Q) { const int kb = r / 24, nb = r % 24; transpose_item(w_q_b, 768, g_q_a, Wqkv_t, 384, scr, 64 * kb, 64 * kb, 32 * nb, map_wq(32 * nb + l31), lane_); continue; } r -= I_Q;
            if (r < I_KV) { const int kb = r / 32, nb = r % 32; transpose_item(w_kv_b, 1024, g_kv_a, Wqkv_t, 384, scr, 64 * kb, 256 + 64 * kb, 768 + 32 * nb, map_wkv(32 * nb + l31), lane_); continue; } r -= I_KV;
            if (r < I_O) { const int kb = r / 32, nb = r % 32; transpose_item(w_o, 1024, nullptr, Wo_t, 1024, scr, 64 * kb, 64 * kb, 32 * nb, 32 * nb + l31, lane_); continue; } r -= I_O;
            if (r < I_GU) { const int kb = r / 176, nb = r % 176; const int n = 32 * nb + l31, pn = n >> 8, j = n & 255; const bool up = j >= 128;
                transpose_item(up ? w_up : w_gate, FFN_H, g_ffn, Wgu_t, 1024, scr, 64 * kb, 64 * kb, 32 * nb, 128 * pn + (j & 127), lane_); continue; } r -= I_GU;
            { const int kb = r / 32, nb = r % 32; transpose_item(w_down, 1024, nullptr, Wd_t, FFN_H, scr, 64 * kb, 64 * kb, 32 * nb, 32 * nb + l31, lane_); }
        }
        { const int gt = F.vcu * (NWAVES * 64) + tid_, NGT = F.G * NWAVES * 64; const v4u z = (v4u){0u, 0u, 0u, 0u};
          for (int i = gt; i < 768 * 16; i += NGT) *(GAS v4u*)(Wqkv_t + (size_t)(i >> 4) * 384 + 256 + (i & 15) * 8) = z;
          for (int i = gt; i < 1024 * 32; i += NGT) *(GAS v4u*)(Wqkv_t + (size_t)(768 + (i >> 5)) * 384 + (i & 31) * 8) = z;
          for (int i = gt; i < SEQ_L * 16; i += NGT) { const int pos = i >> 4, k = i & 15; const float ang = (float)pos * ROPE_INV_FREQ[k];
              const double t = (double)ang * 0.15915494309189535; const float fr = (float)(t - __builtin_rint(t));
              ROPE[2 * i] = __builtin_amdgcn_cosf(fr); ROPE[2 * i + 1] = __builtin_amdgcn_sinf(fr); } }
        { for (int m = gw; m < M_TOK; m += 4 * NGW) { f32x4 v[4][4]; float s[4];
#pragma unroll
              for (int q = 0; q < 4; ++q) { const GAS f32x4* xr = (const GAS f32x4*)(x + (size_t)(m + q * NGW) * D_MODEL) + lane_;
#pragma unroll
                  for (int j = 0; j < 4; ++j) v[q][j] = __builtin_nontemporal_load(&xr[64 * j]); }
#pragma unroll
              for (int q = 0; q < 4; ++q) { float t = 0.f;
#pragma unroll
                  for (int j = 0; j < 4; ++j) t += (v[q][j].x * v[q][j].x + v[q][j].y * v[q][j].y) + (v[q][j].z * v[q][j].z + v[q][j].w * v[q][j].w);
                  s[q] = t; }
#pragma unroll
              for (int o = 1; o < 64; o <<= 1)
#pragma unroll
                  for (int q = 0; q < 4; ++q) s[q] += __shfl_xor(s[q], o);
#pragma unroll
              for (int q = 0; q < 4; ++q) { const float rstd = __builtin_amdgcn_rsqf(s[q] * (1.f / D_MODEL) + 1e-6f);
                  GAS unsigned long long* o8 = (GAS unsigned long long*)(XN + (size_t)(m + q * NGW) * D_MODEL) + lane_;
#pragma unroll
                  for (int j = 0; j < 4; ++j) { const f32x4 y = v[q][j]; o8[64 * j] = (unsigned long long)pk2(y.x, y.y) | ((unsigned long long)pk2(y.z, y.w) << 32); }
                  if (lane_ == 0) RSTDX[m + q * NGW] = rstd; } } }
        if (BOTH(0) && rep_ == REPS(0) - 1) { xcd_barrier(bar);
#ifndef NO_TEAM
            team = xcc_team_setup(bar);
            if (team) { const int rank = (int)bar.st[2]; bxv = rank * 8 + (int)bar.x; F.vcu = (int)bar.x * (F.G / 8) + rank;
#if defined(STAGGER_TICKS) && STAGGER_TICKS > 0
                { const unsigned long long t0 = __builtin_amdgcn_s_memrealtime(), dt = (unsigned long long)bar.x * STAGGER_TICKS; while (__builtin_amdgcn_s_memrealtime() - t0 < dt) __builtin_amdgcn_s_sleep(8); }
#endif
            }
#endif
        }
        if (PROBE_REPEAT == 9 && rep_ == 0) { _Pragma("nounroll") for (int q_ = 0; q_ < 4 * reps2; ++q_) GRID_BAR(); }
    }
    if (IN(1)) _Pragma("nounroll") for (int rep_ = 0; rep_ < REPS(1); ++rep_) {
        PH_BEGIN();
        pg8::Gemm g{XN, Win_t, M_TOK, 2048, D_MODEL}; pg8::StaticOrder S; S.init(M_TOK, 2048, F.G, bxv);
        pg8::EpiInProj E{CQKV, KR, DQ, DK, DVb, SSQ_Q, SSQ_KV, ROPE, RSTDX, 0.125f * 1.4426950408889634f};
        pg8::gemm_phase<pg8::EpiInProj, pg8::StaticOrder, true, true>(F.lds + RING_OFF, g, S, E);
        if (BOTH(1) && rep_ == REPS(1) - 1) GRID_BAR();
    }
    if (IN(2)) _Pragma("nounroll") for (int rep_ = 0; rep_ < REPS(2); ++rep_) {
        PH_BEGIN();
        int kq_ = 384; asm volatile("" : "+s"(kq_));
        pg8::Gemm g{CQKV, Wqkv_t, M_TOK, 1792, kq_}; pg8::SplitOrder S; S.init(M_TOK, 1792, F.G, bxv);
        pg8::EpiQKV E{QA, KN, VA, SSQ_Q, SSQ_KV, ROPE, 0.10206207261596575f * 1.4426950408889634f};
        pg8::gemm_phase<pg8::EpiQKV, pg8::SplitOrder, true, true>(F.lds + RING_OFF, g, S, E);
        if (BOTH(2) && rep_ == REPS(2) - 1) GRID_BAR();
    }
    if (IN(3)) _Pragma("nounroll") for (int rep_ = 0; rep_ < REPS(3); ++rep_) {
        PH_BEGIN();
        const float* lam_q1 = INP(7); const float* lam_k1 = INP(8); const float* lam_q2 = INP(9); const float* lam_k2 = INP(10); const float* g_subln = INP(11); const float* rel_bias = INP(12);
        char* shm = (char*)lds + RING_OFF;
#ifndef ATT_ONLY
#define ATT_ONLY 3
#endif
        if (ATT_ONLY & 1) { const att::MlaT T{QA, KN, KR, VA, MIX}; const int bb = F.vcu >> 5, v = F.vcu & 31;
          for (int i = 0; i < 4; ++i) { const int qb = (i & 1) ? 15 - (v & 15) : (v & 15); att::mla_unit(bb, 2 * i + (v >> 4), qb, T, shm); } }
        if (ATT_ONLY & 2) { float lam;
          { const float a = wave_sum(lam_q1[att::otid() & 63] * lam_k1[att::otid() & 63]), b2 = wave_sum(lam_q2[att::otid() & 63] * lam_k2[att::otid() & 63]); lam = __expf(a) - __expf(b2) + 0.2f; }
          const att::DiffT T{DQ, DK, DVb, MIX, OB, rel_bias, g_subln, lam}; const int bb = F.vcu >> 5, v = F.vcu & 31;
          for (int i = 0; i < 2; ++i) { const int qb = (i & 1) ? 15 - (v & 15) : (v & 15); att::diff_unit(bb, 2 * i + (v >> 4), qb, T, shm); } }
        if (BOTH(3) && rep_ == REPS(3) - 1) GRID_BAR();
    }
    if (IN(4)) _Pragma("nounroll") for (int rep_ = 0; rep_ < REPS(4); ++rep_) {
        PH_BEGIN();
        pg8::Gemm g{MIX, Wo_t, M_TOK, D_MODEL, D_MODEL}; pg8::StaticOrder S; S.init(M_TOK, D_MODEL, F.G, bxv);
        pg8::EpiOutProj E{XN, X1B, SSQ_X1};
        pg8::gemm_phase<pg8::EpiOutProj, pg8::StaticOrder, true, true>(F.lds + RING_OFF, g, S, E);
        if (BOTH(4) && rep_ == REPS(4) - 1) GRID_BAR();
    }
    if (IN(5)) _Pragma("nounroll") for (int rep_ = 0; rep_ < REPS(5); ++rep_) {
        PH_BEGIN();
        pg8::Gemm g{X1B, Wgu_t, M_TOK, 2 * FFN_H, D_MODEL}; pg8::StaticOrder S; S.init(M_TOK, 2 * FFN_H, F.G, bxv);
        const pg8::HMap hm{ws, WS_XN, WS_MIX, WS_DQ, WS_DK, WS_DV}; pg8::EpiGateUp E{hm, SSQ_X1};
        pg8::gemm_phase<pg8::EpiGateUp, pg8::StaticOrder, true, true>(F.lds + RING_OFF, g, S, E);
        if (BOTH(5) && rep_ == REPS(5) - 1) GRID_BAR();
    }
    if (IN(6)) _Pragma("nounroll") for (int rep_ = 0; rep_ < REPS(6); ++rep_) {
        PH_BEGIN(); float* out = OUTP(); const float* g_final = INP(18);
        pg8::Gemm g{HB, Wd_t, M_TOK, D_MODEL, FFN_H}; pg8::PanelOrder S; S.init(M_TOK, D_MODEL, F.G, bxv); S.hm = pg8::HMap{ws, WS_XN, WS_MIX, WS_DQ, WS_DK, WS_DV};
        pg8::EpiDownNorm E{X1B, out, g_final, (unsigned*)(ws + WS_XCH), (unsigned*)(F.ctl + CW_SEAM), F.lds + XL_OFF};
        pg8::gemm_phase<pg8::EpiDownNorm, pg8::PanelOrder, true, true>(F.lds + RING_OFF, g, S, E);
    }
#undef IN
#undef BOTH
#undef GRID_BAR
}

#ifndef MK_N_LAUNCHES
#define MK_N_LAUNCHES 1
#endif
extern "C" void kernel_launch(void* const* d_in, const int* in_sizes, int n_in, void* d_out, int out_size, void* d_ws, size_t ws_size, hipStream_t stream) {
    static int grid = 0;
    if (grid == 0) {
        if (n_in != 19 || in_sizes[0] != M_TOK * D_MODEL || out_size != M_TOK * D_MODEL || ws_size < WS_END) { fprintf(stderr, "kernel_launch: unexpected shapes (n_in %d, in0 %d, out %d, ws %zu)\n", n_in, n_in > 0 ? in_sizes[0] : -1, out_size, ws_size); grid = -1; return; }
        int dev = 0, cus = 0, per_cu = 0;
        if (hipGetDevice(&dev) != hipSuccess || hipDeviceGetAttribute(&cus, hipDeviceAttributeMultiprocessorCount, dev) != hipSuccess) { grid = -1; return; }
        if (hipFuncSetAttribute((const void*)hyb_fwd, hipFuncAttributeMaxDynamicSharedMemorySize, LDS_BYTES) != hipSuccess) { fprintf(stderr, "kernel_launch: hipFuncSetAttribute failed\n"); grid = -1; return; }
        if (hipOccupancyMaxActiveBlocksPerMultiprocessor(&per_cu, (const void*)hyb_fwd, NWAVES * 64, LDS_BYTES) != hipSuccess || per_cu < 1) fprintf(stderr, "kernel_launch: occupancy query reports %d\n", per_cu);
        (void)hipGetLastError();
        grid = cus;
        if (grid != 256) fprintf(stderr, "kernel_launch: %d CUs (built for 256)\n", grid);
    }
    if (grid < 0) return;
    if (hipMemsetAsync((char*)d_ws + WS_CTL, 0, CTL_ZERO_BYTES, stream) != hipSuccess) return;
    Args a{};
    for (int i = 0; i < 19; ++i) a.in[i] = (const float*)d_in[i];
    a.out = (float*)d_out; a.ws = (unsigned char*)d_ws;
    if (MK_N_LAUNCHES == 1) { a.ph_lo = 0; a.ph_hi = 7; hipLaunchKernelGGL(hyb_fwd, dim3(grid), dim3(NWAVES * 64), LDS_BYTES, stream, a); }
    else { for (int p = 0; p < 7; ++p) { a.ph_lo = p; a.ph_hi = p + 1; hipLaunchKernelGGL(hyb_fwd, dim3(grid), dim3(NWAVES * 64), LDS_BYTES, stream, a); } }
}
```

```cpp
#include <hip/hip_runtime.h>
#include <cstdio>
#include <cstdint>
namespace pg8 {
#define PG8_LAS __attribute__((address_space(3)))
typedef unsigned short bf16_t;
typedef short bf16x8 __attribute__((ext_vector_type(8)));
typedef float f32x4 __attribute__((ext_vector_type(4)));
typedef unsigned u32x4 __attribute__((ext_vector_type(4)));
constexpr int BM = 256, BK = 64, HALF = 128, HTB = HALF * BK * 2  , STAGE_BYTES = 8 * HTB, NXCD = 8, WGM = 8;

__host__ __device__ __forceinline__ int lds_byte(int r, int c) { const int st = (r >> 4) * 2 + (c >> 5), rr = r & 15, cc = c & 31, ob = rr * 64 + cc * 2; return st * 1024 + (ob ^ (((ob >> 9) & 1) << 5)); }
__host__ __device__ __forceinline__ void stage_rc(int b, int& R, int& C) { const int st = b / 1024, sb = b % 1024, swz = sb ^ (((sb >> 9) & 1) << 5); R = (st >> 1) * 16 + swz / 64; C = (st & 1) * 32 + (swz % 64) / 2; }
__host__ __device__ __forceinline__ int perm32(int rho) { const int n = rho >> 4, i = rho & 15; return 8 * (i >> 2) + 4 * n + (i & 3); }

struct Unit { int pm, pn; int kofs, nt; };
struct Gemm { const bf16_t* A; const bf16_t* Bt; int M, N, K; };

struct StaticOrder {
    static constexpr bool KSPLIT = false, APANEL = false;
    int nM, nN, nwg, G, c;
    __host__ __device__ void init(int M, int N, int G_, int c_) { nM = M / BM; nN = N / BM; nwg = nM * nN; G = G_; c = c_; }
    __host__ __device__ bool next(int i, Unit& u) const {
        const long L = (long)i * G + c; if (L >= nwg) return false;
        int wgid = (int)L; { const int q = nwg / NXCD, r = nwg % NXCD, xcd = wgid % NXCD, off = wgid / NXCD; wgid = (xcd < r ? xcd * (q + 1) : r * (q + 1) + (xcd - r) * q) + off; }
        const int nig = WGM * nN, gid = wgid / nig, fm = gid * WGM, gsz = (nM - fm) < WGM ? (nM - fm) : WGM;
        u.pm = fm + ((wgid % nig) % gsz); u.pn = (wgid % nig) / gsz; return true;
    }
    __device__ __forceinline__ void a_ready(const Unit&) const {}
    __device__ __forceinline__ void done(const Unit&) const {}
};

typedef float f32x2p __attribute__((ext_vector_type(2))); typedef __bf16 bf16x2p __attribute__((ext_vector_type(2)));
__device__ __forceinline__ unsigned cvt_pk_bf16(float lo, float hi) { f32x2p v = {lo, hi}; bf16x2p b = __builtin_convertvector(v, bf16x2p); return __builtin_bit_cast(unsigned, b); }
typedef float f32x2 __attribute__((ext_vector_type(2)));
__device__ __forceinline__ u32x4 pack8(const f32x4 a, const f32x4 b) { u32x4 w; w.x = cvt_pk_bf16(a[0], a[1]); w.y = cvt_pk_bf16(a[2], a[3]); w.z = cvt_pk_bf16(b[0], b[1]); w.w = cvt_pk_bf16(b[2], b[3]); return w; }
__device__ __forceinline__ float sq8(const f32x4 a, const f32x4 b) { return ((a[0] * a[0] + a[1] * a[1]) + (a[2] * a[2] + a[3] * a[3])) + ((b[0] * b[0] + b[1] * b[1]) + (b[2] * b[2] + b[3] * b[3])); }
__device__ __forceinline__ float fq_sum(float s) {
    s += __int_as_float(__builtin_amdgcn_ds_swizzle(__float_as_int(s), (16 << 10) | 0x1f));
    auto rr = __builtin_amdgcn_permlane32_swap(__float_as_uint(s), __float_as_uint(s), false, false); return __uint_as_float(rr[0]) + __uint_as_float(rr[1]); }
__device__ __forceinline__ void rope8(f32x4& v0, f32x4& v1, const f32x4 cs0, const f32x4 cs1) {
    const float a0 = v0[0] * cs0[0] - v0[1] * cs0[1], b0 = v0[1] * cs0[0] + v0[0] * cs0[1];
    const float a1 = v0[2] * cs0[2] - v0[3] * cs0[3], b1 = v0[3] * cs0[2] + v0[2] * cs0[3];
    const float a2 = v1[0] * cs1[0] - v1[1] * cs1[1], b2 = v1[1] * cs1[0] + v1[0] * cs1[1];
    const float a3 = v1[2] * cs1[2] - v1[3] * cs1[3], b3 = v1[3] * cs1[2] + v1[2] * cs1[3];
    v0 = (f32x4){a0, b0, a1, b1}; v1 = (f32x4){a2, b2, a3, b3};
}
constexpr int SEQ_LEN = 4096;
constexpr float RMS_EPS = 1e-6f;

__device__ __forceinline__ u32x4 tr16x4(const u32x4 w, const int bidx) { u32x4 r; r.x = __builtin_amdgcn_ds_bpermute(bidx, w.x); r.y = __builtin_amdgcn_ds_bpermute(bidx, w.y); r.z = __builtin_amdgcn_ds_bpermute(bidx, w.z); r.w = __builtin_amdgcn_ds_bpermute(bidx, w.w); return r; }
#define EPI_LANE_T() const int bidx = (((t2_ & 3) * 16) + ((t2_ >> 2) & 15)) * 4, fr2 = (t2_ >> 2) & 15, fq2 = t2_ & 3
#define EPI_LANE() { int t_ = threadIdx.x; asm volatile("" : "+v"(t_)); fr = t_ & 15; fq = (t_ >> 4) & 3; }
struct EpiInProj {
    static constexpr bool PERM = true, AFTER_DRAIN = false;
    bf16_t *CQKV, *KR, *DQ, *DK, *DV; float *SSQ_Q, *SSQ_KV; const float* rope; const float* rstdx; float c2d;
    __device__ __forceinline__ void operator()(f32x4 (&acc)[2][2][4][2], const Unit& u, int wr, int wc, int fr, int fq) const {
        EPI_LANE(); int t2_ = threadIdx.x; asm volatile("" : "+v"(t2_)); EPI_LANE_T(); const int row2 = u.pm * BM + wr * 64 + fr2, cw2 = wc * 32 + 8 * fq2;
        const int row0 = u.pm * BM + wr * 64 + fr, cw = wc * 32 + 8 * fq;
        { float rx[2][4];
#pragma unroll
          for (int ai = 0; ai < 2; ++ai)
#pragma unroll
              for (int m = 0; m < 4; ++m) rx[ai][m] = rstdx[row0 + ai * HALF + m * 16];
#pragma unroll
          for (int ai = 0; ai < 2; ++ai)
#pragma unroll
              for (int m = 0; m < 4; ++m)
#pragma unroll
                  for (int bj = 0; bj < 2; ++bj) { acc[ai][bj][m][0] *= rx[ai][m]; acc[ai][bj][m][1] *= rx[ai][m]; } }
        if (u.pn == 0) {
#pragma unroll
            for (int ai = 0; ai < 2; ++ai)
#pragma unroll
                for (int m = 0; m < 4; ++m) { const size_t row = (size_t)(row0 + ai * HALF + m * 16); float s = 0.f;
#pragma unroll
                    for (int bj = 0; bj < 2; ++bj) { const f32x4 v0 = acc[ai][bj][m][0], v1 = acc[ai][bj][m][1]; s += sq8(v0, v1); *(u32x4*)(CQKV + (size_t)(row2 + ai * HALF + m * 16) * 384 + bj * HALF + cw2) = tr16x4(pack8(v0, v1), bidx); }
                    s = fq_sum(s); if (fq == 0) SSQ_Q[row * 4 + wc] = s; }
        } else if (u.pn == 1) {
            f32x4 cs[2][4][2];
            if (wc == 0) {
#pragma unroll
                for (int ai = 0; ai < 2; ++ai)
#pragma unroll
                    for (int m = 0; m < 4; ++m) { const float* t = rope + (size_t)((row0 + ai * HALF + m * 16) & (SEQ_LEN - 1)) * 32 + 8 * fq; cs[ai][m][0] = *(const f32x4*)t; cs[ai][m][1] = *(const f32x4*)(t + 4); }
            }
#pragma unroll
            for (int ai = 0; ai < 2; ++ai)
#pragma unroll
                for (int m = 0; m < 4; ++m) { const size_t row = (size_t)(row0 + ai * HALF + m * 16);
                    { const f32x4 v0 = acc[ai][0][m][0], v1 = acc[ai][0][m][1]; float s = sq8(v0, v1); *(u32x4*)(CQKV + (size_t)(row2 + ai * HALF + m * 16) * 384 + 256 + cw2) = tr16x4(pack8(v0, v1), bidx);
                      s = fq_sum(s); if (fq == 0) SSQ_KV[row * 4 + wc] = s; }
                    if (wc == 0) { f32x4 v0 = acc[ai][1][m][0], v1 = acc[ai][1][m][1]; rope8(v0, v1, cs[ai][m][0], cs[ai][m][1]); *(u32x4*)(KR + (size_t)(row2 + ai * HALF + m * 16) * 32 + 8 * fq2) = tr16x4(pack8(v0, v1), bidx); } }
        } else {
            bf16_t* dst = DQ + (size_t)((u.pn - 2) >> 1) * ((size_t)32768 * 512); const int cb2 = ((u.pn - 2) & 1) * 256 + cw2; const float sc = u.pn < 4 ? c2d : 1.f;
#pragma unroll
            for (int ai = 0; ai < 2; ++ai)
#pragma unroll
                for (int m = 0; m < 4; ++m) { const size_t row = (size_t)(row0 + ai * HALF + m * 16);
#pragma unroll
                    for (int bj = 0; bj < 2; ++bj) *(u32x4*)(dst + (size_t)(row2 + ai * HALF + m * 16) * 512 + cb2 + bj * HALF) = tr16x4(pack8(acc[ai][bj][m][0] * sc, acc[ai][bj][m][1] * sc), bidx); }
        }
    }
};
struct EpiQKV {
    static constexpr bool PERM = true, AFTER_DRAIN = false;
    bf16_t *QA, *KN, *VA; const float *SSQ_Q, *SSQ_KV; const float* rope; float c2a;
    __device__ __forceinline__ void rstd4(float (&rs)[4], const float* ssq, int rowb, float inv, float mul) const {
        f32x4 pp[4];
#pragma unroll
        for (int m = 0; m < 4; ++m) pp[m] = *(const f32x4*)(ssq + (size_t)(rowb + m * 16) * 4);
#pragma unroll
        for (int m = 0; m < 4; ++m) rs[m] = __builtin_amdgcn_rsqf(((pp[m][0] + pp[m][1]) + (pp[m][2] + pp[m][3])) * inv + RMS_EPS) * mul;
    }
    __device__ __forceinline__ void rstd8(float (&rs)[2][4], const float* ssq, int rowb, float inv, float mul) const {
        f32x4 pp[2][4];
#pragma unroll
        for (int ai = 0; ai < 2; ++ai)
#pragma unroll
            for (int m = 0; m < 4; ++m) pp[ai][m] = *(const f32x4*)(ssq + (size_t)(rowb + ai * HALF + m * 16) * 4);
#pragma unroll
        for (int ai = 0; ai < 2; ++ai)
#pragma unroll
            for (int m = 0; m < 4; ++m) rs[ai][m] = __builtin_amdgcn_rsqf(((pp[ai][m][0] + pp[ai][m][1]) + (pp[ai][m][2] + pp[ai][m][3])) * inv + RMS_EPS) * mul;
    }
    __device__ __forceinline__ void operator()(const f32x4 (&acc)[2][2][4][2], const Unit& u, int wr, int wc, int fr, int fq) const {
        EPI_LANE(); int t2_ = threadIdx.x; asm volatile("" : "+v"(t2_)); EPI_LANE_T(); const int row2 = u.pm * BM + wr * 64 + fr2, cw2 = wc * 32 + 8 * fq2;
        const int row0 = u.pm * BM + wr * 64 + fr, cw = wc * 32 + 8 * fq;
        if (u.pn < 2) {
            float rs2[2][4]; rstd8(rs2, SSQ_Q, row0, 1.f / 256.f, c2a);
#pragma unroll
            for (int ai = 0; ai < 2; ++ai) { const float (&rs)[4] = rs2[ai];
#pragma unroll
                for (int m = 0; m < 4; ++m) { const size_t row = (size_t)(row0 + ai * HALF + m * 16);
#pragma unroll
                    for (int bj = 0; bj < 2; ++bj) { const int n = u.pn * 256 + bj * HALF + cw2; *(u32x4*)(QA + (size_t)(row2 + ai * HALF + m * 16) * 768 + (n >> 6) * 96 + (n & 63)) = tr16x4(pack8(acc[ai][bj][m][0] * rs[m], acc[ai][bj][m][1] * rs[m]), bidx); } }
                asm volatile("" ::: "memory"); }
        } else if (u.pn == 2) {
            float rs2[2][4]; rstd8(rs2, SSQ_Q, row0, 1.f / 256.f, c2a);
            f32x4 cs[2][2][2];
#define QKV_CS_LOAD(B_, AI_, MP_) _Pragma("unroll") for (int mm = 0; mm < 2; ++mm) { const float* t = rope + (size_t)((row0 + (AI_) * HALF + (2 * (MP_) + mm) * 16) & (SEQ_LEN - 1)) * 32 + 8 * fq; cs[B_][mm][0] = *(const f32x4*)t; cs[B_][mm][1] = *(const f32x4*)(t + 4); }
            QKV_CS_LOAD(0, 0, 0);
#pragma unroll
            for (int ib = 0; ib < 4; ++ib) { const int ai = ib >> 1, mp = ib & 1, bb = ib & 1;
                if (ib + 1 < 4) { QKV_CS_LOAD((ib + 1) & 1, (ib + 1) >> 1, (ib + 1) & 1); }
#pragma unroll
                for (int mm = 0; mm < 2; ++mm) { const int m = 2 * mp + mm;
#pragma unroll
                    for (int bj = 0; bj < 2; ++bj) { f32x4 v0 = acc[ai][bj][m][0] * rs2[ai][m], v1 = acc[ai][bj][m][1] * rs2[ai][m]; rope8(v0, v1, cs[bb][mm][0], cs[bb][mm][1]); *(u32x4*)(QA + (size_t)(row2 + ai * HALF + m * 16) * 768 + (4 * bj + wc) * 96 + 64 + 8 * fq2) = tr16x4(pack8(v0, v1), bidx); } } }
#undef QKV_CS_LOAD
        } else {
            bf16_t* dst = KN + (size_t)((u.pn - 3) >> 1) * ((size_t)32768 * 512); const int cb2 = ((u.pn - 3) & 1) * 256 + cw2;
            float rs2[2][4]; rstd8(rs2, SSQ_KV, row0, 1.f / 128.f, 1.f);
#pragma unroll
            for (int ai = 0; ai < 2; ++ai) { const float (&rs)[4] = rs2[ai];
#pragma unroll
                for (int m = 0; m < 4; ++m) { const size_t row = (size_t)(row0 + ai * HALF + m * 16);
#pragma unroll
                    for (int bj = 0; bj < 2; ++bj) *(u32x4*)(dst + (size_t)(row2 + ai * HALF + m * 16) * 512 + cb2 + bj * HALF) = tr16x4(pack8(acc[ai][bj][m][0] * rs[m], acc[ai][bj][m][1] * rs[m]), bidx); }
                asm volatile("" ::: "memory"); }
        }
    }
};
struct EpiOutProj {
    static constexpr bool PERM = true, AFTER_DRAIN = false;
    const bf16_t* XB; bf16_t* X1B; float* SSQ;
    __device__ __forceinline__ void operator()(const f32x4 (&acc)[2][2][4][2], const Unit& u, int wr, int wc, int fr, int fq) const {
        EPI_LANE();
        int t2_ = threadIdx.x; asm volatile("" : "+v"(t2_)); EPI_LANE_T();
        const int row0 = u.pm * BM + wr * 64 + fr, cw = u.pn * BM + wc * 32 + 8 * fq;
        bf16_t* const st = X1B + (size_t)(u.pm * BM + wr * 64 + fr2) * 1024 + u.pn * BM + wc * 32 + 8 * fq2;
        u32x4 xb[2][4][2];
#pragma unroll
        for (int ai = 0; ai < 2; ++ai)
#pragma unroll
            for (int m = 0; m < 4; ++m)
#pragma unroll
                for (int bj = 0; bj < 2; ++bj) xb[ai][m][bj] = __builtin_nontemporal_load((const u32x4*)(XB + (size_t)(row0 + ai * HALF + m * 16) * 1024 + cw + bj * HALF));
#pragma unroll
        for (int ai = 0; ai < 2; ++ai)
#pragma unroll
            for (int m = 0; m < 4; ++m) { const size_t row = (size_t)(row0 + ai * HALF + m * 16); float s = 0.f;
#pragma unroll
                for (int bj = 0; bj < 2; ++bj) { const u32x4 w = xb[ai][m][bj];
                    const f32x4 v0 = acc[ai][bj][m][0] + (f32x4){__uint_as_float(w.x << 16), __uint_as_float(w.x & 0xffff0000u), __uint_as_float(w.y << 16), __uint_as_float(w.y & 0xffff0000u)};
                    const f32x4 v1 = acc[ai][bj][m][1] + (f32x4){__uint_as_float(w.z << 16), __uint_as_float(w.z & 0xffff0000u), __uint_as_float(w.w << 16), __uint_as_float(w.w & 0xffff0000u)};
                    s += sq8(v0, v1); *(u32x4*)(st + (size_t)(ai * HALF + m * 16) * 1024 + bj * HALF) = tr16x4(pack8(v0, v1), bidx); }
                s = fq_sum(s); if (fq == 0) SSQ[row * 16 + u.pn * 4 + wc] = s; }
    }
};
struct HMap { unsigned char* ws; size_t xn, mix, dq, dk, dv;
    __host__ __device__ __forceinline__ bf16_t* panel(int pm) const { const int b = pm >> 4, p = pm & 15; constexpr size_t PB = (size_t)256 * 2816 * 2, MB = (size_t)1 << 20;
        size_t off;
        if (p < 5) off = xn + (size_t)b * 8 * MB + (size_t)p * PB;
        else if (p < 10) off = mix + (size_t)b * 8 * MB + (size_t)(p - 5) * PB;
        else if (p < 12) off = dq + (size_t)b * 4 * MB + (size_t)(p - 10) * PB;
        else if (p < 14) off = dk + (size_t)b * 4 * MB + (size_t)(p - 12) * PB;
        else off = dv + (size_t)b * 4 * MB + (size_t)(p - 14) * PB;
        return (bf16_t*)(ws + off); } };
struct PanelOrder {
    static constexpr bool KSPLIT = false, APANEL = true;
    StaticOrder so; HMap hm;
    __host__ __device__ void init(int M, int N, int G_, int c_) { so.init(M, N, G_, c_); }
    __host__ __device__ bool next(int i, Unit& u) const { return so.next(i, u); }
    __device__ __forceinline__ const char* a_panel(int pm) const { return (const char*)hm.panel(pm); }
    __device__ __forceinline__ void a_ready(const Unit&) const {}
    __device__ __forceinline__ void done(const Unit&) const {}
};
struct EpiGateUp {
    static constexpr bool PERM = true, AFTER_DRAIN = false;
    HMap hm; const float* SSQ;
    __device__ __forceinline__ void operator()(const f32x4 (&acc)[2][2][4][2], const Unit& u, int wr, int wc, int fr, int fq) const {
        EPI_LANE(); int t2_ = threadIdx.x; asm volatile("" : "+v"(t2_)); EPI_LANE_T(); const int row2 = u.pm * BM + wr * 64 + fr2, cw2 = wc * 32 + 8 * fq2;
        const int row0 = u.pm * BM + wr * 64 + fr, cw = u.pn * HALF + wc * 32 + 8 * fq;
        bf16_t* const Hp = hm.panel(u.pm) + (size_t)(wr * 64 + fr2) * 2816 + u.pn * HALF + cw2;
        float rs[2][4];
        { f32x4 pp[2][4];
#pragma unroll
          for (int ai = 0; ai < 2; ++ai)
#pragma unroll
              for (int m = 0; m < 4; ++m) pp[ai][m] = *(const f32x4*)(SSQ + (size_t)(row0 + ai * HALF + m * 16) * 16 + 4 * fq);
#pragma unroll
          for (int ai = 0; ai < 2; ++ai)
#pragma unroll
              for (int m = 0; m < 4; ++m) rs[ai][m] = __builtin_amdgcn_rsqf(fq_sum((pp[ai][m][0] + pp[ai][m][1]) + (pp[ai][m][2] + pp[ai][m][3])) * (1.f / 1024.f) + RMS_EPS); }
#pragma unroll
        for (int ai = 0; ai < 2; ++ai)
#pragma unroll
            for (int m = 0; m < 4; ++m) { const size_t row = (size_t)(row0 + ai * HALF + m * 16); const float r = rs[ai][m];
                f32x4 hv[2];
#pragma unroll
                for (int n = 0; n < 2; ++n) { const f32x4 g = acc[ai][0][m][n] * r, up = acc[ai][1][m][n] * r;
#pragma unroll
                    for (int j = 0; j < 4; ++j) { const float e = __builtin_amdgcn_exp2f(g[j] * -1.4426950408889634f); hv[n][j] = g[j] * __builtin_amdgcn_rcpf(1.0f + e) * up[j]; } }
                *(u32x4*)(Hp + (size_t)(ai * HALF + m * 16) * 2816) = tr16x4(pack8(hv[0], hv[1]), bidx); }
    }
};
struct EpiDownNorm {
    static constexpr bool PERM = true, AFTER_DRAIN = false;
    const bf16_t* X1B; float* OUT; const float* G; unsigned* xbuf; unsigned* cnt; PG8_LAS unsigned char* xl;
    __device__ __forceinline__ void operator()(f32x4 (&acc)[2][2][4][2], const Unit& u, int wr, int wc, int fr, int fq) const {
        int t_ = threadIdx.x; asm volatile("" : "+v"(t_)); fr = t_ & 15; fq = (t_ >> 4) & 3; const int lane = t_ & 63, wid = wr * 4 + wc; const int t2_ = t_; EPI_LANE_T();
        PG8_LAS float* P = (PG8_LAS float*)xl; PG8_LAS float* S = (PG8_LAS float*)(xl + 4096); PG8_LAS unsigned* flag = (PG8_LAS unsigned*)(xl + 5120);
        const int row0 = u.pm * BM + wr * 64 + fr, cw = u.pn * BM + wc * 32 + 8 * fq;
        f32x4 gv[2][2];
#pragma unroll
        for (int bj = 0; bj < 2; ++bj) { gv[bj][0] = *(const f32x4*)(G + cw + bj * HALF); gv[bj][1] = *(const f32x4*)(G + cw + bj * HALF + 4); }
        u32x4 xb[2][4][2];
#pragma unroll
        for (int ai = 0; ai < 2; ++ai)
#pragma unroll
            for (int m = 0; m < 4; ++m)
#pragma unroll
                for (int bj = 0; bj < 2; ++bj) xb[ai][m][bj] = __builtin_nontemporal_load((const u32x4*)(X1B + (size_t)(row0 + ai * HALF + m * 16) * 1024 + cw + bj * HALF));
#pragma unroll
        for (int ai = 0; ai < 2; ++ai) {
#pragma unroll
            for (int m = 0; m < 4; ++m) { float s = 0.f;
#pragma unroll
                for (int bj = 0; bj < 2; ++bj) { const u32x4 w = xb[ai][m][bj];
                    const f32x4 a0 = (f32x4){__uint_as_float(w.x << 16), __uint_as_float(w.x & 0xffff0000u), __uint_as_float(w.y << 16), __uint_as_float(w.y & 0xffff0000u)};
                    const f32x4 a1 = (f32x4){__uint_as_float(w.z << 16), __uint_as_float(w.z & 0xffff0000u), __uint_as_float(w.w << 16), __uint_as_float(w.w & 0xffff0000u)};
                    acc[ai][bj][m][0] += a0; acc[ai][bj][m][1] += a1; s += sq8(acc[ai][bj][m][0], acc[ai][bj][m][1]); }
                s = fq_sum(s); if (fq == 0) P[(ai * HALF + wr * 64 + m * 16 + fr) * 4 + wc] = s; }
        }
        asm volatile("s_waitcnt lgkmcnt(0)" ::: "memory"); __builtin_amdgcn_s_barrier(); asm volatile("" ::: "memory");
        const int prow = wid * 32 + (lane & 31);
        if (lane < 32) { const float tot = (P[prow * 4 + 0] + P[prow * 4 + 1]) + (P[prow * 4 + 2] + P[prow * 4 + 3]);
            __hip_atomic_store(xbuf + ((size_t)(u.pm * BM + prow) * 4 + u.pn), __float_as_uint(tot), __ATOMIC_RELAXED, __HIP_MEMORY_SCOPE_AGENT); }
        asm volatile("s_waitcnt vmcnt(0)" ::: "memory");
        if (lane == 0) __hip_atomic_fetch_add(cnt + 64 * u.pm, 1u, __ATOMIC_RELAXED, __HIP_MEMORY_SCOPE_AGENT);
        if (wid == 0) { unsigned sp = 0;
            while ((unsigned)__builtin_amdgcn_readfirstlane(__hip_atomic_load(cnt + 64 * u.pm, __ATOMIC_RELAXED, __HIP_MEMORY_SCOPE_AGENT)) < 32u) { __builtin_amdgcn_s_sleep(2); if (++sp > (1u << 22)) break; }
            __builtin_amdgcn_fence(__ATOMIC_ACQUIRE, "agent");
            if (lane == 0) flag[0] = sp; }
        asm volatile("s_waitcnt vmcnt(0) lgkmcnt(0)" ::: "memory"); __builtin_amdgcn_s_barrier(); asm volatile("" ::: "memory");
        if (lane < 32) { const unsigned* slot = xbuf + (size_t)(u.pm * BM + prow) * 4; float q = 0.f;
#pragma unroll
            for (int t = 0; t < 4; ++t) q += __uint_as_float(__hip_atomic_load(slot + t, __ATOMIC_RELAXED, __HIP_MEMORY_SCOPE_AGENT));
            S[prow] = __builtin_amdgcn_rsqf(q * (1.f / 1024.f) + RMS_EPS); }
        asm volatile("s_waitcnt lgkmcnt(0)" ::: "memory"); __builtin_amdgcn_s_barrier(); asm volatile("" ::: "memory");
#pragma unroll
        for (int ai = 0; ai < 2; ++ai)
#pragma unroll
            for (int m = 0; m < 4; ++m) { const int r = ai * HALF + wr * 64 + m * 16 + fr; const float rs = S[r]; const size_t off = (size_t)(u.pm * BM + r) * 1024 + cw;
#pragma unroll
                for (int bj = 0; bj < 2; ++bj) { const f32x4 o0 = acc[ai][bj][m][0] * rs * gv[bj][0], o1 = acc[ai][bj][m][1] * rs * gv[bj][1]; float* const op = OUT + (size_t)(u.pm * BM + ai * HALF + wr * 64 + m * 16 + fr2) * 1024 + u.pn * BM + wc * 32 + 8 * fq2 + bj * HALF;
                    *(u32x4*)op = tr16x4(__builtin_bit_cast(u32x4, o0), bidx); *(u32x4*)(op + 4) = tr16x4(__builtin_bit_cast(u32x4, o1), bidx); } }
    }
};

struct SplitOrder {
    static constexpr bool KSPLIT = true, APANEL = false;
    StaticOrder so;
    __host__ __device__ void init(int M, int N, int G_, int c_) { so.init(M, N, G_, c_); }
    __host__ __device__ bool next(int i, Unit& u) const { if (!so.next(i, u)) return false; if (u.pn < 3) { u.kofs = 0; u.nt = 4; } else { u.kofs = 256 * 2; u.nt = 2; } return true; }
    __device__ __forceinline__ void a_ready(const Unit&) const {}
    __device__ __forceinline__ void done(const Unit&) const {}
};
template <class Epi, class Sched, bool ALIGN_EPI = false, bool SP2 = false>
__device__ __forceinline__ void gemm_phase(PG8_LAS unsigned char* lds, const Gemm g, const Sched& S, const Epi& E) {
    const int tid = threadIdx.x, wid = __builtin_amdgcn_readfirstlane(tid >> 6), lane = tid & 63, wr = wid >> 2, wc = wid & 3, fr = lane & 15, fq = lane >> 4;
    const int K = g.K; int nt = K / BK;
    unsigned voffA[2], voffB[2];
#pragma unroll
    for (int i = 0; i < 2; ++i) { int R, C; stage_rc(tid * 16 + i * 8192, R, C); const int Rb = Epi::PERM ? ((R & ~31) + perm32(R & 31)) : R;
        voffA[i] = (unsigned)(R * K + C) * 2u; voffB[i] = (unsigned)(Rb * K + C) * 2u; }
    const size_t kstep = (size_t)(BK * 2);
    const size_t hstep = (size_t)HALF * K * 2;
    const size_t tstep = 2 * hstep;
    const unsigned ldsw = (unsigned)wid * 1024u;
    const int aoff = lds_byte(wr * 64 + fr, fq * 8), boff = lds_byte(wc * 32 + fr, fq * 8);
#define PG8_SA(b, h) (((b) * 2 + (h)) * HTB)
#define PG8_SB(b, h) ((4 + (b) * 2 + (h)) * HTB)
#define PG8_STAGE(bufoff, gbase, voff) do { _Pragma("unroll") for (int _i = 0; _i < 2; ++_i) \
        __builtin_amdgcn_global_load_lds((const unsigned*)((const char*)(gbase) + (voff)[_i]), (PG8_LAS unsigned*)(lds + (bufoff) + ldsw + _i * 8192), 16, 0, 0); } while (0)
#define PG8_LDA(dst, b, h) do { _Pragma("unroll") for (int m = 0; m < 4; ++m) _Pragma("unroll") for (int k = 0; k < 2; ++k) dst[m][k] = *(const PG8_LAS bf16x8*)(lds + PG8_SA(b, h) + aoff + m * 2048 + k * 1024); } while (0)
#define PG8_LDB(dst, b, h) do { _Pragma("unroll") for (int n = 0; n < 2; ++n) _Pragma("unroll") for (int k = 0; k < 2; ++k) dst[n][k] = *(const PG8_LAS bf16x8*)(lds + PG8_SB(b, h) + boff + n * 2048 + k * 1024); } while (0)
#define PG8_MMA(ai, bj, At, Bt) do { __builtin_amdgcn_s_setprio(1); _Pragma("unroll") for (int m = 0; m < 4; ++m) _Pragma("unroll") for (int n = 0; n < 2; ++n) _Pragma("unroll") for (int k = 0; k < 2; ++k) \
        acc[ai][bj][m][n] = __builtin_amdgcn_mfma_f32_16x16x32_bf16(Bt[n][k], At[m][k], acc[ai][bj][m][n], 0, 0, 0); __builtin_amdgcn_s_setprio(0); } while (0)
#define PG8_WAIT_V(n) asm volatile("s_waitcnt vmcnt(" #n ")" ::: "memory")
#define PG8_WAIT_L(n) asm volatile("s_waitcnt lgkmcnt(" #n ")" ::: "memory")
#define PG8_BAR __builtin_amdgcn_s_barrier()
#define PG8_SCHED __builtin_amdgcn_sched_barrier(0)
    Unit cur, nxt; int ui = 0;
    if (!S.next(0, cur)) return;
    f32x4 acc[2][2][4][2];
#pragma unroll
    for (int a = 0; a < 2; ++a)
#pragma unroll
        for (int b = 0; b < 2; ++b)
#pragma unroll
            for (int m = 0; m < 4; ++m)
#pragma unroll
                for (int n = 0; n < 2; ++n) acc[a][b][m][n] = (f32x4){0.f, 0.f, 0.f, 0.f};
    bf16x8 At[4][2], B0[2][2], B1[2][2];
    const char* cA; if constexpr (Sched::APANEL) cA = S.a_panel(cur.pm); else cA = (const char*)g.A + (size_t)cur.pm * tstep + (Sched::KSPLIT ? cur.kofs : 0);
    const char* cB = (const char*)g.Bt + (size_t)cur.pn * tstep + (Sched::KSPLIT ? cur.kofs : 0);
    S.a_ready(cur);
    if constexpr (SP2) {
        PG8_STAGE(PG8_SB(0, 0), cB, voffB); PG8_STAGE(PG8_SB(0, 1), cB + hstep, voffB); PG8_STAGE(PG8_SA(0, 0), cA, voffA); PG8_STAGE(PG8_SA(0, 1), cA + hstep, voffA);
        if (wr == 1) PG8_BAR;
        PG8_WAIT_V(2); PG8_BAR;
        PG8_STAGE(PG8_SB(1, 0), cB + kstep, voffB); PG8_STAGE(PG8_SA(1, 0), cA + kstep, voffA); PG8_STAGE(PG8_SB(1, 1), cB + hstep + kstep, voffB);
        PG8_WAIT_V(6); PG8_BAR;
    } else {
        PG8_STAGE(PG8_SB(0, 0), cB, voffB); PG8_STAGE(PG8_SA(0, 0), cA, voffA); PG8_STAGE(PG8_SB(0, 1), cB + hstep, voffB); PG8_STAGE(PG8_SA(0, 1), cA + hstep, voffA);
        if (wr == 1) PG8_BAR;
        PG8_WAIT_V(4); PG8_BAR;
        PG8_STAGE(PG8_SB(1, 0), cB + kstep, voffB); PG8_STAGE(PG8_SA(1, 0), cA + kstep, voffA); PG8_STAGE(PG8_SB(1, 1), cB + hstep + kstep, voffB);
        PG8_WAIT_V(6); PG8_BAR;
    }
    for (;;) {
        const bool has_next = S.next(ui + 1, nxt);
        const char* nA; if constexpr (Sched::APANEL) nA = has_next ? S.a_panel(nxt.pm) : cA; else nA = has_next ? (const char*)g.A + (size_t)nxt.pm * tstep + (Sched::KSPLIT ? nxt.kofs : 0) : cA;
        const char* nB = has_next ? (const char*)g.Bt + (size_t)nxt.pn * tstep + (Sched::KSPLIT ? nxt.kofs : 0) : cB;
        if constexpr (Sched::KSPLIT) nt = cur.nt;
        for (int t = 0; t < nt; t += 2) {
            const bool last = (t == nt - 2);
            const char* a1 = cA + (size_t)(t + 1) * kstep;
            const char* a2 = last ? nA : cA + (size_t)(t + 2) * kstep; const char* b2 = last ? nB : cB + (size_t)(t + 2) * kstep;
            const char* a3 = a2 + kstep; const char* b3 = b2 + kstep;
            if (last && has_next) S.a_ready(nxt);
            if constexpr (SP2) {
            PG8_LDB(B0, 0, 0); PG8_LDB(B1, 0, 1); PG8_SCHED; PG8_LDA(At, 0, 0); PG8_STAGE(PG8_SA(1, 1), a1 + hstep, voffA);
            PG8_WAIT_V(8); PG8_WAIT_L(0); PG8_BAR; PG8_MMA(0, 0, At, B0); PG8_MMA(0, 1, At, B1); PG8_BAR; PG8_SCHED;
            PG8_LDA(At, 0, 1); PG8_STAGE(PG8_SB(0, 0), b2, voffB); PG8_STAGE(PG8_SB(0, 1), b2 + hstep, voffB); PG8_STAGE(PG8_SA(0, 0), a2, voffA);
            PG8_WAIT_V(8); PG8_WAIT_L(0); PG8_BAR; PG8_MMA(1, 0, At, B0); PG8_MMA(1, 1, At, B1); PG8_BAR; PG8_SCHED;
            PG8_LDB(B0, 1, 0); PG8_LDB(B1, 1, 1); PG8_SCHED; PG8_LDA(At, 1, 0); PG8_STAGE(PG8_SA(0, 1), a2 + hstep, voffA);
            PG8_WAIT_V(8); PG8_WAIT_L(0); PG8_BAR; PG8_MMA(0, 0, At, B0); PG8_MMA(0, 1, At, B1); PG8_BAR; PG8_SCHED;
            PG8_LDA(At, 1, 1); PG8_STAGE(PG8_SB(1, 0), b3, voffB); PG8_STAGE(PG8_SB(1, 1), b3 + hstep, voffB); PG8_STAGE(PG8_SA(1, 0), a3, voffA);
            PG8_WAIT_V(8); PG8_WAIT_L(0); PG8_BAR; PG8_MMA(1, 0, At, B0); PG8_MMA(1, 1, At, B1); PG8_BAR; PG8_SCHED;
            } else {
            PG8_LDB(B0, 0, 0); PG8_SCHED; PG8_LDA(At, 0, 0); PG8_STAGE(PG8_SA(1, 1), a1 + hstep, voffA);
            PG8_WAIT_L(8); PG8_BAR; PG8_WAIT_L(0); PG8_MMA(0, 0, At, B0); PG8_BAR; PG8_SCHED;
            PG8_LDB(B1, 0, 1); PG8_STAGE(PG8_SB(0, 0), b2, voffB);
            PG8_BAR; PG8_WAIT_L(0); PG8_MMA(0, 1, At, B1); PG8_BAR;
            PG8_LDA(At, 0, 1); PG8_STAGE(PG8_SA(0, 0), a2, voffA);
            PG8_BAR; PG8_WAIT_L(0); PG8_MMA(1, 0, At, B0); PG8_BAR; PG8_SCHED;
            PG8_STAGE(PG8_SB(0, 1), b2 + hstep, voffB);
            PG8_WAIT_V(6); PG8_BAR; PG8_MMA(1, 1, At, B1); PG8_BAR;
            PG8_LDB(B0, 1, 0); PG8_SCHED; PG8_LDA(At, 1, 0); PG8_STAGE(PG8_SA(0, 1), a2 + hstep, voffA);
            PG8_WAIT_L(8); PG8_BAR; PG8_WAIT_L(0); PG8_MMA(0, 0, At, B0); PG8_BAR; PG8_SCHED;
            PG8_LDB(B1, 1, 1); PG8_STAGE(PG8_SB(1, 0), b3, voffB);
            PG8_BAR; PG8_WAIT_L(0); PG8_MMA(0, 1, At, B1); PG8_BAR;
            PG8_LDA(At, 1, 1); PG8_STAGE(PG8_SA(1, 0), a3, voffA);
            PG8_BAR; PG8_WAIT_L(0); PG8_MMA(1, 0, At, B0); PG8_BAR; PG8_SCHED;
            PG8_STAGE(PG8_SB(1, 1), b3 + hstep, voffB);
            PG8_WAIT_V(6); PG8_BAR; PG8_MMA(1, 1, At, B1); PG8_BAR;
            }
        }
        if constexpr (ALIGN_EPI) { if (wr == 0) PG8_BAR; }
        if constexpr (!Epi::AFTER_DRAIN) { E(acc, cur, wr, wc, fr, fq); S.done(cur); }
        if (!has_next) break;
#pragma unroll
        for (int a = 0; a < 2; ++a)
#pragma unroll
            for (int b = 0; b < 2; ++b)
#pragma unroll
                for (int m = 0; m < 4; ++m)
#pragma unroll
                    for (int n = 0; n < 2; ++n) acc[a][b][m][n] = (f32x4){0.f, 0.f, 0.f, 0.f};
        cur = nxt; cA = nA; cB = nB; ++ui;
        if constexpr (ALIGN_EPI) { if (wr == 1) PG8_BAR; }
    }
    PG8_WAIT_V(0);
    if constexpr (!ALIGN_EPI) { if (wr == 0) PG8_BAR; }
    PG8_BAR;
    if constexpr (Epi::AFTER_DRAIN) { E.fused(acc, cur, wr, wc, fr, fq, lds, wid, lane); S.done(cur); }
#undef PG8_SA
#undef PG8_SB
#undef PG8_STAGE
#undef PG8_LDA
#undef PG8_LDB
#undef PG8_MMA
#undef PG8_WAIT_V
#undef PG8_WAIT_L
#undef PG8_BAR
#undef PG8_SCHED
}
}
namespace att {
using bf16x8 = __attribute__((ext_vector_type(8))) short;
using s16x4 = __attribute__((ext_vector_type(4))) short;
using f32x16 = __attribute__((ext_vector_type(16))) float;
using u32x4 = __attribute__((ext_vector_type(4))) unsigned;
typedef unsigned short bf16;
constexpr int SEQ = 4096, NW = 8, QB = 256, KVBLK = 64, NSLOT = 3;
#ifndef ATT_THRL
#define ATT_THRL 8
#endif
constexpr float TSUM = (ATT_THRL == 0) ? 0.25f : (float)(1 << (ATT_THRL + 2));
__device__ __forceinline__ int otid() { int t = threadIdx.x; asm volatile("" : "+v"(t)); return t; }
template <int PAT> __device__ __forceinline__ float swz_xor(float v) { return __int_as_float(__builtin_amdgcn_ds_swizzle(__float_as_int(v), PAT)); }
__device__ __forceinline__ int crow(int r, int hi) { return (r & 3) + 8 * (r >> 2) + 4 * hi; }
#define SBAR() __builtin_amdgcn_sched_barrier(0)
#define PIN(x) asm volatile("" : "+v"(x))
#define WAIT_BAR(N) asm volatile("s_waitcnt vmcnt(" #N ") lgkmcnt(0)\n\ts_barrier" ::: "memory")
#define MFMA32(a, b, c) __builtin_amdgcn_mfma_f32_32x32x16_bf16(a, b, c, 0, 0, 0)
#define EX(v) __builtin_amdgcn_exp2f(v)
#define MX3(a, b, c) __builtin_fmaxf(__builtin_fmaxf((a), (b)), (c))
__device__ __forceinline__ int imax_(int a, int b) { return a > b ? a : b; }
__device__ __forceinline__ int imin_(int a, int b) { return a < b ? a : b; }
__device__ __forceinline__ void glds16(const void* gsrc, unsigned lds_dst) { unsigned keep;
    asm volatile("s_mov_b32 %0, m0\n\ts_mov_b32 m0, %2\n\ts_nop 0\n\tglobal_load_lds_dwordx4 %1, off\n\ts_mov_b32 m0, %0" : "=&s"(keep) : "v"(gsrc), "s"(lds_dst) : "memory"); }
typedef float f32x2_t __attribute__((ext_vector_type(2))); typedef __bf16 bf16x2_t __attribute__((ext_vector_type(2)));
__device__ __forceinline__ unsigned cvtpk_s(float lo, float hi) { f32x2_t v = {lo, hi}; bf16x2_t b = __builtin_convertvector(v, bf16x2_t); return __builtin_bit_cast(unsigned, b); }
typedef __attribute__((address_space(3))) const char* lds_cptr;
typedef short v4i16_t __attribute__((ext_vector_type(4)));
__device__ __forceinline__ s16x4 vtr(lds_cptr p) { return __builtin_bit_cast(s16x4, __builtin_amdgcn_ds_read_tr16_b64_v4i16((__attribute__((address_space(3))) v4i16_t*)p)); }
__device__ __forceinline__ bf16x8 kld(lds_cptr p) { return *(const __attribute__((address_space(3))) bf16x8*)p; }
__device__ __forceinline__ float rowmax(const f32x16& p0, const f32x16& p1) {
    float a = MX3(p0[0], p0[1], p1[0]), b = MX3(p0[2], p0[3], p1[1]); a = MX3(a, p1[2], p1[3]);
#pragma unroll
    for (int r = 4; r < 16; r += 4) { a = MX3(a, p0[r], p0[r + 1]); b = MX3(b, p0[r + 2], p0[r + 3]); a = MX3(a, p1[r], p1[r + 1]); b = MX3(b, p1[r + 2], p1[r + 3]); }
    const float m = __builtin_fmaxf(a, b);
    auto rr = __builtin_amdgcn_permlane32_swap(__float_as_uint(m), __float_as_uint(m), false, false);
    return __builtin_fmaxf(__uint_as_float(rr[0]), __uint_as_float(rr[1]));
}
template <int DQK, int DV> struct Lay {
    static constexpr int KB = 64 * DQK * 2, VB = 64 * DV * 2;
    static constexpr int LDS_K = 0, LDS_V = NSLOT * KB, LDS_WS = NSLOT * (KB + VB), OSTW = (DV == 128) ? 8192 : 4096, LDS_OST = LDS_WS + NW * 256, LDS_BT = LDS_OST + NW * OSTW, LDS_END = LDS_BT + 2048;
};
#define STEP_MLA(C0, C1, P0, P1, t, BAND, GK, GV, GL) do { SBAR(); \
    const lds_cptr vp_ = vp0 + sl_prev * L::VB; \
      \
      \
    VRD(0, 0); VRD(4, 4); SBAR(); C0 = MFMA32(kf[0], qr[0], negm); SBAR(); \
    VRD(1, 1); VRD(5, 5); SBAR(); C1 = MFMA32(kf[1], qr[0], negm); SBAR(); \
    VRD(2, 2); VRD(6, 6); SBAR(); C0 = MFMA32(kf[2], qr[1], C0); SBAR(); \
    VRD(3, 3); VRD(7, 7); SBAR(); C1 = MFMA32(kf[3], qr[1], C1); float sacc = P0[0] + P0[1]; sacc += P0[2]; sacc += P0[3]; sacc += P0[4]; sacc += P0[5]; PIN(sacc); pw0[0] = PKW(P0, 0); pw0[1] = PKW(P0, 2); PIN(pw0); SBAR(); \
    C0 = MFMA32(kf[4], qr[2], C0); sacc += P0[6]; sacc += P0[7]; sacc += P0[8]; sacc += P0[9]; PIN(sacc); pw0[2] = PKW(P0, 4); pw0[3] = PKW(P0, 6); PIN(pw0); SBAR(); \
    C1 = MFMA32(kf[5], qr[2], C1); sacc += P0[10]; sacc += P0[11]; sacc += P0[12]; sacc += P0[13]; PIN(sacc); pw1[0] = PKW(P0, 8); pw1[1] = PKW(P0, 10); PIN(pw1); SBAR(); \
    C0 = MFMA32(kf[6], qr[3], C0); sacc += P0[14]; sacc += P0[15]; sacc += P1[0]; PIN(sacc); pw1[2] = PKW(P0, 12); pw1[3] = PKW(P0, 14); PIN(pw1); SBAR(); \
    C1 = MFMA32(kf[7], qr[3], C1); sacc += P1[1]; sacc += P1[2]; sacc += P1[3]; PIN(sacc); pw2[0] = PKW(P1, 0); pw2[1] = PKW(P1, 2); PIN(pw2); SBAR(); \
    C0 = MFMA32(kf[8], qr[4], C0); sacc += P1[4]; sacc += P1[5]; sacc += P1[6]; PIN(sacc); pw2[2] = PKW(P1, 4); pw2[3] = PKW(P1, 6); PIN(pw2); SBAR(); \
    C1 = MFMA32(kf[9], qr[4], C1); sacc += P1[7]; sacc += P1[8]; sacc += P1[9]; PIN(sacc); pw3[0] = PKW(P1, 8); pw3[1] = PKW(P1, 10); PIN(pw3); SBAR(); \
    C0 = MFMA32(kf[10], qr[5], C0); sacc += P1[10]; sacc += P1[11]; sacc += P1[12]; PIN(sacc); pw3[2] = PKW(P1, 12); PIN(pw3); SBAR(); \
    C1 = MFMA32(kf[11], qr[5], C1); sacc += P1[13]; sacc += P1[14]; sacc += P1[15]; PIN(sacc); pw3[3] = PKW(P1, 14); PIN(pw3); SBAR(); \
    l_reg += sacc; \
    MIDDLE(C0, C1, t, BAND); \
    SBAR(); \
    o[0] = MFMA32(PAF(0), VFR(0), o[0]); if (GK) DMA_KN(sl_cur); if (GV) DMA_VN(sl_next); C0[0] = EX(C0[0]); C0[1] = EX(C0[1]); C0[2] = EX(C0[2]); C0[3] = EX(C0[3]); PIN(C0); SBAR(); \
    KRD(GL, 0); o[1] = MFMA32(PAF(0), VFR(4), o[1]); C0[4] = EX(C0[4]); C0[5] = EX(C0[5]); C0[6] = EX(C0[6]); C0[7] = EX(C0[7]); PIN(C0); SBAR(); \
    KRD(GL, 1); o[0] = MFMA32(PAF(1), VFR(1), o[0]); C0[8] = EX(C0[8]); C0[9] = EX(C0[9]); C0[10] = EX(C0[10]); C0[11] = EX(C0[11]); PIN(C0); SBAR(); \
    KRD(GL, 2); o[1] = MFMA32(PAF(1), VFR(5), o[1]); C0[12] = EX(C0[12]); C0[13] = EX(C0[13]); C0[14] = EX(C0[14]); C0[15] = EX(C0[15]); PIN(C0); SBAR(); \
    KRD(GL, 3); o[0] = MFMA32(PAF(2), VFR(2), o[0]); C1[0] = EX(C1[0]); C1[1] = EX(C1[1]); C1[2] = EX(C1[2]); C1[3] = EX(C1[3]); PIN(C1); SBAR(); \
    KRD(GL, 4); o[1] = MFMA32(PAF(2), VFR(6), o[1]); C1[4] = EX(C1[4]); C1[5] = EX(C1[5]); C1[6] = EX(C1[6]); C1[7] = EX(C1[7]); PIN(C1); SBAR(); \
    KRD(GL, 5); o[0] = MFMA32(PAF(3), VFR(3), o[0]); C1[8] = EX(C1[8]); C1[9] = EX(C1[9]); C1[10] = EX(C1[10]); C1[11] = EX(C1[11]); PIN(C1); SBAR(); \
    o[1] = MFMA32(PAF(3), VFR(7), o[1]); C1[12] = EX(C1[12]); C1[13] = EX(C1[13]); C1[14] = EX(C1[14]); C1[15] = EX(C1[15]); PIN(C1); SBAR(); \
    } while (0)
#define STEP_DIF(C0, C1, P0, P1, t, BAND, GK, GV, GL) do { SBAR(); \
    const lds_cptr vp_ = vp0 + sl_prev * L::VB; \
      \
    float sacc = P0[0] + P0[1]; \
    C0 = MFMA32(kf[0], qr[0], inin); sacc += P0[2]; sacc += P0[3]; sacc += P0[4]; sacc += P0[5]; PIN(sacc); pw0[0] = PKW(P0, 0); pw0[1] = PKW(P0, 2); PIN(pw0); SBAR(); \
    C1 = MFMA32(kf[1], qr[0], inin); sacc += P0[6]; sacc += P0[7]; sacc += P0[8]; sacc += P0[9]; PIN(sacc); pw0[2] = PKW(P0, 4); pw0[3] = PKW(P0, 6); PIN(pw0); SBAR(); \
    C0 = MFMA32(kf[2], qr[1], C0); sacc += P0[10]; sacc += P0[11]; sacc += P0[12]; sacc += P0[13]; PIN(sacc); pw1[0] = PKW(P0, 8); pw1[1] = PKW(P0, 10); PIN(pw1); SBAR(); \
    C1 = MFMA32(kf[3], qr[1], C1); sacc += P0[14]; sacc += P0[15]; sacc += P1[0]; sacc += P1[1]; PIN(sacc); pw1[2] = PKW(P0, 12); pw1[3] = PKW(P0, 14); PIN(pw1); SBAR(); \
    VRD(0, 0); SBAR(); C0 = MFMA32(kf[4], qr[2], C0); sacc += P1[2]; sacc += P1[3]; sacc += P1[4]; sacc += P1[5]; PIN(sacc); pw2[0] = PKW(P1, 0); pw2[1] = PKW(P1, 2); PIN(pw2); SBAR(); \
    VRD(1, 4); SBAR(); C1 = MFMA32(kf[5], qr[2], C1); sacc += P1[6]; sacc += P1[7]; sacc += P1[8]; sacc += P1[9]; PIN(sacc); pw2[2] = PKW(P1, 4); pw2[3] = PKW(P1, 6); PIN(pw2); SBAR(); \
    VRD(2, 8); SBAR(); C0 = MFMA32(kf[6], qr[3], C0); sacc += P1[10]; sacc += P1[11]; sacc += P1[12]; sacc += P1[13]; PIN(sacc); pw3[0] = PKW(P1, 8); pw3[1] = PKW(P1, 10); PIN(pw3); SBAR(); \
    VRD(3, 12); SBAR(); C1 = MFMA32(kf[7], qr[3], C1); sacc += P1[14]; sacc += P1[15]; PIN(sacc); pw3[2] = PKW(P1, 12); pw3[3] = PKW(P1, 14); PIN(pw3); SBAR(); \
    l_reg += sacc; \
    MIDDLE(C0, C1, t, BAND); \
    SBAR(); \
    o[0] = MFMA32(PAF(0), VFR(0), o[0]); if (GK) DMA_KN(sl_cur); if (GV) DMA_VN(sl_next); VRD(0, 1); C0[0] = EX(C0[0]); C0[1] = EX(C0[1]); PIN(C0); SBAR(); \
    o[1] = MFMA32(PAF(0), VFR(1), o[1]); VRD(1, 5); C0[2] = EX(C0[2]); C0[3] = EX(C0[3]); PIN(C0); SBAR(); \
    o[2] = MFMA32(PAF(0), VFR(2), o[2]); VRD(2, 9); C0[4] = EX(C0[4]); C0[5] = EX(C0[5]); PIN(C0); SBAR(); \
    o[3] = MFMA32(PAF(0), VFR(3), o[3]); VRD(3, 13); C0[6] = EX(C0[6]); C0[7] = EX(C0[7]); PIN(C0); SBAR(); \
    o[0] = MFMA32(PAF(1), VFR(0), o[0]); VRD(0, 2); C0[8] = EX(C0[8]); C0[9] = EX(C0[9]); PIN(C0); SBAR(); \
    o[1] = MFMA32(PAF(1), VFR(1), o[1]); VRD(1, 6); C0[10] = EX(C0[10]); C0[11] = EX(C0[11]); PIN(C0); SBAR(); \
    o[2] = MFMA32(PAF(1), VFR(2), o[2]); VRD(2, 10); C0[12] = EX(C0[12]); C0[13] = EX(C0[13]); PIN(C0); SBAR(); \
    o[3] = MFMA32(PAF(1), VFR(3), o[3]); VRD(3, 14); C0[14] = EX(C0[14]); C0[15] = EX(C0[15]); PIN(C0); SBAR(); \
    o[0] = MFMA32(PAF(2), VFR(0), o[0]); VRD(0, 3); C1[0] = EX(C1[0]); C1[1] = EX(C1[1]); PIN(C1); SBAR(); \
    KRD(GL, 0); o[1] = MFMA32(PAF(2), VFR(1), o[1]); VRD(1, 7); C1[2] = EX(C1[2]); C1[3] = EX(C1[3]); PIN(C1); SBAR(); \
    KRD(GL, 1); o[2] = MFMA32(PAF(2), VFR(2), o[2]); VRD(2, 11); C1[4] = EX(C1[4]); C1[5] = EX(C1[5]); PIN(C1); SBAR(); \
    KRD(GL, 2); o[3] = MFMA32(PAF(2), VFR(3), o[3]); VRD(3, 15); C1[6] = EX(C1[6]); C1[7] = EX(C1[7]); PIN(C1); SBAR(); \
    KRD(GL, 3); o[0] = MFMA32(PAF(3), VFR(0), o[0]); C1[8] = EX(C1[8]); C1[9] = EX(C1[9]); PIN(C1); SBAR(); \
    o[1] = MFMA32(PAF(3), VFR(1), o[1]); C1[10] = EX(C1[10]); C1[11] = EX(C1[11]); PIN(C1); SBAR(); \
    o[2] = MFMA32(PAF(3), VFR(2), o[2]); C1[12] = EX(C1[12]); C1[13] = EX(C1[13]); PIN(C1); SBAR(); \
    o[3] = MFMA32(PAF(3), VFR(3), o[3]); C1[14] = EX(C1[14]); C1[15] = EX(C1[15]); PIN(C1); { const float iv_ = INI_ADD((t) + 1) - mhat; const unsigned long long pr_ = ((unsigned long long)__float_as_uint(iv_) << 32) | __float_as_uint(iv_); _Pragma("unroll") for (int r_ = 0; r_ < 16; r_ += 2) { unsigned long long q_; asm volatile("v_mov_b64 %0, %1" : "=v"(q_) : "v"(pr_)); inin[r_] = __uint_as_float((unsigned)q_); inin[r_ + 1] = __uint_as_float((unsigned)(q_ >> 32)); } } PIN(inin); SBAR(); \
    } while (0)
#define PKW(P, i) cvtpk_s(P[i], P[i + 1])
#define PAF(k) __builtin_bit_cast(bf16x8, pw##k)
#define VFR(i) (bf16x8){vlo[i][0], vlo[i][1], vlo[i][2], vlo[i][3], vhi[i][0], vhi[i][1], vhi[i][2], vhi[i][3]}
#define VRD(s, f) do { vlo[s] = vtr(vp_ + (((f) >> 2) * 4096 + ((f) & 3) * 1024)); vhi[s] = vtr(vp_ + (((f) >> 2) * 4096 + ((f) & 3) * 1024 + 512)); } while (0)
#define KRD(G, j) do { if (G) { const lds_cptr kq_ = kp0 + sl_next * L::KB + (j) * 2048; kf[2 * (j)] = kld(kq_); kf[2 * (j) + 1] = kld(kq_ + 512); SBAR(); } } while (0)
#define ROT() do { sl_prev = sl_cur; sl_cur = sl_next; sl_next = (sl_next == NSLOT - 1) ? 0 : sl_next + 1; DMA_ADV(); } while (0)
#define CMASK(C0, C1, t) do { } while (0)
#define DECIDE(C0, C1) do { resc = false; \
      if (__builtin_expect(__any(sacc > TSUM), 0)) { int e_ = (sacc > TSUM) ? imin_(imax_(((__float_as_int(sacc) >> 23) & 255) - 126, 0), 126) : 0;     \
        { auto rr_ = __builtin_amdgcn_permlane32_swap((unsigned)e_, (unsigned)e_, false, false); e_ = imax_((int)rr_[0], (int)rr_[1]); }            \
        const float dl_ = (float)e_; mhat += dl_; NEGM_UPDATE(); \
        _Pragma("unroll") for (int r_ = 0; r_ < 16; ++r_) { C0[r_] -= dl_; C1[r_] -= dl_; } \
        const float f_ = __int_as_float((127 - e_) << 23); l_reg *= f_; if (hi == 0) wsf[r32] = f_; resc = true; } } while (0)
#define RESC(NO_) do { if (resc) { asm volatile("s_waitcnt lgkmcnt(0)" ::: "memory"); \
      _Pragma("unroll") for (int r_ = 0; r_ < 16; ++r_) { const float f_ = wsf[crow(r_, hi)]; _Pragma("unroll") for (int d_ = 0; d_ < NO_; ++d_) o[d_][r_] *= f_; } } } while (0)
#define ENDW(tt, W2, W1) do { if ((tt) + 3 < NT) { WAIT_BAR(W2); } else if ((tt) + 2 < NT) { WAIT_BAR(W1); } else { WAIT_BAR(0); } } while (0)
#define DRAIN_PV(P0, P1, slot_, NO_) do { float sacc_ = P0[0] + P0[1]; \
      _Pragma("unroll") for (int r_ = 2; r_ < 16; ++r_) sacc_ += P0[r_]; \
      _Pragma("unroll") for (int r_ = 0; r_ < 16; ++r_) sacc_ += P1[r_]; \
      l_reg += sacc_; \
      pw0 = (u32x4){PKW(P0, 0), PKW(P0, 2), PKW(P0, 4), PKW(P0, 6)}; pw1 = (u32x4){PKW(P0, 8), PKW(P0, 10), PKW(P0, 12), PKW(P0, 14)}; \
      pw2 = (u32x4){PKW(P1, 0), PKW(P1, 2), PKW(P1, 4), PKW(P1, 6)}; pw3 = (u32x4){PKW(P1, 8), PKW(P1, 10), PKW(P1, 12), PKW(P1, 14)}; \
      const lds_cptr vp_ = vp0 + (slot_) * L::VB; \
      _Pragma("unroll") for (int d_ = 0; d_ < NO_; ++d_) { \
          VRD(0, d_ * 4 + 0); VRD(1, d_ * 4 + 1); VRD(2, d_ * 4 + 2); VRD(3, d_ * 4 + 3); \
          o[d_] = MFMA32(PAF(0), VFR(0), o[d_]); o[d_] = MFMA32(PAF(1), VFR(1), o[d_]); o[d_] = MFMA32(PAF(2), VFR(2), o[d_]); o[d_] = MFMA32(PAF(3), VFR(3), o[d_]); SBAR(); } } while (0)
#define BSTEP(STEPX, NO_, C0, C1, P0, P1, t, GK, GV, GL) do { \
      if ((t) <= Lw) { STEPX(C0, C1, P0, P1, t, false, GK, GV, ((GL) && ((t) + 1 <= Lw))); } \
      else { resc = false; if (GK) DMA_KN(sl_cur); if (GV) DMA_VN(sl_next); \
             if ((t) == Lw + 1) DRAIN_PV(P0, P1, sl_prev, NO_); } } while (0)

template <int DQK, int DV>
__device__ __forceinline__ void store_rows(const f32x16 (&y)[DV / 32], bf16* dst, int pitch, char* shm) {
    typedef Lay<DQK, DV> L;
    const int tid_ = otid(), lane = tid_ & 63, r32 = lane & 31, hi = lane >> 5; const int wid = __builtin_amdgcn_readfirstlane(tid_ >> 6);
    bf16* stg = (bf16*)(shm + L::LDS_OST + wid * L::OSTW);
#pragma unroll
    for (int half = 0; half < DV / 64; ++half) {
#pragma unroll
        for (int r = 0; r < 16; ++r) { const int orow = crow(r, hi);
#pragma unroll
            for (int d0 = 0; d0 < 2; ++d0) { const unsigned pk = cvtpk_s(y[2 * half + d0][r], 0.f); stg[orow * 64 + d0 * 32 + r32] = (bf16)(pk & 0xffffu); } }
        asm volatile("s_waitcnt lgkmcnt(0)" ::: "memory");
#pragma unroll
        for (int i = 0; i < 4; ++i) { const int row = i * 8 + (lane >> 3), ch = lane & 7; const u32x4 v = *(const u32x4*)(stg + row * 64 + ch * 8);
            *(u32x4*)(dst + (long)(32 * wid + i * 8 + (lane >> 3)) * pitch + half * 64 + ch * 8) = v; }
        asm volatile("s_waitcnt lgkmcnt(0)" ::: "memory");
    }
}
template <int DQK, int DV>
__device__ __forceinline__ void row_rcp(float (&rli)[16], float l_reg, char* shm) {
    typedef Lay<DQK, DV> L;
    const int tid_ = otid(), lane = tid_ & 63, r32 = lane & 31, hi = lane >> 5; const int wid = __builtin_amdgcn_readfirstlane(tid_ >> 6);
    float* wsf = (float*)(shm + L::LDS_WS) + wid * 64;
    { auto rr = __builtin_amdgcn_permlane32_swap(__float_as_uint(l_reg), __float_as_uint(l_reg), false, false); l_reg = __uint_as_float(rr[0]) + __uint_as_float(rr[1]); }
    if (hi == 0) wsf[32 + r32] = l_reg;
    asm volatile("s_waitcnt lgkmcnt(0)" ::: "memory");
#pragma unroll
    for (int r = 0; r < 16; ++r) rli[r] = __builtin_amdgcn_rcpf(wsf[32 + crow(r, hi)]);
}

struct MlaT { const bf16 *QA, *KN, *KR, *VA; bf16* MIX; };
__device__ __forceinline__ void mla_unit(int b, int h, int qb, const MlaT& T, char* shm, const bool warm, const int nh, const int nqb, u32x4 (&qrw)[6]) {
    typedef Lay<96, 64> L;
    const int tid = otid(), lane = tid & 63, r32 = lane & 31, hi = lane >> 5; const int wid = __builtin_amdgcn_readfirstlane(tid >> 6);
    const long rowbase = (long)b * SEQ; const int q0 = qb * QB, NT = 4 * qb + 4; const int Lw = NT - 4 + (wid >> 1);
    const bf16* Qrow = T.QA + (rowbase + q0 + 32 * wid + r32) * 768 + h * 96;
    const unsigned lds0 = (unsigned)(uintptr_t)shm; float* wsf = (float*)(shm + L::LDS_WS) + wid * 64;
    const bf16* ksrc = T.KN + rowbase * 512 + h * 64 + (long)lane * 512 + wid * 8;
    const bf16* k2src = T.KR + rowbase * 32 + (long)lane * 32 + (wid & 3) * 8;
    const bf16* vsrc = T.VA + rowbase * 512 + h * 64 + (long)(16 * (wid & 3) + (lane >> 2)) * 512 + (wid >> 2) * 32 + (lane & 3) * 8;
    const unsigned kdst = lds0 + L::LDS_K + wid * 1024, k2dst = lds0 + L::LDS_K + (8 + (wid & 3)) * 1024, vdst = lds0 + L::LDS_V + wid * 1024;
#define DMA_K(t, slot) do { glds16(ksrc + (long)(t) * KVBLK * 512, (unsigned)__builtin_amdgcn_readfirstlane(kdst + (slot) * L::KB)); glds16(k2src + (long)(t) * KVBLK * 32, (unsigned)__builtin_amdgcn_readfirstlane(k2dst + (slot) * L::KB)); } while (0)
#define DMA_V(t, slot) glds16(vsrc + (long)(t) * KVBLK * 512, (unsigned)__builtin_amdgcn_readfirstlane(vdst + (slot) * L::VB))
    const bf16 *kpn = ksrc + 3L * KVBLK * 512, *k2pn = k2src + 3L * KVBLK * 32, *vpn = vsrc + 1L * KVBLK * 512;
#define DMA_KN(slot) do { glds16(kpn, (unsigned)__builtin_amdgcn_readfirstlane(kdst + (slot) * L::KB)); glds16(k2pn, (unsigned)__builtin_amdgcn_readfirstlane(k2dst + (slot) * L::KB)); } while (0)
#define DMA_VN(slot) glds16(vpn, (unsigned)__builtin_amdgcn_readfirstlane(vdst + (slot) * L::VB))
#define DMA_ADV() do { kpn += KVBLK * 512; k2pn += KVBLK * 32; vpn += KVBLK * 512; } while (0)
#define INI_ADD(t) 0.f
#define NEGM_UPDATE() do { _Pragma("unroll") for (int r_ = 0; r_ < 16; ++r_) negm[r_] = -mhat; } while (0)
#define MIDDLE(C0, C1, t, BAND) do { if (BAND) CMASK(C0, C1, t); DECIDE(C0, C1); } while (0)
    const lds_cptr shm3 = (lds_cptr)shm;
    const lds_cptr vp0 = shm3 + L::LDS_V + ((lane >> 4) & 1) * 32 + (lane & 3) * 8 + (4 * hi + ((lane & 15) >> 2)) * 64;
    const lds_cptr kp0 = shm3 + L::LDS_K + hi * 1024 + r32 * 16;
    if (!warm) { DMA_K(0, 0); DMA_V(0, 0); DMA_K(1, 1);
#pragma unroll
      for (int d0 = 0; d0 < 6; ++d0) qrw[d0] = *reinterpret_cast<const u32x4*>(&Qrow[d0 * 16 + hi * 8]); }
    bf16x8 qr[6];
#pragma unroll
    for (int d0 = 0; d0 < 6; ++d0) qr[d0] = __builtin_bit_cast(bf16x8, qrw[d0]);
    float mhat = 0.f, l_reg = 0.f; f32x16 o[2]; o[0] = f32x16{}; o[1] = f32x16{};
    bool resc = false;
    f32x16 pA0, pA1, pB0, pB1; bf16x8 kf[12]; s16x4 vlo[8], vhi[8]; u32x4 pw0, pw1, pw2, pw3;
    int sl_prev = 0, sl_cur = 0, sl_next = 1;
    if (!warm) DMA_K(2, 2);
    WAIT_BAR(5);
    { f32x16 z = f32x16{};
#pragma unroll
      for (int d0 = 0; d0 < 6; ++d0) { const bf16x8 b0 = kld(kp0 + d0 * 2048), b1 = kld(kp0 + d0 * 2048 + 512);
          if (d0 == 0) { pA0 = MFMA32(b0, qr[0], z); pA1 = MFMA32(b1, qr[0], z); } else { pA0 = MFMA32(b0, qr[d0], pA0); pA1 = MFMA32(b1, qr[d0], pA1); } }
      const float rm = rowmax(pA0, pA1); mhat = rm;
#pragma unroll
      for (int r = 0; r < 16; ++r) { pA0[r] = EX(pA0[r] - rm); pA1[r] = EX(pA1[r] - rm); } }
    f32x16 negm; NEGM_UPDATE(); asm volatile("" : "+v"(negm));
    WAIT_BAR(0);
    DMA_KN(0); DMA_VN(1); ROT();
#pragma unroll
    for (int j = 0; j < 6; ++j) { const lds_cptr kq = kp0 + sl_cur * L::KB + j * 2048; kf[2 * j] = kld(kq); kf[2 * j + 1] = kld(kq + 512); }
    WAIT_BAR(3);
    int t = 1;
    for (; t + 5 < NT; t += 2) {
        STEP_MLA(pB0, pB1, pA0, pA1, t, false, true, true, true);     WAIT_BAR(3); RESC(2); ROT();
        STEP_MLA(pA0, pA1, pB0, pB1, t + 1, false, true, true, true); WAIT_BAR(3); RESC(2); ROT();
    }
#pragma nounroll
    for (; t <= Lw; ++t) {
        STEP_MLA(pB0, pB1, pA0, pA1, t, false, (t + 3 < NT), (t + 1 < NT), (t + 1 <= Lw));
        if (t + 1 < NT) { ENDW(t, 3, 1); }
        RESC(2);
        if (t + 1 < NT) ROT();
        pA0 = pB0; pA1 = pB1;
    }
    if (t < NT) {
        if (t + 3 < NT) DMA_KN(sl_cur); if (t + 1 < NT) DMA_VN(sl_next);
        DRAIN_PV(pA0, pA1, sl_prev, 2);
        if (t + 1 < NT) { ENDW(t, 3, 1); ROT(); }
        ++t;
#pragma nounroll
        for (; t < NT; ++t) {
            if (t + 3 < NT) DMA_KN(sl_cur); if (t + 1 < NT) DMA_VN(sl_next);
            if (t + 1 < NT) { ENDW(t, 3, 1); ROT(); }
        }
    } else { DRAIN_PV(pA0, pA1, sl_cur, 2); }
    asm volatile("s_waitcnt lgkmcnt(0)\n\ts_barrier" ::: "memory");
    int nh_ = nh, nqb_ = nqb; asm volatile("" : "+s"(nh_), "+s"(nqb_));
    if (nh_ >= 0) { const int t2_ = otid(), ln_ = t2_ & 63; const int w2_ = __builtin_amdgcn_readfirstlane(t2_ >> 6);
      const bf16* ksrc = T.KN + rowbase * 512 + nh_ * 64 + (long)ln_ * 512 + w2_ * 8;
      const bf16* k2src = T.KR + rowbase * 32 + (long)ln_ * 32 + (w2_ & 3) * 8;
      const bf16* vsrc = T.VA + rowbase * 512 + nh_ * 64 + (long)(16 * (w2_ & 3) + (ln_ >> 2)) * 512 + (w2_ >> 2) * 32 + (ln_ & 3) * 8;
      const unsigned lds1 = (unsigned)(uintptr_t)shm; const unsigned kdst = lds1 + L::LDS_K + w2_ * 1024, k2dst = lds1 + L::LDS_K + (8 + (w2_ & 3)) * 1024, vdst = lds1 + L::LDS_V + w2_ * 1024;
      DMA_K(0, 0); DMA_V(0, 0); DMA_K(1, 1);
      const bf16* Qn = T.QA + (rowbase + (long)nqb_ * QB + 32 * w2_ + (ln_ & 31)) * 768 + nh_ * 96;
#pragma unroll
      for (int d0 = 0; d0 < 6; ++d0) qrw[d0] = *reinterpret_cast<const u32x4*>(&Qn[d0 * 16 + (ln_ >> 5) * 8]);
      DMA_K(2, 2); }
    float rli[16]; row_rcp<96, 64>(rli, l_reg, shm);
#pragma unroll
    for (int d = 0; d < 2; ++d)
#pragma unroll
        for (int r = 0; r < 16; ++r) o[d][r] *= rli[r];
    store_rows<96, 64>(o, T.MIX + (rowbase + q0) * 1024 + h * 64, 1024, shm);
    if (nh_ < 0) asm volatile("s_waitcnt lgkmcnt(0)\n\ts_barrier" ::: "memory");
#undef DMA_K
#undef DMA_V
#undef DMA_KN
#undef DMA_VN
#undef DMA_ADV
#undef INI_ADD
#undef NEGM_UPDATE
#undef MIDDLE
}

struct DiffT { const bf16 *DQ, *DK, *DV; bf16* MIX; float* OB; const float *rel_bias, *g_subln; float lam; };
__device__ __forceinline__ int t5_bucket(int rel) {
    const int n = rel < 0 ? -rel : rel; int bk = n;
    if (n >= 8) { bk = 2 + (31 - __clz(n * n)); bk = bk > 15 ? 15 : bk; }
    return (rel > 0 ? 16 : 0) + bk;
}
__device__ __forceinline__ void diff_pass(f32x16 (&o)[4], float& l_out, int b, int h, int qb, int mo, const DiffT& T, char* shm, float cfar) {
    typedef Lay<64, 128> L;
    const int tid = otid(), lane = tid & 63, r32 = lane & 31, hi = lane >> 5; const int wid = __builtin_amdgcn_readfirstlane(tid >> 6);
    const long rowbase = (long)b * SEQ; const int q0 = qb * QB, NT = 4 * qb + 4; const int Lw = NT - 4 + (wid >> 1);
    const int urow = 32 * wid + r32;
    const bf16* Qrow = T.DQ + (rowbase + q0 + urow) * 512 + h * 128 + mo;
    const unsigned lds0 = (unsigned)(uintptr_t)shm; float* wsf = (float*)(shm + L::LDS_WS) + wid * 64;
    const float* bt = (const float*)(shm + L::LDS_BT);
    const bf16* ksrc = T.DK + rowbase * 512 + h * 128 + mo + (long)lane * 512 + wid * 8;
    const bf16* vsrc = T.DV + rowbase * 512 + h * 128 + (long)(16 * (wid & 3) + (lane >> 2)) * 512 + (wid >> 2) * 32 + (lane & 3) * 8;
    const unsigned kdst = lds0 + L::LDS_K + wid * 1024, vdst = lds0 + L::LDS_V + wid * 1024;
#define DMA_K(t, slot) glds16(ksrc + (long)(t) * KVBLK * 512, (unsigned)__builtin_amdgcn_readfirstlane(kdst + (slot) * L::KB))
#define DMA_V(t, slot) do { glds16(vsrc + (long)(t) * KVBLK * 512, (unsigned)__builtin_amdgcn_readfirstlane(vdst + (slot) * L::VB)); glds16(vsrc + (long)(t) * KVBLK * 512 + 64, (unsigned)__builtin_amdgcn_readfirstlane(vdst + (slot) * L::VB + 8192)); } while (0)
    const bf16 *kpn = ksrc + 3L * KVBLK * 512, *vpn = vsrc + 1L * KVBLK * 512;
#define DMA_KN(slot) glds16(kpn, (unsigned)__builtin_amdgcn_readfirstlane(kdst + (slot) * L::KB))
#define DMA_VN(slot) do { glds16(vpn, (unsigned)__builtin_amdgcn_readfirstlane(vdst + (slot) * L::VB)); glds16(vpn + 64, (unsigned)__builtin_amdgcn_readfirstlane(vdst + (slot) * L::VB + 8192)); } while (0)
#define DMA_ADV() do { kpn += KVBLK * 512; vpn += KVBLK * 512; } while (0)
#define INI_ADD(t) (((t) < NT - 6) ? cfar : 0.f)
#define NEGM_UPDATE() do { } while (0)
#define BIAS_ADD(C0, C1, t) do { if ((t) >= NT - 6) { const float* bp_ = bt + (64 * (t) - (q0 + urow) + 384 + 4 * hi); \
      _Pragma("unroll") for (int r_ = 0; r_ < 16; ++r_) { C0[r_] += bp_[(r_ & 3) + 8 * (r_ >> 2)]; C1[r_] += bp_[32 + (r_ & 3) + 8 * (r_ >> 2)]; } } } while (0)
#define MIDDLE(C0, C1, t, BAND) do { BIAS_ADD(C0, C1, t); if (BAND) CMASK(C0, C1, t); DECIDE(C0, C1); } while (0)
    const lds_cptr shm3 = (lds_cptr)shm;
    const lds_cptr vp0 = shm3 + L::LDS_V + ((lane >> 4) & 1) * 32 + (lane & 3) * 8 + (4 * hi + ((lane & 15) >> 2)) * 64;
    const lds_cptr kp0 = shm3 + L::LDS_K + hi * 1024 + r32 * 16;
    DMA_K(0, 0); DMA_V(0, 0); DMA_K(1, 1);
    bf16x8 qr[4];
#pragma unroll
    for (int d0 = 0; d0 < 4; ++d0) qr[d0] = *reinterpret_cast<const bf16x8*>(&Qrow[d0 * 16 + hi * 8]);
    float mhat = 0.f, l_reg = 0.f;
#pragma unroll
    for (int d = 0; d < 4; ++d) o[d] = f32x16{};
    bool resc = false;
    f32x16 pA0, pA1, pB0, pB1; bf16x8 kf[8]; s16x4 vlo[8], vhi[8]; u32x4 pw0, pw1, pw2, pw3;
    int sl_prev = 0, sl_cur = 0, sl_next = 1;
    DMA_K(2, 2);
    WAIT_BAR(4);
    { f32x16 z; { const float iv = INI_ADD(0);
#pragma unroll
        for (int r = 0; r < 16; ++r) z[r] = iv; }
#pragma unroll
      for (int d0 = 0; d0 < 4; ++d0) { const bf16x8 b0 = kld(kp0 + d0 * 2048), b1 = kld(kp0 + d0 * 2048 + 512);
          if (d0 == 0) { pA0 = MFMA32(b0, qr[0], z); pA1 = MFMA32(b1, qr[0], z); } else { pA0 = MFMA32(b0, qr[d0], pA0); pA1 = MFMA32(b1, qr[d0], pA1); } }
      BIAS_ADD(pA0, pA1, 0);
      const float rm = rowmax(pA0, pA1); mhat = rm;
#pragma unroll
      for (int r = 0; r < 16; ++r) { pA0[r] = EX(pA0[r] - rm); pA1[r] = EX(pA1[r] - rm); } }
    f32x16 inin; { const float iv = INI_ADD(1) - mhat;
#pragma unroll
        for (int r = 0; r < 16; ++r) inin[r] = iv; }
    asm volatile("" : "+v"(inin));
    WAIT_BAR(0);
    DMA_KN(0); DMA_VN(1); ROT();
#pragma unroll
    for (int j = 0; j < 4; ++j) { const lds_cptr kq = kp0 + sl_cur * L::KB + j * 2048; kf[2 * j] = kld(kq); kf[2 * j + 1] = kld(kq + 512); }
    WAIT_BAR(3);
    int t = 1;
    for (; t + 5 < NT; t += 2) {
        STEP_DIF(pB0, pB1, pA0, pA1, t, false, true, true, true);     WAIT_BAR(3); RESC(4); ROT();
        STEP_DIF(pA0, pA1, pB0, pB1, t + 1, false, true, true, true); WAIT_BAR(3); RESC(4); ROT();
    }
#pragma nounroll
    for (; t <= Lw; ++t) {
        STEP_DIF(pB0, pB1, pA0, pA1, t, false, (t + 3 < NT), (t + 1 < NT), (t + 1 <= Lw));
        if (t + 1 < NT) { ENDW(t, 3, 2); }
        RESC(4);
        if (t + 1 < NT) ROT();
        pA0 = pB0; pA1 = pB1;
    }
    if (t < NT) {
        if (t + 3 < NT) DMA_KN(sl_cur); if (t + 1 < NT) DMA_VN(sl_next);
        DRAIN_PV(pA0, pA1, sl_prev, 4);
        if (t + 1 < NT) { ENDW(t, 3, 2); ROT(); }
        ++t;
#pragma nounroll
        for (; t < NT; ++t) {
            if (t + 3 < NT) DMA_KN(sl_cur); if (t + 1 < NT) DMA_VN(sl_next);
            if (t + 1 < NT) { ENDW(t, 3, 2); ROT(); }
        }
    } else { DRAIN_PV(pA0, pA1, sl_cur, 4); }
    l_out = l_reg;
    asm volatile("s_waitcnt lgkmcnt(0)\n\ts_barrier" ::: "memory");
#undef DMA_K
#undef DMA_V
#undef DMA_KN
#undef DMA_VN
#undef DMA_ADV
#undef INI_ADD
#undef NEGM_UPDATE
#undef BIAS_ADD
#undef MIDDLE
}
__device__ __forceinline__ void diff_unit(int b, int h, int qb, const DiffT& T, char* shm) {
    typedef Lay<64, 128> L;
    const int tid = otid(); const int wid = __builtin_amdgcn_readfirstlane(tid >> 6);
    const long rowbase = (long)b * SEQ; const int q0 = qb * QB;
    constexpr float LOG2E = 1.4426950408889634f;
    { float* bt = (float*)(shm + L::LDS_BT); if (tid < 448) bt[tid] = T.rel_bias[t5_bucket(tid - 384) * 4 + h] * LOG2E; }
    const float cfar = T.rel_bias[15 * 4 + h] * LOG2E;
    asm volatile("s_waitcnt lgkmcnt(0)\n\ts_barrier" ::: "memory");
    unsigned* const obw = (unsigned*)(shm + L::LDS_OST + wid * L::OSTW);
    f32x16 o[4]; float l_reg; float rli[16];
    const float lam = T.lam;
#pragma nounroll
    for (int pass = 0; pass < 2; ++pass) {
        diff_pass(o, l_reg, b, h, qb, (pass == 0) ? 64 : 0, T, shm, cfar);
        row_rcp<64, 128>(rli, l_reg, shm);
        if (pass == 0) { unsigned* ob = obw + (otid() & 63);
#pragma unroll
            for (int d = 0; d < 4; ++d)
#pragma unroll
                for (int r = 0; r < 16; r += 2) ob[(d * 8 + (r >> 1)) * 64] = cvtpk_s(o[d][r] * rli[r], o[d][r + 1] * rli[r + 1]);
        }
    }
    float ss[16]; const int lane2 = otid() & 63, r32 = lane2 & 31; const unsigned* ob = obw + lane2;
    unsigned pk2_[4][8];
#pragma unroll
    for (int d = 0; d < 4; ++d)
#pragma unroll
        for (int j = 0; j < 8; ++j) pk2_[d][j] = ob[(d * 8 + j) * 64];
    asm volatile("s_waitcnt lgkmcnt(0)" ::: "memory");
#pragma unroll
    for (int r = 0; r < 16; ++r) { float s = 0.f;
#pragma unroll
        for (int d = 0; d < 4; ++d) { const unsigned w = pk2_[d][r >> 1]; const float o2 = __uint_as_float((r & 1) ? (w & 0xffff0000u) : (w << 16));
            const float y = o[d][r] * rli[r] - lam * o2; o[d][r] = y; s += y * y; }
        ss[r] = s; }
#define SWZ_STEP(K) _Pragma("unroll") for (int r = 0; r < 16; ++r) ss[r] += swz_xor<((K) << 10) | 0x1f>(ss[r]);
    SWZ_STEP(1) SWZ_STEP(2) SWZ_STEP(4) SWZ_STEP(8) SWZ_STEP(16)
#undef SWZ_STEP
#pragma unroll
    for (int d = 0; d < 4; ++d) { const float g = T.g_subln[d * 32 + r32] * 0.8f;
#pragma unroll
        for (int r = 0; r < 16; ++r) o[d][r] *= g * __builtin_amdgcn_rsqf(ss[r] * (1.f / 128.f) + 1e-6f); }
    store_rows<64, 128>(o, T.MIX + (rowbase + q0) * 1024 + 512 + h * 128, 1024, shm);
    asm volatile("s_waitcnt lgkmcnt(0)\n\ts_barrier" ::: "memory");
}
#undef SBAR
#undef PIN
#undef WAIT_BAR
#undef MFMA32
#undef EX
#undef MX3
}
#define GAS __attribute__((address_space(1)))
#define LAS __attribute__((address_space(3)))
typedef unsigned short bf16;
typedef unsigned v4u __attribute__((ext_vector_type(4)));
typedef float f32x4 __attribute__((ext_vector_type(4)));
typedef short bf16x8 __attribute__((ext_vector_type(8)));
typedef GAS unsigned gu32;
typedef GAS unsigned long long gu64;
#define RLX_AGENT __ATOMIC_RELAXED, __HIP_MEMORY_SCOPE_AGENT
#define LDS_WAIT() asm volatile("s_waitcnt lgkmcnt(0)" ::: "memory")
#define VM_WAIT() asm volatile("s_waitcnt vmcnt(0)" ::: "memory")
__device__ __forceinline__ unsigned long long rt() { return __builtin_amdgcn_s_memrealtime(); }
__device__ __forceinline__ unsigned f2bf(float f) { unsigned u = __builtin_bit_cast(unsigned, f); return (u + 0x7fffu + ((u >> 16) & 1u)) >> 16; }
__device__ __forceinline__ unsigned pk2(float lo, float hi) { return f2bf(lo) | (f2bf(hi) << 16); }

#define XB_TMO      128
#define XB_XCNT(j)  (256  + 64 * (j))
#define XB_XSUB(j)  (1280 + 64 * (j))
#define XB_XGEN(j)  (2304 + 64 * (j))
#define XB_TOP      3328
#define XB_TOPGEN   3392
#define XCD_BAR_WORDS 3456
#define XB_SPIN_CAP (1u << 18)

__device__ __forceinline__ unsigned xb_ld(unsigned* p)              { return __hip_atomic_load(p, __ATOMIC_RELAXED, __HIP_MEMORY_SCOPE_AGENT); }
__device__ __forceinline__ unsigned xb_add(unsigned* p, unsigned v) { return __hip_atomic_fetch_add(p, v, __ATOMIC_RELAXED, __HIP_MEMORY_SCOPE_AGENT); }
__device__ __forceinline__ unsigned xb_xcc_id() { return (unsigned)__builtin_amdgcn_s_getreg((3 << 11) | 20) & 0xFu; }
#define XB_SPIN(cond, bar) do { unsigned _sp = 0; while (cond) { __builtin_amdgcn_s_sleep(1); \
    if ((++_sp & 255u) == 0u) { if (xb_ld(&(bar)[XB_TMO])) break; if (_sp > XB_SPIN_CAP) { atomicAdd(&(bar)[XB_TMO], 1u); break; } } } } while (0)

struct XcdBarrier {
    unsigned* bar; unsigned x;
    volatile LAS unsigned* st;
};

__device__ __forceinline__ XcdBarrier xcd_barrier_post(unsigned* bar, volatile LAS unsigned* st) {
    XcdBarrier b; b.bar = bar; b.x = xb_xcc_id(); b.st = st;
    if (threadIdx.x == 0) st[2] = xb_add(&bar[XB_XCNT(b.x)], 1u);
    return b;
}
__device__ __forceinline__ void xcd_barrier_complete(unsigned* bar, unsigned x, unsigned& nloc, unsigned& nx) {
    const unsigned G = gridDim.x * gridDim.y * gridDim.z;
    unsigned sum, cnt, mine, sp = 0u;
    for (;;) {
        sum = 0u; cnt = 0u; mine = 0u;
#pragma unroll
        for (unsigned j = 0; j < 16; ++j) { const unsigned c = xb_ld(&bar[XB_XCNT(j)]); sum += c; cnt += (c > 0u) ? 1u : 0u; mine = (j == x) ? c : mine; }
        if (sum == G) break;
        __builtin_amdgcn_s_sleep(1);
        if ((++sp & 255u) == 0u) { if (xb_ld(&bar[XB_TMO])) break; if (sp > XB_SPIN_CAP) { atomicAdd(&bar[XB_TMO], 1u); break; } }
    }
    nloc = mine > 0u ? mine : 1u; nx = cnt > 0u ? cnt : 1u;
}

__device__ __forceinline__ void xcd_barrier(const XcdBarrier& b) {
    asm volatile("s_waitcnt vmcnt(0)" ::: "memory");
    __syncthreads();
    if (threadIdx.x == 0) {
        unsigned* bar = b.bar;
        __builtin_amdgcn_s_waitcnt(0);
        unsigned nloc = b.st[0], nx = b.st[1];
        if (nloc == 0u) { xcd_barrier_complete(bar, b.x, nloc, nx); b.st[0] = nloc; b.st[1] = nx; }
        const unsigned old = xb_add(&bar[XB_XSUB(b.x)], 1u);
        const unsigned gen = old / nloc;
        if (old + 1u == (gen + 1u) * nloc) {
            __builtin_amdgcn_fence(__ATOMIC_RELEASE, "agent");
            asm volatile("s_waitcnt vmcnt(0)" ::: "memory");
            const unsigned og = xb_add(&bar[XB_TOP], 1u);
            const unsigned tg = og / nx;
            if (og + 1u == (tg + 1u) * nx) xb_add(&bar[XB_TOPGEN], 1u);
            else XB_SPIN(xb_ld(&bar[XB_TOPGEN]) == tg, bar);
            __builtin_amdgcn_fence(__ATOMIC_ACQUIRE, "agent");
            xb_add(&bar[XB_XGEN(b.x)], 1u);
            asm volatile("s_waitcnt vmcnt(0)" ::: "memory");
        } else {
            XB_SPIN(xb_ld(&bar[XB_XGEN(b.x)]) == gen, bar);
            __builtin_amdgcn_fence(__ATOMIC_ACQUIRE, "agent");
            asm volatile("s_waitcnt vmcnt(0)" ::: "memory");
        }
    }
    __syncthreads();
}

__device__ __forceinline__ void xcc_barrier(const XcdBarrier& b) {
    asm volatile("s_waitcnt vmcnt(0)" ::: "memory");
    __syncthreads();
    if (threadIdx.x == 0) {
        unsigned* bar = b.bar;
        __builtin_amdgcn_s_waitcnt(0);
        const unsigned nloc = b.st[0];
        const unsigned old = xb_add(&bar[XB_XSUB(b.x)], 1u);
        const unsigned gen = old / nloc;
        if (old + 1u == (gen + 1u) * nloc) xb_add(&bar[XB_XGEN(b.x)], 1u);
        else XB_SPIN(xb_ld(&bar[XB_XGEN(b.x)]) == gen, bar);
        __builtin_amdgcn_fence(__ATOMIC_ACQUIRE, "agent");
        asm volatile("s_waitcnt vmcnt(0)" ::: "memory");
    }
    __syncthreads();
}
__device__ __forceinline__ bool xcc_team_setup(const XcdBarrier& b) {
    if (threadIdx.x < 64) { const unsigned G = gridDim.x, j = threadIdx.x & 15u;
        const unsigned c = xb_ld(&b.bar[XB_XCNT(j)]);
        const bool okl = (j < 8u) ? (c == G / 8u) : (c == 0u);
        const bool ok = ((G % 8u) == 0u) && (__all(okl ? 1 : 0) != 0);
        if (threadIdx.x == 0) b.st[3] = ok ? 1u : 0u; }
    __syncthreads();
    return b.st[3] != 0u;
}

constexpr int NWAVES = 8;
constexpr int M_TOK = 32768, D_MODEL = 1024, SEQ_L = 4096, FFN_H = 2816, IN_COLS = 1952;
constexpr size_t MiB = 1u << 20;
constexpr size_t WS_CTL = 0, CTL_ZERO_BYTES = 128 * 1024;
constexpr size_t WS_WIN = 2 * MiB;
constexpr size_t WS_WQKV = 6 * MiB;
constexpr size_t WS_WO = 8 * MiB;
constexpr size_t WS_WGU = 10 * MiB;
constexpr size_t WS_WD = 22 * MiB;
constexpr size_t WS_XCH = 27 * MiB + 512 * 1024;
constexpr size_t WS_ROPE = 28 * MiB;
constexpr size_t WS_RSTDX = 28 * MiB + 512 * 1024;
constexpr size_t WS_SSQQ = 29 * MiB;
constexpr size_t WS_SSQKV = 29 * MiB + 512 * 1024;
constexpr size_t WS_SSQX1 = 30 * MiB;
constexpr size_t WS_XN = 32 * MiB;
constexpr size_t WS_CQKV = 96 * MiB;
constexpr size_t WS_KR = 120 * MiB;
constexpr size_t WS_DQ = 128 * MiB, WS_DK = 160 * MiB, WS_DV = 192 * MiB;
constexpr size_t WS_QA = 224 * MiB;
constexpr size_t WS_KN = 272 * MiB, WS_VA = 304 * MiB;
constexpr size_t WS_MIX = 336 * MiB;
constexpr size_t WS_OB = 400 * MiB;
constexpr size_t WS_H = 96 * MiB;
constexpr size_t WS_END = 464 * MiB;
static_assert(WS_H + (size_t)M_TOK * FFN_H * 2 <= WS_MIX, "h overlay");
constexpr int CW_TMO = 0, CW_CODE = 1, CW_BAR = 4096, CW_SEAM = 16384;
constexpr int RING_OFF = 0, RING_BYTES = 131072;
constexpr int LDS_BYTES = 147456;
constexpr int XL_OFF = RING_BYTES;
constexpr int LDSCTL_OFF = LDS_BYTES - 1024, MISC_OFF = LDSCTL_OFF + 320;
static_assert(att::Lay<64, 128>::LDS_END <= LDSCTL_OFF && att::Lay<96, 64>::LDS_END <= LDSCTL_OFF, "attention scratch stays below the control words");

struct Args { const float* in[19]; float* out; unsigned char* ws; int ph_lo, ph_hi; };
static_assert(sizeof(Args) == 19 * 8 + 8 + 8 + 8, "no padding in Args");

__device__ __forceinline__ float wave_sum(float v) {
#pragma unroll
    for (int o = 1; o < 64; o <<= 1) v += __shfl_xor(v, o);
    return v;
}
__device__ __forceinline__ void transpose_item(const float* W, int ldw, const float* gain, bf16* WT, int ldt, LAS float* scr, int ks0, int kd0, int drow0, int srccol, int lane) {
    float v[32]; const int sc = srccol < 0 ? 0 : srccol;
#pragma unroll
    for (int i = 0; i < 32; ++i) { const int kk = 2 * i + (lane >> 5); v[i] = __builtin_nontemporal_load(&W[(size_t)(ks0 + kk) * ldw + sc]); }
    if (gain) {
        float gg[32];
#pragma unroll
        for (int i = 0; i < 32; ++i) { const int kk = 2 * i + (lane >> 5); gg[i] = gain[ks0 + kk]; }
#pragma unroll
        for (int i = 0; i < 32; ++i) v[i] *= gg[i];
    }
#pragma unroll
    for (int i = 0; i < 32; ++i) { const int kk = 2 * i + (lane >> 5); scr[kk * 33 + (lane & 31)] = srccol < 0 ? 0.f : v[i]; }
    LDS_WAIT(); asm volatile("" ::: "memory");
    const int c = lane & 7;
#pragma unroll
    for (int j = 0; j < 4; ++j) { const int n = (lane >> 3) + 8 * j; const LAS float* s = scr + (8 * c) * 33 + n;
        v4u o; o.x = pk2(s[0 * 33], s[1 * 33]); o.y = pk2(s[2 * 33], s[3 * 33]); o.z = pk2(s[4 * 33], s[5 * 33]); o.w = pk2(s[6 * 33], s[7 * 33]);
        *(GAS v4u*)(WT + (size_t)(drow0 + n) * ldt + kd0 + 8 * c) = o; }
    LDS_WAIT(); asm volatile("" ::: "memory");
}
__device__ __forceinline__ int map_win(int n) {
    if (n < 256) return n;
    if (n < 512) { const int j = n - 256; if (j < 128) return 256 + j; if (j < 160) { const int p = j - 128; return 384 + (p >> 1) + 16 * (p & 1); } return -1; }
    return 416 + (n - 512);
}
__device__ __forceinline__ int map_wq(int n) {
    if (n < 512) return (n >> 6) * 96 + (n & 63);
    const int j = n - 512, h = j >> 5, p = j & 31; return h * 96 + 64 + (p >> 1) + 16 * (p & 1);
}
__device__ __forceinline__ int map_wkv(int n) {
    if (n < 512) return (n >> 6) * 128 + (n & 63);
    const int j = n - 512; return (j >> 6) * 128 + 64 + (j & 63);
}

__constant__ float ROPE_INV_FREQ[16] = {1.0f, 0.5623413324356079f, 0.3162277638912201f, 0.17782793939113617f, 0.10000000149011612f, 0.05623413249850273f, 0.03162277489900589f, 0.017782794311642647f,
    0.009999999776482582f, 0.005623413249850273f, 0.003162277629598975f, 0.0017782794311642647f, 0.0010000000474974513f, 0.000562341301701963f, 0.0003162277571391314f, 0.00017782794020604342f};

struct Frame {
    LAS unsigned char* lds; volatile LAS unsigned* MISC; gu32* ctl;
    int wave, vcu, G;
};

__global__ void __launch_bounds__(NWAVES * 64, 2) hyb_fwd(Args args) {
    extern __shared__ __attribute__((aligned(16))) unsigned char lds[];
    Frame F;
    F.lds = (LAS unsigned char*)lds; F.MISC = (volatile LAS unsigned*)(F.lds + MISC_OFF);
    F.wave = __builtin_amdgcn_readfirstlane((int)threadIdx.x >> 6);
    F.G = gridDim.x; { const int bx = blockIdx.x; F.vcu = (F.G % 8 == 0) ? (bx % 8) * (F.G / 8) + bx / 8 : bx; }
    F.ctl = (gu32*)(args.ws + WS_CTL);
#define CAS __attribute__((address_space(4)))
#define PH_BEGIN() const CAS char* kap_ = (const CAS char*)__builtin_amdgcn_kernarg_segment_ptr(); asm volatile("" : "+s"(kap_)); unsigned char* const ws = *(unsigned char* const CAS*)(kap_ + 160)
#define INP(k) (*(const float* const CAS*)(kap_ + 8 * (k)))
#define OUTP() (*(float* const CAS*)(kap_ + 152))
#define Win_t ((bf16*)(ws + WS_WIN))
#define Wqkv_t ((bf16*)(ws + WS_WQKV))
#define Wo_t ((bf16*)(ws + WS_WO))
#define Wgu_t ((bf16*)(ws + WS_WGU))
#define Wd_t ((bf16*)(ws + WS_WD))
#define ROPE ((float*)(ws + WS_ROPE))
#define RSTDX ((float*)(ws + WS_RSTDX))
#define SSQ_Q ((float*)(ws + WS_SSQQ))
#define SSQ_KV ((float*)(ws + WS_SSQKV))
#define SSQ_X1 ((float*)(ws + WS_SSQX1))
#define XN ((bf16*)(ws + WS_XN))
#define CQKV ((bf16*)(ws + WS_CQKV))
#define KR ((bf16*)(ws + WS_KR))
#define DQ ((bf16*)(ws + WS_DQ))
#define DK ((bf16*)(ws + WS_DK))
#define DVb ((bf16*)(ws + WS_DV))
#define QA ((bf16*)(ws + WS_QA))
#define KN ((bf16*)(ws + WS_KN))
#define VA ((bf16*)(ws + WS_VA))
#define MIX ((bf16*)(ws + WS_MIX))
#define OB ((float*)(ws + WS_OB))
#define X1B ((bf16*)(ws + WS_OB))
#define HB ((bf16*)(ws + WS_H))
    for (int u = threadIdx.x; u < (LDS_BYTES - LDSCTL_OFF) / 4; u += NWAVES * 64) ((LAS unsigned*)(F.lds + LDSCTL_OFF))[u] = 0u;
    __syncthreads();
    XcdBarrier bar = xcd_barrier_post((unsigned*)(F.ctl + CW_BAR), F.MISC + 8);
    const int lo = args.ph_lo, hi = args.ph_hi;
#ifndef PHASES
#define PHASES 0xFF
#endif
#define IN(k) (((PHASES >> (k)) & 1) && lo <= (k) && (k) < hi)
#define BOTH(k) (IN(k) && IN((k) + 1))
#define GRID_BAR() do { if (team) xcc_barrier(bar); else xcd_barrier(bar); } while (0)
    bool team = false; int bxv = (int)blockIdx.x;
#ifndef PROBE_REPEAT
#define PROBE_REPEAT -1
#endif
#define REPS(k) ((PROBE_REPEAT == (k)) ? reps2 : 1)
    int reps2 = 2; asm volatile("" : "+s"(reps2));
    const int gw = F.vcu * NWAVES + F.wave, NGW = F.G * NWAVES;

    if (IN(0)) _Pragma("nounroll") for (int rep_ = 0; rep_ < REPS(0); ++rep_) {
        PH_BEGIN(); const int tid_ = att::otid(), lane_ = tid_ & 63;
        const float* x = INP(0); const float* w_in = INP(1); const float* g_attn = INP(2); const float* g_q_a = INP(3); const float* w_q_b = INP(4); const float* g_kv_a = INP(5); const float* w_kv_b = INP(6);
        const float* w_o = INP(13); const float* g_ffn = INP(14); const float* w_gate = INP(15); const float* w_up = INP(16); const float* w_down = INP(17);
        LAS float* scr = (LAS float*)(F.lds + RING_OFF + F.wave * 16384);
        constexpr int I_IN = 16 * 64, I_Q = 4 * 24, I_KV = 2 * 32, I_O = 16 * 32, I_GU = 16 * 176, I_D = 44 * 32;
        constexpr int NITEMS = I_IN + I_Q + I_KV + I_O + I_GU + I_D;
        for (int it = gw; it < NITEMS; it += NGW) {
            int r = it; const int l31 = lane_ & 31;
            if (r < I_IN) { const int kb = r / 64, nb = r % 64; transpose_item(w_in, IN_COLS, g_attn, Win_t, 1024, scr, 64 * kb, 64 * kb, 32 * nb, map_win(32 * nb + l31), lane_); continue; } r -= I_IN;
            if (r < I_Q) { const int kb = r / 24, nb = r % 24; transpose_item(w_q_b, 768, g_q_a, Wqkv_t, 384, scr, 64 * kb, 64 * kb, 32 * nb, map_wq(32 * nb + l31), lane_); continue; } r -= I_Q;
            if (r < I_KV) { const int kb = r / 32, nb = r % 32; transpose_item(w_kv_b, 1024, g_kv_a, Wqkv_t, 384, scr, 64 * kb, 256 + 64 * kb, 768 + 32 * nb, map_wkv(32 * nb + l31), lane_); continue; } r -= I_KV;
            if (r < I_O) { const int kb = r / 32, nb = r % 32; transpose_item(w_o, 1024, nullptr, Wo_t, 1024, scr, 64 * kb, 64 * kb, 32 * nb, 32 * nb + l31, lane_); continue; } r -= I_O;
            if (r < I_GU) { const int kb = r / 176, nb = r % 176; const int n = 32 * nb + l31, pn = n >> 8, j = n & 255; const bool up = j >= 128;
                transpose_item(up ? w_up : w_gate, FFN_H, g_ffn, Wgu_t, 1024, scr, 64 * kb, 64 * kb, 32 * nb, 128 * pn + (j & 127), lane_); continue; } r -= I_GU;
            { const int kb = r / 32, nb = r % 32; transpose_item(w_down, 1024, nullptr, Wd_t, FFN_H, scr, 64 * kb, 64 * kb, 32 * nb, 32 * nb + l31, lane_); }
        }
        { const int gt = F.vcu * (NWAVES * 64) + tid_, NGT = F.G * NWAVES * 64; const v4u z = (v4u){0u, 0u, 0u, 0u};
          for (int i = gt; i < 768 * 16; i += NGT) *(GAS v4u*)(Wqkv_t + (size_t)(i >> 4) * 384 + 256 + (i & 15) * 8) = z;
          for (int i = gt; i < 1024 * 32; i += NGT) *(GAS v4u*)(Wqkv_t + (size_t)(768 + (i >> 5)) * 384 + (i & 31) * 8) = z;
          for (int i = gt; i < SEQ_L * 16; i += NGT) { const int pos = i >> 4, k = i & 15; const float ang = (float)pos * ROPE_INV_FREQ[k];
              const double t = (double)ang * 0.15915494309189535; const float fr = (float)(t - __builtin_rint(t));
              ROPE[2 * i] = __builtin_amdgcn_cosf(fr); ROPE[2 * i + 1] = __builtin_amdgcn_sinf(fr); } }
        { for (int m = gw; m < M_TOK; m += 4 * NGW) { f32x4 v[4][4]; float s[4];
#pragma unroll
              for (int q = 0; q < 4; ++q) { const GAS f32x4* xr = (const GAS f32x4*)(x + (size_t)(m + q * NGW) * D_MODEL) + lane_;
#pragma unroll
                  for (int j = 0; j < 4; ++j) v[q][j] = __builtin_nontemporal_load(&xr[64 * j]); }
#pragma unroll
              for (int q = 0; q < 4; ++q) { float t = 0.f;
#pragma unroll
                  for (int j = 0; j < 4; ++j) t += (v[q][j].x * v[q][j].x + v[q][j].y * v[q][j].y) + (v[q][j].z * v[q][j].z + v[q][j].w * v[q][j].w);
                  s[q] = t; }
#pragma unroll
              for (int o = 1; o < 64; o <<= 1)
#pragma unroll
                  for (int q = 0; q < 4; ++q) s[q] += __shfl_xor(s[q], o);
#pragma unroll
              for (int q = 0; q < 4; ++q) { const float rstd = __builtin_amdgcn_rsqf(s[q] * (1.f / D_MODEL) + 1e-6f);
                  GAS unsigned long long* o8 = (GAS unsigned long long*)(XN + (size_t)(m + q * NGW) * D_MODEL) + lane_;
#pragma unroll
                  for (int j = 0; j < 4; ++j) { const f32x4 y = v[q][j]; o8[64 * j] = (unsigned long long)pk2(y.x, y.y) | ((unsigned long long)pk2(y.z, y.w) << 32); }
                  if (lane_ == 0) RSTDX[m + q * NGW] = rstd; } } }
        if (BOTH(0) && rep_ == REPS(0) - 1) { xcd_barrier(bar);
#ifndef NO_TEAM
            team = xcc_team_setup(bar);
            if (team) { const int rank = (int)bar.st[2]; bxv = rank * 8 + (int)bar.x; F.vcu = (int)bar.x * (F.G / 8) + rank;
#if defined(STAGGER_TICKS) && STAGGER_TICKS > 0
                { const unsigned long long t0 = __builtin_amdgcn_s_memrealtime(), dt = (unsigned long long)bar.x * STAGGER_TICKS; while (__builtin_amdgcn_s_memrealtime() - t0 < dt) __builtin_amdgcn_s_sleep(8); }
#endif
            }
#endif
        }
        if (PROBE_REPEAT == 9 && rep_ == 0) { _Pragma("nounroll") for (int q_ = 0; q_ < 4 * reps2; ++q_) GRID_BAR(); }
    }
    if (IN(1)) _Pragma("nounroll") for (int rep_ = 0; rep_ < REPS(1); ++rep_) {
        PH_BEGIN();
        pg8::Gemm g{XN, Win_t, M_TOK, 2048, D_MODEL}; pg8::StaticOrder S; S.init(M_TOK, 2048, F.G, bxv);
        pg8::EpiInProj E{CQKV, KR, DQ, DK, DVb, SSQ_Q, SSQ_KV, ROPE, RSTDX, 0.125f * 1.4426950408889634f};
        pg8::gemm_phase<pg8::EpiInProj, pg8::StaticOrder, true, true>(F.lds + RING_OFF, g, S, E);
        if (BOTH(1) && rep_ == REPS(1) - 1) GRID_BAR();
    }
    if (IN(2)) _Pragma("nounroll") for (int rep_ = 0; rep_ < REPS(2); ++rep_) {
        PH_BEGIN();
        int kq_ = 384; asm volatile("" : "+s"(kq_));
        pg8::Gemm g{CQKV, Wqkv_t, M_TOK, 1792, kq_}; pg8::SplitOrder S; S.init(M_TOK, 1792, F.G, bxv);
        pg8::EpiQKV E{QA, KN, VA, SSQ_Q, SSQ_KV, ROPE, 0.10206207261596575f * 1.4426950408889634f};
        pg8::gemm_phase<pg8::EpiQKV, pg8::SplitOrder, true, true>(F.lds + RING_OFF, g, S, E);
        if (BOTH(2) && rep_ == REPS(2) - 1) GRID_BAR();
    }
    if (IN(3)) _Pragma("nounroll") for (int rep_ = 0; rep_ < REPS(3); ++rep_) {
        PH_BEGIN();
        const float* lam_q1 = INP(7); const float* lam_k1 = INP(8); const float* lam_q2 = INP(9); const float* lam_k2 = INP(10); const float* g_subln = INP(11); const float* rel_bias = INP(12);
        char* shm = (char*)lds + RING_OFF;
#ifndef ATT_ONLY
#define ATT_ONLY 3
#endif
        if (ATT_ONLY & 1) { const att::MlaT T{QA, KN, KR, VA, MIX}; const int bb = F.vcu >> 5, v = F.vcu & 31;
          att::u32x4 qr[6];
#pragma unroll
          for (int d0 = 0; d0 < 6; ++d0) qr[d0] = att::u32x4{0u, 0u, 0u, 0u};
          _Pragma("nounroll") for (int i = 0; i < 4; ++i) { const int qb = (i & 1) ? 15 - (v & 15) : (v & 15), nqb = (i & 1) ? (v & 15) : 15 - (v & 15);
            att::mla_unit(bb, 2 * i + (v >> 4), qb, T, shm, i > 0, (i < 3) ? 2 * (i + 1) + (v >> 4) : -1, nqb, qr); } }
        if (ATT_ONLY & 2) { float lam;
          { const float a = wave_sum(lam_q1[att::otid() & 63] * lam_k1[att::otid() & 63]), b2 = wave_sum(lam_q2[att::otid() & 63] * lam_k2[att::otid() & 63]); lam = __expf(a) - __expf(b2) + 0.2f; }
          const att::DiffT T{DQ, DK, DVb, MIX, OB, rel_bias, g_subln, lam}; const int bb = F.vcu >> 5, v = F.vcu & 31;
          for (int i = 0; i < 2; ++i) { const int qb = (i & 1) ? 15 - (v & 15) : (v & 15); att::diff_unit(bb, 2 * i + (v >> 4), qb, T, shm); } }
        if (BOTH(3) && rep_ == REPS(3) - 1) GRID_BAR();
    }
    if (IN(4)) _Pragma("nounroll") for (int rep_ = 0; rep_ < REPS(4); ++rep_) {
        PH_BEGIN();
        pg8::Gemm g{MIX, Wo_t, M_TOK, D_MODEL, D_MODEL}; pg8::StaticOrder S; S.init(M_TOK, D_MODEL, F.G, bxv);
        pg8::EpiOutProj E{XN, X1B, SSQ_X1};
        pg8::gemm_phase<pg8::EpiOutProj, pg8::StaticOrder, true, true>(F.lds + RING_OFF, g, S, E);
        if (BOTH(4) && rep_ == REPS(4) - 1) GRID_BAR();
    }
    if (IN(5)) _Pragma("nounroll") for (int rep_ = 0; rep_ < REPS(5); ++rep_) {
        PH_BEGIN();
        pg8::Gemm g{X1B, Wgu_t, M_TOK, 2 * FFN_H, D_MODEL}; pg8::StaticOrder S; S.init(M_TOK, 2 * FFN_H, F.G, bxv);
        const pg8::HMap hm{ws, WS_XN, WS_MIX, WS_DQ, WS_DK, WS_DV}; pg8::EpiGateUp E{hm, SSQ_X1};
        pg8::gemm_phase<pg8::EpiGateUp, pg8::StaticOrder, true, true>(F.lds + RING_OFF, g, S, E);
        if (BOTH(5) && rep_ == REPS(5) - 1) GRID_BAR();
    }
    if (IN(6)) _Pragma("nounroll") for (int rep_ = 0; rep_ < REPS(6); ++rep_) {
        PH_BEGIN(); float* out = OUTP(); const float* g_final = INP(18);
        pg8::Gemm g{HB, Wd_t, M_TOK, D_MODEL, FFN_H}; pg8::PanelOrder S; S.init(M_TOK, D_MODEL, F.G, bxv); S.hm = pg8::HMap{ws, WS_XN, WS_MIX, WS_DQ, WS_DK, WS_DV};
        pg8::EpiDownNorm E{X1B, out, g_final, (unsigned*)(ws + WS_XCH), (unsigned*)(F.ctl + CW_SEAM), F.lds + XL_OFF};
        pg8::gemm_phase<pg8::EpiDownNorm, pg8::PanelOrder, true, true>(F.lds + RING_OFF, g, S, E);
    }
#undef IN
#undef BOTH
#undef GRID_BAR
}

#ifndef MK_N_LAUNCHES
#define MK_N_LAUNCHES 1
#endif
extern "C" void kernel_launch(void* const* d_in, const int* in_sizes, int n_in, void* d_out, int out_size, void* d_ws, size_t ws_size, hipStream_t stream) {
    static int grid = 0;
    if (grid == 0) {
        if (n_in != 19 || in_sizes[0] != M_TOK * D_MODEL || out_size != M_TOK * D_MODEL || ws_size < WS_END) { fprintf(stderr, "kernel_launch: unexpected shapes (n_in %d, in0 %d, out %d, ws %zu)\n", n_in, n_in > 0 ? in_sizes[0] : -1, out_size, ws_size); grid = -1; return; }
        int dev = 0, cus = 0, per_cu = 0;
        if (hipGetDevice(&dev) != hipSuccess || hipDeviceGetAttribute(&cus, hipDeviceAttributeMultiprocessorCount, dev) != hipSuccess) { grid = -1; return; }
        if (hipFuncSetAttribute((const void*)hyb_fwd, hipFuncAttributeMaxDynamicSharedMemorySize, LDS_BYTES) != hipSuccess) { fprintf(stderr, "kernel_launch: hipFuncSetAttribute failed\n"); grid = -1; return; }
        if (hipOccupancyMaxActiveBlocksPerMultiprocessor(&per_cu, (const void*)hyb_fwd, NWAVES * 64, LDS_BYTES) != hipSuccess || per_cu < 1) fprintf(stderr, "kernel_launch: occupancy query reports %d\n", per_cu);
        (void)hipGetLastError();
        grid = cus;
        if (grid != 256) fprintf(stderr, "kernel_launch: %d CUs (built for 256)\n", grid);
    }
    if (grid < 0) return;
    if (hipMemsetAsync((char*)d_ws + WS_CTL, 0, CTL_ZERO_BYTES, stream) != hipSuccess) return;
    Args a{};
    for (int i = 0; i < 19; ++i) a.in[i] = (const float*)d_in[i];
    a.out = (float*)d_out; a.ws = (unsigned char*)d_ws;
    if (MK_N_LAUNCHES == 1) { a.ph_lo = 0; a.ph_hi = 7; hipLaunchKernelGGL(hyb_fwd, dim3(grid), dim3(NWAVES * 64), LDS_BYTES, stream, a); }
    else { for (int p = 0; p < 7; ++p) { a.ph_lo = p; a.ph_hi = p + 1; hipLaunchKernelGGL(hyb_fwd, dim3(grid), dim3(NWAVES * 64), LDS_BYTES, stream, a); } }
}
```
